# Optimizing an MI355X kernel written in HIP

```python
import math
import jax, jax.numpy as jnp
from jax import lax
import numpy as np

D_MODEL = 2048
BATCH = 4
SEQ = 8192
DEPTH = 1

MEM_LEN = 256
D_MIX = D_MODEL
HEAD_DIM = 64
NSA_WIDTH = D_MIX // 2
CONV_WIDTH = D_MIX - NSA_WIDTH
NSA_HEADS = NSA_WIDTH // HEAD_DIM
NSA_KV_HEADS = 4
NSA_GROUP = NSA_HEADS // NSA_KV_HEADS
CMP_BLOCK = 32
CMP_STRIDE = 16
CMP_HIDDEN = 256
SEL_BLOCK = 64
SEL_TOPK = 16
WIN = 512
Q_BLOCK = 128
CONV_K = 31
REL_BUCKETS = 32
REL_MAX_DIST = 128
X_HEADS = 4
X_HEAD_DIM = D_MODEL // X_HEADS
MOE_GROUPS = 4
MOE_EXPERTS_PER_GROUP = 8
MOE_EXPERTS = MOE_GROUPS * MOE_EXPERTS_PER_GROUP
MOE_TOPK = 2
MOE_HIDDEN = 512
MOE_BLOCK = 128
LN_EPS = 1e-5
DEEPNORM_ALPHA = (2 * DEPTH) ** 0.25
DEEPNORM_BETA = (8 * DEPTH) ** -0.25
IN_SIZES = (NSA_HEADS * HEAD_DIM,) + (NSA_KV_HEADS * HEAD_DIM,) * 6 + (NSA_HEADS * 3, 2 * CONV_WIDTH)
IN_COLS = sum(IN_SIZES)

kernel_name = "hybrid_nsa_conformer_hmoe_deepnorm"


def layer_norm(x, g, b):
    xf = x.astype(jnp.float32)
    mu = jnp.mean(xf, axis=-1, keepdims=True)
    var = jnp.mean(jnp.square(xf - mu), axis=-1, keepdims=True)
    return ((xf - mu) * lax.rsqrt(var + LN_EPS) * g + b).astype(x.dtype)


def masked_softmax(s, mask):
    s = jnp.where(mask, s, -jnp.inf)
    m = jnp.max(s, axis=-1, keepdims=True)
    m = jnp.where(jnp.isfinite(m), m, 0.0)
    p = jnp.exp(s - m)
    return p / jnp.maximum(jnp.sum(p, axis=-1, keepdims=True), 1e-30)


def t5_bucket(dist):
    n = jnp.maximum(dist, 0)
    max_exact = REL_BUCKETS // 2
    nf = jnp.maximum(n, 1).astype(jnp.float32)
    large = max_exact + (jnp.log(nf / max_exact) / math.log(REL_MAX_DIST / max_exact)
                         * (REL_BUCKETS - max_exact)).astype(jnp.int32)
    large = jnp.minimum(large, REL_BUCKETS - 1)
    return jnp.where(n < max_exact, n, large)


def compress(k, pe, w1, w2):
    B, Hk, S, dh = k.shape
    ch = k.reshape(B, Hk, S // CMP_STRIDE, CMP_STRIDE, dh)
    blk = jnp.concatenate([ch[:, :, :-1], ch[:, :, 1:]], axis=3) + pe
    n_cmp = blk.shape[2]
    h = jax.nn.gelu(blk.reshape(B, Hk, n_cmp, CMP_BLOCK * dh) @ w1)
    return h @ w2


def cmp_to_sel_overlap(n_cmp, n_sel):
    cs = np.arange(n_cmp) * CMP_STRIDE
    ce = cs + CMP_BLOCK
    ss = np.arange(n_sel) * SEL_BLOCK
    se = ss + SEL_BLOCK
    ov = np.clip(np.minimum(ce[:, None], se[None, :]) - np.maximum(cs[:, None], ss[None, :]), 0, None)
    return jnp.asarray(ov / CMP_BLOCK, dtype=jnp.float32)


def nsa_attention(q, kc, vc, ks, vs, kw, vw, gates, rel_table):
    B, Hk, G, S, dh = q.shape
    n_q = S // Q_BLOCK
    n_sel = S // SEL_BLOCK
    n_top = min(SEL_TOPK, n_sel)
    n_cmp = kc.shape[2]
    cmp_end = jnp.arange(n_cmp, dtype=jnp.int32) * CMP_STRIDE + CMP_BLOCK - 1
    overlap = cmp_to_sel_overlap(n_cmp, n_sel)
    ks_blocks = ks.reshape(B, Hk, n_sel, SEL_BLOCK, dh)
    vs_blocks = vs.reshape(B, Hk, n_sel, SEL_BLOCK, dh)
    kw_pad = jnp.pad(kw, ((0, 0), (0, 0), (WIN, 0), (0, 0)))
    vw_pad = jnp.pad(vw, ((0, 0), (0, 0), (WIN, 0), (0, 0)))
    tab = rel_table.reshape(REL_BUCKETS, Hk, G).transpose(1, 2, 0)
    h_ix = jnp.arange(Hk)[None, :, None, None, None]
    g_ix = jnp.arange(G)[None, None, :, None, None]
    b_ix = jnp.arange(B)[:, None, None, None]
    hk_ix = jnp.arange(Hk)[None, :, None, None]
    sel_j = jnp.arange(n_sel, dtype=jnp.int32)
    scale = HEAD_DIM ** -0.5

    def block_fn(qi):
        q0 = qi * Q_BLOCK
        qb = lax.dynamic_slice_in_dim(q, q0, Q_BLOCK, axis=3) * scale
        gb = lax.dynamic_slice_in_dim(gates, q0, Q_BLOCK, axis=3)
        t = q0 + jnp.arange(Q_BLOCK, dtype=jnp.int32)

        dist_c = t[:, None] - cmp_end[None, :]
        s_c = jnp.einsum('bhgqd,bhnd->bhgqn', qb, kc, preferred_element_type=jnp.float32)
        s_c = s_c + tab[:, :, t5_bucket(dist_c)]
        p_c = masked_softmax(s_c, dist_c >= 0)
        o_c = jnp.einsum('bhgqn,bhnd->bhgqd', p_c.astype(vc.dtype), vc)

        imp = jnp.einsum('bhgqn,nj->bhqj', p_c, overlap)
        cur = t // SEL_BLOCK
        forced = (sel_j[None, :] == 0) | (sel_j[None, :] == cur[:, None]) | (sel_j[None, :] == cur[:, None] - 1)
        valid = sel_j[None, :] * SEL_BLOCK <= t[:, None]
        score = jnp.where(forced, jnp.inf, jnp.where(valid, imp, -jnp.inf))
        _, idx = lax.top_k(score, n_top)

        k_sel = ks_blocks[b_ix, hk_ix, idx].reshape(B, Hk, Q_BLOCK, n_top * SEL_BLOCK, dh)
        v_sel = vs_blocks[b_ix, hk_ix, idx].reshape(B, Hk, Q_BLOCK, n_top * SEL_BLOCK, dh)
        pos_s = (idx[..., None] * SEL_BLOCK + jnp.arange(SEL_BLOCK, dtype=jnp.int32)).reshape(
            B, Hk, Q_BLOCK, n_top * SEL_BLOCK)
        dist_s = t[:, None] - pos_s
        s_s = jnp.einsum('bhgqd,bhqkd->bhgqk', qb, k_sel, preferred_element_type=jnp.float32)
        s_s = s_s + tab[h_ix, g_ix, t5_bucket(dist_s)[:, :, None]]
        p_s = masked_softmax(s_s, (dist_s >= 0)[:, :, None])
        o_s = jnp.einsum('bhgqk,bhqkd->bhgqd', p_s.astype(v_sel.dtype), v_sel)

        kwb = lax.dynamic_slice_in_dim(kw_pad, q0, Q_BLOCK + WIN, axis=2)
        vwb = lax.dynamic_slice_in_dim(vw_pad, q0, Q_BLOCK + WIN, axis=2)
        pos_w = q0 - WIN + jnp.arange(Q_BLOCK + WIN, dtype=jnp.int32)
        dist_w = t[:, None] - pos_w[None, :]
        mask_w = (dist_w >= 0) & (dist_w < WIN) & (pos_w[None, :] >= 0)
        s_w = jnp.einsum('bhgqd,bhkd->bhgqk', qb, kwb, preferred_element_type=jnp.float32)
        s_w = s_w + tab[:, :, t5_bucket(dist_w)]
        p_w = masked_softmax(s_w, mask_w)
        o_w = jnp.einsum('bhgqk,bhkd->bhgqd', p_w.astype(vwb.dtype), vwb)

        return gb[..., 0:1] * o_c + gb[..., 1:2] * o_s + gb[..., 2:3] * o_w

    out = lax.map(block_fn, jnp.arange(n_q, dtype=jnp.int32))
    return out.transpose(1, 0, 4, 2, 3, 5).reshape(B, S, Hk * G * dh)


def conformer_conv(u, dw_w, dw_b, ln_g, ln_b):
    a, gate = jnp.split(u, 2, axis=-1)
    h = a * jax.nn.sigmoid(gate)
    h = lax.conv_general_dilated(h, dw_w, window_strides=(1,), padding=[(CONV_K - 1, 0)],
                                 dimension_numbers=('NWC', 'WIO', 'NWC'),
                                 feature_group_count=CONV_WIDTH) + dw_b
    return jax.nn.silu(layer_norm(h, ln_g, ln_b))


def memory_cross_attn(x, mem, mem_g, mem_b, wq, wkv, wo):
    B, S, D = x.shape
    m = layer_norm(mem, mem_g, mem_b)
    q = (x @ wq).reshape(B, S, X_HEADS, X_HEAD_DIM)
    k, v = jnp.split(m @ wkv, 2, axis=-1)
    k = k.reshape(B, -1, X_HEADS, X_HEAD_DIM)
    v = v.reshape(B, -1, X_HEADS, X_HEAD_DIM)
    s = jnp.einsum('bshd,bmhd->bhsm', q, k, preferred_element_type=jnp.float32) * (X_HEAD_DIM ** -0.5)
    p = jax.nn.softmax(s, axis=-1)
    o = jnp.einsum('bhsm,bmhd->bshd', p.astype(v.dtype), v).reshape(B, S, X_HEADS * X_HEAD_DIM)
    return o @ wo


def hier_moe(x2d, rg_w, rg_b, re_w, re_b, w_gate, w_up, w_down):
    T, D = x2d.shape
    xf = x2d.astype(jnp.float32)
    lg = xf @ rg_w.astype(jnp.float32) + rg_b.astype(jnp.float32)
    grp = jnp.argmax(lg, axis=-1).astype(jnp.int32)
    w_grp = jnp.take_along_axis(jax.nn.softmax(lg, axis=-1), grp[:, None], axis=-1)[:, 0]
    le = (xf @ re_w.astype(jnp.float32) + re_b.astype(jnp.float32)).reshape(T, MOE_GROUPS, MOE_EXPERTS_PER_GROUP)
    le_g = jnp.take_along_axis(le, grp[:, None, None], axis=1)[:, 0]
    top_v, top_i = lax.top_k(le_g, MOE_TOPK)
    w_tok = w_grp[:, None] * jax.nn.softmax(top_v, axis=-1)
    expert = grp[:, None] * MOE_EXPERTS_PER_GROUP + top_i

    A = T * MOE_TOPK
    e_flat = expert.reshape(A)
    tok_flat = jnp.repeat(jnp.arange(T, dtype=jnp.int32), MOE_TOPK)
    w_flat = w_tok.reshape(A)
    order = jnp.argsort(e_flat)
    e_s, tok_s, w_s = e_flat[order], tok_flat[order], w_flat[order]
    counts = jnp.zeros((MOE_EXPERTS,), jnp.int32).at[e_flat].add(1)
    starts = jnp.cumsum(counts) - counts
    padded = (counts + MOE_BLOCK - 1) // MOE_BLOCK * MOE_BLOCK
    pends = jnp.cumsum(padded)
    pstarts = pends - padded
    dest = pstarts[e_s] + (jnp.arange(A, dtype=jnp.int32) - starts[e_s])
    P = A + MOE_EXPERTS * MOE_BLOCK
    n_blk = P // MOE_BLOCK
    tok_buf = jnp.full((P,), T, jnp.int32).at[dest].set(tok_s)
    w_buf = jnp.zeros((P,), x2d.dtype).at[dest].set(w_s.astype(x2d.dtype))
    blk_e = jnp.minimum(jnp.searchsorted(pends, jnp.arange(n_blk, dtype=jnp.int32) * MOE_BLOCK, side='right'),
                        MOE_EXPERTS - 1).astype(jnp.int32)
    x_pad = jnp.concatenate([x2d, jnp.zeros((1, D), x2d.dtype)], axis=0)

    def run_block(args):
        tok, wb, e = args
        xb = x_pad[tok]
        h = jax.nn.silu(xb @ w_gate[e]) * (xb @ w_up[e])
        return (h @ w_down[e]) * wb[:, None]

    y = lax.map(run_block, (tok_buf.reshape(n_blk, MOE_BLOCK), w_buf.reshape(n_blk, MOE_BLOCK), blk_e))
    out = jnp.zeros((T + 1, D), x2d.dtype).at[tok_buf].add(y.reshape(P, D))
    return out[:T]


def hybrid_layer(x, mem, w_in, cmp_pe_k, cmp_w1_k, cmp_w2_k, cmp_pe_v, cmp_w1_v, cmp_w2_v, rel_table,
                 conv_dw_w, conv_dw_b, conv_ln_g, conv_ln_b, w_out, ln1_g, ln1_b,
                 mem_ln_g, mem_ln_b, xa_wq, xa_wkv, xa_wo, ln2_g, ln2_b,
                 rg_w, rg_b, re_w, re_b, w_gate, w_up, w_down, ln3_g, ln3_b):
    B, S, D = x.shape
    proj = x @ w_in
    cuts = [int(c) for c in np.cumsum(IN_SIZES)[:-1]]
    q, k_c, v_c, k_s, v_s, k_w, v_w, g, u = jnp.split(proj, cuts, axis=-1)

    def kv_heads(t):
        return t.reshape(B, S, NSA_KV_HEADS, HEAD_DIM).transpose(0, 2, 1, 3)

    q = q.reshape(B, S, NSA_KV_HEADS, NSA_GROUP, HEAD_DIM).transpose(0, 2, 3, 1, 4)
    gates = jax.nn.sigmoid(g).reshape(B, S, NSA_KV_HEADS, NSA_GROUP, 3).transpose(0, 2, 3, 1, 4)
    kc = compress(kv_heads(k_c), cmp_pe_k, cmp_w1_k, cmp_w2_k)
    vc = compress(kv_heads(v_c), cmp_pe_v, cmp_w1_v, cmp_w2_v)
    o_nsa = nsa_attention(q, kc, vc, kv_heads(k_s), kv_heads(v_s), kv_heads(k_w), kv_heads(v_w), gates, rel_table)
    o_conv = conformer_conv(u, conv_dw_w, conv_dw_b, conv_ln_g, conv_ln_b)
    mix = jnp.concatenate([o_nsa, o_conv], axis=-1) @ w_out
    x = layer_norm(DEEPNORM_ALPHA * x + mix, ln1_g, ln1_b)

    xa = memory_cross_attn(x, mem, mem_ln_g, mem_ln_b, xa_wq, xa_wkv, xa_wo)
    x = layer_norm(DEEPNORM_ALPHA * x + xa, ln2_g, ln2_b)

    moe = hier_moe(x.reshape(B * S, D), rg_w, rg_b, re_w, re_b, w_gate, w_up, w_down).reshape(B, S, D)
    return layer_norm(DEEPNORM_ALPHA * x + moe, ln3_g, ln3_b)


def setup_inputs(seed: int = 0) -> dict:
    key = jax.random.key(seed)
    keys = iter(jax.random.split(key, 48))

    def nrm(shape, scale):
        return jax.random.normal(next(keys), shape, jnp.float32) * scale

    def gain(shape):
        return 1.0 + nrm(shape, 0.02)

    L = DEPTH
    D = D_MODEL
    return {
        "x": nrm((BATCH, SEQ, D), 1.0),
        "mem": nrm((BATCH, MEM_LEN, D), 1.0),
        "ln_in_g": gain((D,)),
        "ln_in_b": nrm((D,), 0.02),
        "w_in": nrm((L, D, IN_COLS), D ** -0.5),
        "cmp_pe_k": nrm((L, CMP_BLOCK, HEAD_DIM), 0.1),
        "cmp_w1_k": nrm((L, CMP_BLOCK * HEAD_DIM, CMP_HIDDEN), (CMP_BLOCK * HEAD_DIM) ** -0.5),
        "cmp_w2_k": nrm((L, CMP_HIDDEN, HEAD_DIM), CMP_HIDDEN ** -0.5),
        "cmp_pe_v": nrm((L, CMP_BLOCK, HEAD_DIM), 0.1),
        "cmp_w1_v": nrm((L, CMP_BLOCK * HEAD_DIM, CMP_HIDDEN), (CMP_BLOCK * HEAD_DIM) ** -0.5),
        "cmp_w2_v": nrm((L, CMP_HIDDEN, HEAD_DIM), CMP_HIDDEN ** -0.5),
        "rel_table": nrm((REL_BUCKETS, NSA_HEADS), 0.2),
        "conv_dw_w": nrm((L, CONV_K, 1, CONV_WIDTH), CONV_K ** -0.5),
        "conv_dw_b": nrm((L, CONV_WIDTH), 0.02),
        "conv_ln_g": gain((L, CONV_WIDTH)),
        "conv_ln_b": nrm((L, CONV_WIDTH), 0.02),
        "w_out": nrm((L, D_MIX, D), D_MIX ** -0.5 * DEEPNORM_BETA),
        "ln1_g": gain((L, D)),
        "ln1_b": nrm((L, D), 0.02),
        "mem_ln_g": gain((L, D)),
        "mem_ln_b": nrm((L, D), 0.02),
        "xa_wq": nrm((L, D, X_HEADS * X_HEAD_DIM), D ** -0.5),
        "xa_wkv": nrm((L, D, 2 * X_HEADS * X_HEAD_DIM), D ** -0.5),
        "xa_wo": nrm((L, X_HEADS * X_HEAD_DIM, D), (X_HEADS * X_HEAD_DIM) ** -0.5 * DEEPNORM_BETA),
        "ln2_g": gain((L, D)),
        "ln2_b": nrm((L, D), 0.02),
        "router_group_w": nrm((L, D, MOE_GROUPS), D ** -0.5),
        "router_group_b": nrm((L, MOE_GROUPS), 0.01),
        "router_expert_w": nrm((L, D, MOE_EXPERTS), D ** -0.5),
        "router_expert_b": nrm((L, MOE_EXPERTS), 0.01),
        "moe_w_gate": nrm((L, MOE_EXPERTS, D, MOE_HIDDEN), D ** -0.5),
        "moe_w_up": nrm((L, MOE_EXPERTS, D, MOE_HIDDEN), D ** -0.5),
        "moe_w_down": nrm((L, MOE_EXPERTS, MOE_HIDDEN, D), MOE_HIDDEN ** -0.5 * DEEPNORM_BETA),
        "ln3_g": gain((L, D)),
        "ln3_b": nrm((L, D), 0.02),
    }


def reference(x, mem, ln_in_g, ln_in_b, w_in, cmp_pe_k, cmp_w1_k, cmp_w2_k, cmp_pe_v, cmp_w1_v, cmp_w2_v,
              rel_table, conv_dw_w, conv_dw_b, conv_ln_g, conv_ln_b, w_out, ln1_g, ln1_b,
              mem_ln_g, mem_ln_b, xa_wq, xa_wkv, xa_wo, ln2_g, ln2_b,
              router_group_w, router_group_b, router_expert_w, router_expert_b,
              moe_w_gate, moe_w_up, moe_w_down, ln3_g, ln3_b):
    h = layer_norm(x, ln_in_g, ln_in_b)
    for l in range(DEPTH):
        h = hybrid_layer(h, mem, w_in[l], cmp_pe_k[l], cmp_w1_k[l], cmp_w2_k[l], cmp_pe_v[l], cmp_w1_v[l],
                         cmp_w2_v[l], rel_table, conv_dw_w[l], conv_dw_b[l], conv_ln_g[l], conv_ln_b[l],
                         w_out[l], ln1_g[l], ln1_b[l], mem_ln_g[l], mem_ln_b[l], xa_wq[l], xa_wkv[l], xa_wo[l],
                         ln2_g[l], ln2_b[l], router_group_w[l], router_group_b[l], router_expert_w[l],
                         router_expert_b[l], moe_w_gate[l], moe_w_up[l], moe_w_down[l], ln3_g[l], ln3_b[l])
    return h
```

```cpp
#include <hip/hip_runtime.h>
#include <hip/hip_cooperative_groups.h>
#include <cstdio>
#include <cstdint>
namespace cg = cooperative_groups;

#define DEVI __device__ __forceinline__
#ifndef REP_PREP
#define REP_PREP 1
#define REP_PROJ 1
#define REP_NSA 1
#define REP_WQ 1
#define WQ_VAR 3
#define REP_XATTN 1
#define REP_MOE 1
#define REP_LN3 1
#define REP_CONV 1
#define REP_OUT 1
#define REP_SMALL 1
#endif
#ifndef NSA_REP_MODE
#define NSA_REP_MODE 0
#endif
#ifndef PROBE
#define PROBE 0
#endif
typedef unsigned short bf16_t;
typedef __attribute__((ext_vector_type(8))) short bf16x8;
typedef __attribute__((ext_vector_type(4))) float f32x4;
typedef __attribute__((ext_vector_type(16))) float f32x16;
typedef __attribute__((ext_vector_type(4))) unsigned u32x4;
typedef __attribute__((ext_vector_type(2))) unsigned u32x2;

constexpr int T_ = 32768, D_ = 2048, S_ = 8192, NB_ = 4;
constexpr int NPROJ = 4736;
constexpr int IN_COLS = 4656;
constexpr float ALPHA = 1.189207115002721f;
constexpr float LOG2E = 1.4426950408889634f;
constexpr float LN_EPS = 1e-5f;
constexpr int NTHREADS = 512;
constexpr int LDS_BYTES = 147968;

constexpr size_t MiB = 1ull << 20;
constexpr size_t WS_CTL = 0;
constexpr size_t WS_STATS = 1 * MiB;
constexpr size_t WS_C1BIAS = WS_STATS + 256 * 1024;
constexpr size_t WS_WTOK = WS_STATS + 512 * 1024;
constexpr size_t WS_LOGITS = 2 * MiB;
constexpr size_t WS_LIST = 7 * MiB;
constexpr size_t WS_WC1 = 11 * MiB;
constexpr size_t WS_WC2 = 13 * MiB;
constexpr size_t WS_WR = 14 * MiB;
constexpr size_t WS_WIN = 15 * MiB;
constexpr size_t WS_WOUT = 34 * MiB;
constexpr size_t WS_WQ = 42 * MiB;
constexpr size_t WS_WKV = 50 * MiB;
constexpr size_t WS_WO = 66 * MiB;
constexpr size_t WS_WGU = 74 * MiB;
constexpr size_t WS_WD = 202 * MiB;
constexpr size_t WS_BUFA = 266 * MiB;
constexpr size_t WS_BUFB = 394 * MiB;
constexpr size_t WS_BUFC = 522 * MiB;
constexpr size_t WS_BUFD = 650 * MiB;
constexpr size_t WS_END = 778 * MiB;
constexpr size_t C_KCMP = 0, C_VCMP = 16 * MiB, C_KS = 32 * MiB, C_VST = 48 * MiB, C_KW = 64 * MiB, C_VWT = 80 * MiB,
                 C_GATES = 96 * MiB, C_HID = 102 * MiB, C_KC = 110 * MiB, C_VCT = 111 * MiB;
constexpr int CW_CNT = 64;
constexpr int CW_NSA = 1024;
constexpr int CW_TR = 2048;
constexpr int CW_BAR = 4096;

struct Params {
    const float* in[35];
    float* out;
    unsigned char* ws;
    int ph_lo, ph_hi;
};

DEVI unsigned cvt_pk_bf16(float lo, float hi) { unsigned r; asm("v_cvt_pk_bf16_f32 %0, %1, %2" : "=v"(r) : "v"(lo), "v"(hi)); return r; }
DEVI bf16_t f2bf(float x) { return (bf16_t)(cvt_pk_bf16(x, 0.f) & 0xffffu); }
DEVI float bf2f(unsigned b) { return __uint_as_float(b << 16); }
DEVI void glds16(const void* g, void* l) {
    __builtin_amdgcn_global_load_lds((const __attribute__((address_space(1))) void*)g, (__attribute__((address_space(3))) void*)l, 16, 0, 0);
}
DEVI f32x16 mfma32(bf16x8 a, bf16x8 b, f32x16 c) { return __builtin_amdgcn_mfma_f32_32x32x16_bf16(a, b, c, 0, 0, 0); }
DEVI f32x4 mfma16(bf16x8 a, bf16x8 b, f32x4 c) { return __builtin_amdgcn_mfma_f32_16x16x32_bf16(a, b, c, 0, 0, 0); }
DEVI float fexp2(float x) { return __builtin_amdgcn_exp2f(x); }
DEVI float wave_sum(float v) {
#pragma unroll
    for (int o = 1; o < 64; o <<= 1) v += __shfl_xor(v, o);
    return v;
}
DEVI float sigmoidf_(float x) { return 1.f / (1.f + __expf(-x)); }
DEVI float gelu_tanh(float x) {
    const float u = 0.7978845608028654f * (x + 0.044715f * x * x * x);
    const float e = __expf(2.f * u);
    const float th = 1.f - 2.f / (e + 1.f);
    return 0.5f * x * (1.f + th);
}

#define LAS __attribute__((address_space(3)))
#define XB_TMO      128
#define XB_XCNT(j)  (256  + 64 * (j))
#define XB_XSUB(j)  (1280 + 64 * (j))
#define XB_XGEN(j)  (2304 + 64 * (j))
#define XB_TOP      3328
#define XB_TOPGEN   3392
#define XB_SPIN_CAP (1u << 22)
DEVI unsigned xb_ld(unsigned* p) { return __hip_atomic_load(p, __ATOMIC_RELAXED, __HIP_MEMORY_SCOPE_AGENT); }
DEVI unsigned xb_add(unsigned* p, unsigned v) { return __hip_atomic_fetch_add(p, v, __ATOMIC_RELAXED, __HIP_MEMORY_SCOPE_AGENT); }
DEVI unsigned xb_xcc_id() { return (unsigned)__builtin_amdgcn_s_getreg((3 << 11) | 20) & 0xFu; }
#define XB_SPIN(cond, bar) do { unsigned _sp = 0; while (cond) { __builtin_amdgcn_s_sleep(1); \
    if ((++_sp & 255u) == 0u) { if (xb_ld(&(bar)[XB_TMO])) break; if (_sp > XB_SPIN_CAP) { atomicAdd(&(bar)[XB_TMO], 1u); break; } } } } while (0)
DEVI void xcd_barrier_post(unsigned* bar) {
    if (threadIdx.x == 0) (void)xb_add(&bar[XB_XCNT(xb_xcc_id())], 1u);
}
DEVI void xcd_barrier_complete(unsigned* bar, unsigned x, unsigned& nloc, unsigned& nx) {
    const unsigned G = gridDim.x * gridDim.y * gridDim.z;
    unsigned sum, cnt, mine, sp = 0u;
    for (;;) {
        sum = 0u; cnt = 0u; mine = 0u;
#pragma unroll
        for (unsigned j = 0; j < 16; ++j) { const unsigned c = xb_ld(&bar[XB_XCNT(j)]); sum += c; cnt += (c > 0u) ? 1u : 0u; mine = (j == x) ? c : mine; }
        if (sum == G) break;
        __builtin_amdgcn_s_sleep(1);
        if ((++sp & 255u) == 0u) { if (xb_ld(&bar[XB_TMO])) break; if (sp > XB_SPIN_CAP) { atomicAdd(&bar[XB_TMO], 1u); break; } }
    }
    nloc = mine > 0u ? mine : 1u; nx = cnt > 0u ? cnt : 1u;
}
DEVI void xcd_barrier(unsigned* bar, volatile LAS unsigned* st) {
    asm volatile("s_waitcnt vmcnt(0)" ::: "memory");
    __syncthreads();
    if (threadIdx.x == 0) {
        const unsigned x = xb_xcc_id();
        __builtin_amdgcn_s_waitcnt(0);
        unsigned nloc = st[0], nx = st[1];
        if (nloc == 0u) { xcd_barrier_complete(bar, x, nloc, nx); st[0] = nloc; st[1] = nx; }
        const unsigned old = xb_add(&bar[XB_XSUB(x)], 1u);
        const unsigned gen = old / nloc;
        if (old + 1u == (gen + 1u) * nloc) {
            __builtin_amdgcn_fence(__ATOMIC_RELEASE, "agent");
            asm volatile("s_waitcnt vmcnt(0)" ::: "memory");
            const unsigned og = xb_add(&bar[XB_TOP], 1u);
            const unsigned tg = og / nx;
            if (og + 1u == (tg + 1u) * nx) xb_add(&bar[XB_TOPGEN], 1u);
            else XB_SPIN(xb_ld(&bar[XB_TOPGEN]) == tg, bar);
            __builtin_amdgcn_fence(__ATOMIC_ACQUIRE, "agent");
            xb_add(&bar[XB_XGEN(x)], 1u);
            asm volatile("s_waitcnt vmcnt(0)" ::: "memory");
        } else {
            XB_SPIN(xb_ld(&bar[XB_XGEN(x)]) == gen, bar);
            __builtin_amdgcn_fence(__ATOMIC_ACQUIRE, "agent");
            asm volatile("s_waitcnt vmcnt(0)" ::: "memory");
        }
    }
    __syncthreads();
}

DEVI void row_load(const float* row, int lane, f32x4 (&v)[8]) {
#pragma unroll
    for (int c = 0; c < 8; ++c) v[c] = *(const f32x4*)(row + c * 256 + lane * 4);
}
DEVI void row_stats(const f32x4 (&v)[8], float& mean, float& rstd) {
    float s = 0.f;
#pragma unroll
    for (int c = 0; c < 8; ++c) s += (v[c].x + v[c].y) + (v[c].z + v[c].w);
    mean = wave_sum(s) * (1.f / D_);
    float q = 0.f;
#pragma unroll
    for (int c = 0; c < 8; ++c) { const f32x4 d = v[c] - mean; q += (d.x * d.x + d.y * d.y) + (d.z * d.z + d.w * d.w); }
    rstd = 1.f / sqrtf(wave_sum(q) * (1.f / D_) + LN_EPS);
}

DEVI const float* wsrc_col(const Params& p, int mat, int e, int n, int& ld) {
    switch (mat) {
    case 0: {
        ld = IN_COLS;
        if (n < 2560) return p.in[4] + n;
        if (n < 2688) { const int j = n - 2560; return j < 48 ? p.in[4] + 2560 + j : nullptr; }
        const int r = n - 2688, grp = r >> 6, within = r & 63;
        const int ch = grp * 32 + (within & 31), isg = within >> 5;
        return p.in[4] + 2608 + isg * 1024 + ch;
    }
    case 1: ld = 256; return p.in[6] + n;
    case 2: ld = 256; return p.in[9] + n;
    case 3: ld = 64; return n < 64 ? p.in[7] + n : nullptr;
    case 4: ld = 64; return n < 64 ? p.in[10] + n : nullptr;
    case 5: ld = 2048; return p.in[16] + n;
    case 6: ld = 2048; return p.in[21] + n;
    case 7: ld = 4096; return p.in[22] + n;
    case 8: ld = 2048; return p.in[23] + n;
    case 9: if (n < 4) { ld = 4; return p.in[26] + n; } if (n < 36) { ld = 32; return p.in[28] + (n - 4); } ld = 1; return nullptr;
    case 10: { ld = 512; const int grp = n >> 6, within = n & 63; const int ch = grp * 32 + (within & 31);
               return ((within >> 5) ? p.in[31] : p.in[30]) + (size_t)e * 2048 * 512 + ch; }
    default: ld = 2048; return p.in[32] + (size_t)e * 512 * 2048 + n;
    }
}
DEVI void wave_transpose_item(const Params& p, char* smem, int mat, int e, int ntile, int ktile, bf16_t* dst, bf16_t* dst_lo, int K) {
    int tid = threadIdx.x; asm volatile("" : "+v"(tid));
    const int lane = tid & 63, w = tid >> 6;
    float* tile = (float*)smem + w * (64 * 65 + 32);
    const int k0 = ktile * 64;
    if (mat == 9) {
        int ld; const float* src = wsrc_col(p, mat, e, ntile * 64 + lane, ld);
#pragma unroll 8
        for (int k = 0; k < 64; ++k) tile[k * 65 + lane] = src ? src[(size_t)(k0 + k) * ld] : 0.f;
    } else {
        const int c4 = lane & 15, kr = lane >> 4;
        int ld; const float* src = wsrc_col(p, mat, e, ntile * 64 + c4 * 4, ld);
        f32x4 v[16];
#pragma unroll
        for (int i = 0; i < 16; ++i) v[i] = src ? *(const f32x4*)(src + (size_t)(k0 + kr + 4 * i) * ld) : (f32x4){0.f, 0.f, 0.f, 0.f};
#pragma unroll
        for (int i = 0; i < 16; ++i) { float* q = tile + (kr + 4 * i) * 65 + c4 * 4; q[0] = v[i].x; q[1] = v[i].y; q[2] = v[i].z; q[3] = v[i].w; }
    }
    asm volatile("s_waitcnt lgkmcnt(0)" ::: "memory");
    const int kc = lane & 7, nr = lane >> 3;
#pragma unroll
    for (int c = 0; c < 8; ++c) {
        const int n = nr + 8 * c;
        float wv[8];
#pragma unroll
        for (int j = 0; j < 8; ++j) wv[j] = tile[(kc * 8 + j) * 65 + n];
        u32x4 o; o.x = cvt_pk_bf16(wv[0], wv[1]); o.y = cvt_pk_bf16(wv[2], wv[3]); o.z = cvt_pk_bf16(wv[4], wv[5]); o.w = cvt_pk_bf16(wv[6], wv[7]);
        const size_t off = (size_t)(ntile * 64 + n) * K + k0 + kc * 8;
        *(u32x4*)(dst + off) = o;
        if (dst_lo) {
            float r[8];
#pragma unroll
            for (int j = 0; j < 8; ++j) r[j] = wv[j] - bf2f((unsigned)f2bf(wv[j]));
            u32x4 l; l.x = cvt_pk_bf16(r[0], r[1]); l.y = cvt_pk_bf16(r[2], r[3]); l.z = cvt_pk_bf16(r[4], r[5]); l.w = cvt_pk_bf16(r[6], r[7]);
            *(u32x4*)(dst_lo + off) = l;
        }
    }
    asm volatile("s_waitcnt lgkmcnt(0)" ::: "memory");
}

DEVI void phase_prep(const Params& p, char* smem) {
    int tid = threadIdx.x; asm volatile("" : "+v"(tid));
    const int lane = tid & 63, w = tid >> 6;
    unsigned char* ws = p.ws;
    for (int r = blockIdx.x; r < 8; r += gridDim.x) {
        const int type = r >> 2, n = (r & 3) * 64 + lane;
        const float* pe = p.in[type ? 8 : 5]; const float* w1 = p.in[type ? 9 : 6];
        float sacc = 0.f;
        for (int k = w * 256; k < (w + 1) * 256; ++k) sacc += pe[k] * w1[(size_t)k * 256 + n];
        float* red = (float*)smem;
        __syncthreads();
        red[w * 64 + lane] = sacc;
        __syncthreads();
        if (w == 0) ((float*)(ws + WS_C1BIAS))[type * 256 + n] = ((red[lane] + red[64 + lane]) + (red[128 + lane] + red[192 + lane])) + ((red[256 + lane] + red[320 + lane]) + (red[384 + lane] + red[448 + lane]));
        __syncthreads();
    }
    constexpr int I_LN = T_, I_MEM = 1024;
    constexpr int I_M0 = 74 * 32, I_M12 = 4 * 32, I_M34 = 2 * 4, I_SQ = 32 * 32, I_KV = 64 * 32, I_R = 2 * 32;
    constexpr int TOTAL = I_LN + I_MEM + I_M0 + 2 * I_M12 + 2 * I_M34 + 3 * I_SQ + I_KV + I_R;
    const int gw = blockIdx.x * 8 + w, NW = gridDim.x * 8;
    for (int it = gw; it < TOTAL; it += NW) {
        int r = it;
        if (r < I_LN) {
            const int t = r;
            f32x4 v[8]; row_load(p.in[0] + (size_t)t * D_, lane, v);
            float mean, rstd; row_stats(v, mean, rstd);
            bf16_t* hb = (bf16_t*)(ws + WS_BUFA) + (size_t)t * D_;
#pragma unroll
            for (int c = 0; c < 8; ++c) {
                const int col = c * 256 + lane * 4;
                const f32x4 g = *(const f32x4*)(p.in[2] + col), b = *(const f32x4*)(p.in[3] + col);
                const f32x4 y = (v[c] - mean) * rstd * g + b;
                u32x2 o; o.x = cvt_pk_bf16(y.x, y.y); o.y = cvt_pk_bf16(y.z, y.w);
                *(u32x2*)(hb + col) = o;
            }
            if (lane == 0) { float* st = (float*)(ws + WS_STATS); st[t * 2] = mean; st[t * 2 + 1] = rstd; }
            continue;
        }
        r -= I_LN;
        if (r < I_MEM) {
            const int t = r;
            f32x4 v[8]; row_load(p.in[1] + (size_t)t * D_, lane, v);
            float mean, rstd; row_stats(v, mean, rstd);
            bf16_t* hb = (bf16_t*)(ws + WS_BUFD) + (size_t)t * D_;
#pragma unroll
            for (int c = 0; c < 8; ++c) {
                const int col = c * 256 + lane * 4;
                const f32x4 g = *(const f32x4*)(p.in[19] + col), b = *(const f32x4*)(p.in[20] + col);
                const f32x4 y = (v[c] - mean) * rstd * g + b;
                u32x2 o; o.x = cvt_pk_bf16(y.x, y.y); o.y = cvt_pk_bf16(y.z, y.w);
                *(u32x2*)(hb + col) = o;
            }
            continue;
        }
        r -= I_MEM;
        if (r < I_M0) { wave_transpose_item(p, smem, 0, 0, r / 32, r % 32, (bf16_t*)(ws + WS_WIN), nullptr, 2048); continue; } r -= I_M0;
        if (r < I_M12) { wave_transpose_item(p, smem, 1, 0, r / 32, r % 32, (bf16_t*)(ws + WS_WC1), nullptr, 2048); continue; } r -= I_M12;
        if (r < I_M12) { wave_transpose_item(p, smem, 2, 0, r / 32, r % 32, (bf16_t*)(ws + WS_WC1) + 256 * 2048, nullptr, 2048); continue; } r -= I_M12;
        if (r < I_M34) { wave_transpose_item(p, smem, 3, 0, r / 4, r % 4, (bf16_t*)(ws + WS_WC2), nullptr, 256); continue; } r -= I_M34;
        if (r < I_M34) { wave_transpose_item(p, smem, 4, 0, r / 4, r % 4, (bf16_t*)(ws + WS_WC2) + 128 * 256, nullptr, 256); continue; } r -= I_M34;
        if (r < I_SQ) { wave_transpose_item(p, smem, 5, 0, r / 32, r % 32, (bf16_t*)(ws + WS_WOUT), nullptr, 2048); continue; } r -= I_SQ;
        if (r < I_SQ) { wave_transpose_item(p, smem, 6, 0, r / 32, r % 32, (bf16_t*)(ws + WS_WQ), nullptr, 2048); continue; } r -= I_SQ;
        if (r < I_KV) { wave_transpose_item(p, smem, 7, 0, r / 32, r % 32, (bf16_t*)(ws + WS_WKV), nullptr, 2048); continue; } r -= I_KV;
        if (r < I_SQ) { wave_transpose_item(p, smem, 8, 0, r / 32, r % 32, (bf16_t*)(ws + WS_WO), nullptr, 2048); continue; } r -= I_SQ;
        wave_transpose_item(p, smem, 9, 0, r / 32, r % 32, (bf16_t*)(ws + WS_WR), (bf16_t*)(ws + WS_WR) + 128 * 2048, 2048);
    }
    __syncthreads();
}

constexpr int MOE_W_ITEMS = 32 * 16 * 32 + 32 * 32 * 8;
DEVI void moe_weight_item(const Params& p, char* smem, int r) {
    unsigned char* ws = p.ws;
    if (r < 32 * 16 * 32) { const int e = r / 512, q = r % 512; wave_transpose_item(p, smem, 10, e, q / 32, q % 32, (bf16_t*)(ws + WS_WGU) + (size_t)e * 1024 * 2048, nullptr, 2048); }
    else { r -= 32 * 16 * 32; const int e = r / 256, q = r % 256; wave_transpose_item(p, smem, 11, e, q / 8, q % 8, (bf16_t*)(ws + WS_WD) + (size_t)e * 2048 * 512, nullptr, 512); }
}

enum { J_PROJ = 0, J_MEMKV, J_CMP1, J_CMP2, J_OUT, J_WQ, J_WO, J_ROUTER, J_MOE1, J_MOE2 };
constexpr int GEMM_STAGE_BYTES = 49152;
constexpr int GEMM_TP = 3 * GEMM_STAGE_BYTES;

template <int job, int VAR = 0>
DEVI void gemm_job(const Params& p, char* smem) {
    unsigned char* ws = p.ws;
    int tid = threadIdx.x; asm volatile("" : "+v"(tid));
    const int lane = tid & 63, w = tid >> 6, wr = w >> 1, wc = w & 1, fr = lane & 15, fq = lane >> 4;
    const int srow = tid >> 3, schunk = (tid & 7) ^ ((tid >> 4) & 7);
    int* tp = (int*)(smem + GEMM_TP);
    int MT = 0, NT = 0, K = 2048, nseg = 1, ntiles = 0, RT = 0;
    switch (job) {
    case J_PROJ: MT = 128; NT = 37; break;
    case J_MEMKV: MT = 4; NT = 32; break;
    case J_CMP1: MT = 64; NT = 2; break;
    case J_CMP2: MT = 64; NT = 1; K = 256; break;
    case J_OUT: case J_WQ: case J_WO: MT = 128; NT = 16; break;
    case J_ROUTER: MT = 128; NT = 1; nseg = 3; break;
    default: break;
    }
    const unsigned* cntw = (const unsigned*)(ws + WS_CTL) + CW_CNT;
    if (job == J_MOE1 || job == J_MOE2) {
        __syncthreads();
        if (tid == 0) { int acc = 0; for (int e = 0; e < 32; ++e) { tp[e] = acc; const int c = (int)__hip_atomic_load(cntw + e, __ATOMIC_RELAXED, __HIP_MEMORY_SCOPE_AGENT); tp[33 + e] = c; acc += (c + 255) >> 8; } tp[32] = acc; }
        __syncthreads();
        RT = tp[32];
        NT = (job == J_MOE1) ? 8 : 16; K = (job == J_MOE1) ? 2048 : 512;
        ntiles = RT * NT;
    } else {
        const int nsr = (MT + 7) >> 3;
        ntiles = (MT < 64) ? MT * NT : ((nsr + 7) >> 3) * 8 * NT * 8;
    }
    int my_tp = 0, my_cnt = 0;
    if (job == J_MOE1 || job == J_MOE2) { my_tp = tp[lane & 31]; my_cnt = tp[33 + (lane & 31)]; }
    const int nk = K >> 6, ntot = nseg * nk;

    for (int ti = blockIdx.x; ti < ntiles; ti += gridDim.x) {
        int mt, nt, e = 0, rt = 0, ecnt = 0, etp = 0;
        if (job == J_MOE1 || job == J_MOE2) {
            nt = ti / RT; const int rtg = ti - nt * RT;
            const unsigned long long bal = __ballot(my_tp <= rtg && my_cnt > 0);
            const unsigned m32 = (unsigned)(bal & 0xffffffffull);
            e = 31 - __builtin_clz(m32);
            etp = __shfl(my_tp, e); ecnt = __shfl(my_cnt, e);
            rt = rtg - etp; mt = 0;
        } else {
            if (MT < 64) { nt = ti / MT; mt = ti - nt * MT; }
            else {
                const int x = ti & 7, jj = ti >> 3, per = 8 * NT, srl = jj / per, idx = jj - srl * per;
                mt = (srl * 8 + x) * 8 + (idx & 7); nt = idx >> 3;
                if (mt >= MT) continue;
            }
        }
        const bf16_t* ap[4]; const bf16_t* bp[2];
#pragma unroll
        for (int r = 0; r < 4; ++r) {
            const int row = r * 64 + srow;
            const bf16_t* a;
            switch (job) {
            case J_PROJ: a = (const bf16_t*)(ws + WS_BUFA) + (size_t)(mt * 256 + row) * 2048; break;
            case J_MEMKV: a = (const bf16_t*)(ws + WS_BUFD) + (size_t)(mt * 256 + row) * 2048; break;
            case J_CMP1: { const int gi = mt >> 1, i = (mt & 1) * 256 + row, ic = i < 510 ? i : 510; const int type = gi >> 4, bh = gi & 15;
                a = (const bf16_t*)(ws + WS_BUFC + (type ? C_VCMP : C_KCMP)) + ((size_t)bh * 8192 + 16 * ic) * 64; break; }
            case J_CMP2: a = (const bf16_t*)(ws + WS_BUFC + C_HID) + (size_t)(mt * 256 + row) * 256; break;
            case J_OUT: a = (const bf16_t*)(ws + WS_BUFA) + (size_t)(mt * 256 + row) * 2048; break;
            case J_WQ: a = (const bf16_t*)(ws + WS_BUFB) + (size_t)(mt * 256 + row) * 2048; break;
            case J_WO: a = (const bf16_t*)(ws + WS_BUFA) + (size_t)(mt * 256 + row) * 2048; break;
            case J_ROUTER: a = (const bf16_t*)(ws + WS_BUFA) + (size_t)(mt * 256 + row) * 2048; break;
            case J_MOE1: { int pos = rt * 256 + row; if (pos >= ecnt) pos = 0; const int aid = ((const int*)(ws + WS_LIST))[(size_t)e * T_ + pos];
                a = (const bf16_t*)(ws + WS_BUFA) + (size_t)(aid >> 1) * 2048; break; }
            default: a = (const bf16_t*)(ws + WS_BUFB) + (size_t)((etp + rt) * 256 + row) * 512; break;
            }
            ap[r] = a + schunk * 8;
        }
#pragma unroll
        for (int r = 0; r < 2; ++r) {
            const int row = r * 64 + srow;
            const bf16_t* b;
            switch (job) {
            case J_PROJ: b = (const bf16_t*)(ws + WS_WIN) + (size_t)(nt * 128 + row) * 2048; break;
            case J_MEMKV: b = (const bf16_t*)(ws + WS_WKV) + (size_t)(nt * 128 + row) * 2048; break;
            case J_CMP1: b = (const bf16_t*)(ws + WS_WC1) + (size_t)(mt >> 5) * 256 * 2048 + (size_t)(nt * 128 + row) * 2048; break;
            case J_CMP2: b = (const bf16_t*)(ws + WS_WC2) + (size_t)(mt >> 5) * 128 * 256 + (size_t)row * 256; break;
            case J_OUT: b = (const bf16_t*)(ws + WS_WOUT) + (size_t)(nt * 128 + row) * 2048; break;
            case J_WQ: b = (const bf16_t*)(ws + WS_WQ) + (size_t)(nt * 128 + row) * 2048; break;
            case J_WO: b = (const bf16_t*)(ws + WS_WO) + (size_t)(nt * 128 + row) * 2048; break;
            case J_ROUTER: b = (const bf16_t*)(ws + WS_WR) + (size_t)row * 2048; break;
            case J_MOE1: b = (const bf16_t*)(ws + WS_WGU) + (size_t)e * 1024 * 2048 + (size_t)(nt * 128 + row) * 2048; break;
            default: b = (const bf16_t*)(ws + WS_WD) + (size_t)e * 2048 * 512 + (size_t)(nt * 128 + row) * 512; break;
            }
            bp[r] = b + schunk * 8;
        }
        const long a_seg1 = (long)(WS_BUFB - WS_BUFA) / 2;
        const long b_seg2 = 128 * 2048;

        f32x4 acc[4][4];
#pragma unroll
        for (int i = 0; i < 4; ++i)
#pragma unroll
            for (int j = 0; j < 4; ++j) acc[i][j] = (f32x4){0.f, 0.f, 0.f, 0.f};

#define GEMM_STAGE(kt_) do { const int _kt = (kt_); int _seg = 0, _k0 = _kt << 6; if (nseg > 1) { _seg = _kt / nk; _k0 = (_kt - _seg * nk) << 6; } \
            const long _ao = (_seg == 1) ? a_seg1 : 0, _bo = (_seg == 2) ? b_seg2 : 0; \
            char* _A = smem + (_kt % 3) * GEMM_STAGE_BYTES; char* _B = _A + 32768; \
            _Pragma("unroll") for (int r = 0; r < 4; ++r) glds16(ap[r] + _ao + _k0, _A + (r * 512 + tid) * 16); \
            _Pragma("unroll") for (int r = 0; r < 2; ++r) glds16(bp[r] + _bo + _k0, _B + (r * 512 + tid) * 16); } while (0)

        GEMM_STAGE(0);
        if (ntot > 1) GEMM_STAGE(1);
        for (int kt = 0; kt < ntot; ++kt) {
            if (kt + 1 < ntot) asm volatile("s_waitcnt vmcnt(6)" ::: "memory"); else asm volatile("s_waitcnt vmcnt(0)" ::: "memory");
            __builtin_amdgcn_s_barrier();
            asm volatile("" ::: "memory");
            if (kt + 2 < ntot && VAR != 1) GEMM_STAGE(kt + 2);
            if (VAR == 2) continue;
            const char* A = smem + (kt % 3) * GEMM_STAGE_BYTES; const char* B = A + 32768;
#pragma unroll
            for (int ks = 0; ks < 2; ++ks) {
                bf16x8 af[4], bfr[4];
                const int coff = ((4 * ks + fq) ^ (fr >> 1)) * 16;
#pragma unroll
                for (int i = 0; i < 4; ++i) {
                    af[i] = *(const bf16x8*)(A + (wr * 64 + i * 16 + fr) * 128 + coff);
                    bfr[i] = *(const bf16x8*)(B + (wc * 64 + i * 16 + fr) * 128 + coff);
                }
#pragma unroll
                for (int i = 0; i < 4; ++i)
#pragma unroll
                    for (int j = 0; j < 4; ++j) acc[i][j] = mfma16(bfr[j], af[i], acc[i][j]);
            }
        }
#undef GEMM_STAGE
        if (VAR != 0 && VAR != 4) { if (acc[0][0].x == 123.456f) p.out[0] = acc[1][1].y + acc[2][2].z + acc[3][3].w; __syncthreads(); continue; }
        asm volatile("s_waitcnt lgkmcnt(0)" ::: "memory"); __builtin_amdgcn_s_barrier(); asm volatile("" ::: "memory");
        float* ep = (float*)smem;
#pragma unroll
        for (int mi = 0; mi < 4; ++mi)
#pragma unroll
            for (int ni = 0; ni < 4; ++ni) *(f32x4*)(ep + (wr * 64 + mi * 16 + fr) * 132 + wc * 64 + ni * 16 + fq * 4) = acc[mi][ni];
        asm volatile("s_waitcnt lgkmcnt(0)" ::: "memory"); __builtin_amdgcn_s_barrier(); asm volatile("" ::: "memory");
        const int row0 = mt * 256, col0 = nt * 128;
#define EP8(row_, c8_, v0_, v1_) const f32x4 v0_ = *(const f32x4*)(ep + (row_) * 132 + (c8_) * 8), v1_ = *(const f32x4*)(ep + (row_) * 132 + (c8_) * 8 + 4)
#define PK8(o_, v0_, v1_) u32x4 o_; o_.x = cvt_pk_bf16(v0_.x, v0_.y); o_.y = cvt_pk_bf16(v0_.z, v0_.w); o_.z = cvt_pk_bf16(v1_.x, v1_.y); o_.w = cvt_pk_bf16(v1_.z, v1_.w)
        switch (job) {
        case J_PROJ: {
            if (nt < 8) {
                bf16_t* Q = (bf16_t*)(ws + WS_BUFB);
#pragma unroll
                for (int i = 0; i < 8; ++i) { const int c = tid + 512 * i, row = c >> 4, c8 = c & 15; EP8(row, c8, a0, a1);
                    const f32x4 b0 = a0 * (0.125f * LOG2E), b1 = a1 * (0.125f * LOG2E); PK8(o, b0, b1);
                    *(u32x4*)(Q + (size_t)(row0 + row) * 1024 + col0 + c8 * 8) = o; }
            } else if (nt < 20) {
                const int reg = (nt - 8) >> 1;
                bf16_t* dst = (bf16_t*)(ws + WS_BUFC + (reg == 0 ? C_KCMP : reg == 1 ? C_VCMP : reg == 2 ? C_KS : reg == 3 ? C_VST : reg == 4 ? C_KW : C_VWT));
                const int b = row0 >> 13, s0 = row0 & 8191;
                if (reg != 3 && reg != 5) {
#pragma unroll
                    for (int i = 0; i < 8; ++i) { const int c = tid + 512 * i, row = c >> 4, c8 = c & 15; EP8(row, c8, a0, a1); PK8(o, a0, a1);
                        const int bh = b * 4 + ((nt - 8) & 1) * 2 + (c8 >> 3);
                        *(u32x4*)(dst + ((size_t)bh * 8192 + s0 + row) * 64 + (c8 & 7) * 8) = o; }
                } else {
#pragma unroll
                    for (int i = 0; i < 8; ++i) { const int c = tid + 512 * i, tg = c & 31, dcol = c >> 5;
                        const int rb = (tg >> 1) * 16 + (tg & 1) * 4;
                        float v[8];
#pragma unroll
                        for (int j = 0; j < 8; ++j) v[j] = ep[(rb + (j & 3) + (j >> 2) * 8) * 132 + dcol];
                        u32x4 o; o.x = cvt_pk_bf16(v[0], v[1]); o.y = cvt_pk_bf16(v[2], v[3]); o.z = cvt_pk_bf16(v[4], v[5]); o.w = cvt_pk_bf16(v[6], v[7]);
                        const int bh = b * 4 + ((nt - 8) & 1) * 2 + (dcol >> 6);
                        *(u32x4*)(dst + ((size_t)bh * 64 + (dcol & 63)) * 8192 + s0 + tg * 8) = o; }
                }
            } else if (nt == 20) {
                float* G = (float*)(ws + WS_BUFC + C_GATES);
#pragma unroll
                for (int i = 0; i < 6; ++i) { const int c = tid + 512 * i, row = c / 12, c4 = c - row * 12;
                    const f32x4 v = *(const f32x4*)(ep + row * 132 + c4 * 4); f32x4 o; o.x = sigmoidf_(v.x); o.y = sigmoidf_(v.y); o.z = sigmoidf_(v.z); o.w = sigmoidf_(v.w);
                    *(f32x4*)(G + (size_t)(row0 + row) * 48 + c4 * 4) = o; }
            } else {
                bf16_t* Hg = (bf16_t*)(ws + WS_BUFB + 64 * MiB);
#pragma unroll
                for (int i = 0; i < 4; ++i) { const int c = tid + 512 * i, row = c >> 3, c8 = c & 7, hh = c8 >> 2, cc = (c8 & 3) * 8;
                    const f32x4 a0 = *(const f32x4*)(ep + row * 132 + hh * 64 + cc), a1 = *(const f32x4*)(ep + row * 132 + hh * 64 + cc + 4);
                    const f32x4 g0 = *(const f32x4*)(ep + row * 132 + hh * 64 + 32 + cc), g1 = *(const f32x4*)(ep + row * 132 + hh * 64 + 32 + cc + 4);
                    u32x4 o; o.x = cvt_pk_bf16(a0.x * sigmoidf_(g0.x), a0.y * sigmoidf_(g0.y)); o.y = cvt_pk_bf16(a0.z * sigmoidf_(g0.z), a0.w * sigmoidf_(g0.w));
                    o.z = cvt_pk_bf16(a1.x * sigmoidf_(g1.x), a1.y * sigmoidf_(g1.y)); o.w = cvt_pk_bf16(a1.z * sigmoidf_(g1.z), a1.w * sigmoidf_(g1.w));
                    *(u32x4*)(Hg + (size_t)(row0 + row) * 1024 + ((nt - 21) * 2 + hh) * 32 + cc) = o; }
            }
        } break;
        case J_MEMKV: {
            const int b = mt;
            if (nt < 16) {
                bf16_t* Kx = (bf16_t*)(ws + WS_BUFD + 4 * MiB);
                const int head = col0 >> 9, d0 = col0 & 511;
#pragma unroll
                for (int i = 0; i < 8; ++i) { const int c = tid + 512 * i, row = c >> 4, c8 = c & 15; EP8(row, c8, a0, a1); PK8(o, a0, a1);
                    *(u32x4*)(Kx + ((size_t)(b * 4 + head) * 256 + row) * 512 + d0 + c8 * 8) = o; }
            } else {
                bf16_t* Vt = (bf16_t*)(ws + WS_BUFD + 8 * MiB);
                const int n2 = col0 - 2048, head = n2 >> 9, d0 = n2 & 511;
#pragma unroll
                for (int i = 0; i < 8; ++i) { const int c = tid + 512 * i, tg = c & 31, dcol = c >> 5;
                    float v[8];
#pragma unroll
                    for (int j = 0; j < 8; ++j) v[j] = ep[(tg * 8 + j) * 132 + dcol];
                    u32x4 o; o.x = cvt_pk_bf16(v[0], v[1]); o.y = cvt_pk_bf16(v[2], v[3]); o.z = cvt_pk_bf16(v[4], v[5]); o.w = cvt_pk_bf16(v[6], v[7]);
                    *(u32x4*)(Vt + ((size_t)(b * 4 + head) * 512 + d0 + dcol) * 256 + tg * 8) = o; }
            }
        } break;
        case J_CMP1: {
            const int type = mt >> 5;
            const float* bias = (const float*)(ws + WS_C1BIAS) + type * 256;
            bf16_t* Hd = (bf16_t*)(ws + WS_BUFC + C_HID);
#pragma unroll
            for (int i = 0; i < 8; ++i) { const int c = tid + 512 * i, row = c >> 4, c8 = c & 15; EP8(row, c8, a0, a1);
                const f32x4 b0 = *(const f32x4*)(bias + col0 + c8 * 8), b1 = *(const f32x4*)(bias + col0 + c8 * 8 + 4);
                u32x4 o; o.x = cvt_pk_bf16(gelu_tanh(a0.x + b0.x), gelu_tanh(a0.y + b0.y)); o.y = cvt_pk_bf16(gelu_tanh(a0.z + b0.z), gelu_tanh(a0.w + b0.w));
                o.z = cvt_pk_bf16(gelu_tanh(a1.x + b1.x), gelu_tanh(a1.y + b1.y)); o.w = cvt_pk_bf16(gelu_tanh(a1.z + b1.z), gelu_tanh(a1.w + b1.w));
                *(u32x4*)(Hd + (size_t)(row0 + row) * 256 + col0 + c8 * 8) = o; }
        } break;
        case J_CMP2: {
            const int gi = mt >> 1, type = gi >> 4, bh = gi & 15, i0 = (mt & 1) * 256;
            if (type == 0) {
                bf16_t* Kc = (bf16_t*)(ws + WS_BUFC + C_KC);
#pragma unroll
                for (int i = 0; i < 4; ++i) { const int c = tid + 512 * i, row = c >> 3, c8 = c & 7; EP8(row, c8, a0, a1); PK8(o, a0, a1);
                    if (i0 + row >= 511) o = (u32x4){0u, 0u, 0u, 0u};
                    *(u32x4*)(Kc + ((size_t)bh * 512 + i0 + row) * 64 + c8 * 8) = o; }
            } else {
                bf16_t* Vc = (bf16_t*)(ws + WS_BUFC + C_VCT);
#pragma unroll
                for (int i = 0; i < 4; ++i) { const int c = tid + 512 * i, tg = c & 31, d = c >> 5;
                    const int rb = (tg >> 1) * 16 + (tg & 1) * 4;
                    float v[8];
#pragma unroll
                    for (int j = 0; j < 8; ++j) { const int r = rb + (j & 3) + (j >> 2) * 8; v[j] = (i0 + r >= 511) ? 0.f : ep[r * 132 + d]; }
                    u32x4 o; o.x = cvt_pk_bf16(v[0], v[1]); o.y = cvt_pk_bf16(v[2], v[3]); o.z = cvt_pk_bf16(v[4], v[5]); o.w = cvt_pk_bf16(v[6], v[7]);
                    *(u32x4*)(Vc + ((size_t)bh * 64 + d) * 512 + i0 + tg * 8) = o; }
            }
        } break;
        case J_OUT: {
            const float* st = (const float*)(ws + WS_STATS);
#pragma unroll
            for (int i = 0; i < 16; ++i) { const int c = tid + 512 * i, row = c >> 5, c4 = c & 31; const int t = row0 + row, n = col0 + c4 * 4;
                const f32x4 v = *(const f32x4*)(ep + row * 132 + c4 * 4);
                const float mean = st[t * 2], rstd = st[t * 2 + 1];
                const f32x4 xv = *(const f32x4*)(p.in[0] + (size_t)t * D_ + n), g = *(const f32x4*)(p.in[2] + n), bb = *(const f32x4*)(p.in[3] + n);
                *(f32x4*)(p.out + (size_t)t * D_ + n) = ((xv - mean) * rstd * g + bb) * ALPHA + v; }
        } break;
        case J_WQ: {
            bf16_t* Qx = (bf16_t*)(ws + WS_BUFC);
            const float sc = 0.04419417382415922f * LOG2E;
#pragma unroll
            for (int i = 0; i < 8; ++i) { const int c = tid + 512 * i, row = c >> 4, c8 = c & 15; EP8(row, c8, a0, a1);
                const f32x4 b0 = a0 * sc, b1 = a1 * sc; PK8(o, b0, b1);
                if (VAR == 4) { if (o.x == 0x12345678u) *(u32x4*)(Qx + (size_t)(row0 + row) * 2048 + col0 + c8 * 8) = o; }
                else *(u32x4*)(Qx + (size_t)(row0 + row) * 2048 + col0 + c8 * 8) = o; }
        } break;
        case J_WO: {
#pragma unroll
            for (int i = 0; i < 16; ++i) { const int c = tid + 512 * i, row = c >> 5, c4 = c & 31;
                float* q = p.out + (size_t)(row0 + row) * D_ + col0 + c4 * 4;
                const f32x4 v = *(const f32x4*)(ep + row * 132 + c4 * 4), r = *(const f32x4*)q;
                *(f32x4*)q = r * ALPHA + v; }
        } break;
        case J_ROUTER: {
            float* L = (float*)(ws + WS_LOGITS);
#pragma unroll
            for (int i = 0; i < 5; ++i) { const int c = tid + 512 * i; if (c < 2304) { const int row = c / 9, c4 = c - row * 9;
                *(f32x4*)(L + (size_t)(row0 + row) * 40 + c4 * 4) = *(const f32x4*)(ep + row * 132 + c4 * 4); } }
        } break;
        case J_MOE1: {
            bf16_t* H = (bf16_t*)(ws + WS_BUFB);
#pragma unroll
            for (int i = 0; i < 4; ++i) { const int c = tid + 512 * i, row = c >> 3, c8 = c & 7, hh = c8 >> 2, cc = (c8 & 3) * 8;
                const f32x4 g0 = *(const f32x4*)(ep + row * 132 + hh * 64 + cc), g1 = *(const f32x4*)(ep + row * 132 + hh * 64 + cc + 4);
                const f32x4 u0 = *(const f32x4*)(ep + row * 132 + hh * 64 + 32 + cc), u1 = *(const f32x4*)(ep + row * 132 + hh * 64 + 32 + cc + 4);
                u32x4 o; o.x = cvt_pk_bf16(g0.x * sigmoidf_(g0.x) * u0.x, g0.y * sigmoidf_(g0.y) * u0.y); o.y = cvt_pk_bf16(g0.z * sigmoidf_(g0.z) * u0.z, g0.w * sigmoidf_(g0.w) * u0.w);
                o.z = cvt_pk_bf16(g1.x * sigmoidf_(g1.x) * u1.x, g1.y * sigmoidf_(g1.y) * u1.y); o.w = cvt_pk_bf16(g1.z * sigmoidf_(g1.z) * u1.z, g1.w * sigmoidf_(g1.w) * u1.w);
                *(u32x4*)(H + ((size_t)(etp + rt) * 256 + row) * 512 + (nt * 2 + hh) * 32 + cc) = o; }
        } break;
        default: {
            bf16_t* Y = (bf16_t*)(ws + WS_BUFC);
            const float* wt = (const float*)(ws + WS_WTOK);
#pragma unroll
            for (int i = 0; i < 8; ++i) { const int c = tid + 512 * i, row = c >> 4, c8 = c & 15; const int pos = rt * 256 + row;
                if (pos < ecnt) { const int aid = ((const int*)(ws + WS_LIST))[(size_t)e * T_ + pos]; const float wv = wt[aid];
                    EP8(row, c8, a0, a1); const f32x4 b0 = a0 * wv, b1 = a1 * wv; PK8(o, b0, b1);
                    *(u32x4*)(Y + (size_t)aid * 2048 + col0 + c8 * 8) = o; } }
        } break;
        }
#undef EP8
#undef PK8
        asm volatile("s_waitcnt lgkmcnt(0)" ::: "memory"); __builtin_amdgcn_s_barrier(); asm volatile("" ::: "memory");
    }
}

DEVI void phase_conv(const Params& p) {
    unsigned char* ws = p.ws;
    int tid = threadIdx.x; asm volatile("" : "+v"(tid));
    const int lane = tid & 63, w = tid >> 6;
    const int c0 = tid * 2;
    const bf16_t* Hg = (const bf16_t*)(ws + WS_BUFB + 64 * MiB);
    float* pre = p.out;
    float* cst = (float*)(ws + WS_LIST);
    float wgt[31][2];
    { const float* wp = p.in[12] + c0;
#pragma unroll
      for (int k = 0; k < 31; ++k) { const float2 v = *(const float2*)wp; wgt[k][0] = v.x; wgt[k][1] = v.y; wp += 1024; asm volatile("" : "+v"(wp)); } }
    const float2 cb = *(const float2*)(p.in[13] + c0);
    for (int it = blockIdx.x; it < T_ / 16; it += gridDim.x) {
        const int t0 = it * 16, s0 = t0 & 8191;
        float acc[16][2];
#pragma unroll
        for (int j = 0; j < 16; ++j) { acc[j][0] = cb.x; acc[j][1] = cb.y; }
        const bf16_t* xp = Hg + ((long)t0 - 30) * 1024 + c0;
#pragma unroll
        for (int i = 0; i < 46; ++i) {
            const int s = s0 - 30 + i;
            float x0 = 0.f, x1 = 0.f;
            if (s >= 0) { const unsigned u = *(const unsigned*)xp; x0 = bf2f(u & 0xffffu); x1 = bf2f(u >> 16); }
            xp += 1024; asm volatile("" : "+v"(xp));
#pragma unroll
            for (int j = 0; j < 16; ++j) { const int k = i - j; if (k >= 0 && k <= 30) { acc[j][0] += wgt[k][0] * x0; acc[j][1] += wgt[k][1] * x1; } }
        }
#pragma unroll
        for (int j = 0; j < 16; ++j) {
            *(float2*)(pre + (size_t)(t0 + j) * 1024 + c0) = make_float2(acc[j][0], acc[j][1]);
            const float sv = wave_sum(acc[j][0] + acc[j][1]);
            const float qv = wave_sum(acc[j][0] * acc[j][0] + acc[j][1] * acc[j][1]);
            if (lane == 0) *(float2*)(cst + ((size_t)(t0 + j) * 8 + w) * 2) = make_float2(sv, qv);
        }
    }
}
DEVI void conv_finish(const Params& p) {
    unsigned char* ws = p.ws;
    int tid = threadIdx.x; asm volatile("" : "+v"(tid));
    const int lane = tid & 63, w = tid >> 6;
    const float* pre = p.out;
    const float* cst = (const float*)(ws + WS_LIST);
    bf16_t* CC = (bf16_t*)(ws + WS_BUFA);
    for (int it = blockIdx.x; it < T_ / 8; it += gridDim.x) {
        const int t = it * 8 + w;
        float sv = 0.f, qv = 0.f;
#pragma unroll
        for (int k = 0; k < 8; ++k) { const float2 a = *(const float2*)(cst + ((size_t)t * 8 + k) * 2); sv += a.x; qv += a.y; }
        const float mean = sv * (1.f / 1024.f);
        float var = qv * (1.f / 1024.f) - mean * mean; var = var > 0.f ? var : 0.f;
        const float rstd = 1.f / sqrtf(var + LN_EPS);
#pragma unroll
        for (int c = 0; c < 4; ++c) {
            const int col = c * 256 + lane * 4;
            const f32x4 x = *(const f32x4*)(pre + (size_t)t * 1024 + col), g = *(const f32x4*)(p.in[14] + col), bb = *(const f32x4*)(p.in[15] + col);
            f32x4 y = (x - mean) * rstd * g + bb;
            y.x *= sigmoidf_(y.x); y.y *= sigmoidf_(y.y); y.z *= sigmoidf_(y.z); y.w *= sigmoidf_(y.w);
            u32x2 o; o.x = cvt_pk_bf16(y.x, y.y); o.y = cvt_pk_bf16(y.z, y.w);
            *(u32x2*)(CC + (size_t)t * 2048 + 1024 + col) = o;
        }
    }
}

enum { M_CMP = 0, M_SEL = 1, M_WIN = 2 };
constexpr int KSTR = 72;
constexpr int NSA_KBUF = 0, NSA_VBUF = 24576;
constexpr int NSA_IMP = 49152;
constexpr int NSA_TBL = 82944;
constexpr int NSA_SEL = NSA_TBL + 4096;
constexpr int NSA_UNIT = NSA_SEL + 1024;

DEVI void attn_issue(char* kdst, char* vdst, const bf16_t* kt, const bf16_t* vt, int vstride, int tid) {
    const int row = tid >> 3, c = (tid & 7) ^ ((row >> 1) & 7);
    glds16(kt + row * 64 + c * 8, kdst + tid * 16);
    glds16(vt + (size_t)row * vstride + c * 8, vdst + tid * 16);
}

constexpr float NSA_THR = 8.f;
template <int MODE, int PASS>
DEVI void nsa_branch(char* smem, const bf16_t* kg, const bf16_t* vg, int vstride, int t_lo, int t_hi, int far_lo, int far_hi, const bf16x8 (&qf)[4], int tq,
                     float c31, const LAS float* tblg, const LAS unsigned* selrow, float& m_ref, bool& mset, f32x16& lacc, float inv_l, f32x16 (&o)[2], LAS float* imp_row) {
    int tid = threadIdx.x; asm volatile("" : "+v"(tid));
    const int lane = tid & 63, l31 = lane & 31, h = lane >> 5, xs = (l31 >> 1) & 7;
    const int n = t_hi - t_lo + 1;
    f32x16 cneg;
    { const float cc = c31 - m_ref;
#pragma unroll
      for (int i = 0; i < 16; ++i) cneg[i] = cc; }
    u32x4 ones_u; ones_u.x = ones_u.y = ones_u.z = ones_u.w = 0x3F803F80u;
    const bf16x8 ones = __builtin_bit_cast(bf16x8, ones_u);
    float imp_carry = 0.f;
    attn_issue(smem + NSA_KBUF, smem + NSA_VBUF, kg + (size_t)t_lo * 4096, vg + t_lo * 64, vstride, tid);
    if (n > 1) { const int tl = t_lo + 1; attn_issue(smem + NSA_KBUF + 8192, smem + NSA_VBUF + 8192, kg + (size_t)tl * 4096, vg + tl * 64, vstride, tid); }
    for (int it = 0; it < n; ++it) {
        const int ti = t_lo + it, buf = it % 3;
        if (it + 1 < n) asm volatile("s_waitcnt vmcnt(2)" ::: "memory"); else asm volatile("s_waitcnt vmcnt(0)" ::: "memory");
        __builtin_amdgcn_s_barrier();
        asm volatile("" ::: "memory");
        if (it + 2 < n) { const int nb = (it + 2) % 3; const int tl = ti + 2; attn_issue(smem + NSA_KBUF + nb * 8192, smem + NSA_VBUF + nb * 8192, kg + (size_t)tl * 4096, vg + tl * 64, vstride, tid); }
        bool selbit = true;
        if (MODE == M_SEL) { selbit = (selrow[ti >> 5] >> (ti & 31)) & 1u; if (!__any(selbit)) continue; }
        const char* Kc = smem + NSA_KBUF + buf * 8192; const char* Vc = smem + NSA_VBUF + buf * 8192;
        f32x16 s[2];
        {
            const int off0 = (h ^ xs) << 4;
            s[0] = mfma32(*(const bf16x8*)(Kc + l31 * 128 + off0), qf[0], cneg);
            s[1] = mfma32(*(const bf16x8*)(Kc + (32 + l31) * 128 + off0), qf[0], cneg);
        }
#pragma unroll
        for (int ks = 1; ks < 4; ++ks) {
            const int off = ((2 * ks + h) ^ xs) << 4;
            s[0] = mfma32(*(const bf16x8*)(Kc + l31 * 128 + off), qf[ks], s[0]);
            s[1] = mfma32(*(const bf16x8*)(Kc + (32 + l31) * 128 + off), qf[ks], s[1]);
        }
        const bool far = (ti >= far_lo) && (ti <= far_hi);
        {
        if (!far) {
            const int dbase = (MODE == M_CMP) ? (tq - 31 - 1024 * ti) : (tq - 64 * ti);
#pragma unroll
            for (int u = 0; u < 2; ++u)
#pragma unroll
                for (int i = 0; i < 16; ++i) {
                    const int kk = 32 * u + (i & 3) + 8 * (i >> 2) + 4 * h;
                    const int dist = dbase - ((MODE == M_CMP) ? 16 * kk : kk);
                    const int idx = (dist < -1 ? -1 : (dist > 191 ? 191 : dist)) + 64;
                    float v = s[u][i] + tblg[idx];
                    if (MODE == M_WIN) v = (dist < 512) ? v : -INFINITY;
                    if (MODE == M_SEL) v = selbit ? v : -INFINITY;
                    s[u][i] = v;
                    if ((i & 3) == 3) asm volatile("" ::: "memory");
                }
        }
        if (PASS != 2) {
            float mx = fmaxf(s[0][0], s[1][0]);
#pragma unroll
            for (int i = 1; i < 16; ++i) mx = fmaxf(mx, fmaxf(s[0][i], s[1][i]));
            if (MODE == M_SEL && !selbit) mx = -INFINITY;
            if (__any(mx > NSA_THR || (!mset && mx > -INFINITY))) {
                const float mc = fmaxf(mx, __shfl_xor(mx, 32));
                const bool mv = (mc > NSA_THR) || (!mset && mc > -INFINITY);
                const float delta = mv ? mc : 0.f;
                const float alpha = mset ? fexp2(-delta) : 1.f;
                mset = mset || mv;
                m_ref += delta;
                const float cc = c31 - m_ref;
#pragma unroll
                for (int i = 0; i < 16; ++i) { cneg[i] = cc; lacc[i] *= alpha; }
#pragma unroll
                for (int u = 0; u < 2; ++u)
#pragma unroll
                    for (int i = 0; i < 16; ++i) s[u][i] -= delta;
                if (PASS == 0) {
#pragma unroll
                    for (int v = 0; v < 2; ++v)
#pragma unroll
                        for (int i = 0; i < 16; ++i) o[v][i] *= alpha;
                }
            }
        }
#pragma unroll
        for (int u = 0; u < 2; ++u)
#pragma unroll
            for (int i = 0; i < 16; ++i) s[u][i] = fexp2(s[u][i]);
        if (PASS == 2) {
            float mainv[8], halfv[8];
#pragma unroll
            for (int u = 0; u < 2; ++u)
#pragma unroll
                for (int c4 = 0; c4 < 4; ++c4) {
                    float hv = 0.5f * s[u][4 * c4 + 3] * inv_l;
                    float mv = ((s[u][4 * c4] + s[u][4 * c4 + 1]) + s[u][4 * c4 + 2]) * inv_l + hv;
                    mv += __builtin_bit_cast(float, __builtin_amdgcn_update_dpp(0, __builtin_bit_cast(int, mv), 0xB1, 0xF, 0xF, true));
                    hv += __builtin_bit_cast(float, __builtin_amdgcn_update_dpp(0, __builtin_bit_cast(int, hv), 0xB1, 0xF, 0xF, true));
                    mv += __builtin_bit_cast(float, __builtin_amdgcn_update_dpp(0, __builtin_bit_cast(int, mv), 0x4E, 0xF, 0xF, true));
                    hv += __builtin_bit_cast(float, __builtin_amdgcn_update_dpp(0, __builtin_bit_cast(int, hv), 0x4E, 0xF, 0xF, true));
                    mainv[u * 4 + c4] = mv; halfv[u * 4 + c4] = __shfl_xor(hv, 32);
                }
#pragma unroll
            for (int gi = 0; gi < 8; ++gi) {
                const float cin = h ? halfv[gi] : (gi ? halfv[gi - 1] : imp_carry);
                const unsigned ia = (unsigned)(size_t)(imp_row + 16 * ti + 2 * gi + h);
                const float val = mainv[gi] + cin;
                asm volatile("ds_write_b32 %0, %1" :: "v"(ia), "v"(val) : "memory");
            }
            imp_carry = halfv[7];
        }
        const unsigned pmask = (MODE == M_SEL && far && !selbit) ? 0u : 0xFFFFFFFFu;
#pragma unroll
        for (int u = 0; u < 2; ++u)
#pragma unroll
            for (int sI = 0; sI < 2; ++sI) {
                u32x4 pk;
                pk.x = cvt_pk_bf16(s[u][8 * sI + 0], s[u][8 * sI + 1]); pk.y = cvt_pk_bf16(s[u][8 * sI + 2], s[u][8 * sI + 3]);
                pk.z = cvt_pk_bf16(s[u][8 * sI + 4], s[u][8 * sI + 5]); pk.w = cvt_pk_bf16(s[u][8 * sI + 6], s[u][8 * sI + 7]);
                if (MODE == M_SEL) { pk.x &= pmask; pk.y &= pmask; pk.z &= pmask; pk.w &= pmask; }
                const bf16x8 pf = __builtin_bit_cast(bf16x8, pk);
                lacc = mfma32(ones, pf, lacc);
                if (PASS != 1) {
                    const int voff = ((2 * (2 * u + sI) + h) ^ xs) << 4;
                    o[0] = mfma32(*(const bf16x8*)(Vc + l31 * 128 + voff), pf, o[0]);
                    o[1] = mfma32(*(const bf16x8*)(Vc + (32 + l31) * 128 + voff), pf, o[1]);
                }
            }
        }
    }
    if (PASS == 2) {
        const int c = 16 * (t_hi + 1);
        if (h == 0 && c < 128) { const unsigned ia = (unsigned)(size_t)(imp_row + c); asm volatile("ds_write_b32 %0, %1" :: "v"(ia), "v"(imp_carry) : "memory"); }
        asm volatile("s_waitcnt lgkmcnt(0)" ::: "memory");
    }
    __syncthreads();
}

DEVI void phase_nsa(const Params& p, char* smem, int ctr_idx) {
    unsigned char* ws = p.ws;
    const int tid0 = threadIdx.x;
    float* imp = (float*)(smem + NSA_IMP);
    unsigned* tot = (unsigned*)(smem + NSA_IMP);
    float* tbl = (float*)(smem + NSA_TBL);
    unsigned* selm = (unsigned*)(smem + NSA_SEL);
    int* sunit = (int*)(smem + NSA_UNIT);
    unsigned* ctr = (unsigned*)(ws + WS_CTL) + CW_NSA + 256 * ctr_idx;
    unsigned* trc = (unsigned*)(ws + WS_CTL) + CW_TR;
    const bf16_t* Q = (const bf16_t*)(ws + WS_BUFB);
    const float* G = (const float*)(ws + WS_BUFC + C_GATES);
    bf16_t* CC = ctr_idx ? (bf16_t*)(p.out + 32 * 1024 * 1024) : (bf16_t*)(ws + WS_BUFA);
    for (;;) {
        int tid = tid0; asm volatile("" : "+v"(tid));
        const int lane = tid & 63, w = tid >> 6, l31 = lane & 31, h = lane >> 5;
        const int qi = l31 >> 2, g = l31 & 3, ql = 8 * w + qi;
        __syncthreads();
        if (tid == 0) {
            const unsigned x = xb_xcc_id() & 7u; int u = -1;
            for (unsigned k = 0; k < 8u && u < 0; ++k) { const unsigned xx = (x + k) & 7u; const unsigned i = atomicAdd(ctr + 16 * xx, 1u); if (i < 256u) u = (int)(i * 8u + xx); }
            *sunit = u;
        }
        __syncthreads();
        const int unit = *sunit;
        if (unit < 0) break;
        const int xq = unit & 7, iq = unit >> 3;
        const int qt = 127 - (iq >> 1), bh = 2 * xq + (iq & 1), b = bh >> 2, hkv = bh & 3, q0 = qt * 64, cur = qt;
        for (int i = tid; i < 4 * 256; i += 512) {
            const int gg = i >> 8, d = (i & 255) - 64;
            float val = -INFINITY;
            if (d >= 0) {
                int bucket;
                if (d < 16) bucket = d;
                else if (d >= 128) bucket = 31;
                else { const int lg = 16 + (int)(logf((float)d / 16.f) / 2.0794415416798357f * 16.f); bucket = lg < 31 ? lg : 31; }
                val = (p.in[11][bucket * 16 + hkv * 4 + gg] - p.in[11][31 * 16 + hkv * 4 + gg]) * LOG2E;
            }
            tbl[i] = val;
        }
        if (tid < 256) selm[tid] = 0u;
        const int tq = q0 + ql;
        const size_t trow = (size_t)b * 8192 + tq;
        bf16x8 qf[4];
        { const bf16_t* qrow = Q + trow * 1024 + hkv * 256 + g * 64;
#pragma unroll
          for (int ks = 0; ks < 4; ++ks) qf[ks] = *(const bf16x8*)(qrow + 16 * ks + 8 * h); }
        float c31 = p.in[11][31 * 16 + hkv * 4 + g] * LOG2E;
        asm volatile("" : "+v"(qf[0]), "+v"(qf[1]), "+v"(qf[2]), "+v"(qf[3]), "+v"(c31));
        const LAS float* tblg = (const LAS float*)(smem + NSA_TBL) + g * 256;
        const LAS unsigned* selrow = (const LAS unsigned*)(smem + NSA_SEL) + ql * 4;
        f32x16 o[2];
#pragma unroll
        for (int v = 0; v < 2; ++v)
#pragma unroll
            for (int i = 0; i < 16; ++i) o[v][i] = 0.f;
        __syncthreads();
        const bf16_t* kc = (const bf16_t*)(ws + WS_BUFC + C_KC) + (size_t)bh * 512 * 64;
        const bf16_t* vct = (const bf16_t*)(ws + WS_BUFC + C_VCT) + (size_t)bh * 64 * 512;
        const int ct_hi = (q0 + 32) >> 10, cfar_hi = (q0 >= 1167) ? ((q0 - 1167) >> 10) : -1;
        float m_ref = 0.f; bool mset = false;
        f32x16 lacc;
#pragma unroll
        for (int i = 0; i < 16; ++i) lacc[i] = 0.f;
        const int rmode = ctr_idx ? NSA_REP_MODE : 0;
        if (rmode != 2) nsa_branch<M_CMP, 1>(smem, kc, vct, 512, 0, ct_hi, 0, cfar_hi, qf, tq, c31, tblg, selrow, m_ref, mset, lacc, 0.f, o, (LAS float*)(smem + NSA_IMP) + ql * 132);
        { const float lt = lacc[0]; const float inv = lt > 0.f ? 1.f / lt : 0.f;
          if (rmode != 2 && rmode != 4) nsa_branch<M_CMP, 2>(smem, kc, vct, 512, 0, ct_hi, 0, cfar_hi, qf, tq, c31, tblg, selrow, m_ref, mset, lacc, inv, o, (LAS float*)(smem + NSA_IMP) + ql * 132);
#pragma unroll
          for (int v = 0; v < 2; ++v)
#pragma unroll
            for (int i = 0; i < 16; ++i) o[v][i] *= inv; }
        asm volatile("s_waitcnt lgkmcnt(0)" ::: "memory"); __syncthreads();
        if (rmode < 2) {
            const int q = tid >> 3, sub = tid & 7, t = q0 + q;
            unsigned key[16];
#pragma unroll
            for (int i = 0; i < 16; ++i) {
                const int j = sub * 16 + i;
                const bool forced = (j == 0) || (j == cur) || (j == cur - 1);
                const bool valid = (j * 64 <= t);
                const float v = imp[q * 132 + j];
                key[i] = forced ? 0xFFFFFFFFu : (valid ? (__float_as_uint(v) + 1u) : 0u);
            }
            unsigned tau = 0u;
            for (int bit = 31; bit >= 0; --bit) {
                const unsigned cand = tau | (1u << bit);
                int c = 0;
#pragma unroll
                for (int i = 0; i < 16; ++i) c += (key[i] >= cand) ? 1 : 0;
                c += __shfl_xor(c, 1); c += __shfl_xor(c, 2); c += __shfl_xor(c, 4);
                if (c >= 16) tau = cand;
            }
            int gt = 0, eq = 0;
#pragma unroll
            for (int i = 0; i < 16; ++i) { gt += (key[i] > tau) ? 1 : 0; eq += (key[i] == tau) ? 1 : 0; }
            int gtt = gt; gtt += __shfl_xor(gtt, 1); gtt += __shfl_xor(gtt, 2); gtt += __shfl_xor(gtt, 4);
            int pre = 0;
#pragma unroll
            for (int sI = 0; sI < 7; ++sI) { const int v = __shfl(eq, (lane & ~7) + sI); if (sI < sub) pre += v; }
            const int need = 16 - gtt;
            unsigned bits = 0u; int run = pre;
#pragma unroll
            for (int i = 0; i < 16; ++i) {
                bool sel = key[i] > tau;
                if (tau > 0u && key[i] == tau) { sel = run < need; ++run; }
                bits |= sel ? (1u << i) : 0u;
            }
            atomicOr(&selm[q * 4 + (sub >> 1)], bits << ((sub & 1) * 16));
        }
        __syncthreads();
        const float gc = G[((size_t)b * 8192 + tq) * 48 + hkv * 12 + g * 3 + 0];
#pragma unroll
        for (int v = 0; v < 2; ++v)
#pragma unroll
            for (int i = 0; i < 16; i += 2) { const float gcc = (PROBE == 1 ? 0.f : gc); tot[(v * 8 + (i >> 1)) * 512 + tid] = cvt_pk_bf16(gcc * o[v][i], gcc * o[v][i + 1]); o[v][i] = 0.f; o[v][i + 1] = 0.f; }
        {
            const bf16_t* ks = (const bf16_t*)(ws + WS_BUFC + C_KS) + (size_t)bh * 8192 * 64;
            const bf16_t* vst = (const bf16_t*)(ws + WS_BUFC + C_VST) + (size_t)bh * 64 * 8192;
            m_ref = 0.f; mset = false;
#pragma unroll
            for (int i = 0; i < 16; ++i) lacc[i] = 0.f;
            if (rmode == 0) nsa_branch<M_SEL, 0>(smem, ks, vst, 8192, 0, cur, 0, cur - 3, qf, tq, c31, tblg, selrow, m_ref, mset, lacc, 0.f, o, (LAS float*)nullptr);
            const float gs = G[((size_t)b * 8192 + tq) * 48 + hkv * 12 + g * 3 + 1];
            const float sc = (PROBE == 2 ? 0.f : gs) / lacc[0];
#pragma unroll
            for (int v = 0; v < 2; ++v)
#pragma unroll
                for (int i = 0; i < 16; i += 2) { const unsigned tv = tot[(v * 8 + (i >> 1)) * 512 + tid];
                    tot[(v * 8 + (i >> 1)) * 512 + tid] = cvt_pk_bf16(bf2f(tv & 0xffffu) + sc * o[v][i], bf2f(tv >> 16) + sc * o[v][i + 1]); o[v][i] = 0.f; o[v][i + 1] = 0.f; }
        }
        {
            const bf16_t* kw = (const bf16_t*)(ws + WS_BUFC + C_KW) + (size_t)bh * 8192 * 64;
            const bf16_t* vwt = (const bf16_t*)(ws + WS_BUFC + C_VWT) + (size_t)bh * 64 * 8192;
            m_ref = 0.f; mset = false;
#pragma unroll
            for (int i = 0; i < 16; ++i) lacc[i] = 0.f;
            const int w_lo = cur >= 8 ? cur - 8 : 0;
            if (rmode == 0 || rmode == 2) nsa_branch<M_WIN, 0>(smem, kw, vwt, 8192, w_lo, cur, cur - 7, cur - 3, qf, tq, c31, tblg, selrow, m_ref, mset, lacc, 0.f, o, (LAS float*)nullptr);
            const float gw = G[((size_t)b * 8192 + tq) * 48 + hkv * 12 + g * 3 + 2];
            const float sc = (PROBE == 3 ? 0.f : gw) / lacc[0];
            bf16_t* orow = CC + trow * 2048 + hkv * 256 + g * 64;
#pragma unroll
            for (int v = 0; v < 2; ++v)
#pragma unroll
                for (int c4 = 0; c4 < 4; ++c4) {
                    const unsigned ta = tot[(v * 8 + 2 * c4) * 512 + tid], tb = tot[(v * 8 + 2 * c4 + 1) * 512 + tid];
                    const float r0 = bf2f(ta & 0xffffu) + sc * o[v][4 * c4 + 0], r1 = bf2f(ta >> 16) + sc * o[v][4 * c4 + 1];
                    const float r2 = bf2f(tb & 0xffffu) + sc * o[v][4 * c4 + 2], r3 = bf2f(tb >> 16) + sc * o[v][4 * c4 + 3];
                    u32x2 ov; ov.x = cvt_pk_bf16(r0, r1); ov.y = cvt_pk_bf16(r2, r3);
                    *(u32x2*)(orow + 32 * v + 8 * c4 + 4 * h) = ov;
                }
        }
        if (ctr_idx == 0) {
            __syncthreads();
            for (int k = 0; k < 3; ++k) {
                int item = 0;
                if (lane == 0) item = (int)atomicAdd(trc, 1u);
                item = __builtin_amdgcn_readfirstlane(item);
                if (item >= MOE_W_ITEMS) break;
                moe_weight_item(p, smem, item);
            }
        }
    }
    if (ctr_idx == 0) {
        __syncthreads();
        for (;;) {
            int item = 0;
            if ((threadIdx.x & 63) == 0) item = (int)atomicAdd(trc, 1u);
            item = __builtin_amdgcn_readfirstlane(item);
            if (item >= MOE_W_ITEMS) break;
            moe_weight_item(p, smem, item);
        }
    }
}

template <int which>
DEVI void phase_ln(const Params& p) {
    unsigned char* ws = p.ws;
    int tid = threadIdx.x; asm volatile("" : "+v"(tid));
    const int lane = tid & 63, w = tid >> 6;
    for (int it = blockIdx.x; it < T_ / 8; it += gridDim.x) {
        const int t = it * 8 + w;
        float* row = p.out + (size_t)t * D_;
        f32x4 v[8]; row_load(row, lane, v);
        if (which == 2) {
            const bf16_t* y0 = (const bf16_t*)(ws + WS_BUFC) + (size_t)t * 2 * D_;
#pragma unroll
            for (int c = 0; c < 8; ++c) {
                const int col = c * 256 + lane * 4;
                const u32x2 a = *(const u32x2*)(y0 + col), b = *(const u32x2*)(y0 + D_ + col);
                v[c].x = v[c].x * ALPHA + (bf2f(a.x & 0xffffu) + bf2f(b.x & 0xffffu));
                v[c].y = v[c].y * ALPHA + (bf2f(a.x >> 16) + bf2f(b.x >> 16));
                v[c].z = v[c].z * ALPHA + (bf2f(a.y & 0xffffu) + bf2f(b.y & 0xffffu));
                v[c].w = v[c].w * ALPHA + (bf2f(a.y >> 16) + bf2f(b.y >> 16));
            }
        }
        float mean, rstd; row_stats(v, mean, rstd);
        const float* gp = p.in[which == 0 ? 17 : which == 1 ? 24 : 33];
        const float* bp = p.in[which == 0 ? 18 : which == 1 ? 25 : 34];
        bf16_t* hi = (bf16_t*)(ws + (which == 0 ? WS_BUFB : WS_BUFA)) + (size_t)t * D_;
        bf16_t* lo = (bf16_t*)(ws + WS_BUFB) + (size_t)t * D_;
#pragma unroll
        for (int c = 0; c < 8; ++c) {
            const int col = c * 256 + lane * 4;
            const f32x4 g = *(const f32x4*)(gp + col), b = *(const f32x4*)(bp + col);
            const f32x4 y = (v[c] - mean) * rstd * g + b;
            *(f32x4*)(row + col) = y;
            if (which != 2) {
                u32x2 o; o.x = cvt_pk_bf16(y.x, y.y); o.y = cvt_pk_bf16(y.z, y.w);
                *(u32x2*)(hi + col) = o;
                if (which == 1) {
                    u32x2 ol;
                    ol.x = cvt_pk_bf16(y.x - bf2f(o.x & 0xffffu), y.y - bf2f(o.x >> 16));
                    ol.y = cvt_pk_bf16(y.z - bf2f(o.y & 0xffffu), y.w - bf2f(o.y >> 16));
                    *(u32x2*)(lo + col) = ol;
                }
            }
        }
    }
}

DEVI void phase_xattn(const Params& p, char* smem) {
    unsigned char* ws = p.ws;
    int tid = threadIdx.x; asm volatile("" : "+v"(tid));
    const int lane = tid & 63, w = tid >> 6, l31 = lane & 31, h = lane >> 5;
    const bf16_t* Qx = (const bf16_t*)(ws + WS_BUFC);
    const bf16_t* Kx = (const bf16_t*)(ws + WS_BUFD + 4 * MiB);
    const bf16_t* Vt = (const bf16_t*)(ws + WS_BUFD + 8 * MiB);
    bf16_t* Ox = (bf16_t*)(ws + WS_BUFA);
    bf16_t* Qs = (bf16_t*)smem;
    bf16_t* Ks = Qs + 256 * KSTR;
    bf16_t* Vs = (bf16_t*)smem;
    for (int unit = blockIdx.x; unit < 512; unit += gridDim.x) {
        const int qt = unit & 31, head = (unit >> 5) & 3, b = unit >> 7;
        const size_t t0 = (size_t)b * 8192 + qt * 256;
        const bf16_t* kbase = Kx + (size_t)(b * 4 + head) * 256 * 512;
        const bf16_t* vbase = Vt + (size_t)(b * 4 + head) * 512 * 256;
        f32x16 s[8];
#pragma unroll
        for (int u = 0; u < 8; ++u)
#pragma unroll
            for (int i = 0; i < 16; ++i) s[u][i] = 0.f;
        for (int dc = 0; dc < 8; ++dc) {
            __syncthreads();
#pragma unroll
            for (int i = 0; i < 4; ++i) { const int c = tid + 512 * i, row = c >> 3, ch = c & 7;
                *(u32x4*)(Qs + row * KSTR + ch * 8) = *(const u32x4*)(Qx + (t0 + row) * 2048 + head * 512 + dc * 64 + ch * 8); }
#pragma unroll
            for (int i = 0; i < 4; ++i) { const int c = tid + 512 * i, row = c >> 3, ch = c & 7;
                *(u32x4*)(Ks + row * KSTR + ch * 8) = *(const u32x4*)(kbase + (size_t)row * 512 + dc * 64 + ch * 8); }
            __syncthreads();
#pragma unroll
            for (int ks = 0; ks < 4; ++ks) {
                const bf16x8 qb = *(const bf16x8*)(Qs + (32 * w + l31) * KSTR + 16 * ks + 8 * h);
#pragma unroll
                for (int u = 0; u < 8; ++u) { const bf16x8 ka = *(const bf16x8*)(Ks + (32 * u + l31) * KSTR + 16 * ks + 8 * h); s[u] = mfma32(ka, qb, s[u]); }
            }
        }
        float mx = -INFINITY;
#pragma unroll
        for (int u = 0; u < 8; ++u)
#pragma unroll
            for (int i = 0; i < 16; ++i) mx = fmaxf(mx, s[u][i]);
        mx = fmaxf(mx, __shfl_xor(mx, 32));
        float ls = 0.f;
        bf16x8 pf[8][2];
#pragma unroll
        for (int u = 0; u < 8; ++u) {
#pragma unroll
            for (int i = 0; i < 16; ++i) { s[u][i] = fexp2(s[u][i] - mx); ls += s[u][i]; }
#pragma unroll
            for (int sI = 0; sI < 2; ++sI) { u32x4 pk;
                pk.x = cvt_pk_bf16(s[u][8 * sI + 0], s[u][8 * sI + 1]); pk.y = cvt_pk_bf16(s[u][8 * sI + 2], s[u][8 * sI + 3]);
                pk.z = cvt_pk_bf16(s[u][8 * sI + 4], s[u][8 * sI + 5]); pk.w = cvt_pk_bf16(s[u][8 * sI + 6], s[u][8 * sI + 7]);
                pf[u][sI] = __builtin_bit_cast(bf16x8, pk); }
        }
        ls += __shfl_xor(ls, 32);
        const float inv = (PROBE == 4 ? 0.f : 1.f) / ls;
        bf16_t* orow = Ox + (t0 + 32 * w + l31) * 2048 + head * 512;
        for (int dc = 0; dc < 8; ++dc) {
            __syncthreads();
#pragma unroll
            for (int i = 0; i < 4; ++i) { const int c = tid + 512 * i, row = c >> 5, ch = c & 31;
                *(u32x4*)(Vs + row * 264 + ch * 8) = *(const u32x4*)(vbase + (size_t)(dc * 64 + row) * 256 + ch * 8); }
            __syncthreads();
            f32x16 o[2];
#pragma unroll
            for (int v = 0; v < 2; ++v)
#pragma unroll
                for (int i = 0; i < 16; ++i) o[v][i] = 0.f;
#pragma unroll
            for (int s4 = 0; s4 < 16; ++s4)
#pragma unroll
                for (int v = 0; v < 2; ++v) {
                    const bf16_t* vr = Vs + (32 * v + l31) * 264 + 16 * s4 + 4 * h;
                    const u32x2 a = *(const u32x2*)vr, bq = *(const u32x2*)(vr + 8);
                    u32x4 vv; vv.x = a.x; vv.y = a.y; vv.z = bq.x; vv.w = bq.y;
                    o[v] = mfma32(__builtin_bit_cast(bf16x8, vv), pf[s4 >> 1][s4 & 1], o[v]);
                }
#pragma unroll
            for (int v = 0; v < 2; ++v)
#pragma unroll
                for (int c4 = 0; c4 < 4; ++c4) {
                    u32x2 ov; ov.x = cvt_pk_bf16(o[v][4 * c4] * inv, o[v][4 * c4 + 1] * inv); ov.y = cvt_pk_bf16(o[v][4 * c4 + 2] * inv, o[v][4 * c4 + 3] * inv);
                    *(u32x2*)(orow + dc * 64 + 32 * v + 8 * c4 + 4 * h) = ov;
                }
        }
        __syncthreads();
    }
}

DEVI void phase_route(const Params& p) {
    unsigned char* ws = p.ws;
    const float* L = (const float*)(ws + WS_LOGITS);
    unsigned* cnt = (unsigned*)(ws + WS_CTL) + CW_CNT;
    int* list = (int*)(ws + WS_LIST);
    float* wt = (float*)(ws + WS_WTOK);
    int tid = threadIdx.x; asm volatile("" : "+v"(tid));
    for (int t = blockIdx.x * NTHREADS + tid; t < T_; t += gridDim.x * NTHREADS) {
        const f32x4 lgv = *(const f32x4*)(L + (size_t)t * 40);
        float lg[4] = {lgv.x + p.in[27][0], lgv.y + p.in[27][1], lgv.z + p.in[27][2], lgv.w + p.in[27][3]};
        int grp = 0; float best = lg[0];
#pragma unroll
        for (int i = 1; i < 4; ++i) if (lg[i] > best) { best = lg[i]; grp = i; }
        float se = 0.f;
#pragma unroll
        for (int i = 0; i < 4; ++i) se += expf(lg[i] - best);
        const float wgrp = 1.f / se;
        const f32x4 e0 = *(const f32x4*)(L + (size_t)t * 40 + 4 + grp * 8), e1 = *(const f32x4*)(L + (size_t)t * 40 + 8 + grp * 8);
        const f32x4 b0 = *(const f32x4*)(p.in[29] + grp * 8), b1 = *(const f32x4*)(p.in[29] + grp * 8 + 4);
        float le[8] = {e0.x + b0.x, e0.y + b0.y, e0.z + b0.z, e0.w + b0.w, e1.x + b1.x, e1.y + b1.y, e1.z + b1.z, e1.w + b1.w};
        int i0 = 0; float v0 = le[0];
#pragma unroll
        for (int i = 1; i < 8; ++i) if (le[i] > v0) { v0 = le[i]; i0 = i; }
        int i1 = -1; float v1 = -INFINITY;
#pragma unroll
        for (int i = 0; i < 8; ++i) if (i != i0 && le[i] > v1) { v1 = le[i]; i1 = i; }
        const float ex = expf(v1 - v0);
        const float w0 = wgrp / (1.f + ex), w1 = wgrp * ex / (1.f + ex);
        const int ea = grp * 8 + i0, eb = grp * 8 + i1;
        const unsigned pa = atomicAdd(cnt + ea, 1u); list[(size_t)ea * T_ + pa] = t * 2;
        const unsigned pb = atomicAdd(cnt + eb, 1u); list[(size_t)eb * T_ + pb] = t * 2 + 1;
        wt[t * 2] = w0; wt[t * 2 + 1] = w1;
    }
}

enum { PH_PREP = 0, PH_PROJ, PH_CMP1, PH_CMP2, PH_NSA, PH_OUT, PH_LN1, PH_WQ, PH_XATTN, PH_WO, PH_LN2, PH_ROUTER, PH_ROUTE, PH_MOE1, PH_MOE2, PH_LN3, PH_COUNT };

__global__ void __launch_bounds__(NTHREADS, 2) fwd_megakernel(Params p) {
    extern __shared__ __attribute__((aligned(16))) char smem[];
    cg::grid_group grid = cg::this_grid();
    volatile LAS unsigned* bar_st = (volatile LAS unsigned*)(smem + LDS_BYTES - 16);
    if (threadIdx.x < 2) bar_st[threadIdx.x] = 0u;
    __syncthreads();
    xcd_barrier_post((unsigned*)(p.ws + WS_CTL) + CW_BAR);
    const int lo = p.ph_lo, hi = p.ph_hi;
#ifndef PHMASK
#define PHMASK 0xFFFFFFFFu
#endif
#define IN(k) (lo <= (k) && (k) < hi && ((PHMASK >> (k)) & 1u))
#define SEAM(k) do { if (IN(k) && IN((k) + 1)) { if ((k) == 0) grid.sync(); else xcd_barrier((unsigned*)(p.ws + WS_CTL) + CW_BAR, (volatile LAS unsigned*)(smem + LDS_BYTES - 16)); } } while (0)
    if (IN(PH_PREP)) for (int r = 0; r < REP_PREP; ++r) phase_prep(p, smem);
    SEAM(PH_PREP);
    if (IN(PH_PROJ)) { for (int r = 0; r < REP_PROJ; ++r) gemm_job<J_PROJ>(p, smem); for (int r = 0; r < REP_SMALL; ++r) gemm_job<J_MEMKV>(p, smem); }
    SEAM(PH_PROJ);
    if (IN(PH_CMP1)) { for (int r = 0; r < REP_SMALL; ++r) gemm_job<J_CMP1>(p, smem); for (int r = 0; r < REP_CONV; ++r) phase_conv(p); }
    SEAM(PH_CMP1);
    if (IN(PH_CMP2)) for (int r = 0; r < REP_SMALL; ++r) gemm_job<J_CMP2>(p, smem);
    SEAM(PH_CMP2);
    if (IN(PH_NSA)) { conv_finish(p); for (int r = 0; r < REP_NSA; ++r) phase_nsa(p, smem, r); }
    SEAM(PH_NSA);
    if (IN(PH_OUT)) for (int r = 0; r < REP_OUT; ++r) gemm_job<J_OUT>(p, smem);
    SEAM(PH_OUT);
    if (IN(PH_LN1)) phase_ln<0>(p);
    SEAM(PH_LN1);
    if (IN(PH_WQ)) { gemm_job<J_WQ>(p, smem); for (int r = 1; r < REP_WQ; ++r) gemm_job<J_WQ, WQ_VAR>(p, smem); }
    SEAM(PH_WQ);
    if (IN(PH_XATTN)) for (int r = 0; r < REP_XATTN; ++r) phase_xattn(p, smem);
    SEAM(PH_XATTN);
    if (IN(PH_WO)) gemm_job<J_WO>(p, smem);
    SEAM(PH_WO);
    if (IN(PH_LN2)) phase_ln<1>(p);
    SEAM(PH_LN2);
    if (IN(PH_ROUTER)) for (int r = 0; r < REP_SMALL; ++r) gemm_job<J_ROUTER>(p, smem);
    SEAM(PH_ROUTER);
    if (IN(PH_ROUTE)) phase_route(p);
    SEAM(PH_ROUTE);
    if (IN(PH_MOE1)) for (int r = 0; r < REP_MOE; ++r) gemm_job<J_MOE1>(p, smem);
    SEAM(PH_MOE1);
    if (IN(PH_MOE2)) for (int r = 0; r < REP_MOE; ++r) gemm_job<J_MOE2>(p, smem);
    SEAM(PH_MOE2);
    if (IN(PH_LN3)) phase_ln<2>(p);
#undef IN
#undef SEAM
}

#ifndef N_SPLIT
#define N_SPLIT 1
#endif

extern "C" void kernel_launch(void* const* d_in, const int* in_sizes, int n_in, void* d_out, int out_size, void* d_ws, size_t ws_size, hipStream_t stream) {
    static int grid_blocks = 0;
    if (grid_blocks == 0) {
        if (n_in != 35 || ws_size < WS_END || out_size != T_ * D_) { fprintf(stderr, "kernel_launch: unexpected sizes n_in %d ws %zu out %d\n", n_in, ws_size, out_size); grid_blocks = -1; return; }
        int dev = 0, cus = 0, per_cu = 0;
        hipGetDevice(&dev);
        hipDeviceGetAttribute(&cus, hipDeviceAttributeMultiprocessorCount, dev);
        hipFuncSetAttribute((const void*)fwd_megakernel, hipFuncAttributeMaxDynamicSharedMemorySize, LDS_BYTES);
        hipOccupancyMaxActiveBlocksPerMultiprocessor(&per_cu, (const void*)fwd_megakernel, NTHREADS, LDS_BYTES);
        if (per_cu < 1) { fprintf(stderr, "kernel_launch: occupancy query says %d blocks per CU\n", per_cu); grid_blocks = -1; return; }
        if (per_cu > 2) per_cu = 2;
        grid_blocks = cus * per_cu;
        fprintf(stderr, "kernel_launch: %d CUs x %d blocks\n", cus, per_cu);
    }
    if (grid_blocks < 0) return;
    hipMemsetAsync((char*)d_ws + WS_CTL, 0, 1 * MiB, stream);
    Params p{};
    for (int i = 0; i < 35; ++i) p.in[i] = (const float*)d_in[i];
    p.out = (float*)d_out; p.ws = (unsigned char*)d_ws;
    if (N_SPLIT == 1) {
        p.ph_lo = 0; p.ph_hi = PH_COUNT;
        void* args[] = {&p};
        hipError_t e = hipLaunchCooperativeKernel((const void*)fwd_megakernel, dim3(grid_blocks), dim3(NTHREADS), args, LDS_BYTES, stream);
        if (e != hipSuccess) fprintf(stderr, "cooperative launch failed: %s (grid %d)\n", hipGetErrorString(e), grid_blocks);
    } else {
        for (int ph = 0; ph < PH_COUNT; ++ph) {
            p.ph_lo = ph; p.ph_hi = ph + 1;
            void* args[] = {&p};
            hipError_t e = hipLaunchCooperativeKernel((const void*)fwd_megakernel, dim3(grid_blocks), dim3(NTHREADS), args, LDS_BYTES, stream);
            if (e != hipSuccess) fprintf(stderr, "launch %d failed: %s\n", ph, hipGetErrorString(e));
        }
    }
}
```

```cpp
#include <hip/hip_runtime.h>
#include <hip/hip_cooperative_groups.h>
#include <cstdio>
#include <cstdint>
namespace cg = cooperative_groups;

#define DEVI __device__ __forceinline__
#ifndef REP_PREP
#define REP_PREP 1
#define REP_PROJ 1
#define REP_NSA 1
#define REP_WQ 1
#define WQ_VAR 3
#define REP_XATTN 1
#define REP_MOE 1
#define REP_LN3 1
#define REP_CONV 1
#define REP_OUT 1
#define REP_SMALL 1
#endif
#ifndef NSA_REP_MODE
#define NSA_REP_MODE 0
#endif
#ifndef TSTAMP_PHASE
#define TSTAMP_PHASE -1
#endif
#ifndef PROBE
#define PROBE 0
#endif
typedef unsigned short bf16_t;
typedef __attribute__((ext_vector_type(8))) short bf16x8;
typedef __attribute__((ext_vector_type(4))) float f32x4;
typedef __attribute__((ext_vector_type(16))) float f32x16;
typedef __attribute__((ext_vector_type(4))) unsigned u32x4;
typedef __attribute__((ext_vector_type(2))) unsigned u32x2;

constexpr int T_ = 32768, D_ = 2048, S_ = 8192, NB_ = 4;
constexpr int NPROJ = 4736;
constexpr int IN_COLS = 4656;
constexpr float ALPHA = 1.189207115002721f;
constexpr float LOG2E = 1.4426950408889634f;
constexpr float LN_EPS = 1e-5f;
constexpr int NTHREADS = 512;
constexpr int LDS_BYTES = 147968;

constexpr size_t MiB = 1ull << 20;
constexpr size_t WS_CTL = 0;
constexpr size_t WS_STATS = 1 * MiB;
constexpr size_t WS_C1BIAS = WS_STATS + 256 * 1024;
constexpr size_t WS_WTOK = WS_STATS + 512 * 1024;
constexpr size_t WS_LOGITS = 2 * MiB;
constexpr size_t WS_LIST = 7 * MiB;
constexpr size_t WS_WC1 = 11 * MiB;
constexpr size_t WS_WC2 = 13 * MiB;
constexpr size_t WS_WR = 14 * MiB;
constexpr size_t WS_WIN = 15 * MiB;
constexpr size_t WS_WOUT = 34 * MiB;
constexpr size_t WS_WQ = 42 * MiB;
constexpr size_t WS_WKV = 50 * MiB;
constexpr size_t WS_WO = 66 * MiB;
constexpr size_t WS_WGU = 74 * MiB;
constexpr size_t WS_WD = 202 * MiB;
constexpr size_t WS_BUFA = 266 * MiB;
constexpr size_t WS_BUFB = 394 * MiB;
constexpr size_t WS_BUFC = 522 * MiB;
constexpr size_t WS_BUFD = 650 * MiB;
constexpr size_t WS_END = 778 * MiB;
constexpr size_t C_KCMP = 0, C_VCMP = 16 * MiB, C_KS = 32 * MiB, C_VST = 48 * MiB, C_KW = 64 * MiB, C_VWT = 80 * MiB,
                 C_GATES = 96 * MiB, C_HID = 102 * MiB, C_KC = 110 * MiB, C_VCT = 111 * MiB;
constexpr int CW_CNT = 64;
constexpr int CW_NSA = 1024;
constexpr int CW_TR = 2048;
constexpr int CW_BAR = 4096;
constexpr size_t CTL_U1 = 65536, CTL_C1 = 73728;
constexpr size_t WS_RSUM1 = WS_LOGITS;

struct Params {
    const float* in[35];
    float* out;
    unsigned char* ws;
    int ph_lo, ph_hi;
};

DEVI unsigned cvt_pk_bf16(float lo, float hi) { unsigned r; asm("v_cvt_pk_bf16_f32 %0, %1, %2" : "=v"(r) : "v"(lo), "v"(hi)); return r; }
DEVI bf16_t f2bf(float x) { return (bf16_t)(cvt_pk_bf16(x, 0.f) & 0xffffu); }
DEVI float bf2f(unsigned b) { return __uint_as_float(b << 16); }
DEVI void glds16(const void* g, void* l) {
    __builtin_amdgcn_global_load_lds((const __attribute__((address_space(1))) void*)g, (__attribute__((address_space(3))) void*)l, 16, 0, 0);
}
DEVI f32x16 mfma32(bf16x8 a, bf16x8 b, f32x16 c) { return __builtin_amdgcn_mfma_f32_32x32x16_bf16(a, b, c, 0, 0, 0); }
DEVI f32x4 mfma16(bf16x8 a, bf16x8 b, f32x4 c) { return __builtin_amdgcn_mfma_f32_16x16x32_bf16(a, b, c, 0, 0, 0); }
DEVI float fexp2(float x) { return __builtin_amdgcn_exp2f(x); }
DEVI float wave_sum(float v) {
#pragma unroll
    for (int o = 1; o < 64; o <<= 1) v += __shfl_xor(v, o);
    return v;
}
DEVI float sigmoidf_(float x) { return 1.f / (1.f + __expf(-x)); }
DEVI float gelu_tanh(float x) {
    const float u = 0.7978845608028654f * (x + 0.044715f * x * x * x);
    const float e = __expf(2.f * u);
    const float th = 1.f - 2.f / (e + 1.f);
    return 0.5f * x * (1.f + th);
}

#define LAS __attribute__((address_space(3)))
#define XB_TMO      128
#define XB_XCNT(j)  (256  + 64 * (j))
#define XB_XSUB(j)  (1280 + 64 * (j))
#define XB_XGEN(j)  (2304 + 64 * (j))
#define XB_TOP      3328
#define XB_TOPGEN   3392
#define XB_SPIN_CAP (1u << 22)
DEVI unsigned xb_ld(unsigned* p) { return __hip_atomic_load(p, __ATOMIC_RELAXED, __HIP_MEMORY_SCOPE_AGENT); }
DEVI unsigned xb_add(unsigned* p, unsigned v) { return __hip_atomic_fetch_add(p, v, __ATOMIC_RELAXED, __HIP_MEMORY_SCOPE_AGENT); }
DEVI unsigned xb_xcc_id() { return (unsigned)__builtin_amdgcn_s_getreg((3 << 11) | 20) & 0xFu; }
#define XB_SPIN(cond, bar) do { unsigned _sp = 0; while (cond) { __builtin_amdgcn_s_sleep(1); \
    if ((++_sp & 255u) == 0u) { if (xb_ld(&(bar)[XB_TMO])) break; if (_sp > XB_SPIN_CAP) { atomicAdd(&(bar)[XB_TMO], 1u); break; } } } } while (0)
DEVI void xcd_barrier_post(unsigned* bar) {
    if (threadIdx.x == 0) (void)xb_add(&bar[XB_XCNT(xb_xcc_id())], 1u);
}
DEVI void xcd_barrier_complete(unsigned* bar, unsigned x, unsigned& nloc, unsigned& nx) {
    const unsigned G = gridDim.x * gridDim.y * gridDim.z;
    unsigned sum, cnt, mine, sp = 0u;
    for (;;) {
        sum = 0u; cnt = 0u; mine = 0u;
#pragma unroll
        for (unsigned j = 0; j < 16; ++j) { const unsigned c = xb_ld(&bar[XB_XCNT(j)]); sum += c; cnt += (c > 0u) ? 1u : 0u; mine = (j == x) ? c : mine; }
        if (sum == G) break;
        __builtin_amdgcn_s_sleep(1);
        if ((++sp & 255u) == 0u) { if (xb_ld(&bar[XB_TMO])) break; if (sp > XB_SPIN_CAP) { atomicAdd(&bar[XB_TMO], 1u); break; } }
    }
    nloc = mine > 0u ? mine : 1u; nx = cnt > 0u ? cnt : 1u;
}
DEVI void xcd_barrier(unsigned* bar, volatile LAS unsigned* st) {
    asm volatile("s_waitcnt vmcnt(0)" ::: "memory");
    __syncthreads();
    if (threadIdx.x == 0) {
        const unsigned x = xb_xcc_id();
        __builtin_amdgcn_s_waitcnt(0);
        unsigned nloc = st[0], nx = st[1];
        if (nloc == 0u) { xcd_barrier_complete(bar, x, nloc, nx); st[0] = nloc; st[1] = nx; }
        const unsigned old = xb_add(&bar[XB_XSUB(x)], 1u);
        const unsigned gen = old / nloc;
        if (old + 1u == (gen + 1u) * nloc) {
            __builtin_amdgcn_fence(__ATOMIC_RELEASE, "agent");
            asm volatile("s_waitcnt vmcnt(0)" ::: "memory");
            const unsigned og = xb_add(&bar[XB_TOP], 1u);
            const unsigned tg = og / nx;
            if (og + 1u == (tg + 1u) * nx) xb_add(&bar[XB_TOPGEN], 1u);
            else XB_SPIN(xb_ld(&bar[XB_TOPGEN]) == tg, bar);
            __builtin_amdgcn_fence(__ATOMIC_ACQUIRE, "agent");
            xb_add(&bar[XB_XGEN(x)], 1u);
            asm volatile("s_waitcnt vmcnt(0)" ::: "memory");
        } else {
            XB_SPIN(xb_ld(&bar[XB_XGEN(x)]) == gen, bar);
            __builtin_amdgcn_fence(__ATOMIC_ACQUIRE, "agent");
            asm volatile("s_waitcnt vmcnt(0)" ::: "memory");
        }
    }
    __syncthreads();
}

DEVI void row_load(const float* row, int lane, f32x4 (&v)[8]) {
#pragma unroll
    for (int c = 0; c < 8; ++c) v[c] = *(const f32x4*)(row + c * 256 + lane * 4);
}
DEVI void row_stats(const f32x4 (&v)[8], float& mean, float& rstd) {
    float s = 0.f;
#pragma unroll
    for (int c = 0; c < 8; ++c) s += (v[c].x + v[c].y) + (v[c].z + v[c].w);
    mean = wave_sum(s) * (1.f / D_);
    float q = 0.f;
#pragma unroll
    for (int c = 0; c < 8; ++c) { const f32x4 d = v[c] - mean; q += (d.x * d.x + d.y * d.y) + (d.z * d.z + d.w * d.w); }
    rstd = 1.f / sqrtf(wave_sum(q) * (1.f / D_) + LN_EPS);
}

DEVI const float* wsrc_col(const Params& p, int mat, int e, int n, int& ld) {
    switch (mat) {
    case 0: {
        ld = IN_COLS;
        if (n < 2560) return p.in[4] + n;
        if (n < 2688) { const int j = n - 2560; return j < 48 ? p.in[4] + 2560 + j : nullptr; }
        const int r = n - 2688, grp = r >> 6, within = r & 63;
        const int ch = grp * 32 + (within & 31), isg = within >> 5;
        return p.in[4] + 2608 + isg * 1024 + ch;
    }
    case 1: ld = 256; return p.in[6] + n;
    case 2: ld = 256; return p.in[9] + n;
    case 3: ld = 64; return n < 64 ? p.in[7] + n : nullptr;
    case 4: ld = 64; return n < 64 ? p.in[10] + n : nullptr;
    case 5: ld = 2048; return p.in[16] + n;
    case 6: ld = 2048; return p.in[21] + n;
    case 7: ld = 4096; return p.in[22] + n;
    case 8: ld = 2048; return p.in[23] + n;
    case 9: if (n < 4) { ld = 4; return p.in[26] + n; } if (n < 36) { ld = 32; return p.in[28] + (n - 4); } ld = 1; return nullptr;
    case 10: { ld = 512; const int grp = n >> 6, within = n & 63; const int ch = grp * 32 + (within & 31);
               return ((within >> 5) ? p.in[31] : p.in[30]) + (size_t)e * 2048 * 512 + ch; }
    default: ld = 2048; return p.in[32] + (size_t)e * 512 * 2048 + n;
    }
}
DEVI void wave_transpose_item(const Params& p, char* smem, int mat, int e, int ntile, int ktile, bf16_t* dst, bf16_t* dst_lo, int K,
                                const float* gvec = nullptr, const float* bvec = nullptr, float* U = nullptr, float* C = nullptr) {
    int tid = threadIdx.x; asm volatile("" : "+v"(tid));
    const int lane = tid & 63, w = tid >> 6;
    float* tile = (float*)smem + w * (64 * 65 + 32);
    const int k0 = ktile * 64;
    if (mat == 9) {
        int ld; const float* src = wsrc_col(p, mat, e, ntile * 64 + lane, ld);
#pragma unroll 8
        for (int k = 0; k < 64; ++k) tile[k * 65 + lane] = src ? src[(size_t)(k0 + k) * ld] : 0.f;
    } else {
        const int c4 = lane & 15, kr = lane >> 4;
        int ld; const float* src = wsrc_col(p, mat, e, ntile * 64 + c4 * 4, ld);
        f32x4 v[16];
#pragma unroll
        for (int i = 0; i < 16; ++i) v[i] = src ? *(const f32x4*)(src + (size_t)(k0 + kr + 4 * i) * ld) : (f32x4){0.f, 0.f, 0.f, 0.f};
#pragma unroll
        for (int i = 0; i < 16; ++i) { float* q = tile + (kr + 4 * i) * 65 + c4 * 4; q[0] = v[i].x; q[1] = v[i].y; q[2] = v[i].z; q[3] = v[i].w; }
    }
    asm volatile("s_waitcnt lgkmcnt(0)" ::: "memory");
    if (gvec) {
        float us = 0.f, cs = 0.f;
#pragma unroll 8
        for (int k = 0; k < 64; ++k) { const float wkn = tile[k * 65 + lane]; us += gvec[k0 + k] * wkn; cs += bvec[k0 + k] * wkn; }
        atomicAdd(U + ntile * 64 + lane, us); atomicAdd(C + ntile * 64 + lane, cs);
    }
    const int kc = lane & 7, nr = lane >> 3;
#pragma unroll
    for (int c = 0; c < 8; ++c) {
        const int n = nr + 8 * c;
        float wv[8];
#pragma unroll
        for (int j = 0; j < 8; ++j) wv[j] = tile[(kc * 8 + j) * 65 + n];
        if (gvec) {
#pragma unroll
            for (int j = 0; j < 8; ++j) wv[j] *= gvec[k0 + kc * 8 + j]; }
        u32x4 o; o.x = cvt_pk_bf16(wv[0], wv[1]); o.y = cvt_pk_bf16(wv[2], wv[3]); o.z = cvt_pk_bf16(wv[4], wv[5]); o.w = cvt_pk_bf16(wv[6], wv[7]);
        const size_t off = (size_t)(ntile * 64 + n) * K + k0 + kc * 8;
        if (!dst_lo) *(u32x4*)(dst + off) = o;
        else {
            float r[8];
#pragma unroll
            for (int j = 0; j < 8; ++j) r[j] = wv[j] - bf2f((unsigned)f2bf(wv[j]));
            u32x4 l; l.x = cvt_pk_bf16(r[0], r[1]); l.y = cvt_pk_bf16(r[2], r[3]); l.z = cvt_pk_bf16(r[4], r[5]); l.w = cvt_pk_bf16(r[6], r[7]);
            const size_t o0 = (size_t)n * K + k0 + kc * 8, o1 = (size_t)(64 + n) * K + k0 + kc * 8;
            if (ntile == 0) { *(u32x4*)(dst + o0) = o; *(u32x4*)(dst_lo + o0) = o; *(u32x4*)(dst + o1) = l; }
            else *(u32x4*)(dst_lo + o1) = (u32x4){0u, 0u, 0u, 0u};
        }
    }
    asm volatile("s_waitcnt lgkmcnt(0)" ::: "memory");
}

DEVI void phase_prep(const Params& p, char* smem) {
    int tid = threadIdx.x; asm volatile("" : "+v"(tid));
    const int lane = tid & 63, w = tid >> 6;
    unsigned char* ws = p.ws;
    for (int r = blockIdx.x; r < 8; r += gridDim.x) {
        const int type = r >> 2, n = (r & 3) * 64 + lane;
        const float* pe = p.in[type ? 8 : 5]; const float* w1 = p.in[type ? 9 : 6];
        float sacc = 0.f;
        for (int k = w * 256; k < (w + 1) * 256; ++k) sacc += pe[k] * w1[(size_t)k * 256 + n];
        float* red = (float*)smem;
        __syncthreads();
        red[w * 64 + lane] = sacc;
        __syncthreads();
        if (w == 0) ((float*)(ws + WS_C1BIAS))[type * 256 + n] = ((red[lane] + red[64 + lane]) + (red[128 + lane] + red[192 + lane])) + ((red[256 + lane] + red[320 + lane]) + (red[384 + lane] + red[448 + lane]));
        __syncthreads();
    }
    constexpr int I_LN = T_, I_MEM = 1024;
    constexpr int I_M0 = 74 * 32, I_M12 = 4 * 32, I_M34 = 2 * 4, I_SQ = 32 * 32, I_KV = 64 * 32, I_R = 2 * 32;
    constexpr int TOTAL = I_LN + I_MEM + I_M0 + 2 * I_M12 + 2 * I_M34 + 3 * I_SQ + I_KV + I_R;
    const int gw = blockIdx.x * 8 + w, NW = gridDim.x * 8;
    for (int it = gw; it < TOTAL; it += NW) {
        int r = it;
        if (r < I_LN) {
            const int t = r;
            f32x4 v[8]; row_load(p.in[0] + (size_t)t * D_, lane, v);
            float mean, rstd; row_stats(v, mean, rstd);
            bf16_t* hb = (bf16_t*)(ws + WS_BUFA) + (size_t)t * D_;
#pragma unroll
            for (int c = 0; c < 8; ++c) {
                const int col = c * 256 + lane * 4;
                const f32x4 g = *(const f32x4*)(p.in[2] + col), b = *(const f32x4*)(p.in[3] + col);
                const f32x4 y = (v[c] - mean) * rstd * g + b;
                u32x2 o; o.x = cvt_pk_bf16(y.x, y.y); o.y = cvt_pk_bf16(y.z, y.w);
                *(u32x2*)(hb + col) = o;
            }
            if (lane == 0) { float* st = (float*)(ws + WS_STATS); st[t * 2] = mean; st[t * 2 + 1] = rstd; }
            continue;
        }
        r -= I_LN;
        if (r < I_MEM) {
            const int t = r;
            f32x4 v[8]; row_load(p.in[1] + (size_t)t * D_, lane, v);
            float mean, rstd; row_stats(v, mean, rstd);
            bf16_t* hb = (bf16_t*)(ws + WS_BUFD) + (size_t)t * D_;
#pragma unroll
            for (int c = 0; c < 8; ++c) {
                const int col = c * 256 + lane * 4;
                const f32x4 g = *(const f32x4*)(p.in[19] + col), b = *(const f32x4*)(p.in[20] + col);
                const f32x4 y = (v[c] - mean) * rstd * g + b;
                u32x2 o; o.x = cvt_pk_bf16(y.x, y.y); o.y = cvt_pk_bf16(y.z, y.w);
                *(u32x2*)(hb + col) = o;
            }
            continue;
        }
        r -= I_MEM;
        if (r < I_M0) { wave_transpose_item(p, smem, 0, 0, r / 32, r % 32, (bf16_t*)(ws + WS_WIN), nullptr, 2048); continue; } r -= I_M0;
        if (r < I_M12) { wave_transpose_item(p, smem, 1, 0, r / 32, r % 32, (bf16_t*)(ws + WS_WC1), nullptr, 2048); continue; } r -= I_M12;
        if (r < I_M12) { wave_transpose_item(p, smem, 2, 0, r / 32, r % 32, (bf16_t*)(ws + WS_WC1) + 256 * 2048, nullptr, 2048); continue; } r -= I_M12;
        if (r < I_M34) { wave_transpose_item(p, smem, 3, 0, r / 4, r % 4, (bf16_t*)(ws + WS_WC2), nullptr, 256); continue; } r -= I_M34;
        if (r < I_M34) { wave_transpose_item(p, smem, 4, 0, r / 4, r % 4, (bf16_t*)(ws + WS_WC2) + 128 * 256, nullptr, 256); continue; } r -= I_M34;
        if (r < I_SQ) { wave_transpose_item(p, smem, 5, 0, r / 32, r % 32, (bf16_t*)(ws + WS_WOUT), nullptr, 2048); continue; } r -= I_SQ;
        if (r < I_SQ) { wave_transpose_item(p, smem, 6, 0, r / 32, r % 32, (bf16_t*)(ws + WS_WQ), nullptr, 2048, p.in[17], p.in[18], (float*)(ws + WS_CTL + CTL_U1), (float*)(ws + WS_CTL + CTL_C1)); continue; } r -= I_SQ;
        if (r < I_KV) { wave_transpose_item(p, smem, 7, 0, r / 32, r % 32, (bf16_t*)(ws + WS_WKV), nullptr, 2048); continue; } r -= I_KV;
        if (r < I_SQ) { wave_transpose_item(p, smem, 8, 0, r / 32, r % 32, (bf16_t*)(ws + WS_WO), nullptr, 2048); continue; } r -= I_SQ;
        wave_transpose_item(p, smem, 9, 0, r / 32, r % 32, (bf16_t*)(ws + WS_WR), (bf16_t*)(ws + WS_WR) + 128 * 2048, 2048);
    }
    __syncthreads();
}

constexpr int MOE_W_ITEMS = 32 * 16 * 32 + 32 * 32 * 8;
DEVI void moe_weight_item(const Params& p, char* smem, int r) {
    unsigned char* ws = p.ws;
    if (r < 32 * 16 * 32) { const int e = r / 512, q = r % 512; wave_transpose_item(p, smem, 10, e, q / 32, q % 32, (bf16_t*)(ws + WS_WGU) + (size_t)e * 1024 * 2048, nullptr, 2048); }
    else { r -= 32 * 16 * 32; const int e = r / 256, q = r % 256; wave_transpose_item(p, smem, 11, e, q / 8, q % 8, (bf16_t*)(ws + WS_WD) + (size_t)e * 2048 * 512, nullptr, 512); }
}

enum { J_PROJ = 0, J_MEMKV, J_CMP1, J_CMP2, J_OUT, J_WQ, J_WO, J_ROUTER, J_MOE1, J_MOE2 };
constexpr int GEMM_STAGE_BYTES = 49152;
constexpr int GEMM_TP = 3 * GEMM_STAGE_BYTES;

template <int job, int VAR = 0>
DEVI void gemm_job(const Params& p, char* smem) {
    unsigned char* ws = p.ws;
    int tid = threadIdx.x; asm volatile("" : "+v"(tid));
    const int lane = tid & 63, w = tid >> 6, wr = w >> 1, wc = w & 1, fr = lane & 15, fq = lane >> 4;
    const int srow = tid >> 3, schunk = (tid & 7) ^ ((tid >> 4) & 7);
    int* tp = (int*)(smem + GEMM_TP);
    int MT = 0, NT = 0, K = 2048, nseg = 1, ntiles = 0, RT = 0;
    switch (job) {
    case J_PROJ: MT = 128; NT = 37; break;
    case J_MEMKV: MT = 4; NT = 32; break;
    case J_CMP1: MT = 64; NT = 2; break;
    case J_CMP2: MT = 64; NT = 1; K = 256; break;
    case J_OUT: case J_WQ: case J_WO: MT = 128; NT = 16; break;
    case J_ROUTER: MT = 128; NT = 1; nseg = 2; break;
    default: break;
    }
    const unsigned* cntw = (const unsigned*)(ws + WS_CTL) + CW_CNT;
    if (job == J_MOE1 || job == J_MOE2) {
        __syncthreads();
        if (tid == 0) { int acc = 0; for (int e = 0; e < 32; ++e) { tp[e] = acc; const int c = (int)__hip_atomic_load(cntw + e, __ATOMIC_RELAXED, __HIP_MEMORY_SCOPE_AGENT); tp[33 + e] = c; acc += (c + 255) >> 8; } tp[32] = acc; }
        __syncthreads();
        RT = tp[32];
        NT = (job == J_MOE1) ? 8 : 16; K = (job == J_MOE1) ? 2048 : 512;
        { int mx = 0;
#pragma unroll
          for (int x = 0; x < 8; ++x) { int t = 0;
#pragma unroll
              for (int k = 0; k < 4; ++k) t += (tp[33 + x + 8 * k] + 255) >> 8;
              mx = t > mx ? t : mx; }
          ntiles = mx * NT * 8; }
    } else {
        const int nsr = (MT + 7) >> 3;
        ntiles = (MT < 64) ? MT * NT : ((nsr + 7) >> 3) * 8 * NT * 8;
    }
    int my_tp = 0, my_cnt = 0;
    if (job == J_MOE1 || job == J_MOE2) { my_tp = tp[lane & 31]; my_cnt = tp[33 + (lane & 31)]; }
    const int nk = K >> 6, ntot = nseg * nk;

    for (int ti = blockIdx.x; ti < ntiles; ti += gridDim.x) {
        int mt, nt, e = 0, rt = 0, ecnt = 0, etp = 0;
        if (job == J_MOE1 || job == J_MOE2) {
            const int x = ti & 7; int jj = ti >> 3; bool found = false; mt = 0; nt = 0;
#pragma unroll
            for (int k = 0; k < 4; ++k) {
                const int ee = x + 8 * k;
                const int c = __shfl(my_cnt, ee), rtc = (c + 255) >> 8, tot = rtc * NT;
                if (!found) { if (jj < tot) { found = true; e = ee; ecnt = c; etp = __shfl(my_tp, ee); const int per = 4 * rtc, ng = jj / per, r2 = jj - ng * per; nt = ng * 4 + r2 / rtc; rt = r2 - (r2 / rtc) * rtc; } else jj -= tot; }
            }
            if (!found) continue;
        } else {
            if (MT < 64) { nt = ti / MT; mt = ti - nt * MT; }
            else {
                const int x = ti & 7, jj = ti >> 3, per = 8 * NT, srl = jj / per, idx = jj - srl * per;
                mt = (srl * 8 + x) * 8 + (idx & 7); nt = idx >> 3;
                if (mt >= MT) continue;
            }
        }
        const bf16_t* ap[4]; const bf16_t* bp[2];
#pragma unroll
        for (int r = 0; r < 4; ++r) {
            const int row = r * 64 + srow;
            const bf16_t* a;
            switch (job) {
            case J_PROJ: a = (const bf16_t*)(ws + WS_BUFA) + (size_t)(mt * 256 + row) * 2048; break;
            case J_MEMKV: a = (const bf16_t*)(ws + WS_BUFD) + (size_t)(mt * 256 + row) * 2048; break;
            case J_CMP1: { const int gi = mt >> 1, i = (mt & 1) * 256 + row, ic = i < 510 ? i : 510; const int type = gi >> 4, bh = gi & 15;
                a = (const bf16_t*)(ws + WS_BUFC + (type ? C_VCMP : C_KCMP)) + ((size_t)bh * 8192 + 16 * ic) * 64; break; }
            case J_CMP2: a = (const bf16_t*)(ws + WS_BUFC + C_HID) + (size_t)(mt * 256 + row) * 256; break;
            case J_OUT: a = (const bf16_t*)(ws + WS_BUFA) + (size_t)(mt * 256 + row) * 2048; break;
            case J_WQ: a = (const bf16_t*)(ws + WS_BUFB) + (size_t)(mt * 256 + row) * 2048; break;
            case J_WO: a = (const bf16_t*)(ws + WS_BUFA) + (size_t)(mt * 256 + row) * 2048; break;
            case J_ROUTER: a = (const bf16_t*)(ws + WS_BUFA) + (size_t)(mt * 256 + row) * 2048; break;
            case J_MOE1: { int pos = rt * 256 + row; if (pos >= ecnt) pos = 0; const int aid = ((const int*)(ws + WS_LIST))[(size_t)e * T_ + pos];
                a = (const bf16_t*)(ws + WS_BUFA) + (size_t)(aid >> 1) * 2048; break; }
            default: a = (const bf16_t*)(ws + WS_BUFB) + (size_t)((etp + rt) * 256 + row) * 512; break;
            }
            ap[r] = a + schunk * 8;
        }
#pragma unroll
        for (int r = 0; r < 2; ++r) {
            const int row = r * 64 + srow;
            const bf16_t* b;
            switch (job) {
            case J_PROJ: b = (const bf16_t*)(ws + WS_WIN) + (size_t)(nt * 128 + row) * 2048; break;
            case J_MEMKV: b = (const bf16_t*)(ws + WS_WKV) + (size_t)(nt * 128 + row) * 2048; break;
            case J_CMP1: b = (const bf16_t*)(ws + WS_WC1) + (size_t)(mt >> 5) * 256 * 2048 + (size_t)(nt * 128 + row) * 2048; break;
            case J_CMP2: b = (const bf16_t*)(ws + WS_WC2) + (size_t)(mt >> 5) * 128 * 256 + (size_t)row * 256; break;
            case J_OUT: b = (const bf16_t*)(ws + WS_WOUT) + (size_t)(nt * 128 + row) * 2048; break;
            case J_WQ: b = (const bf16_t*)(ws + WS_WQ) + (size_t)(nt * 128 + row) * 2048; break;
            case J_WO: b = (const bf16_t*)(ws + WS_WO) + (size_t)(nt * 128 + row) * 2048; break;
            case J_ROUTER: b = (const bf16_t*)(ws + WS_WR) + (size_t)row * 2048; break;
            case J_MOE1: b = (const bf16_t*)(ws + WS_WGU) + (size_t)e * 1024 * 2048 + (size_t)(nt * 128 + row) * 2048; break;
            default: b = (const bf16_t*)(ws + WS_WD) + (size_t)e * 2048 * 512 + (size_t)(nt * 128 + row) * 512; break;
            }
            bp[r] = b + schunk * 8;
        }
        const long a_seg1 = (long)(WS_BUFB - WS_BUFA) / 2;
        const long b_seg2 = 128 * 2048;

        f32x4 acc[4][4];
#pragma unroll
        for (int i = 0; i < 4; ++i)
#pragma unroll
            for (int j = 0; j < 4; ++j) acc[i][j] = (f32x4){0.f, 0.f, 0.f, 0.f};

#define GEMM_STAGE(kt_) do { const int _kt = (kt_); int _seg = 0, _k0 = _kt << 6; if (nseg > 1) { _seg = _kt / nk; _k0 = (_kt - _seg * nk) << 6; } \
            const long _ao = (_seg == 1) ? a_seg1 : 0, _bo = (_seg == 1) ? b_seg2 : 0; \
            char* _A = smem + (_kt % 3) * GEMM_STAGE_BYTES; char* _B = _A + 32768; \
            _Pragma("unroll") for (int r = 0; r < 4; ++r) glds16(ap[r] + _ao + _k0, _A + (r * 512 + tid) * 16); \
            _Pragma("unroll") for (int r = 0; r < 2; ++r) glds16(bp[r] + _bo + _k0, _B + (r * 512 + tid) * 16); } while (0)

        f32x4 pre[8];
        if (job == J_OUT || job == J_WO) {
            const float* src = (job == J_OUT) ? p.in[0] : p.out;
#pragma unroll
            for (int i = 0; i < 8; ++i) pre[i] = *(const f32x4*)(src + (size_t)(mt * 256 + (tid >> 5) + 16 * i) * D_ + nt * 128 + (tid & 31) * 4);
        }
        GEMM_STAGE(0);
        if (ntot > 1) GEMM_STAGE(1);
        for (int kt = 0; kt < ntot; ++kt) {
            if (kt + 1 < ntot) asm volatile("s_waitcnt vmcnt(6)" ::: "memory"); else asm volatile("s_waitcnt vmcnt(0)" ::: "memory");
            __builtin_amdgcn_s_barrier();
            asm volatile("" ::: "memory");
            if (kt + 2 < ntot && VAR != 1) GEMM_STAGE(kt + 2);
            if (VAR == 2) continue;
            const char* A = smem + (kt % 3) * GEMM_STAGE_BYTES; const char* B = A + 32768;
#pragma unroll
            for (int ks = 0; ks < 2; ++ks) {
                bf16x8 af[4], bfr[4];
                const int coff = ((4 * ks + fq) ^ (fr >> 1)) * 16;
#pragma unroll
                for (int i = 0; i < 4; ++i) {
                    af[i] = *(const bf16x8*)(A + (wr * 64 + i * 16 + fr) * 128 + coff);
                    bfr[i] = *(const bf16x8*)(B + (wc * 64 + i * 16 + fr) * 128 + coff);
                }
#pragma unroll
                for (int i = 0; i < 4; ++i)
#pragma unroll
                    for (int j = 0; j < 4; ++j) acc[i][j] = mfma16(bfr[j], af[i], acc[i][j]);
            }
        }
#undef GEMM_STAGE
        if (VAR != 0 && VAR != 4) { if (acc[0][0].x == 123.456f) p.out[0] = acc[1][1].y + acc[2][2].z + acc[3][3].w; __syncthreads(); continue; }
        asm volatile("s_waitcnt lgkmcnt(0)" ::: "memory"); __builtin_amdgcn_s_barrier(); asm volatile("" ::: "memory");
        float* ep = (float*)smem;
#pragma unroll
        for (int mi = 0; mi < 4; ++mi)
#pragma unroll
            for (int ni = 0; ni < 4; ++ni) *(f32x4*)(ep + (wr * 64 + mi * 16 + fr) * 132 + wc * 64 + ni * 16 + fq * 4) = acc[mi][ni];
        asm volatile("s_waitcnt lgkmcnt(0)" ::: "memory"); __builtin_amdgcn_s_barrier(); asm volatile("" ::: "memory");
        const int row0 = mt * 256, col0 = nt * 128;
#define EP8(row_, c8_, v0_, v1_) const f32x4 v0_ = *(const f32x4*)(ep + (row_) * 132 + (c8_) * 8), v1_ = *(const f32x4*)(ep + (row_) * 132 + (c8_) * 8 + 4)
#define PK8(o_, v0_, v1_) u32x4 o_; o_.x = cvt_pk_bf16(v0_.x, v0_.y); o_.y = cvt_pk_bf16(v0_.z, v0_.w); o_.z = cvt_pk_bf16(v1_.x, v1_.y); o_.w = cvt_pk_bf16(v1_.z, v1_.w)
        switch (job) {
        case J_PROJ: {
            if (nt < 8) {
                bf16_t* Q = (bf16_t*)(ws + WS_BUFB);
#pragma unroll
                for (int i = 0; i < 8; ++i) { const int c = tid + 512 * i, row = c >> 4, c8 = c & 15; EP8(row, c8, a0, a1);
                    const f32x4 b0 = a0 * (0.125f * LOG2E), b1 = a1 * (0.125f * LOG2E); PK8(o, b0, b1);
                    *(u32x4*)(Q + (size_t)(row0 + row) * 1024 + col0 + c8 * 8) = o; }
            } else if (nt < 20) {
                const int reg = (nt - 8) >> 1;
                bf16_t* dst = (bf16_t*)(ws + WS_BUFC + (reg == 0 ? C_KCMP : reg == 1 ? C_VCMP : reg == 2 ? C_KS : reg == 3 ? C_VST : reg == 4 ? C_KW : C_VWT));
                const int b = row0 >> 13, s0 = row0 & 8191;
                if (reg != 3 && reg != 5) {
#pragma unroll
                    for (int i = 0; i < 8; ++i) { const int c = tid + 512 * i, row = c >> 4, c8 = c & 15; EP8(row, c8, a0, a1); PK8(o, a0, a1);
                        const int bh = b * 4 + ((nt - 8) & 1) * 2 + (c8 >> 3);
                        *(u32x4*)(dst + ((size_t)bh * 8192 + s0 + row) * 64 + (c8 & 7) * 8) = o; }
                } else {
#pragma unroll
                    for (int i = 0; i < 8; ++i) { const int c = tid + 512 * i, tg = c & 31, dcol = c >> 5;
                        const int rb = (tg >> 1) * 16 + (tg & 1) * 4;
                        float v[8];
#pragma unroll
                        for (int j = 0; j < 8; ++j) v[j] = ep[(rb + (j & 3) + (j >> 2) * 8) * 132 + dcol];
                        u32x4 o; o.x = cvt_pk_bf16(v[0], v[1]); o.y = cvt_pk_bf16(v[2], v[3]); o.z = cvt_pk_bf16(v[4], v[5]); o.w = cvt_pk_bf16(v[6], v[7]);
                        const int bh = b * 4 + ((nt - 8) & 1) * 2 + (dcol >> 6);
                        *(u32x4*)(dst + ((size_t)bh * 64 + (dcol & 63)) * 8192 + s0 + tg * 8) = o; }
                }
            } else if (nt == 20) {
                float* G = (float*)(ws + WS_BUFC + C_GATES);
#pragma unroll
                for (int i = 0; i < 6; ++i) { const int c = tid + 512 * i, row = c / 12, c4 = c - row * 12;
                    const f32x4 v = *(const f32x4*)(ep + row * 132 + c4 * 4); f32x4 o; o.x = sigmoidf_(v.x); o.y = sigmoidf_(v.y); o.z = sigmoidf_(v.z); o.w = sigmoidf_(v.w);
                    *(f32x4*)(G + (size_t)(row0 + row) * 48 + c4 * 4) = o; }
            } else {
                bf16_t* Hg = (bf16_t*)(ws + WS_BUFB + 64 * MiB);
#pragma unroll
                for (int i = 0; i < 4; ++i) { const int c = tid + 512 * i, row = c >> 3, c8 = c & 7, hh = c8 >> 2, cc = (c8 & 3) * 8;
                    const f32x4 a0 = *(const f32x4*)(ep + row * 132 + hh * 64 + cc), a1 = *(const f32x4*)(ep + row * 132 + hh * 64 + cc + 4);
                    const f32x4 g0 = *(const f32x4*)(ep + row * 132 + hh * 64 + 32 + cc), g1 = *(const f32x4*)(ep + row * 132 + hh * 64 + 32 + cc + 4);
                    u32x4 o; o.x = cvt_pk_bf16(a0.x * sigmoidf_(g0.x), a0.y * sigmoidf_(g0.y)); o.y = cvt_pk_bf16(a0.z * sigmoidf_(g0.z), a0.w * sigmoidf_(g0.w));
                    o.z = cvt_pk_bf16(a1.x * sigmoidf_(g1.x), a1.y * sigmoidf_(g1.y)); o.w = cvt_pk_bf16(a1.z * sigmoidf_(g1.z), a1.w * sigmoidf_(g1.w));
                    *(u32x4*)(Hg + (size_t)(row0 + row) * 1024 + ((nt - 21) * 2 + hh) * 32 + cc) = o; }
            }
        } break;
        case J_MEMKV: {
            const int b = mt;
            if (nt < 16) {
                bf16_t* Kx = (bf16_t*)(ws + WS_BUFD + 4 * MiB);
                const int head = col0 >> 9, d0 = col0 & 511;
#pragma unroll
                for (int i = 0; i < 8; ++i) { const int c = tid + 512 * i, row = c >> 4, c8 = c & 15; EP8(row, c8, a0, a1); PK8(o, a0, a1);
                    *(u32x4*)(Kx + ((size_t)(b * 4 + head) * 256 + row) * 512 + d0 + c8 * 8) = o; }
            } else {
                bf16_t* Vt = (bf16_t*)(ws + WS_BUFD + 8 * MiB);
                const int n2 = col0 - 2048, head = n2 >> 9, d0 = n2 & 511;
#pragma unroll
                for (int i = 0; i < 8; ++i) { const int c = tid + 512 * i, tg = c & 31, dcol = c >> 5;
                    float v[8];
#pragma unroll
                    for (int j = 0; j < 8; ++j) v[j] = ep[(tg * 8 + j) * 132 + dcol];
                    u32x4 o; o.x = cvt_pk_bf16(v[0], v[1]); o.y = cvt_pk_bf16(v[2], v[3]); o.z = cvt_pk_bf16(v[4], v[5]); o.w = cvt_pk_bf16(v[6], v[7]);
                    *(u32x4*)(Vt + ((size_t)(b * 4 + head) * 512 + d0 + dcol) * 256 + tg * 8) = o; }
            }
        } break;
        case J_CMP1: {
            const int type = mt >> 5;
            const float* bias = (const float*)(ws + WS_C1BIAS) + type * 256;
            bf16_t* Hd = (bf16_t*)(ws + WS_BUFC + C_HID);
            const f32x4 b0 = *(const f32x4*)(bias + col0 + (tid & 15) * 8), b1 = *(const f32x4*)(bias + col0 + (tid & 15) * 8 + 4);
#pragma unroll
            for (int i = 0; i < 8; ++i) { const int c = tid + 512 * i, row = c >> 4, c8 = c & 15; EP8(row, c8, a0, a1);
                u32x4 o; o.x = cvt_pk_bf16(gelu_tanh(a0.x + b0.x), gelu_tanh(a0.y + b0.y)); o.y = cvt_pk_bf16(gelu_tanh(a0.z + b0.z), gelu_tanh(a0.w + b0.w));
                o.z = cvt_pk_bf16(gelu_tanh(a1.x + b1.x), gelu_tanh(a1.y + b1.y)); o.w = cvt_pk_bf16(gelu_tanh(a1.z + b1.z), gelu_tanh(a1.w + b1.w));
                *(u32x4*)(Hd + (size_t)(row0 + row) * 256 + col0 + c8 * 8) = o; }
        } break;
        case J_CMP2: {
            const int gi = mt >> 1, type = gi >> 4, bh = gi & 15, i0 = (mt & 1) * 256;
            if (type == 0) {
                bf16_t* Kc = (bf16_t*)(ws + WS_BUFC + C_KC);
#pragma unroll
                for (int i = 0; i < 4; ++i) { const int c = tid + 512 * i, row = c >> 3, c8 = c & 7; EP8(row, c8, a0, a1); PK8(o, a0, a1);
                    if (i0 + row >= 511) o = (u32x4){0u, 0u, 0u, 0u};
                    *(u32x4*)(Kc + ((size_t)bh * 512 + i0 + row) * 64 + c8 * 8) = o; }
            } else {
                bf16_t* Vc = (bf16_t*)(ws + WS_BUFC + C_VCT);
#pragma unroll
                for (int i = 0; i < 4; ++i) { const int c = tid + 512 * i, tg = c & 31, d = c >> 5;
                    const int rb = (tg >> 1) * 16 + (tg & 1) * 4;
                    float v[8];
#pragma unroll
                    for (int j = 0; j < 8; ++j) { const int r = rb + (j & 3) + (j >> 2) * 8; v[j] = (i0 + r >= 511) ? 0.f : ep[r * 132 + d]; }
                    u32x4 o; o.x = cvt_pk_bf16(v[0], v[1]); o.y = cvt_pk_bf16(v[2], v[3]); o.z = cvt_pk_bf16(v[4], v[5]); o.w = cvt_pk_bf16(v[6], v[7]);
                    *(u32x4*)(Vc + ((size_t)bh * 64 + d) * 512 + i0 + tg * 8) = o; }
            }
        } break;
        case J_OUT: {
            const float* st = (const float*)(ws + WS_STATS);
            const int c4 = tid & 31, n = col0 + c4 * 4;
            const f32x4 g = *(const f32x4*)(p.in[2] + n), bb = *(const f32x4*)(p.in[3] + n);
#pragma unroll
            for (int hlf = 0; hlf < 2; ++hlf) {
                f32x4 xv[8]; float2 sm[8];
#pragma unroll
                for (int i = 0; i < 8; ++i) { const int row = (tid >> 5) + 16 * (hlf * 8 + i), t = row0 + row;
                    xv[i] = hlf ? *(const f32x4*)(p.in[0] + (size_t)t * D_ + n) : pre[i]; sm[i] = *(const float2*)(st + t * 2); }
#pragma unroll
                for (int i = 0; i < 8; ++i) { const int row = (tid >> 5) + 16 * (hlf * 8 + i), t = row0 + row;
                    const f32x4 v = *(const f32x4*)(ep + row * 132 + c4 * 4);
                    const f32x4 y = ((xv[i] - sm[i].x) * sm[i].y * g + bb) * ALPHA + v;
                    *(f32x4*)(p.out + (size_t)t * D_ + n) = y;
                    u32x2 yb; yb.x = cvt_pk_bf16(y.x, y.y); yb.y = cvt_pk_bf16(y.z, y.w);
                    *(u32x2*)((bf16_t*)(ws + WS_BUFB) + (size_t)t * D_ + n) = yb;
                    float rs = (y.x + y.y) + (y.z + y.w), rq = (y.x * y.x + y.y * y.y) + (y.z * y.z + y.w * y.w);
#pragma unroll
                    for (int o = 1; o < 32; o <<= 1) { rs += __shfl_xor(rs, o); rq += __shfl_xor(rq, o); }
                    if ((tid & 31) == 0) { float* rsum = (float*)(ws + WS_RSUM1) + (size_t)t * 2; atomicAdd(rsum, rs); atomicAdd(rsum + 1, rq); } }
            }
        } break;
        case J_WQ: {
            bf16_t* Qx = (bf16_t*)(ws + WS_BUFC);
            const float sc = 0.04419417382415922f * LOG2E;
            const float* U = (const float*)(ws + WS_CTL + CTL_U1); const float* Cv = (const float*)(ws + WS_CTL + CTL_C1);
            const float* rsum = (const float*)(ws + WS_RSUM1);
            const int c8 = tid & 15, n = col0 + c8 * 8;
            const f32x4 u0 = *(const f32x4*)(U + n), u1 = *(const f32x4*)(U + n + 4), c0 = *(const f32x4*)(Cv + n), c1 = *(const f32x4*)(Cv + n + 4);
            float2 rsq[8];
#pragma unroll
            for (int i = 0; i < 8; ++i) rsq[i] = *(const float2*)(rsum + (size_t)(row0 + (tid >> 4) + 32 * i) * 2);
#pragma unroll
            for (int i = 0; i < 8; ++i) { const int row = (tid >> 4) + 32 * i; EP8(row, c8, a0, a1);
                const int t = row0 + row;
                const float mean = rsq[i].x * (1.f / D_); float var = rsq[i].y * (1.f / D_) - mean * mean; var = var > 0.f ? var : 0.f;
                const float rstd = __builtin_amdgcn_rsqf(var + LN_EPS), mr = mean * rstd;
                const f32x4 b0 = (a0 * rstd - u0 * mr + c0) * sc, b1 = (a1 * rstd - u1 * mr + c1) * sc; PK8(o, b0, b1);
                *(u32x4*)(Qx + (size_t)t * 2048 + n) = o; }
        } break;
        case J_WO: {
            const float* st = (const float*)(ws + WS_STATS);
            const int c4 = tid & 31, n = col0 + c4 * 4;
            const f32x4 g = *(const f32x4*)(p.in[17] + n), bb = *(const f32x4*)(p.in[18] + n);
#pragma unroll
            for (int hlf = 0; hlf < 2; ++hlf) {
                f32x4 rv[8]; float2 sm[8];
#pragma unroll
                for (int i = 0; i < 8; ++i) { const int row = (tid >> 5) + 16 * (hlf * 8 + i), t = row0 + row;
                    rv[i] = hlf ? *(const f32x4*)(p.out + (size_t)t * D_ + n) : pre[i]; const float2 rsq = *(const float2*)((const float*)(ws + WS_RSUM1) + (size_t)t * 2);
                    const float mean = rsq.x * (1.f / D_); float var = rsq.y * (1.f / D_) - mean * mean; var = var > 0.f ? var : 0.f;
                    sm[i] = make_float2(mean, 1.f / sqrtf(var + LN_EPS)); }
#pragma unroll
                for (int i = 0; i < 8; ++i) { const int row = (tid >> 5) + 16 * (hlf * 8 + i), t = row0 + row;
                    const f32x4 v = *(const f32x4*)(ep + row * 132 + c4 * 4);
                    *(f32x4*)(p.out + (size_t)t * D_ + n) = ((rv[i] - sm[i].x) * sm[i].y * g + bb) * ALPHA + v; }
            }
        } break;
        case J_ROUTER: {
            if (tid < 256) {
                const int row = tid, t = row0 + row;
                const float* er = ep + row * 132;
                unsigned* cnt = (unsigned*)(ws + WS_CTL) + CW_CNT;
                int* list = (int*)(ws + WS_LIST);
                float* wt = (float*)(ws + WS_WTOK);
                float lg[4];
#pragma unroll
                for (int i = 0; i < 4; ++i) lg[i] = er[i] + er[64 + i] + p.in[27][i];
                int grp = 0; float best = lg[0];
#pragma unroll
                for (int i = 1; i < 4; ++i) if (lg[i] > best) { best = lg[i]; grp = i; }
                float se = 0.f;
#pragma unroll
                for (int i = 0; i < 4; ++i) se += expf(lg[i] - best);
                const float wgrp = 1.f / se;
                float le[8];
#pragma unroll
                for (int i = 0; i < 8; ++i) le[i] = er[4 + grp * 8 + i] + er[68 + grp * 8 + i] + p.in[29][grp * 8 + i];
                int i0 = 0; float v0 = le[0];
#pragma unroll
                for (int i = 1; i < 8; ++i) if (le[i] > v0) { v0 = le[i]; i0 = i; }
                int i1 = -1; float v1 = -INFINITY;
#pragma unroll
                for (int i = 0; i < 8; ++i) if (i != i0 && le[i] > v1) { v1 = le[i]; i1 = i; }
                const float ex = expf(v1 - v0);
                const float w0 = wgrp / (1.f + ex), w1 = wgrp * ex / (1.f + ex);
                const int ea = grp * 8 + i0, eb = grp * 8 + i1;
                const unsigned pa = atomicAdd(cnt + ea, 1u); list[(size_t)ea * T_ + pa] = t * 2;
                const unsigned pb = atomicAdd(cnt + eb, 1u); list[(size_t)eb * T_ + pb] = t * 2 + 1;
                wt[t * 2] = w0; wt[t * 2 + 1] = w1;
            }
        } break;
        case J_MOE1: {
            bf16_t* H = (bf16_t*)(ws + WS_BUFB);
#pragma unroll
            for (int i = 0; i < 4; ++i) { const int c = tid + 512 * i, row = c >> 3, c8 = c & 7, hh = c8 >> 2, cc = (c8 & 3) * 8;
                const f32x4 g0 = *(const f32x4*)(ep + row * 132 + hh * 64 + cc), g1 = *(const f32x4*)(ep + row * 132 + hh * 64 + cc + 4);
                const f32x4 u0 = *(const f32x4*)(ep + row * 132 + hh * 64 + 32 + cc), u1 = *(const f32x4*)(ep + row * 132 + hh * 64 + 32 + cc + 4);
                u32x4 o; o.x = cvt_pk_bf16(g0.x * sigmoidf_(g0.x) * u0.x, g0.y * sigmoidf_(g0.y) * u0.y); o.y = cvt_pk_bf16(g0.z * sigmoidf_(g0.z) * u0.z, g0.w * sigmoidf_(g0.w) * u0.w);
                o.z = cvt_pk_bf16(g1.x * sigmoidf_(g1.x) * u1.x, g1.y * sigmoidf_(g1.y) * u1.y); o.w = cvt_pk_bf16(g1.z * sigmoidf_(g1.z) * u1.z, g1.w * sigmoidf_(g1.w) * u1.w);
                *(u32x4*)(H + ((size_t)(etp + rt) * 256 + row) * 512 + (nt * 2 + hh) * 32 + cc) = o; }
        } break;
        default: {
            bf16_t* Y = (bf16_t*)(ws + WS_BUFC);
            const float* wt = (const float*)(ws + WS_WTOK);
            const int c8 = tid & 15;
            int aid[8]; float wv[8];
#pragma unroll
            for (int i = 0; i < 8; ++i) { const int pos = rt * 256 + (tid >> 4) + 32 * i; aid[i] = (pos < ecnt) ? ((const int*)(ws + WS_LIST))[(size_t)e * T_ + pos] : -1; }
#pragma unroll
            for (int i = 0; i < 8; ++i) wv[i] = (aid[i] >= 0) ? wt[aid[i]] : 0.f;
#pragma unroll
            for (int i = 0; i < 8; ++i) { const int row = (tid >> 4) + 32 * i;
                if (aid[i] >= 0) { EP8(row, c8, a0, a1); const f32x4 b0 = a0 * wv[i], b1 = a1 * wv[i]; PK8(o, b0, b1);
                    *(u32x4*)(Y + (size_t)aid[i] * 2048 + col0 + c8 * 8) = o; } }
        } break;
        }
#undef EP8
#undef PK8
        asm volatile("s_waitcnt lgkmcnt(0)" ::: "memory"); __builtin_amdgcn_s_barrier(); asm volatile("" ::: "memory");
    }
}

DEVI void phase_conv(const Params& p) {
    unsigned char* ws = p.ws;
    int tid = threadIdx.x; asm volatile("" : "+v"(tid));
    const int lane = tid & 63, w = tid >> 6;
    const int c0 = tid * 2;
    const bf16_t* Hg = (const bf16_t*)(ws + WS_BUFB + 64 * MiB);
    float* pre = p.out;
    float* cst = (float*)(ws + WS_LIST);
    float wgt[31][2];
    { const float* wp = p.in[12] + c0;
#pragma unroll
      for (int k = 0; k < 31; ++k) { const float2 v = *(const float2*)wp; wgt[k][0] = v.x; wgt[k][1] = v.y; wp += 1024; asm volatile("" : "+v"(wp)); } }
    const float2 cb = *(const float2*)(p.in[13] + c0);
    for (int it = blockIdx.x; it < T_ / 16; it += gridDim.x) {
        const int t0 = it * 16, s0 = t0 & 8191;
        float acc[16][2];
#pragma unroll
        for (int j = 0; j < 16; ++j) { acc[j][0] = cb.x; acc[j][1] = cb.y; }
        const bf16_t* xp = Hg + ((long)t0 - 30) * 1024 + c0;
#pragma unroll
        for (int i = 0; i < 46; ++i) {
            const int s = s0 - 30 + i;
            float x0 = 0.f, x1 = 0.f;
            if (s >= 0) { const unsigned u = *(const unsigned*)xp; x0 = bf2f(u & 0xffffu); x1 = bf2f(u >> 16); }
            xp += 1024; asm volatile("" : "+v"(xp));
#pragma unroll
            for (int j = 0; j < 16; ++j) { const int k = i - j; if (k >= 0 && k <= 30) { acc[j][0] += wgt[k][0] * x0; acc[j][1] += wgt[k][1] * x1; } }
        }
#pragma unroll
        for (int j = 0; j < 16; ++j) {
            *(float2*)(pre + (size_t)(t0 + j) * 1024 + c0) = make_float2(acc[j][0], acc[j][1]);
            const float sv = wave_sum(acc[j][0] + acc[j][1]);
            const float qv = wave_sum(acc[j][0] * acc[j][0] + acc[j][1] * acc[j][1]);
            if (lane == 0) *(float2*)(cst + ((size_t)(t0 + j) * 8 + w) * 2) = make_float2(sv, qv);
        }
    }
}
DEVI void conv_finish(const Params& p) {
    unsigned char* ws = p.ws;
    int tid = threadIdx.x; asm volatile("" : "+v"(tid));
    const int lane = tid & 63, w = tid >> 6;
    const float* pre = p.out;
    const float* cst = (const float*)(ws + WS_LIST);
    bf16_t* CC = (bf16_t*)(ws + WS_BUFA);
    for (int it = blockIdx.x; it < T_ / 8; it += gridDim.x) {
        const int t = it * 8 + w;
        float sv = 0.f, qv = 0.f;
#pragma unroll
        for (int k = 0; k < 8; ++k) { const float2 a = *(const float2*)(cst + ((size_t)t * 8 + k) * 2); sv += a.x; qv += a.y; }
        const float mean = sv * (1.f / 1024.f);
        float var = qv * (1.f / 1024.f) - mean * mean; var = var > 0.f ? var : 0.f;
        const float rstd = 1.f / sqrtf(var + LN_EPS);
#pragma unroll
        for (int c = 0; c < 4; ++c) {
            const int col = c * 256 + lane * 4;
            const f32x4 x = *(const f32x4*)(pre + (size_t)t * 1024 + col), g = *(const f32x4*)(p.in[14] + col), bb = *(const f32x4*)(p.in[15] + col);
            f32x4 y = (x - mean) * rstd * g + bb;
            y.x *= sigmoidf_(y.x); y.y *= sigmoidf_(y.y); y.z *= sigmoidf_(y.z); y.w *= sigmoidf_(y.w);
            u32x2 o; o.x = cvt_pk_bf16(y.x, y.y); o.y = cvt_pk_bf16(y.z, y.w);
            *(u32x2*)(CC + (size_t)t * 2048 + 1024 + col) = o;
        }
    }
}

enum { M_CMP = 0, M_SEL = 1, M_WIN = 2 };
constexpr int KSTR = 72;
constexpr int NSA_KBUF = 0, NSA_VBUF = 49152;
constexpr int NSA_IMP = 98304;
constexpr int NSA_TBL = 132096;
constexpr int NSA_SEL = NSA_TBL + 4096;
constexpr int NSA_UNIT = NSA_SEL + 1024;

DEVI void attn_issue(char* kdst, char* vdst, const bf16_t* kt, const bf16_t* vt, int vstride, int tid) {
    const int row = tid >> 3, c = (tid & 7) ^ ((row >> 1) & 7);
    glds16(kt + row * 64 + c * 8, kdst + tid * 16);
    glds16(vt + (size_t)row * vstride + c * 8, vdst + tid * 16);
}

constexpr float NSA_THR = 8.f;
template <int MODE, int PASS>
DEVI void nsa_branch(char* smem, const bf16_t* kg, const bf16_t* vg, int vstride, int t_lo, int t_hi, int far_lo, int far_hi, const bf16x8 (&qf)[4], int tq,
                     float c31, const LAS float* tblg, const LAS unsigned* selrow, float& m_ref, bool& mset, f32x16& lacc, float inv_l, f32x16 (&o)[2], LAS float* imp_row) {
    int tid = threadIdx.x; asm volatile("" : "+v"(tid));
    const int lane = tid & 63, l31 = lane & 31, h = lane >> 5, xs = (l31 >> 1) & 7;
    const int n = t_hi - t_lo + 1;
    f32x16 cneg;
    { const float cc = c31 - m_ref;
#pragma unroll
      for (int i = 0; i < 16; ++i) cneg[i] = cc; }
    u32x4 ones_u; ones_u.x = ones_u.y = ones_u.z = ones_u.w = 0x3F803F80u;
    const bf16x8 ones = __builtin_bit_cast(bf16x8, ones_u);
    float imp_carry = 0.f;
    const int nS = (n + 1) >> 1;
#define NSA_ISSUE_PAIR(js_) do { const int _sl = (js_) % 3; \
        _Pragma("unroll") for (int _sb = 0; _sb < 2; ++_sb) { int _t = t_lo + 2 * (js_) + _sb; _t = _t > t_hi ? t_hi : _t; \
            attn_issue(smem + NSA_KBUF + _sl * 16384 + _sb * 8192, smem + NSA_VBUF + _sl * 16384 + _sb * 8192, kg + (size_t)_t * 4096, vg + _t * 64, vstride, tid); } } while (0)
    NSA_ISSUE_PAIR(0);
    if (nS > 1) NSA_ISSUE_PAIR(1);
    for (int it = 0; it < n; ++it) {
        const int ti = t_lo + it, js = it >> 1, buf = (js % 3) * 2 + (it & 1);
        if ((it & 1) == 0) {
            if (js + 1 < nS) asm volatile("s_waitcnt vmcnt(4)" ::: "memory"); else asm volatile("s_waitcnt vmcnt(0)" ::: "memory");
            __builtin_amdgcn_s_barrier();
            asm volatile("" ::: "memory");
            if (js + 2 < nS) NSA_ISSUE_PAIR(js + 2);
        }
        bool selbit = true;
        if (MODE == M_SEL) { selbit = (selrow[ti >> 5] >> (ti & 31)) & 1u; if (!__any(selbit)) continue; }
        const char* Kc = smem + NSA_KBUF + buf * 8192; const char* Vc = smem + NSA_VBUF + buf * 8192;
        f32x16 s[2];
        {
            const int off0 = (h ^ xs) << 4;
            s[0] = mfma32(*(const bf16x8*)(Kc + l31 * 128 + off0), qf[0], cneg);
            s[1] = mfma32(*(const bf16x8*)(Kc + (32 + l31) * 128 + off0), qf[0], cneg);
        }
#pragma unroll
        for (int ks = 1; ks < 4; ++ks) {
            const int off = ((2 * ks + h) ^ xs) << 4;
            s[0] = mfma32(*(const bf16x8*)(Kc + l31 * 128 + off), qf[ks], s[0]);
            s[1] = mfma32(*(const bf16x8*)(Kc + (32 + l31) * 128 + off), qf[ks], s[1]);
        }
        const bool far = (ti >= far_lo) && (ti <= far_hi);
        {
        if (!far) {
            const int dbase = (MODE == M_CMP) ? (tq - 31 - 1024 * ti) : (tq - 64 * ti);
#pragma unroll
            for (int u = 0; u < 2; ++u)
#pragma unroll
                for (int i = 0; i < 16; ++i) {
                    const int kk = 32 * u + (i & 3) + 8 * (i >> 2) + 4 * h;
                    const int dist = dbase - ((MODE == M_CMP) ? 16 * kk : kk);
                    const int idx = (dist < -1 ? -1 : (dist > 191 ? 191 : dist)) + 64;
                    float v = s[u][i] + tblg[idx];
                    if (MODE == M_WIN) v = (dist < 512) ? v : -INFINITY;
                    if (MODE == M_SEL) v = selbit ? v : -INFINITY;
                    s[u][i] = v;
                    if ((i & 3) == 3) asm volatile("" ::: "memory");
                }
        }
        if (PASS != 2) {
            float mx = fmaxf(s[0][0], s[1][0]);
#pragma unroll
            for (int i = 1; i < 16; ++i) mx = fmaxf(mx, fmaxf(s[0][i], s[1][i]));
            if (MODE == M_SEL && !selbit) mx = -INFINITY;
            if (__any(mx > NSA_THR || (!mset && mx > -INFINITY))) {
                const float mc = fmaxf(mx, __shfl_xor(mx, 32));
                const bool mv = (mc > NSA_THR) || (!mset && mc > -INFINITY);
                const float delta = mv ? mc : 0.f;
                const float alpha = mset ? fexp2(-delta) : 1.f;
                mset = mset || mv;
                m_ref += delta;
                const float cc = c31 - m_ref;
#pragma unroll
                for (int i = 0; i < 16; ++i) { cneg[i] = cc; lacc[i] *= alpha; }
#pragma unroll
                for (int u = 0; u < 2; ++u)
#pragma unroll
                    for (int i = 0; i < 16; ++i) s[u][i] -= delta;
                if (PASS == 0) {
#pragma unroll
                    for (int v = 0; v < 2; ++v)
#pragma unroll
                        for (int i = 0; i < 16; ++i) o[v][i] *= alpha;
                }
            }
        }
#pragma unroll
        for (int u = 0; u < 2; ++u)
#pragma unroll
            for (int i = 0; i < 16; ++i) s[u][i] = fexp2(s[u][i]);
        if (PASS == 2) {
            float mainv[8], halfv[8];
#pragma unroll
            for (int u = 0; u < 2; ++u)
#pragma unroll
                for (int c4 = 0; c4 < 4; ++c4) {
                    float hv = 0.5f * s[u][4 * c4 + 3] * inv_l;
                    float mv = ((s[u][4 * c4] + s[u][4 * c4 + 1]) + s[u][4 * c4 + 2]) * inv_l + hv;
                    mv += __builtin_bit_cast(float, __builtin_amdgcn_update_dpp(0, __builtin_bit_cast(int, mv), 0xB1, 0xF, 0xF, true));
                    hv += __builtin_bit_cast(float, __builtin_amdgcn_update_dpp(0, __builtin_bit_cast(int, hv), 0xB1, 0xF, 0xF, true));
                    mv += __builtin_bit_cast(float, __builtin_amdgcn_update_dpp(0, __builtin_bit_cast(int, mv), 0x4E, 0xF, 0xF, true));
                    hv += __builtin_bit_cast(float, __builtin_amdgcn_update_dpp(0, __builtin_bit_cast(int, hv), 0x4E, 0xF, 0xF, true));
                    mainv[u * 4 + c4] = mv; halfv[u * 4 + c4] = __shfl_xor(hv, 32);
                }
#pragma unroll
            for (int gi = 0; gi < 8; ++gi) {
                const float cin = h ? halfv[gi] : (gi ? halfv[gi - 1] : imp_carry);
                const unsigned ia = (unsigned)(size_t)(imp_row + 16 * ti + 2 * gi + h);
                const float val = mainv[gi] + cin;
                asm volatile("ds_write_b32 %0, %1" :: "v"(ia), "v"(val) : "memory");
            }
            imp_carry = halfv[7];
        }
        const unsigned pmask = (MODE == M_SEL && far && !selbit) ? 0u : 0xFFFFFFFFu;
#pragma unroll
        for (int u = 0; u < 2; ++u)
#pragma unroll
            for (int sI = 0; sI < 2; ++sI) {
                u32x4 pk;
                pk.x = cvt_pk_bf16(s[u][8 * sI + 0], s[u][8 * sI + 1]); pk.y = cvt_pk_bf16(s[u][8 * sI + 2], s[u][8 * sI + 3]);
                pk.z = cvt_pk_bf16(s[u][8 * sI + 4], s[u][8 * sI + 5]); pk.w = cvt_pk_bf16(s[u][8 * sI + 6], s[u][8 * sI + 7]);
                if (MODE == M_SEL) { pk.x &= pmask; pk.y &= pmask; pk.z &= pmask; pk.w &= pmask; }
                const bf16x8 pf = __builtin_bit_cast(bf16x8, pk);
                lacc = mfma32(ones, pf, lacc);
                if (PASS != 1) {
                    const int voff = ((2 * (2 * u + sI) + h) ^ xs) << 4;
                    o[0] = mfma32(*(const bf16x8*)(Vc + l31 * 128 + voff), pf, o[0]);
                    o[1] = mfma32(*(const bf16x8*)(Vc + (32 + l31) * 128 + voff), pf, o[1]);
                }
            }
        }
    }
    if (PASS == 2) {
        const int c = 16 * (t_hi + 1);
        if (h == 0 && c < 128) { const unsigned ia = (unsigned)(size_t)(imp_row + c); asm volatile("ds_write_b32 %0, %1" :: "v"(ia), "v"(imp_carry) : "memory"); }
        asm volatile("s_waitcnt lgkmcnt(0)" ::: "memory");
    }
#undef NSA_ISSUE_PAIR
    __syncthreads();
}

DEVI void phase_nsa(const Params& p, char* smem, int ctr_idx) {
    unsigned char* ws = p.ws;
    const int tid0 = threadIdx.x;
    float* imp = (float*)(smem + NSA_IMP);
    unsigned* tot = (unsigned*)(smem + NSA_IMP);
    float* tbl = (float*)(smem + NSA_TBL);
    unsigned* selm = (unsigned*)(smem + NSA_SEL);
    int* sunit = (int*)(smem + NSA_UNIT);
    unsigned* ctr = (unsigned*)(ws + WS_CTL) + CW_NSA + 256 * ctr_idx;
    unsigned* trc = (unsigned*)(ws + WS_CTL) + CW_TR;
    const bf16_t* Q = (const bf16_t*)(ws + WS_BUFB);
    const float* G = (const float*)(ws + WS_BUFC + C_GATES);
    bf16_t* CC = ctr_idx ? (bf16_t*)(p.out + 32 * 1024 * 1024) : (bf16_t*)(ws + WS_BUFA);
    for (;;) {
        int tid = tid0; asm volatile("" : "+v"(tid));
        const int lane = tid & 63, w = tid >> 6, l31 = lane & 31, h = lane >> 5;
        const int qi = l31 >> 2, g = l31 & 3, ql = 8 * w + qi;
        __syncthreads();
        if (tid == 0) {
            const unsigned x = xb_xcc_id() & 7u; int u = -1;
            for (unsigned k = 0; k < 8u && u < 0; ++k) { const unsigned xx = (x + k) & 7u; const unsigned i = atomicAdd(ctr + 16 * xx, 1u); if (i < 256u) u = (int)(i * 8u + xx); }
            *sunit = u;
        }
        __syncthreads();
        const int unit = *sunit;
        if (unit < 0) break;
        const int xq = unit & 7, iq = unit >> 3;
        const int qt = 127 - (iq >> 1), bh = 2 * xq + (iq & 1), b = bh >> 2, hkv = bh & 3, q0 = qt * 64, cur = qt;
        for (int i = tid; i < 4 * 256; i += 512) {
            const int gg = i >> 8, d = (i & 255) - 64;
            float val = -INFINITY;
            if (d >= 0) {
                int bucket;
                if (d < 16) bucket = d;
                else if (d >= 128) bucket = 31;
                else { const int lg = 16 + (int)(logf((float)d / 16.f) / 2.0794415416798357f * 16.f); bucket = lg < 31 ? lg : 31; }
                val = (p.in[11][bucket * 16 + hkv * 4 + gg] - p.in[11][31 * 16 + hkv * 4 + gg]) * LOG2E;
            }
            tbl[i] = val;
        }
        if (tid < 256) selm[tid] = 0u;
        const int tq = q0 + ql;
        const size_t trow = (size_t)b * 8192 + tq;
        bf16x8 qf[4];
        { const bf16_t* qrow = Q + trow * 1024 + hkv * 256 + g * 64;
#pragma unroll
          for (int ks = 0; ks < 4; ++ks) qf[ks] = *(const bf16x8*)(qrow + 16 * ks + 8 * h); }
        float c31 = p.in[11][31 * 16 + hkv * 4 + g] * LOG2E;
        asm volatile("" : "+v"(qf[0]), "+v"(qf[1]), "+v"(qf[2]), "+v"(qf[3]), "+v"(c31));
        const LAS float* tblg = (const LAS float*)(smem + NSA_TBL) + g * 256;
        const LAS unsigned* selrow = (const LAS unsigned*)(smem + NSA_SEL) + ql * 4;
        f32x16 o[2];
#pragma unroll
        for (int v = 0; v < 2; ++v)
#pragma unroll
            for (int i = 0; i < 16; ++i) o[v][i] = 0.f;
        __syncthreads();
        const bf16_t* kc = (const bf16_t*)(ws + WS_BUFC + C_KC) + (size_t)bh * 512 * 64;
        const bf16_t* vct = (const bf16_t*)(ws + WS_BUFC + C_VCT) + (size_t)bh * 64 * 512;
        const int ct_hi = (q0 + 32) >> 10, cfar_hi = (q0 >= 1167) ? ((q0 - 1167) >> 10) : -1;
        float m_ref = 0.f; bool mset = false;
        f32x16 lacc;
#pragma unroll
        for (int i = 0; i < 16; ++i) lacc[i] = 0.f;
        const int rmode = ctr_idx ? NSA_REP_MODE : 0;
        if (rmode != 2) nsa_branch<M_CMP, 1>(smem, kc, vct, 512, 0, ct_hi, 0, cfar_hi, qf, tq, c31, tblg, selrow, m_ref, mset, lacc, 0.f, o, (LAS float*)(smem + NSA_IMP) + ql * 132);
        { const float lt = lacc[0]; const float inv = lt > 0.f ? 1.f / lt : 0.f;
          if (rmode != 2 && rmode != 4) nsa_branch<M_CMP, 2>(smem, kc, vct, 512, 0, ct_hi, 0, cfar_hi, qf, tq, c31, tblg, selrow, m_ref, mset, lacc, inv, o, (LAS float*)(smem + NSA_IMP) + ql * 132);
#pragma unroll
          for (int v = 0; v < 2; ++v)
#pragma unroll
            for (int i = 0; i < 16; ++i) o[v][i] *= inv; }
        asm volatile("s_waitcnt lgkmcnt(0)" ::: "memory"); __syncthreads();
        if (rmode < 2) {
            const int q = tid >> 3, sub = tid & 7, t = q0 + q;
            unsigned key[16];
#pragma unroll
            for (int i = 0; i < 16; ++i) {
                const int j = sub * 16 + i;
                const bool forced = (j == 0) || (j == cur) || (j == cur - 1);
                const bool valid = (j * 64 <= t);
                const float v = imp[q * 132 + j];
                key[i] = forced ? 0xFFFFFFFFu : (valid ? (__float_as_uint(v) + 1u) : 0u);
            }
            unsigned tau = 0u;
            for (int bit = 31; bit >= 0; --bit) {
                const unsigned cand = tau | (1u << bit);
                int c = 0;
#pragma unroll
                for (int i = 0; i < 16; ++i) c += (key[i] >= cand) ? 1 : 0;
                c += __builtin_amdgcn_update_dpp(0, c, 0xB1, 0xF, 0xF, true); c += __builtin_amdgcn_update_dpp(0, c, 0x4E, 0xF, 0xF, true); c += __builtin_amdgcn_update_dpp(0, c, 0x141, 0xF, 0xF, true);
                if (c >= 16) tau = cand;
            }
            int gt = 0, eq = 0;
#pragma unroll
            for (int i = 0; i < 16; ++i) { gt += (key[i] > tau) ? 1 : 0; eq += (key[i] == tau) ? 1 : 0; }
            int gtt = gt; gtt += __builtin_amdgcn_update_dpp(0, gtt, 0xB1, 0xF, 0xF, true); gtt += __builtin_amdgcn_update_dpp(0, gtt, 0x4E, 0xF, 0xF, true); gtt += __builtin_amdgcn_update_dpp(0, gtt, 0x141, 0xF, 0xF, true);
            int pre = 0;
#pragma unroll
            for (int sI = 0; sI < 7; ++sI) { const int v = __shfl(eq, (lane & ~7) + sI); if (sI < sub) pre += v; }
            const int need = 16 - gtt;
            unsigned bits = 0u; int run = pre;
#pragma unroll
            for (int i = 0; i < 16; ++i) {
                bool sel = key[i] > tau;
                if (tau > 0u && key[i] == tau) { sel = run < need; ++run; }
                bits |= sel ? (1u << i) : 0u;
            }
            atomicOr(&selm[q * 4 + (sub >> 1)], bits << ((sub & 1) * 16));
        }
        __syncthreads();
        const float gc = G[((size_t)b * 8192 + tq) * 48 + hkv * 12 + g * 3 + 0];
#pragma unroll
        for (int v = 0; v < 2; ++v)
#pragma unroll
            for (int i = 0; i < 16; i += 2) { const float gcc = (PROBE == 1 ? 0.f : gc); tot[(v * 8 + (i >> 1)) * 512 + tid] = cvt_pk_bf16(gcc * o[v][i], gcc * o[v][i + 1]); o[v][i] = 0.f; o[v][i + 1] = 0.f; }
        {
            const bf16_t* ks = (const bf16_t*)(ws + WS_BUFC + C_KS) + (size_t)bh * 8192 * 64;
            const bf16_t* vst = (const bf16_t*)(ws + WS_BUFC + C_VST) + (size_t)bh * 64 * 8192;
            m_ref = 0.f; mset = false;
#pragma unroll
            for (int i = 0; i < 16; ++i) lacc[i] = 0.f;
            if (rmode == 0) nsa_branch<M_SEL, 0>(smem, ks, vst, 8192, 0, cur, 0, cur - 3, qf, tq, c31, tblg, selrow, m_ref, mset, lacc, 0.f, o, (LAS float*)nullptr);
            const float gs = G[((size_t)b * 8192 + tq) * 48 + hkv * 12 + g * 3 + 1];
            const float sc = (PROBE == 2 ? 0.f : gs) / lacc[0];
#pragma unroll
            for (int v = 0; v < 2; ++v)
#pragma unroll
                for (int i = 0; i < 16; i += 2) { const unsigned tv = tot[(v * 8 + (i >> 1)) * 512 + tid];
                    tot[(v * 8 + (i >> 1)) * 512 + tid] = cvt_pk_bf16(bf2f(tv & 0xffffu) + sc * o[v][i], bf2f(tv >> 16) + sc * o[v][i + 1]); o[v][i] = 0.f; o[v][i + 1] = 0.f; }
        }
        {
            const bf16_t* kw = (const bf16_t*)(ws + WS_BUFC + C_KW) + (size_t)bh * 8192 * 64;
            const bf16_t* vwt = (const bf16_t*)(ws + WS_BUFC + C_VWT) + (size_t)bh * 64 * 8192;
            m_ref = 0.f; mset = false;
#pragma unroll
            for (int i = 0; i < 16; ++i) lacc[i] = 0.f;
            const int w_lo = cur >= 8 ? cur - 8 : 0;
            if (rmode == 0 || rmode == 2) nsa_branch<M_WIN, 0>(smem, kw, vwt, 8192, w_lo, cur, cur - 7, cur - 3, qf, tq, c31, tblg, selrow, m_ref, mset, lacc, 0.f, o, (LAS float*)nullptr);
            const float gw = G[((size_t)b * 8192 + tq) * 48 + hkv * 12 + g * 3 + 2];
            const float sc = (PROBE == 3 ? 0.f : gw) / lacc[0];
            bf16_t* orow = CC + trow * 2048 + hkv * 256 + g * 64;
#pragma unroll
            for (int v = 0; v < 2; ++v)
#pragma unroll
                for (int c4 = 0; c4 < 4; ++c4) {
                    const unsigned ta = tot[(v * 8 + 2 * c4) * 512 + tid], tb = tot[(v * 8 + 2 * c4 + 1) * 512 + tid];
                    const float r0 = bf2f(ta & 0xffffu) + sc * o[v][4 * c4 + 0], r1 = bf2f(ta >> 16) + sc * o[v][4 * c4 + 1];
                    const float r2 = bf2f(tb & 0xffffu) + sc * o[v][4 * c4 + 2], r3 = bf2f(tb >> 16) + sc * o[v][4 * c4 + 3];
                    u32x2 ov; ov.x = cvt_pk_bf16(r0, r1); ov.y = cvt_pk_bf16(r2, r3);
                    *(u32x2*)(orow + 32 * v + 8 * c4 + 4 * h) = ov;
                }
        }
        if (ctr_idx == 0) {
            __syncthreads();
            for (int k = 0; k < 3; ++k) {
                int item = 0;
                if (lane == 0) item = (int)atomicAdd(trc, 1u);
                item = __builtin_amdgcn_readfirstlane(item);
                if (item >= MOE_W_ITEMS) break;
                moe_weight_item(p, smem, item);
            }
        }
    }
    if (ctr_idx == 0) {
        __syncthreads();
        for (;;) {
            int item = 0;
            if ((threadIdx.x & 63) == 0) item = (int)atomicAdd(trc, 1u);
            item = __builtin_amdgcn_readfirstlane(item);
            if (item >= MOE_W_ITEMS) break;
            moe_weight_item(p, smem, item);
        }
    }
}

template <int which>
DEVI void phase_ln(const Params& p) {
    unsigned char* ws = p.ws;
    int tid = threadIdx.x; asm volatile("" : "+v"(tid));
    const int lane = tid & 63, w = tid >> 6;
    for (int it = blockIdx.x; it < T_ / 8; it += gridDim.x) {
        const int t = it * 8 + w;
        float* row = p.out + (size_t)t * D_;
        f32x4 v[8]; row_load(row, lane, v);
        float mean, rstd; row_stats(v, mean, rstd);
        if (which == 0) {
            if (lane == 0) { float* st = (float*)(ws + WS_STATS); st[t * 2] = mean; st[t * 2 + 1] = rstd; }
            bf16_t* hi = (bf16_t*)(ws + WS_BUFB) + (size_t)t * D_;
#pragma unroll
            for (int c = 0; c < 8; ++c) {
                const int col = c * 256 + lane * 4;
                const f32x4 g = *(const f32x4*)(p.in[17] + col), b = *(const f32x4*)(p.in[18] + col);
                const f32x4 y = (v[c] - mean) * rstd * g + b;
                u32x2 o; o.x = cvt_pk_bf16(y.x, y.y); o.y = cvt_pk_bf16(y.z, y.w);
                *(u32x2*)(hi + col) = o;
            }
        } else if (which == 1) {
            bf16_t* hi = (bf16_t*)(ws + WS_BUFA) + (size_t)t * D_;
            bf16_t* lo = (bf16_t*)(ws + WS_BUFB) + (size_t)t * D_;
#pragma unroll
            for (int c = 0; c < 8; ++c) {
                const int col = c * 256 + lane * 4;
                const f32x4 g = *(const f32x4*)(p.in[24] + col), b = *(const f32x4*)(p.in[25] + col);
                const f32x4 y = (v[c] - mean) * rstd * g + b;
                u32x2 o; o.x = cvt_pk_bf16(y.x, y.y); o.y = cvt_pk_bf16(y.z, y.w);
                *(u32x2*)(hi + col) = o;
                u32x2 ol;
                ol.x = cvt_pk_bf16(y.x - bf2f(o.x & 0xffffu), y.y - bf2f(o.x >> 16));
                ol.y = cvt_pk_bf16(y.z - bf2f(o.y & 0xffffu), y.w - bf2f(o.y >> 16));
                *(u32x2*)(lo + col) = ol;
            }
        } else {
            const bf16_t* y0 = (const bf16_t*)(ws + WS_BUFC) + (size_t)t * 2 * D_;
#pragma unroll
            for (int c = 0; c < 8; ++c) {
                const int col = c * 256 + lane * 4;
                const f32x4 g = *(const f32x4*)(p.in[24] + col), b = *(const f32x4*)(p.in[25] + col);
                const f32x4 x2 = (v[c] - mean) * rstd * g + b;
                const u32x2 a = *(const u32x2*)(y0 + col), bq = *(const u32x2*)(y0 + D_ + col);
                v[c].x = x2.x * ALPHA + (bf2f(a.x & 0xffffu) + bf2f(bq.x & 0xffffu));
                v[c].y = x2.y * ALPHA + (bf2f(a.x >> 16) + bf2f(bq.x >> 16));
                v[c].z = x2.z * ALPHA + (bf2f(a.y & 0xffffu) + bf2f(bq.y & 0xffffu));
                v[c].w = x2.w * ALPHA + (bf2f(a.y >> 16) + bf2f(bq.y >> 16));
            }
            row_stats(v, mean, rstd);
#pragma unroll
            for (int c = 0; c < 8; ++c) {
                const int col = c * 256 + lane * 4;
                const f32x4 g = *(const f32x4*)(p.in[33] + col), b = *(const f32x4*)(p.in[34] + col);
                *(f32x4*)(row + col) = (v[c] - mean) * rstd * g + b;
            }
        }
    }
}

DEVI void phase_xattn(const Params& p, char* smem) {
    unsigned char* ws = p.ws;
    int tid = threadIdx.x; asm volatile("" : "+v"(tid));
    const int lane = tid & 63, w = tid >> 6, l31 = lane & 31, h = lane >> 5;
    const bf16_t* Qx = (const bf16_t*)(ws + WS_BUFC);
    const bf16_t* Kx = (const bf16_t*)(ws + WS_BUFD + 4 * MiB);
    const bf16_t* Vt = (const bf16_t*)(ws + WS_BUFD + 8 * MiB);
    bf16_t* Ox = (bf16_t*)(ws + WS_BUFA);
    const int tid0 = tid;
    for (int unit = blockIdx.x; unit < 512; unit += gridDim.x) {
        int tid = tid0; asm volatile("" : "+v"(tid));
        const int srow = tid >> 2, spc = (tid & 3) ^ ((srow >> 2) & 3);
        const int vrow = tid >> 5, vpc = (tid & 31) ^ (vrow & 7);
        const int qt = unit & 31, head = (unit >> 5) & 3, b = unit >> 7;
        const size_t t0 = (size_t)b * 8192 + qt * 256;
        const bf16_t* kbase = Kx + (size_t)(b * 4 + head) * 256 * 512;
        const bf16_t* vbase = Vt + (size_t)(b * 4 + head) * 512 * 256;
        const bf16_t* qbase = Qx + t0 * 2048 + head * 512;
#define XA_ISSUE(dc_) do { char* _S = smem + ((dc_) & 3) * 32768; \
        _Pragma("unroll") for (int r = 0; r < 2; ++r) { const int row = srow + 128 * r; \
            glds16(qbase + (size_t)row * 2048 + (dc_) * 32 + spc * 8, _S + (r * 512 + tid) * 16); \
            glds16(kbase + (size_t)row * 512 + (dc_) * 32 + spc * 8, _S + 16384 + (r * 512 + tid) * 16); } } while (0)
#define XV_ISSUE(dc_) do { char* _S = smem + ((dc_) & 3) * 32768; \
        _Pragma("unroll") for (int i = 0; i < 4; ++i) { const int row = vrow + 16 * i; \
            glds16(vbase + (size_t)((dc_) * 64 + row) * 256 + vpc * 8, _S + (i * 512 + tid) * 16); } } while (0)
        __syncthreads();
        XA_ISSUE(0); XA_ISSUE(1); XA_ISSUE(2);
        f32x16 s[8];
#pragma unroll
        for (int u = 0; u < 8; ++u)
#pragma unroll
            for (int i = 0; i < 16; ++i) s[u][i] = 0.f;
        for (int dc = 0; dc < 16; ++dc) {
            if (dc < 14) asm volatile("s_waitcnt vmcnt(8)" ::: "memory"); else if (dc == 14) asm volatile("s_waitcnt vmcnt(4)" ::: "memory"); else asm volatile("s_waitcnt vmcnt(0)" ::: "memory");
            __builtin_amdgcn_s_barrier();
            asm volatile("" ::: "memory");
            if (dc + 3 < 16) XA_ISSUE(dc + 3);
            int lo = l31 * 64; asm volatile("" : "+v"(lo));
            const char* Qs = smem + (dc & 3) * 32768 + lo; const char* Ks = Qs + 16384;
#pragma unroll
            for (int ks = 0; ks < 2; ++ks) {
                const int po = ((2 * ks + h) ^ ((l31 >> 2) & 3)) << 4;
                const bf16x8 qb = *(const bf16x8*)(Qs + w * 2048 + po);
#pragma unroll
                for (int u = 0; u < 8; ++u) { const bf16x8 ka = *(const bf16x8*)(Ks + po + u * 2048); s[u] = mfma32(ka, qb, s[u]); }
            }
        }
        asm volatile("s_waitcnt lgkmcnt(0)" ::: "memory"); __builtin_amdgcn_s_barrier(); asm volatile("" ::: "memory");
        XV_ISSUE(0); XV_ISSUE(1); XV_ISSUE(2);
        float mx = -INFINITY;
#pragma unroll
        for (int u = 0; u < 8; ++u)
#pragma unroll
            for (int i = 0; i < 16; ++i) mx = fmaxf(mx, s[u][i]);
        mx = fmaxf(mx, __shfl_xor(mx, 32));
        float ls = 0.f;
        bf16x8 pf[8][2];
#pragma unroll
        for (int u = 0; u < 8; ++u) {
#pragma unroll
            for (int i = 0; i < 16; ++i) { s[u][i] = fexp2(s[u][i] - mx); ls += s[u][i]; }
#pragma unroll
            for (int sI = 0; sI < 2; ++sI) { u32x4 pk;
                pk.x = cvt_pk_bf16(s[u][8 * sI + 0], s[u][8 * sI + 1]); pk.y = cvt_pk_bf16(s[u][8 * sI + 2], s[u][8 * sI + 3]);
                pk.z = cvt_pk_bf16(s[u][8 * sI + 4], s[u][8 * sI + 5]); pk.w = cvt_pk_bf16(s[u][8 * sI + 6], s[u][8 * sI + 7]);
                pf[u][sI] = __builtin_bit_cast(bf16x8, pk); }
        }
        ls += __shfl_xor(ls, 32);
        const float inv = (PROBE == 4 ? 0.f : 1.f) / ls;
        bf16_t* orow = Ox + (t0 + 32 * w + l31) * 2048 + head * 512;
        int xo[8];
#pragma unroll
        for (int j = 0; j < 8; ++j) xo[j] = (j ^ (l31 & 7)) << 4;
        for (int dc = 0; dc < 8; ++dc) {
            if (dc < 6) asm volatile("s_waitcnt vmcnt(8)" ::: "memory"); else if (dc == 6) asm volatile("s_waitcnt vmcnt(4)" ::: "memory"); else asm volatile("s_waitcnt vmcnt(0)" ::: "memory");
            __builtin_amdgcn_s_barrier();
            asm volatile("" ::: "memory");
            if (dc + 3 < 8) XV_ISSUE(dc + 3);
            int lov = l31 * 512 + 8 * h; asm volatile("" : "+v"(lov));
            const char* Vs = smem + (dc & 3) * 32768 + lov;
            f32x16 o[2];
#pragma unroll
            for (int v = 0; v < 2; ++v)
#pragma unroll
                for (int i = 0; i < 16; ++i) o[v][i] = 0.f;
#pragma unroll
            for (int s4 = 0; s4 < 16; ++s4)
#pragma unroll
                for (int v = 0; v < 2; ++v) {
                    const char* vp = Vs + v * 16384 + (s4 >> 2) * 128;
                    const u32x2 a = *(const u32x2*)(vp + xo[(2 * s4) & 7]), bq = *(const u32x2*)(vp + xo[(2 * s4 + 1) & 7]);
                    u32x4 vv; vv.x = a.x; vv.y = a.y; vv.z = bq.x; vv.w = bq.y;
                    o[v] = mfma32(__builtin_bit_cast(bf16x8, vv), pf[s4 >> 1][s4 & 1], o[v]);
                }
#pragma unroll
            for (int v = 0; v < 2; ++v)
#pragma unroll
                for (int c4 = 0; c4 < 4; ++c4) {
                    u32x2 ov; ov.x = cvt_pk_bf16(o[v][4 * c4] * inv, o[v][4 * c4 + 1] * inv); ov.y = cvt_pk_bf16(o[v][4 * c4 + 2] * inv, o[v][4 * c4 + 3] * inv);
                    *(u32x2*)(orow + dc * 64 + 32 * v + 8 * c4 + 4 * h) = ov;
                }
        }
#undef XA_ISSUE
#undef XV_ISSUE
        asm volatile("s_waitcnt vmcnt(0)" ::: "memory");
        __syncthreads();
    }
}

DEVI void phase_route(const Params& p) {
    unsigned char* ws = p.ws;
    const float* L = (const float*)(ws + WS_LOGITS);
    unsigned* cnt = (unsigned*)(ws + WS_CTL) + CW_CNT;
    int* list = (int*)(ws + WS_LIST);
    float* wt = (float*)(ws + WS_WTOK);
    int tid = threadIdx.x; asm volatile("" : "+v"(tid));
    for (int t = blockIdx.x * NTHREADS + tid; t < T_; t += gridDim.x * NTHREADS) {
        const f32x4 lgv = *(const f32x4*)(L + (size_t)t * 40);
        float lg[4] = {lgv.x + p.in[27][0], lgv.y + p.in[27][1], lgv.z + p.in[27][2], lgv.w + p.in[27][3]};
        int grp = 0; float best = lg[0];
#pragma unroll
        for (int i = 1; i < 4; ++i) if (lg[i] > best) { best = lg[i]; grp = i; }
        float se = 0.f;
#pragma unroll
        for (int i = 0; i < 4; ++i) se += expf(lg[i] - best);
        const float wgrp = 1.f / se;
        const f32x4 e0 = *(const f32x4*)(L + (size_t)t * 40 + 4 + grp * 8), e1 = *(const f32x4*)(L + (size_t)t * 40 + 8 + grp * 8);
        const f32x4 b0 = *(const f32x4*)(p.in[29] + grp * 8), b1 = *(const f32x4*)(p.in[29] + grp * 8 + 4);
        float le[8] = {e0.x + b0.x, e0.y + b0.y, e0.z + b0.z, e0.w + b0.w, e1.x + b1.x, e1.y + b1.y, e1.z + b1.z, e1.w + b1.w};
        int i0 = 0; float v0 = le[0];
#pragma unroll
        for (int i = 1; i < 8; ++i) if (le[i] > v0) { v0 = le[i]; i0 = i; }
        int i1 = -1; float v1 = -INFINITY;
#pragma unroll
        for (int i = 0; i < 8; ++i) if (i != i0 && le[i] > v1) { v1 = le[i]; i1 = i; }
        const float ex = expf(v1 - v0);
        const float w0 = wgrp / (1.f + ex), w1 = wgrp * ex / (1.f + ex);
        const int ea = grp * 8 + i0, eb = grp * 8 + i1;
        const unsigned pa = atomicAdd(cnt + ea, 1u); list[(size_t)ea * T_ + pa] = t * 2;
        const unsigned pb = atomicAdd(cnt + eb, 1u); list[(size_t)eb * T_ + pb] = t * 2 + 1;
        wt[t * 2] = w0; wt[t * 2 + 1] = w1;
    }
}

enum { PH_PREP = 0, PH_PROJ, PH_CMP1, PH_CMP2, PH_NSA, PH_OUT, PH_LN1, PH_WQ, PH_XATTN, PH_WO, PH_LN2, PH_ROUTER, PH_ROUTE, PH_MOE1, PH_MOE2, PH_LN3, PH_COUNT };

__global__ void __launch_bounds__(NTHREADS, 2) fwd_megakernel(Params p) {
    extern __shared__ __attribute__((aligned(16))) char smem[];
    cg::grid_group grid = cg::this_grid();
    volatile LAS unsigned* bar_st = (volatile LAS unsigned*)(smem + LDS_BYTES - 16);
    if (threadIdx.x < 2) bar_st[threadIdx.x] = 0u;
    __syncthreads();
    xcd_barrier_post((unsigned*)(p.ws + WS_CTL) + CW_BAR);
    const int lo = p.ph_lo, hi = p.ph_hi;
    unsigned long long ts0 = 0, ts1 = 0;
    if (TSTAMP_PHASE >= 0) ts0 = __builtin_amdgcn_s_memrealtime();
#ifndef PHMASK
#define PHMASK 0xFFFFFFFFu
#endif
#define IN(k) (lo <= (k) && (k) < hi && ((PHMASK >> (k)) & 1u))
#define SEAM(k) do { if (IN(k) && IN((k) + 1)) { if ((k) == 0) grid.sync(); else xcd_barrier((unsigned*)(p.ws + WS_CTL) + CW_BAR, (volatile LAS unsigned*)(smem + LDS_BYTES - 16)); } if ((k) == TSTAMP_PHASE) ts1 = __builtin_amdgcn_s_memrealtime(); } while (0)
    if (IN(PH_PREP)) for (int r = 0; r < REP_PREP; ++r) phase_prep(p, smem);
    SEAM(PH_PREP);
    if (IN(PH_PROJ)) { for (int r = 0; r < REP_PROJ; ++r) gemm_job<J_PROJ>(p, smem); for (int r = 0; r < REP_SMALL; ++r) gemm_job<J_MEMKV>(p, smem); }
    SEAM(PH_PROJ);
    if (IN(PH_CMP1)) { for (int r = 0; r < REP_SMALL; ++r) gemm_job<J_CMP1>(p, smem); for (int r = 0; r < REP_CONV; ++r) phase_conv(p); }
    SEAM(PH_CMP1);
    if (IN(PH_CMP2)) for (int r = 0; r < REP_SMALL; ++r) gemm_job<J_CMP2>(p, smem);
    SEAM(PH_CMP2);
    if (IN(PH_NSA)) { conv_finish(p); for (int r = 0; r < REP_NSA; ++r) phase_nsa(p, smem, r); }
    SEAM(PH_NSA);
    if (IN(PH_OUT)) for (int r = 0; r < REP_OUT; ++r) gemm_job<J_OUT>(p, smem);
    SEAM(PH_OUT);
    if (IN(PH_WQ)) { gemm_job<J_WQ>(p, smem); for (int r = 1; r < REP_WQ; ++r) gemm_job<J_WQ, WQ_VAR>(p, smem); }
    SEAM(PH_WQ);
    if (IN(PH_XATTN)) for (int r = 0; r < REP_XATTN; ++r) phase_xattn(p, smem);
    SEAM(PH_XATTN);
    if (IN(PH_WO)) gemm_job<J_WO>(p, smem);
    SEAM(PH_WO);
    if (IN(PH_LN2)) phase_ln<1>(p);
    SEAM(PH_LN2);
    if (IN(PH_ROUTER)) for (int r = 0; r < REP_SMALL; ++r) gemm_job<J_ROUTER>(p, smem);
    SEAM(PH_ROUTER);
    if (IN(PH_MOE1)) for (int r = 0; r < REP_MOE; ++r) gemm_job<J_MOE1>(p, smem);
    SEAM(PH_MOE1);
    if (IN(PH_MOE2)) for (int r = 0; r < REP_MOE; ++r) gemm_job<J_MOE2>(p, smem);
    SEAM(PH_MOE2);
    if (IN(PH_LN3)) phase_ln<2>(p);
    if (TSTAMP_PHASE >= 0 && blockIdx.x == 0 && threadIdx.x == 0) { const unsigned long long t2 = __builtin_amdgcn_s_memrealtime(); const unsigned long long wait = 4ull * (ts1 - ts0); while (__builtin_amdgcn_s_memrealtime() - t2 < wait) __builtin_amdgcn_s_sleep(32); }
#undef IN
#undef SEAM
}

#ifndef N_SPLIT
#define N_SPLIT 1
#endif

extern "C" void kernel_launch(void* const* d_in, const int* in_sizes, int n_in, void* d_out, int out_size, void* d_ws, size_t ws_size, hipStream_t stream) {
    static int grid_blocks = 0;
    if (grid_blocks == 0) {
        if (n_in != 35 || ws_size < WS_END || out_size != T_ * D_) { fprintf(stderr, "kernel_launch: unexpected sizes n_in %d ws %zu out %d\n", n_in, ws_size, out_size); grid_blocks = -1; return; }
        int dev = 0, cus = 0, per_cu = 0;
        hipGetDevice(&dev);
        hipDeviceGetAttribute(&cus, hipDeviceAttributeMultiprocessorCount, dev);
        hipFuncSetAttribute((const void*)fwd_megakernel, hipFuncAttributeMaxDynamicSharedMemorySize, LDS_BYTES);
        hipOccupancyMaxActiveBlocksPerMultiprocessor(&per_cu, (const void*)fwd_megakernel, NTHREADS, LDS_BYTES);
        if (per_cu < 1) { fprintf(stderr, "kernel_launch: occupancy query says %d blocks per CU\n", per_cu); grid_blocks = -1; return; }
        if (per_cu > 2) per_cu = 2;
        grid_blocks = cus * per_cu;
        fprintf(stderr, "kernel_launch: %d CUs x %d blocks\n", cus, per_cu);
    }
    if (grid_blocks < 0) return;
    hipMemsetAsync((char*)d_ws + WS_CTL, 0, 1 * MiB, stream);
    hipMemsetAsync((char*)d_ws + WS_RSUM1, 0, 1 * MiB, stream);
    Params p{};
    for (int i = 0; i < 35; ++i) p.in[i] = (const float*)d_in[i];
    p.out = (float*)d_out; p.ws = (unsigned char*)d_ws;
    if (N_SPLIT == 1) {
        p.ph_lo = 0; p.ph_hi = PH_COUNT;
        void* args[] = {&p};
        hipError_t e = hipLaunchCooperativeKernel((const void*)fwd_megakernel, dim3(grid_blocks), dim3(NTHREADS), args, LDS_BYTES, stream);
        if (e != hipSuccess) fprintf(stderr, "cooperative launch failed: %s (grid %d)\n", hipGetErrorString(e), grid_blocks);
    } else {
        for (int ph = 0; ph < PH_COUNT; ++ph) {
            p.ph_lo = ph; p.ph_hi = ph + 1;
            void* args[] = {&p};
            hipError_t e = hipLaunchCooperativeKernel((const void*)fwd_megakernel, dim3(grid_blocks), dim3(NTHREADS), args, LDS_BYTES, stream);
            if (e != hipSuccess) fprintf(stderr, "launch %d failed: %s\n", ph, hipGetErrorString(e));
        }
    }
}
```

```cpp
#include <hip/hip_runtime.h>
#include <hip/hip_cooperative_groups.h>
#include <cstdio>
#include <cstdint>
namespace cg = cooperative_groups;

#define DEVI __device__ __forceinline__
#ifndef REP_PREP
#define REP_PREP 1
#define REP_PROJ 1
#define REP_NSA 1
#define REP_WQ 1
#define WQ_VAR 3
#define REP_XATTN 1
#define REP_MOE 1
#define REP_LN3 1
#define REP_CONV 1
#define REP_OUT 1
#define REP_SMALL 1
#endif
#ifndef NSA_REP_MODE
#define NSA_REP_MODE 0
#endif
#ifndef TSTAMP_PHASE
#define TSTAMP_PHASE -1
#endif
#ifndef PROBE
#define PROBE 0
#endif
typedef unsigned short bf16_t;
typedef __attribute__((ext_vector_type(8))) short bf16x8;
typedef __attribute__((ext_vector_type(4))) float f32x4;
typedef __attribute__((ext_vector_type(16))) float f32x16;
typedef __attribute__((ext_vector_type(4))) unsigned u32x4;
typedef __attribute__((ext_vector_type(2))) unsigned u32x2;

constexpr int T_ = 32768, D_ = 2048, S_ = 8192, NB_ = 4;
constexpr int NPROJ = 4736;
constexpr int IN_COLS = 4656;
constexpr float ALPHA = 1.189207115002721f;
constexpr float LOG2E = 1.4426950408889634f;
constexpr float LN_EPS = 1e-5f;
constexpr int NTHREADS = 512;
constexpr int LDS_BYTES = 147968;

constexpr size_t MiB = 1ull << 20;
constexpr size_t WS_CTL = 0;
constexpr size_t WS_STATS = 1 * MiB;
constexpr size_t WS_C1BIAS = WS_STATS + 256 * 1024;
constexpr size_t WS_WTOK = WS_STATS + 512 * 1024;
constexpr size_t WS_LOGITS = 2 * MiB;
constexpr size_t WS_LIST = 7 * MiB;
constexpr size_t WS_WC1 = 11 * MiB;
constexpr size_t WS_WC2 = 13 * MiB;
constexpr size_t WS_WR = 14 * MiB;
constexpr size_t WS_WIN = 15 * MiB;
constexpr size_t WS_WOUT = 34 * MiB;
constexpr size_t WS_WQ = 42 * MiB;
constexpr size_t WS_WKV = 50 * MiB;
constexpr size_t WS_WO = 66 * MiB;
constexpr size_t WS_WGU = 74 * MiB;
constexpr size_t WS_WD = 202 * MiB;
constexpr size_t WS_BUFA = 266 * MiB;
constexpr size_t WS_BUFB = 394 * MiB;
constexpr size_t WS_BUFC = 522 * MiB;
constexpr size_t WS_BUFD = 650 * MiB;
constexpr size_t WS_END = 778 * MiB;
constexpr size_t C_KCMP = 0, C_VCMP = 16 * MiB, C_KS = 32 * MiB, C_VST = 48 * MiB, C_KW = 64 * MiB, C_VWT = 80 * MiB,
                 C_GATES = 96 * MiB, C_HID = 102 * MiB, C_KC = 110 * MiB, C_VCT = 111 * MiB;
constexpr int CW_CNT = 64;
constexpr int CW_NSA = 1024;
constexpr int CW_TR = 2048;
constexpr int CW_BAR = 4096;
constexpr size_t CTL_U1 = 65536, CTL_C1 = 73728;
constexpr size_t WS_RSUM1 = WS_LOGITS;

struct Params {
    const float* in[35];
    float* out;
    unsigned char* ws;
    int ph_lo, ph_hi;
};

DEVI unsigned cvt_pk_bf16(float lo, float hi) { unsigned r; asm("v_cvt_pk_bf16_f32 %0, %1, %2" : "=v"(r) : "v"(lo), "v"(hi)); return r; }
DEVI bf16_t f2bf(float x) { return (bf16_t)(cvt_pk_bf16(x, 0.f) & 0xffffu); }
DEVI float bf2f(unsigned b) { return __uint_as_float(b << 16); }
DEVI void glds16(const void* g, void* l) {
    __builtin_amdgcn_global_load_lds((const __attribute__((address_space(1))) void*)g, (__attribute__((address_space(3))) void*)l, 16, 0, 0);
}
DEVI f32x16 mfma32(bf16x8 a, bf16x8 b, f32x16 c) { return __builtin_amdgcn_mfma_f32_32x32x16_bf16(a, b, c, 0, 0, 0); }
DEVI f32x4 mfma16(bf16x8 a, bf16x8 b, f32x4 c) { return __builtin_amdgcn_mfma_f32_16x16x32_bf16(a, b, c, 0, 0, 0); }
DEVI float fexp2(float x) { return __builtin_amdgcn_exp2f(x); }
DEVI float wave_sum(float v) {
#pragma unroll
    for (int o = 1; o < 64; o <<= 1) v += __shfl_xor(v, o);
    return v;
}
DEVI float sigmoidf_(float x) { return 1.f / (1.f + __expf(-x)); }
DEVI float gelu_tanh(float x) {
    const float u = 0.7978845608028654f * (x + 0.044715f * x * x * x);
    const float e = __expf(2.f * u);
    const float th = 1.f - 2.f / (e + 1.f);
    return 0.5f * x * (1.f + th);
}

#define LAS __attribute__((address_space(3)))
#define XB_TMO      128
#define XB_XCNT(j)  (256  + 64 * (j))
#define XB_XSUB(j)  (1280 + 64 * (j))
#define XB_XGEN(j)  (2304 + 64 * (j))
#define XB_TOP      3328
#define XB_TOPGEN   3392
#define XB_SPIN_CAP (1u << 22)
DEVI unsigned xb_ld(unsigned* p) { return __hip_atomic_load(p, __ATOMIC_RELAXED, __HIP_MEMORY_SCOPE_AGENT); }
DEVI unsigned xb_add(unsigned* p, unsigned v) { return __hip_atomic_fetch_add(p, v, __ATOMIC_RELAXED, __HIP_MEMORY_SCOPE_AGENT); }
DEVI unsigned xb_xcc_id() { return (unsigned)__builtin_amdgcn_s_getreg((3 << 11) | 20) & 0xFu; }
#define XB_SPIN(cond, bar) do { unsigned _sp = 0; while (cond) { __builtin_amdgcn_s_sleep(1); \
    if ((++_sp & 255u) == 0u) { if (xb_ld(&(bar)[XB_TMO])) break; if (_sp > XB_SPIN_CAP) { atomicAdd(&(bar)[XB_TMO], 1u); break; } } } } while (0)
DEVI void xcd_barrier_post(unsigned* bar) {
    if (threadIdx.x == 0) (void)xb_add(&bar[XB_XCNT(xb_xcc_id())], 1u);
}
DEVI void xcd_barrier_complete(unsigned* bar, unsigned x, unsigned& nloc, unsigned& nx) {
    const unsigned G = gridDim.x * gridDim.y * gridDim.z;
    unsigned sum, cnt, mine, sp = 0u;
    for (;;) {
        sum = 0u; cnt = 0u; mine = 0u;
#pragma unroll
        for (unsigned j = 0; j < 16; ++j) { const unsigned c = xb_ld(&bar[XB_XCNT(j)]); sum += c; cnt += (c > 0u) ? 1u : 0u; mine = (j == x) ? c : mine; }
        if (sum == G) break;
        __builtin_amdgcn_s_sleep(1);
        if ((++sp & 255u) == 0u) { if (xb_ld(&bar[XB_TMO])) break; if (sp > XB_SPIN_CAP) { atomicAdd(&bar[XB_TMO], 1u); break; } }
    }
    nloc = mine > 0u ? mine : 1u; nx = cnt > 0u ? cnt : 1u;
}
DEVI void xcd_barrier(unsigned* bar, volatile LAS unsigned* st) {
    asm volatile("s_waitcnt vmcnt(0)" ::: "memory");
    __syncthreads();
    if (threadIdx.x == 0) {
        const unsigned x = xb_xcc_id();
        __builtin_amdgcn_s_waitcnt(0);
        unsigned nloc = st[0], nx = st[1];
        if (nloc == 0u) { xcd_barrier_complete(bar, x, nloc, nx); st[0] = nloc; st[1] = nx; }
        const unsigned old = xb_add(&bar[XB_XSUB(x)], 1u);
        const unsigned gen = old / nloc;
        if (old + 1u == (gen + 1u) * nloc) {
            __builtin_amdgcn_fence(__ATOMIC_RELEASE, "agent");
            asm volatile("s_waitcnt vmcnt(0)" ::: "memory");
            const unsigned og = xb_add(&bar[XB_TOP], 1u);
            const unsigned tg = og / nx;
            if (og + 1u == (tg + 1u) * nx) xb_add(&bar[XB_TOPGEN], 1u);
            else XB_SPIN(xb_ld(&bar[XB_TOPGEN]) == tg, bar);
            __builtin_amdgcn_fence(__ATOMIC_ACQUIRE, "agent");
            xb_add(&bar[XB_XGEN(x)], 1u);
            asm volatile("s_waitcnt vmcnt(0)" ::: "memory");
        } else {
            XB_SPIN(xb_ld(&bar[XB_XGEN(x)]) == gen, bar);
            __builtin_amdgcn_fence(__ATOMIC_ACQUIRE, "agent");
            asm volatile("s_waitcnt vmcnt(0)" ::: "memory");
        }
    }
    __syncthreads();
}

DEVI void row_load(const float* row, int lane, f32x4 (&v)[8]) {
#pragma unroll
    for (int c = 0; c < 8; ++c) v[c] = *(const f32x4*)(row + c * 256 + lane * 4);
}
DEVI void row_stats(const f32x4 (&v)[8], float& mean, float& rstd) {
    float s = 0.f;
#pragma unroll
    for (int c = 0; c < 8; ++c) s += (v[c].x + v[c].y) + (v[c].z + v[c].w);
    mean = wave_sum(s) * (1.f / D_);
    float q = 0.f;
#pragma unroll
    for (int c = 0; c < 8; ++c) { const f32x4 d = v[c] - mean; q += (d.x * d.x + d.y * d.y) + (d.z * d.z + d.w * d.w); }
    rstd = 1.f / sqrtf(wave_sum(q) * (1.f / D_) + LN_EPS);
}

DEVI const float* wsrc_col(const Params& p, int mat, int e, int n, int& ld) {
    switch (mat) {
    case 0: {
        ld = IN_COLS;
        if (n < 2560) return p.in[4] + n;
        if (n < 2688) { const int j = n - 2560; return j < 48 ? p.in[4] + 2560 + j : nullptr; }
        const int r = n - 2688, grp = r >> 6, within = r & 63;
        const int ch = grp * 32 + (within & 31), isg = within >> 5;
        return p.in[4] + 2608 + isg * 1024 + ch;
    }
    case 1: ld = 256; return p.in[6] + n;
    case 2: ld = 256; return p.in[9] + n;
    case 3: ld = 64; return n < 64 ? p.in[7] + n : nullptr;
    case 4: ld = 64; return n < 64 ? p.in[10] + n : nullptr;
    case 5: ld = 2048; return p.in[16] + n;
    case 6: ld = 2048; return p.in[21] + n;
    case 7: ld = 4096; return p.in[22] + n;
    case 8: ld = 2048; return p.in[23] + n;
    case 9: if (n < 4) { ld = 4; return p.in[26] + n; } if (n < 36) { ld = 32; return p.in[28] + (n - 4); } ld = 1; return nullptr;
    case 10: { ld = 512; const int grp = n >> 6, within = n & 63; const int ch = grp * 32 + (within & 31);
               return ((within >> 5) ? p.in[31] : p.in[30]) + (size_t)e * 2048 * 512 + ch; }
    default: ld = 2048; return p.in[32] + (size_t)e * 512 * 2048 + n;
    }
}
DEVI void wave_transpose_item(const Params& p, char* smem, int mat, int e, int ntile, int ktile, bf16_t* dst, bf16_t* dst_lo, int K,
                                const float* gvec = nullptr, const float* bvec = nullptr, float* U = nullptr, float* C = nullptr) {
    int tid = threadIdx.x; asm volatile("" : "+v"(tid));
    const int lane = tid & 63, w = tid >> 6;
    float* tile = (float*)smem + w * (64 * 65 + 32);
    const int k0 = ktile * 64;
    if (mat == 9) {
        int ld; const float* src = wsrc_col(p, mat, e, ntile * 64 + lane, ld);
#pragma unroll 8
        for (int k = 0; k < 64; ++k) tile[k * 65 + lane] = src ? src[(size_t)(k0 + k) * ld] : 0.f;
    } else {
        const int c4 = lane & 15, kr = lane >> 4;
        int ld; const float* src = wsrc_col(p, mat, e, ntile * 64 + c4 * 4, ld);
        f32x4 v[16];
#pragma unroll
        for (int i = 0; i < 16; ++i) v[i] = src ? *(const f32x4*)(src + (size_t)(k0 + kr + 4 * i) * ld) : (f32x4){0.f, 0.f, 0.f, 0.f};
#pragma unroll
        for (int i = 0; i < 16; ++i) { float* q = tile + (kr + 4 * i) * 65 + c4 * 4; q[0] = v[i].x; q[1] = v[i].y; q[2] = v[i].z; q[3] = v[i].w; }
    }
    asm volatile("s_waitcnt lgkmcnt(0)" ::: "memory");
    if (gvec) {
        float us = 0.f, cs = 0.f;
#pragma unroll 8
        for (int k = 0; k < 64; ++k) { const float wkn = tile[k * 65 + lane]; us += gvec[k0 + k] * wkn; cs += bvec[k0 + k] * wkn; }
        atomicAdd(U + ntile * 64 + lane, us); atomicAdd(C + ntile * 64 + lane, cs);
    }
    const int kc = lane & 7, nr = lane >> 3;
#pragma unroll
    for (int c = 0; c < 8; ++c) {
        const int n = nr + 8 * c;
        float wv[8];
#pragma unroll
        for (int j = 0; j < 8; ++j) wv[j] = tile[(kc * 8 + j) * 65 + n];
        if (gvec) {
#pragma unroll
            for (int j = 0; j < 8; ++j) wv[j] *= gvec[k0 + kc * 8 + j]; }
        u32x4 o; o.x = cvt_pk_bf16(wv[0], wv[1]); o.y = cvt_pk_bf16(wv[2], wv[3]); o.z = cvt_pk_bf16(wv[4], wv[5]); o.w = cvt_pk_bf16(wv[6], wv[7]);
        const size_t off = (size_t)(ntile * 64 + n) * K + k0 + kc * 8;
        if (!dst_lo) *(u32x4*)(dst + off) = o;
        else {
            float r[8];
#pragma unroll
            for (int j = 0; j < 8; ++j) r[j] = wv[j] - bf2f((unsigned)f2bf(wv[j]));
            u32x4 l; l.x = cvt_pk_bf16(r[0], r[1]); l.y = cvt_pk_bf16(r[2], r[3]); l.z = cvt_pk_bf16(r[4], r[5]); l.w = cvt_pk_bf16(r[6], r[7]);
            const size_t o0 = (size_t)n * K + k0 + kc * 8, o1 = (size_t)(64 + n) * K + k0 + kc * 8;
            if (ntile == 0) { *(u32x4*)(dst + o0) = o; *(u32x4*)(dst_lo + o0) = o; *(u32x4*)(dst + o1) = l; }
            else *(u32x4*)(dst_lo + o1) = (u32x4){0u, 0u, 0u, 0u};
        }
    }
    asm volatile("s_waitcnt lgkmcnt(0)" ::: "memory");
}

DEVI void phase_prep(const Params& p, char* smem) {
    int tid = threadIdx.x; asm volatile("" : "+v"(tid));
    const int lane = tid & 63, w = tid >> 6;
    unsigned char* ws = p.ws;
    for (int r = blockIdx.x; r < 8; r += gridDim.x) {
        const int type = r >> 2, n = (r & 3) * 64 + lane;
        const float* pe = p.in[type ? 8 : 5]; const float* w1 = p.in[type ? 9 : 6];
        float sacc = 0.f;
        for (int k = w * 256; k < (w + 1) * 256; ++k) sacc += pe[k] * w1[(size_t)k * 256 + n];
        float* red = (float*)smem;
        __syncthreads();
        red[w * 64 + lane] = sacc;
        __syncthreads();
        if (w == 0) ((float*)(ws + WS_C1BIAS))[type * 256 + n] = ((red[lane] + red[64 + lane]) + (red[128 + lane] + red[192 + lane])) + ((red[256 + lane] + red[320 + lane]) + (red[384 + lane] + red[448 + lane]));
        __syncthreads();
    }
    constexpr int I_LN = T_, I_MEM = 1024;
    constexpr int I_M0 = 74 * 32, I_M12 = 4 * 32, I_M34 = 2 * 4, I_SQ = 32 * 32, I_KV = 64 * 32, I_R = 2 * 32;
    constexpr int TOTAL = I_LN + I_MEM + I_M0 + 2 * I_M12 + 2 * I_M34 + 3 * I_SQ + I_KV + I_R;
    const int gw = blockIdx.x * 8 + w, NW = gridDim.x * 8;
    for (int it = gw; it < TOTAL; it += NW) {
        int r = it;
        if (r < I_LN) {
            const int t = r;
            f32x4 v[8]; row_load(p.in[0] + (size_t)t * D_, lane, v);
            float mean, rstd; row_stats(v, mean, rstd);
            bf16_t* hb = (bf16_t*)(ws + WS_BUFA) + (size_t)t * D_;
#pragma unroll
            for (int c = 0; c < 8; ++c) {
                const int col = c * 256 + lane * 4;
                const f32x4 g = *(const f32x4*)(p.in[2] + col), b = *(const f32x4*)(p.in[3] + col);
                const f32x4 y = (v[c] - mean) * rstd * g + b;
                u32x2 o; o.x = cvt_pk_bf16(y.x, y.y); o.y = cvt_pk_bf16(y.z, y.w);
                *(u32x2*)(hb + col) = o;
            }
            if (lane == 0) { float* st = (float*)(ws + WS_STATS); st[t * 2] = mean; st[t * 2 + 1] = rstd; }
            continue;
        }
        r -= I_LN;
        if (r < I_MEM) {
            const int t = r;
            f32x4 v[8]; row_load(p.in[1] + (size_t)t * D_, lane, v);
            float mean, rstd; row_stats(v, mean, rstd);
            bf16_t* hb = (bf16_t*)(ws + WS_BUFD) + (size_t)t * D_;
#pragma unroll
            for (int c = 0; c < 8; ++c) {
                const int col = c * 256 + lane * 4;
                const f32x4 g = *(const f32x4*)(p.in[19] + col), b = *(const f32x4*)(p.in[20] + col);
                const f32x4 y = (v[c] - mean) * rstd * g + b;
                u32x2 o; o.x = cvt_pk_bf16(y.x, y.y); o.y = cvt_pk_bf16(y.z, y.w);
                *(u32x2*)(hb + col) = o;
            }
            continue;
        }
        r -= I_MEM;
        if (r < I_M0) { wave_transpose_item(p, smem, 0, 0, r / 32, r % 32, (bf16_t*)(ws + WS_WIN), nullptr, 2048); continue; } r -= I_M0;
        if (r < I_M12) { wave_transpose_item(p, smem, 1, 0, r / 32, r % 32, (bf16_t*)(ws + WS_WC1), nullptr, 2048); continue; } r -= I_M12;
        if (r < I_M12) { wave_transpose_item(p, smem, 2, 0, r / 32, r % 32, (bf16_t*)(ws + WS_WC1) + 256 * 2048, nullptr, 2048); continue; } r -= I_M12;
        if (r < I_M34) { wave_transpose_item(p, smem, 3, 0, r / 4, r % 4, (bf16_t*)(ws + WS_WC2), nullptr, 256); continue; } r -= I_M34;
        if (r < I_M34) { wave_transpose_item(p, smem, 4, 0, r / 4, r % 4, (bf16_t*)(ws + WS_WC2) + 128 * 256, nullptr, 256); continue; } r -= I_M34;
        if (r < I_SQ) { wave_transpose_item(p, smem, 5, 0, r / 32, r % 32, (bf16_t*)(ws + WS_WOUT), nullptr, 2048); continue; } r -= I_SQ;
        if (r < I_SQ) { wave_transpose_item(p, smem, 6, 0, r / 32, r % 32, (bf16_t*)(ws + WS_WQ), nullptr, 2048, p.in[17], p.in[18], (float*)(ws + WS_CTL + CTL_U1), (float*)(ws + WS_CTL + CTL_C1)); continue; } r -= I_SQ;
        if (r < I_KV) { wave_transpose_item(p, smem, 7, 0, r / 32, r % 32, (bf16_t*)(ws + WS_WKV), nullptr, 2048); continue; } r -= I_KV;
        if (r < I_SQ) { wave_transpose_item(p, smem, 8, 0, r / 32, r % 32, (bf16_t*)(ws + WS_WO), nullptr, 2048); continue; } r -= I_SQ;
        wave_transpose_item(p, smem, 9, 0, r / 32, r % 32, (bf16_t*)(ws + WS_WR), (bf16_t*)(ws + WS_WR) + 128 * 2048, 2048);
    }
    __syncthreads();
}

constexpr int MOE_W_ITEMS = 32 * 16 * 32 + 32 * 32 * 8;
DEVI void moe_weight_item(const Params& p, char* smem, int r) {
    unsigned char* ws = p.ws;
    if (r < 32 * 16 * 32) { const int e = r / 512, q = r % 512; wave_transpose_item(p, smem, 10, e, q / 32, q % 32, (bf16_t*)(ws + WS_WGU) + (size_t)e * 1024 * 2048, nullptr, 2048); }
    else { r -= 32 * 16 * 32; const int e = r / 256, q = r % 256; wave_transpose_item(p, smem, 11, e, q / 8, q % 8, (bf16_t*)(ws + WS_WD) + (size_t)e * 2048 * 512, nullptr, 512); }
}

enum { J_PROJ = 0, J_MEMKV, J_CMP1, J_CMP2, J_OUT, J_WQ, J_WO, J_ROUTER, J_MOE1, J_MOE2 };
constexpr int GEMM_STAGE_BYTES = 49152;
constexpr int GEMM_TP = 3 * GEMM_STAGE_BYTES;

template <int job, int VAR = 0>
DEVI void gemm_job(const Params& p, char* smem) {
    unsigned char* ws = p.ws;
    int tid = threadIdx.x; asm volatile("" : "+v"(tid));
    const int lane = tid & 63, w = tid >> 6, wr = w >> 1, wc = w & 1, fr = lane & 15, fq = lane >> 4;
    const int srow = tid >> 3, schunk = (tid & 7) ^ ((tid >> 4) & 7);
    int* tp = (int*)(smem + GEMM_TP);
    int MT = 0, NT = 0, K = 2048, nseg = 1, ntiles = 0, RT = 0;
    switch (job) {
    case J_PROJ: MT = 128; NT = 37; break;
    case J_MEMKV: MT = 4; NT = 32; break;
    case J_CMP1: MT = 64; NT = 2; break;
    case J_CMP2: MT = 64; NT = 1; K = 256; break;
    case J_OUT: case J_WQ: case J_WO: MT = 128; NT = 16; break;
    case J_ROUTER: MT = 128; NT = 1; nseg = 2; break;
    default: break;
    }
    const unsigned* cntw = (const unsigned*)(ws + WS_CTL) + CW_CNT;
    if (job == J_MOE1 || job == J_MOE2) {
        __syncthreads();
        if (tid == 0) { int acc = 0; for (int e = 0; e < 32; ++e) { tp[e] = acc; const int c = (int)__hip_atomic_load(cntw + e, __ATOMIC_RELAXED, __HIP_MEMORY_SCOPE_AGENT); tp[33 + e] = c; acc += (c + 255) >> 8; } tp[32] = acc; }
        __syncthreads();
        RT = tp[32];
        NT = (job == J_MOE1) ? 8 : 16; K = (job == J_MOE1) ? 2048 : 512;
        { int mx = 0;
#pragma unroll
          for (int x = 0; x < 8; ++x) { int t = 0;
#pragma unroll
              for (int k = 0; k < 4; ++k) t += (tp[33 + x + 8 * k] + 255) >> 8;
              mx = t > mx ? t : mx; }
          ntiles = mx * NT * 8; }
    } else {
        const int nsr = (MT + 7) >> 3;
        ntiles = (MT < 64) ? MT * NT : ((nsr + 7) >> 3) * 8 * NT * 8;
    }
    int my_tp = 0, my_cnt = 0;
    if (job == J_MOE1 || job == J_MOE2) { my_tp = tp[lane & 31]; my_cnt = tp[33 + (lane & 31)]; }
    const int nk = K >> 6, ntot = nseg * nk;

    for (int ti = blockIdx.x; ti < ntiles; ti += gridDim.x) {
        int mt, nt, e = 0, rt = 0, ecnt = 0, etp = 0;
        if (job == J_MOE1 || job == J_MOE2) {
            const int x = ti & 7; int jj = ti >> 3; bool found = false; mt = 0; nt = 0;
#pragma unroll
            for (int k = 0; k < 4; ++k) {
                const int ee = x + 8 * k;
                const int c = __shfl(my_cnt, ee), rtc = (c + 255) >> 8, tot = rtc * NT;
                if (!found) { if (jj < tot) { found = true; e = ee; ecnt = c; etp = __shfl(my_tp, ee); const int per = 4 * rtc, ng = jj / per, r2 = jj - ng * per; nt = ng * 4 + r2 / rtc; rt = r2 - (r2 / rtc) * rtc; } else jj -= tot; }
            }
            if (!found) continue;
        } else {
            if (MT < 64) { nt = ti / MT; mt = ti - nt * MT; }
            else {
                const int x = ti & 7, jj = ti >> 3, per = 8 * NT, srl = jj / per, idx = jj - srl * per;
                mt = (srl * 8 + x) * 8 + (idx & 7); nt = idx >> 3;
                if (mt >= MT) continue;
            }
        }
        const bf16_t* ap[4]; const bf16_t* bp[2];
#pragma unroll
        for (int r = 0; r < 4; ++r) {
            const int row = r * 64 + srow;
            const bf16_t* a;
            switch (job) {
            case J_PROJ: a = (const bf16_t*)(ws + WS_BUFA) + (size_t)(mt * 256 + row) * 2048; break;
            case J_MEMKV: a = (const bf16_t*)(ws + WS_BUFD) + (size_t)(mt * 256 + row) * 2048; break;
            case J_CMP1: { const int gi = mt >> 1, i = (mt & 1) * 256 + row, ic = i < 510 ? i : 510; const int type = gi >> 4, bh = gi & 15;
                a = (const bf16_t*)(ws + WS_BUFC + (type ? C_VCMP : C_KCMP)) + ((size_t)bh * 8192 + 16 * ic) * 64; break; }
            case J_CMP2: a = (const bf16_t*)(ws + WS_BUFC + C_HID) + (size_t)(mt * 256 + row) * 256; break;
            case J_OUT: a = (const bf16_t*)(ws + WS_BUFA) + (size_t)(mt * 256 + row) * 2048; break;
            case J_WQ: a = (const bf16_t*)(ws + WS_BUFB) + (size_t)(mt * 256 + row) * 2048; break;
            case J_WO: a = (const bf16_t*)(ws + WS_BUFA) + (size_t)(mt * 256 + row) * 2048; break;
            case J_ROUTER: a = (const bf16_t*)(ws + WS_BUFA) + (size_t)(mt * 256 + row) * 2048; break;
            case J_MOE1: { int pos = rt * 256 + row; if (pos >= ecnt) pos = 0; const int aid = ((const int*)(ws + WS_LIST))[(size_t)e * T_ + pos];
                a = (const bf16_t*)(ws + WS_BUFA) + (size_t)(aid >> 1) * 2048; break; }
            default: a = (const bf16_t*)(ws + WS_BUFB) + (size_t)((etp + rt) * 256 + row) * 512; break;
            }
            ap[r] = a + schunk * 8;
        }
#pragma unroll
        for (int r = 0; r < 2; ++r) {
            const int row = r * 64 + srow;
            const bf16_t* b;
            switch (job) {
            case J_PROJ: b = (const bf16_t*)(ws + WS_WIN) + (size_t)(nt * 128 + row) * 2048; break;
            case J_MEMKV: b = (const bf16_t*)(ws + WS_WKV) + (size_t)(nt * 128 + row) * 2048; break;
            case J_CMP1: b = (const bf16_t*)(ws + WS_WC1) + (size_t)(mt >> 5) * 256 * 2048 + (size_t)(nt * 128 + row) * 2048; break;
            case J_CMP2: b = (const bf16_t*)(ws + WS_WC2) + (size_t)(mt >> 5) * 128 * 256 + (size_t)row * 256; break;
            case J_OUT: b = (const bf16_t*)(ws + WS_WOUT) + (size_t)(nt * 128 + row) * 2048; break;
            case J_WQ: b = (const bf16_t*)(ws + WS_WQ) + (size_t)(nt * 128 + row) * 2048; break;
            case J_WO: b = (const bf16_t*)(ws + WS_WO) + (size_t)(nt * 128 + row) * 2048; break;
            case J_ROUTER: b = (const bf16_t*)(ws + WS_WR) + (size_t)row * 2048; break;
            case J_MOE1: b = (const bf16_t*)(ws + WS_WGU) + (size_t)e * 1024 * 2048 + (size_t)(nt * 128 + row) * 2048; break;
            default: b = (const bf16_t*)(ws + WS_WD) + (size_t)e * 2048 * 512 + (size_t)(nt * 128 + row) * 512; break;
            }
            bp[r] = b + schunk * 8;
        }
        const long a_seg1 = (long)(WS_BUFB - WS_BUFA) / 2;
        const long b_seg2 = 128 * 2048;

        f32x4 acc[4][4];
#pragma unroll
        for (int i = 0; i < 4; ++i)
#pragma unroll
            for (int j = 0; j < 4; ++j) acc[i][j] = (f32x4){0.f, 0.f, 0.f, 0.f};

#define GEMM_STAGE(kt_) do { const int _kt = (kt_); int _seg = 0, _k0 = _kt << 6; if (nseg > 1) { _seg = _kt / nk; _k0 = (_kt - _seg * nk) << 6; } \
            const long _ao = (_seg == 1) ? a_seg1 : 0, _bo = (_seg == 1) ? b_seg2 : 0; \
            char* _A = smem + (_kt % 3) * GEMM_STAGE_BYTES; char* _B = _A + 32768; \
            _Pragma("unroll") for (int r = 0; r < 4; ++r) glds16(ap[r] + _ao + _k0, _A + (r * 512 + tid) * 16); \
            _Pragma("unroll") for (int r = 0; r < 2; ++r) glds16(bp[r] + _bo + _k0, _B + (r * 512 + tid) * 16); } while (0)

        f32x4 pre[8];
        if (job == J_OUT || job == J_WO) {
            const float* src = (job == J_OUT) ? p.in[0] : p.out;
#pragma unroll
            for (int i = 0; i < 8; ++i) pre[i] = *(const f32x4*)(src + (size_t)(mt * 256 + (tid >> 5) + 16 * i) * D_ + nt * 128 + (tid & 31) * 4);
        }
        GEMM_STAGE(0);
        if (ntot > 1) GEMM_STAGE(1);
        for (int kt = 0; kt < ntot; ++kt) {
            if (kt + 1 < ntot) asm volatile("s_waitcnt vmcnt(6)" ::: "memory"); else asm volatile("s_waitcnt vmcnt(0)" ::: "memory");
            __builtin_amdgcn_s_barrier();
            asm volatile("" ::: "memory");
            if (kt + 2 < ntot && VAR != 1) GEMM_STAGE(kt + 2);
            if (VAR == 2) continue;
            const char* A = smem + (kt % 3) * GEMM_STAGE_BYTES; const char* B = A + 32768;
#pragma unroll
            for (int ks = 0; ks < 2; ++ks) {
                bf16x8 af[4], bfr[4];
                const int coff = ((4 * ks + fq) ^ (fr >> 1)) * 16;
#pragma unroll
                for (int i = 0; i < 4; ++i) {
                    af[i] = *(const bf16x8*)(A + (wr * 64 + i * 16 + fr) * 128 + coff);
                    bfr[i] = *(const bf16x8*)(B + (wc * 64 + i * 16 + fr) * 128 + coff);
                }
#pragma unroll
                for (int i = 0; i < 4; ++i)
#pragma unroll
                    for (int j = 0; j < 4; ++j) acc[i][j] = mfma16(bfr[j], af[i], acc[i][j]);
            }
        }
#undef GEMM_STAGE
        if (VAR != 0 && VAR != 4) { if (acc[0][0].x == 123.456f) p.out[0] = acc[1][1].y + acc[2][2].z + acc[3][3].w; __syncthreads(); continue; }
        asm volatile("s_waitcnt lgkmcnt(0)" ::: "memory"); __builtin_amdgcn_s_barrier(); asm volatile("" ::: "memory");
        float* ep = (float*)smem;
#pragma unroll
        for (int mi = 0; mi < 4; ++mi)
#pragma unroll
            for (int ni = 0; ni < 4; ++ni) *(f32x4*)(ep + (wr * 64 + mi * 16 + fr) * 132 + wc * 64 + ni * 16 + fq * 4) = acc[mi][ni];
        asm volatile("s_waitcnt lgkmcnt(0)" ::: "memory"); __builtin_amdgcn_s_barrier(); asm volatile("" ::: "memory");
        const int row0 = mt * 256, col0 = nt * 128;
#define EP8(row_, c8_, v0_, v1_) const f32x4 v0_ = *(const f32x4*)(ep + (row_) * 132 + (c8_) * 8), v1_ = *(const f32x4*)(ep + (row_) * 132 + (c8_) * 8 + 4)
#define PK8(o_, v0_, v1_) u32x4 o_; o_.x = cvt_pk_bf16(v0_.x, v0_.y); o_.y = cvt_pk_bf16(v0_.z, v0_.w); o_.z = cvt_pk_bf16(v1_.x, v1_.y); o_.w = cvt_pk_bf16(v1_.z, v1_.w)
        switch (job) {
        case J_PROJ: {
            if (nt < 8) {
                bf16_t* Q = (bf16_t*)(ws + WS_BUFB);
#pragma unroll
                for (int i = 0; i < 8; ++i) { const int c = tid + 512 * i, row = c >> 4, c8 = c & 15; EP8(row, c8, a0, a1);
                    const f32x4 b0 = a0 * (0.125f * LOG2E), b1 = a1 * (0.125f * LOG2E); PK8(o, b0, b1);
                    *(u32x4*)(Q + (size_t)(row0 + row) * 1024 + col0 + c8 * 8) = o; }
            } else if (nt < 20) {
                const int reg = (nt - 8) >> 1;
                bf16_t* dst = (bf16_t*)(ws + WS_BUFC + (reg == 0 ? C_KCMP : reg == 1 ? C_VCMP : reg == 2 ? C_KS : reg == 3 ? C_VST : reg == 4 ? C_KW : C_VWT));
                const int b = row0 >> 13, s0 = row0 & 8191;
                if (reg != 3 && reg != 5) {
#pragma unroll
                    for (int i = 0; i < 8; ++i) { const int c = tid + 512 * i, row = c >> 4, c8 = c & 15; EP8(row, c8, a0, a1); PK8(o, a0, a1);
                        const int bh = b * 4 + ((nt - 8) & 1) * 2 + (c8 >> 3);
                        *(u32x4*)(dst + ((size_t)bh * 8192 + s0 + row) * 64 + (c8 & 7) * 8) = o; }
                } else {
#pragma unroll
                    for (int i = 0; i < 8; ++i) { const int c = tid + 512 * i, tg = c & 31, dcol = c >> 5;
                        const int rb = (tg >> 1) * 16 + (tg & 1) * 4;
                        float v[8];
#pragma unroll
                        for (int j = 0; j < 8; ++j) v[j] = ep[(rb + (j & 3) + (j >> 2) * 8) * 132 + dcol];
                        u32x4 o; o.x = cvt_pk_bf16(v[0], v[1]); o.y = cvt_pk_bf16(v[2], v[3]); o.z = cvt_pk_bf16(v[4], v[5]); o.w = cvt_pk_bf16(v[6], v[7]);
                        const int bh = b * 4 + ((nt - 8) & 1) * 2 + (dcol >> 6);
                        *(u32x4*)(dst + ((size_t)bh * 64 + (dcol & 63)) * 8192 + s0 + tg * 8) = o; }
                }
            } else if (nt == 20) {
                float* G = (float*)(ws + WS_BUFC + C_GATES);
#pragma unroll
                for (int i = 0; i < 6; ++i) { const int c = tid + 512 * i, row = c / 12, c4 = c - row * 12;
                    const f32x4 v = *(const f32x4*)(ep + row * 132 + c4 * 4); f32x4 o; o.x = sigmoidf_(v.x); o.y = sigmoidf_(v.y); o.z = sigmoidf_(v.z); o.w = sigmoidf_(v.w);
                    *(f32x4*)(G + (size_t)(row0 + row) * 48 + c4 * 4) = o; }
            } else {
                bf16_t* Hg = (bf16_t*)(ws + WS_BUFB + 64 * MiB);
#pragma unroll
                for (int i = 0; i < 4; ++i) { const int c = tid + 512 * i, row = c >> 3, c8 = c & 7, hh = c8 >> 2, cc = (c8 & 3) * 8;
                    const f32x4 a0 = *(const f32x4*)(ep + row * 132 + hh * 64 + cc), a1 = *(const f32x4*)(ep + row * 132 + hh * 64 + cc + 4);
                    const f32x4 g0 = *(const f32x4*)(ep + row * 132 + hh * 64 + 32 + cc), g1 = *(const f32x4*)(ep + row * 132 + hh * 64 + 32 + cc + 4);
                    u32x4 o; o.x = cvt_pk_bf16(a0.x * sigmoidf_(g0.x), a0.y * sigmoidf_(g0.y)); o.y = cvt_pk_bf16(a0.z * sigmoidf_(g0.z), a0.w * sigmoidf_(g0.w));
                    o.z = cvt_pk_bf16(a1.x * sigmoidf_(g1.x), a1.y * sigmoidf_(g1.y)); o.w = cvt_pk_bf16(a1.z * sigmoidf_(g1.z), a1.w * sigmoidf_(g1.w));
                    *(u32x4*)(Hg + (size_t)(row0 + row) * 1024 + ((nt - 21) * 2 + hh) * 32 + cc) = o; }
            }
        } break;
        case J_MEMKV: {
            const int b = mt;
            if (nt < 16) {
                bf16_t* Kx = (bf16_t*)(ws + WS_BUFD + 4 * MiB);
                const int head = col0 >> 9, d0 = col0 & 511;
#pragma unroll
                for (int i = 0; i < 8; ++i) { const int c = tid + 512 * i, row = c >> 4, c8 = c & 15; EP8(row, c8, a0, a1); PK8(o, a0, a1);
                    *(u32x4*)(Kx + ((size_t)(b * 4 + head) * 256 + row) * 512 + d0 + c8 * 8) = o; }
            } else {
                bf16_t* Vt = (bf16_t*)(ws + WS_BUFD + 8 * MiB);
                const int n2 = col0 - 2048, head = n2 >> 9, d0 = n2 & 511;
#pragma unroll
                for (int i = 0; i < 8; ++i) { const int c = tid + 512 * i, tg = c & 31, dcol = c >> 5;
                    float v[8];
#pragma unroll
                    for (int j = 0; j < 8; ++j) v[j] = ep[(tg * 8 + j) * 132 + dcol];
                    u32x4 o; o.x = cvt_pk_bf16(v[0], v[1]); o.y = cvt_pk_bf16(v[2], v[3]); o.z = cvt_pk_bf16(v[4], v[5]); o.w = cvt_pk_bf16(v[6], v[7]);
                    *(u32x4*)(Vt + ((size_t)(b * 4 + head) * 512 + d0 + dcol) * 256 + tg * 8) = o; }
            }
        } break;
        case J_CMP1: {
            const int type = mt >> 5;
            const float* bias = (const float*)(ws + WS_C1BIAS) + type * 256;
            bf16_t* Hd = (bf16_t*)(ws + WS_BUFC + C_HID);
            const f32x4 b0 = *(const f32x4*)(bias + col0 + (tid & 15) * 8), b1 = *(const f32x4*)(bias + col0 + (tid & 15) * 8 + 4);
#pragma unroll
            for (int i = 0; i < 8; ++i) { const int c = tid + 512 * i, row = c >> 4, c8 = c & 15; EP8(row, c8, a0, a1);
                u32x4 o; o.x = cvt_pk_bf16(gelu_tanh(a0.x + b0.x), gelu_tanh(a0.y + b0.y)); o.y = cvt_pk_bf16(gelu_tanh(a0.z + b0.z), gelu_tanh(a0.w + b0.w));
                o.z = cvt_pk_bf16(gelu_tanh(a1.x + b1.x), gelu_tanh(a1.y + b1.y)); o.w = cvt_pk_bf16(gelu_tanh(a1.z + b1.z), gelu_tanh(a1.w + b1.w));
                *(u32x4*)(Hd + (size_t)(row0 + row) * 256 + col0 + c8 * 8) = o; }
        } break;
        case J_CMP2: {
            const int gi = mt >> 1, type = gi >> 4, bh = gi & 15, i0 = (mt & 1) * 256;
            if (type == 0) {
                bf16_t* Kc = (bf16_t*)(ws + WS_BUFC + C_KC);
#pragma unroll
                for (int i = 0; i < 4; ++i) { const int c = tid + 512 * i, row = c >> 3, c8 = c & 7; EP8(row, c8, a0, a1); PK8(o, a0, a1);
                    if (i0 + row >= 511) o = (u32x4){0u, 0u, 0u, 0u};
                    *(u32x4*)(Kc + ((size_t)bh * 512 + i0 + row) * 64 + c8 * 8) = o; }
            } else {
                bf16_t* Vc = (bf16_t*)(ws + WS_BUFC + C_VCT);
#pragma unroll
                for (int i = 0; i < 4; ++i) { const int c = tid + 512 * i, tg = c & 31, d = c >> 5;
                    const int rb = (tg >> 1) * 16 + (tg & 1) * 4;
                    float v[8];
#pragma unroll
                    for (int j = 0; j < 8; ++j) { const int r = rb + (j & 3) + (j >> 2) * 8; v[j] = (i0 + r >= 511) ? 0.f : ep[r * 132 + d]; }
                    u32x4 o; o.x = cvt_pk_bf16(v[0], v[1]); o.y = cvt_pk_bf16(v[2], v[3]); o.z = cvt_pk_bf16(v[4], v[5]); o.w = cvt_pk_bf16(v[6], v[7]);
                    *(u32x4*)(Vc + ((size_t)bh * 64 + d) * 512 + i0 + tg * 8) = o; }
            }
        } break;
        case J_OUT: {
            const float* st = (const float*)(ws + WS_STATS);
            const int c4 = tid & 31, n = col0 + c4 * 4;
            const f32x4 g = *(const f32x4*)(p.in[2] + n), bb = *(const f32x4*)(p.in[3] + n);
#pragma unroll
            for (int hlf = 0; hlf < 2; ++hlf) {
                f32x4 xv[8]; float2 sm[8];
#pragma unroll
                for (int i = 0; i < 8; ++i) { const int row = (tid >> 5) + 16 * (hlf * 8 + i), t = row0 + row;
                    xv[i] = hlf ? *(const f32x4*)(p.in[0] + (size_t)t * D_ + n) : pre[i]; sm[i] = *(const float2*)(st + t * 2); }
#pragma unroll
                for (int i = 0; i < 8; ++i) { const int row = (tid >> 5) + 16 * (hlf * 8 + i), t = row0 + row;
                    const f32x4 v = *(const f32x4*)(ep + row * 132 + c4 * 4);
                    const f32x4 y = ((xv[i] - sm[i].x) * sm[i].y * g + bb) * ALPHA + v;
                    *(f32x4*)(p.out + (size_t)t * D_ + n) = y;
                    u32x2 yb; yb.x = cvt_pk_bf16(y.x, y.y); yb.y = cvt_pk_bf16(y.z, y.w);
                    *(u32x2*)((bf16_t*)(ws + WS_BUFB) + (size_t)t * D_ + n) = yb;
                    float rs = (y.x + y.y) + (y.z + y.w), rq = (y.x * y.x + y.y * y.y) + (y.z * y.z + y.w * y.w);
#pragma unroll
                    for (int o = 1; o < 32; o <<= 1) { rs += __shfl_xor(rs, o); rq += __shfl_xor(rq, o); }
                    if ((tid & 31) == 0) { float* rsum = (float*)(ws + WS_RSUM1) + (size_t)t * 2; atomicAdd(rsum, rs); atomicAdd(rsum + 1, rq); } }
            }
        } break;
        case J_WQ: {
            bf16_t* Qx = (bf16_t*)(ws + WS_BUFC);
            const float sc = 0.04419417382415922f * LOG2E;
            const float* U = (const float*)(ws + WS_CTL + CTL_U1); const float* Cv = (const float*)(ws + WS_CTL + CTL_C1);
            const float* rsum = (const float*)(ws + WS_RSUM1);
            const int c8 = tid & 15, n = col0 + c8 * 8;
            const f32x4 u0 = *(const f32x4*)(U + n), u1 = *(const f32x4*)(U + n + 4), c0 = *(const f32x4*)(Cv + n), c1 = *(const f32x4*)(Cv + n + 4);
            float2 rsq[8];
#pragma unroll
            for (int i = 0; i < 8; ++i) rsq[i] = *(const float2*)(rsum + (size_t)(row0 + (tid >> 4) + 32 * i) * 2);
#pragma unroll
            for (int i = 0; i < 8; ++i) { const int row = (tid >> 4) + 32 * i; EP8(row, c8, a0, a1);
                const int t = row0 + row;
                const float mean = rsq[i].x * (1.f / D_); float var = rsq[i].y * (1.f / D_) - mean * mean; var = var > 0.f ? var : 0.f;
                const float rstd = __builtin_amdgcn_rsqf(var + LN_EPS), mr = mean * rstd;
                const f32x4 b0 = (a0 * rstd - u0 * mr + c0) * sc, b1 = (a1 * rstd - u1 * mr + c1) * sc; PK8(o, b0, b1);
                *(u32x4*)(Qx + (size_t)t * 2048 + n) = o; }
        } break;
        case J_WO: {
            const float* st = (const float*)(ws + WS_STATS);
            const int c4 = tid & 31, n = col0 + c4 * 4;
            const f32x4 g = *(const f32x4*)(p.in[17] + n), bb = *(const f32x4*)(p.in[18] + n);
#pragma unroll
            for (int hlf = 0; hlf < 2; ++hlf) {
                f32x4 rv[8]; float2 sm[8];
#pragma unroll
                for (int i = 0; i < 8; ++i) { const int row = (tid >> 5) + 16 * (hlf * 8 + i), t = row0 + row;
                    rv[i] = hlf ? *(const f32x4*)(p.out + (size_t)t * D_ + n) : pre[i]; const float2 rsq = *(const float2*)((const float*)(ws + WS_RSUM1) + (size_t)t * 2);
                    const float mean = rsq.x * (1.f / D_); float var = rsq.y * (1.f / D_) - mean * mean; var = var > 0.f ? var : 0.f;
                    sm[i] = make_float2(mean, 1.f / sqrtf(var + LN_EPS)); }
#pragma unroll
                for (int i = 0; i < 8; ++i) { const int row = (tid >> 5) + 16 * (hlf * 8 + i), t = row0 + row;
                    const f32x4 v = *(const f32x4*)(ep + row * 132 + c4 * 4);
                    *(f32x4*)(p.out + (size_t)t * D_ + n) = ((rv[i] - sm[i].x) * sm[i].y * g + bb) * ALPHA + v; }
            }
        } break;
        case J_ROUTER: {
            if (tid < 256) {
                const int row = tid, t = row0 + row;
                const float* er = ep + row * 132;
                unsigned* cnt = (unsigned*)(ws + WS_CTL) + CW_CNT;
                int* list = (int*)(ws + WS_LIST);
                float* wt = (float*)(ws + WS_WTOK);
                float lg[4];
#pragma unroll
                for (int i = 0; i < 4; ++i) lg[i] = er[i] + er[64 + i] + p.in[27][i];
                int grp = 0; float best = lg[0];
#pragma unroll
                for (int i = 1; i < 4; ++i) if (lg[i] > best) { best = lg[i]; grp = i; }
                float se = 0.f;
#pragma unroll
                for (int i = 0; i < 4; ++i) se += expf(lg[i] - best);
                const float wgrp = 1.f / se;
                float le[8];
#pragma unroll
                for (int i = 0; i < 8; ++i) le[i] = er[4 + grp * 8 + i] + er[68 + grp * 8 + i] + p.in[29][grp * 8 + i];
                int i0 = 0; float v0 = le[0];
#pragma unroll
                for (int i = 1; i < 8; ++i) if (le[i] > v0) { v0 = le[i]; i0 = i; }
                int i1 = -1; float v1 = -INFINITY;
#pragma unroll
                for (int i = 0; i < 8; ++i) if (i != i0 && le[i] > v1) { v1 = le[i]; i1 = i; }
                const float ex = expf(v1 - v0);
                const float w0 = wgrp / (1.f + ex), w1 = wgrp * ex / (1.f + ex);
                const int ea = grp * 8 + i0, eb = grp * 8 + i1;
                const unsigned pa = atomicAdd(cnt + ea, 1u); list[(size_t)ea * T_ + pa] = t * 2;
                const unsigned pb = atomicAdd(cnt + eb, 1u); list[(size_t)eb * T_ + pb] = t * 2 + 1;
                wt[t * 2] = w0; wt[t * 2 + 1] = w1;
            }
        } break;
        case J_MOE1: {
            bf16_t* H = (bf16_t*)(ws + WS_BUFB);
#pragma unroll
            for (int i = 0; i < 4; ++i) { const int c = tid + 512 * i, row = c >> 3, c8 = c & 7, hh = c8 >> 2, cc = (c8 & 3) * 8;
                const f32x4 g0 = *(const f32x4*)(ep + row * 132 + hh * 64 + cc), g1 = *(const f32x4*)(ep + row * 132 + hh * 64 + cc + 4);
                const f32x4 u0 = *(const f32x4*)(ep + row * 132 + hh * 64 + 32 + cc), u1 = *(const f32x4*)(ep + row * 132 + hh * 64 + 32 + cc + 4);
                u32x4 o; o.x = cvt_pk_bf16(g0.x * sigmoidf_(g0.x) * u0.x, g0.y * sigmoidf_(g0.y) * u0.y); o.y = cvt_pk_bf16(g0.z * sigmoidf_(g0.z) * u0.z, g0.w * sigmoidf_(g0.w) * u0.w);
                o.z = cvt_pk_bf16(g1.x * sigmoidf_(g1.x) * u1.x, g1.y * sigmoidf_(g1.y) * u1.y); o.w = cvt_pk_bf16(g1.z * sigmoidf_(g1.z) * u1.z, g1.w * sigmoidf_(g1.w) * u1.w);
                *(u32x4*)(H + ((size_t)(etp + rt) * 256 + row) * 512 + (nt * 2 + hh) * 32 + cc) = o; }
        } break;
        default: {
            bf16_t* Y = (bf16_t*)(ws + WS_BUFC);
            const float* wt = (const float*)(ws + WS_WTOK);
            const int c8 = tid & 15;
            int aid[8]; float wv[8];
#pragma unroll
            for (int i = 0; i < 8; ++i) { const int pos = rt * 256 + (tid >> 4) + 32 * i; aid[i] = (pos < ecnt) ? ((const int*)(ws + WS_LIST))[(size_t)e * T_ + pos] : -1; }
#pragma unroll
            for (int i = 0; i < 8; ++i) wv[i] = (aid[i] >= 0) ? wt[aid[i]] : 0.f;
#pragma unroll
            for (int i = 0; i < 8; ++i) { const int row = (tid >> 4) + 32 * i;
                if (aid[i] >= 0) { EP8(row, c8, a0, a1); const f32x4 b0 = a0 * wv[i], b1 = a1 * wv[i]; PK8(o, b0, b1);
                    *(u32x4*)(Y + (size_t)aid[i] * 2048 + col0 + c8 * 8) = o; } }
        } break;
        }
#undef EP8
#undef PK8
        asm volatile("s_waitcnt lgkmcnt(0)" ::: "memory"); __builtin_amdgcn_s_barrier(); asm volatile("" ::: "memory");
    }
}

DEVI void phase_conv(const Params& p) {
    unsigned char* ws = p.ws;
    int tid = threadIdx.x; asm volatile("" : "+v"(tid));
    const int lane = tid & 63, w = tid >> 6;
    const int c0 = tid * 2;
    const bf16_t* Hg = (const bf16_t*)(ws + WS_BUFB + 64 * MiB);
    float* pre = p.out;
    float* cst = (float*)(ws + WS_LIST);
    float wgt[31][2];
    { const float* wp = p.in[12] + c0;
#pragma unroll
      for (int k = 0; k < 31; ++k) { const float2 v = *(const float2*)wp; wgt[k][0] = v.x; wgt[k][1] = v.y; wp += 1024; asm volatile("" : "+v"(wp)); } }
    const float2 cb = *(const float2*)(p.in[13] + c0);
    for (int it = blockIdx.x; it < T_ / 16; it += gridDim.x) {
        const int t0 = it * 16, s0 = t0 & 8191;
        float acc[16][2];
#pragma unroll
        for (int j = 0; j < 16; ++j) { acc[j][0] = cb.x; acc[j][1] = cb.y; }
        const bf16_t* xp = Hg + ((long)t0 - 30) * 1024 + c0;
#pragma unroll
        for (int i = 0; i < 46; ++i) {
            const int s = s0 - 30 + i;
            float x0 = 0.f, x1 = 0.f;
            if (s >= 0) { const unsigned u = *(const unsigned*)xp; x0 = bf2f(u & 0xffffu); x1 = bf2f(u >> 16); }
            xp += 1024; asm volatile("" : "+v"(xp));
#pragma unroll
            for (int j = 0; j < 16; ++j) { const int k = i - j; if (k >= 0 && k <= 30) { acc[j][0] += wgt[k][0] * x0; acc[j][1] += wgt[k][1] * x1; } }
        }
#pragma unroll
        for (int j = 0; j < 16; ++j) {
            *(float2*)(pre + (size_t)(t0 + j) * 1024 + c0) = make_float2(acc[j][0], acc[j][1]);
            const float sv = wave_sum(acc[j][0] + acc[j][1]);
            const float qv = wave_sum(acc[j][0] * acc[j][0] + acc[j][1] * acc[j][1]);
            if (lane == 0) *(float2*)(cst + ((size_t)(t0 + j) * 8 + w) * 2) = make_float2(sv, qv);
        }
    }
}
DEVI void conv_finish(const Params& p) {
    unsigned char* ws = p.ws;
    int tid = threadIdx.x; asm volatile("" : "+v"(tid));
    const int lane = tid & 63, w = tid >> 6;
    const float* pre = p.out;
    const float* cst = (const float*)(ws + WS_LIST);
    bf16_t* CC = (bf16_t*)(ws + WS_BUFA);
    for (int it = blockIdx.x; it < T_ / 8; it += gridDim.x) {
        const int t = it * 8 + w;
        float sv = 0.f, qv = 0.f;
#pragma unroll
        for (int k = 0; k < 8; ++k) { const float2 a = *(const float2*)(cst + ((size_t)t * 8 + k) * 2); sv += a.x; qv += a.y; }
        const float mean = sv * (1.f / 1024.f);
        float var = qv * (1.f / 1024.f) - mean * mean; var = var > 0.f ? var : 0.f;
        const float rstd = 1.f / sqrtf(var + LN_EPS);
#pragma unroll
        for (int c = 0; c < 4; ++c) {
            const int col = c * 256 + lane * 4;
            const f32x4 x = *(const f32x4*)(pre + (size_t)t * 1024 + col), g = *(const f32x4*)(p.in[14] + col), bb = *(const f32x4*)(p.in[15] + col);
            f32x4 y = (x - mean) * rstd * g + bb;
            y.x *= sigmoidf_(y.x); y.y *= sigmoidf_(y.y); y.z *= sigmoidf_(y.z); y.w *= sigmoidf_(y.w);
            u32x2 o; o.x = cvt_pk_bf16(y.x, y.y); o.y = cvt_pk_bf16(y.z, y.w);
            *(u32x2*)(CC + (size_t)t * 2048 + 1024 + col) = o;
        }
    }
}

enum { M_CMP = 0, M_SEL = 1, M_WIN = 2 };
constexpr int KSTR = 72;
constexpr int NSA_KBUF = 0, NSA_VBUF = 49152;
constexpr int NSA_IMP = 98304;
constexpr int NSA_TBL = 132096;
constexpr int NSA_SEL = NSA_TBL + 4096;
constexpr int NSA_UNIT = NSA_SEL + 1024;

DEVI void attn_issue(char* kdst, char* vdst, const bf16_t* kt, const bf16_t* vt, int vstride, int tid) {
    const int row = tid >> 3, c = (tid & 7) ^ ((row >> 1) & 7);
    glds16(kt + row * 64 + c * 8, kdst + tid * 16);
    glds16(vt + (size_t)row * vstride + c * 8, vdst + tid * 16);
}

constexpr float NSA_THR = 8.f;
template <int MODE, int PASS>
DEVI void nsa_branch(char* smem, const bf16_t* kg, const bf16_t* vg, int vstride, int t_lo, int t_hi, int far_lo, int far_hi, const bf16x8 (&qf)[4], int tq,
                     float c31, const LAS float* tblg, const LAS unsigned* selrow, float& m_ref, bool& mset, f32x16& lacc, float inv_l, f32x16 (&o)[2], LAS float* imp_row) {
    int tid = threadIdx.x; asm volatile("" : "+v"(tid));
    const int lane = tid & 63, l31 = lane & 31, h = lane >> 5, xs = (l31 >> 1) & 7;
    const int n = t_hi - t_lo + 1;
    f32x16 cneg;
    { const float cc = c31 - m_ref;
#pragma unroll
      for (int i = 0; i < 16; ++i) cneg[i] = cc; }
    u32x4 ones_u; ones_u.x = ones_u.y = ones_u.z = ones_u.w = 0x3F803F80u;
    const bf16x8 ones = __builtin_bit_cast(bf16x8, ones_u);
    float imp_carry = 0.f;
    const int nS = (n + 1) >> 1;
#define NSA_ISSUE_PAIR(js_) do { const int _sl = (js_) % 3; \
        _Pragma("unroll") for (int _sb = 0; _sb < 2; ++_sb) { int _t = t_lo + 2 * (js_) + _sb; _t = _t > t_hi ? t_hi : _t; \
            attn_issue(smem + NSA_KBUF + _sl * 16384 + _sb * 8192, smem + NSA_VBUF + _sl * 16384 + _sb * 8192, kg + (size_t)_t * 4096, vg + _t * 64, vstride, tid); } } while (0)
    NSA_ISSUE_PAIR(0);
    if (nS > 1) NSA_ISSUE_PAIR(1);
    for (int it = 0; it < n; ++it) {
        const int ti = t_lo + it, js = it >> 1, buf = (js % 3) * 2 + (it & 1);
        if ((it & 1) == 0) {
            if (js + 1 < nS) asm volatile("s_waitcnt vmcnt(4)" ::: "memory"); else asm volatile("s_waitcnt vmcnt(0)" ::: "memory");
            __builtin_amdgcn_s_barrier();
            asm volatile("" ::: "memory");
            if (js + 2 < nS) NSA_ISSUE_PAIR(js + 2);
        }
        bool selbit = true;
        if (MODE == M_SEL) { selbit = (selrow[ti >> 5] >> (ti & 31)) & 1u; if (!__any(selbit)) continue; }
        const char* Kc = smem + NSA_KBUF + buf * 8192; const char* Vc = smem + NSA_VBUF + buf * 8192;
        f32x16 s[2];
        {
            const int off0 = (h ^ xs) << 4;
            s[0] = mfma32(*(const bf16x8*)(Kc + l31 * 128 + off0), qf[0], cneg);
            s[1] = mfma32(*(const bf16x8*)(Kc + (32 + l31) * 128 + off0), qf[0], cneg);
        }
#pragma unroll
        for (int ks = 1; ks < 4; ++ks) {
            const int off = ((2 * ks + h) ^ xs) << 4;
            s[0] = mfma32(*(const bf16x8*)(Kc + l31 * 128 + off), qf[ks], s[0]);
            s[1] = mfma32(*(const bf16x8*)(Kc + (32 + l31) * 128 + off), qf[ks], s[1]);
        }
        const bool far = (ti >= far_lo) && (ti <= far_hi);
        {
        if (!far) {
            const int dbase = (MODE == M_CMP) ? (tq - 31 - 1024 * ti) : (tq - 64 * ti);
#pragma unroll
            for (int u = 0; u < 2; ++u)
#pragma unroll
                for (int i = 0; i < 16; ++i) {
                    const int kk = 32 * u + (i & 3) + 8 * (i >> 2) + 4 * h;
                    const int dist = dbase - ((MODE == M_CMP) ? 16 * kk : kk);
                    const int idx = (dist < -1 ? -1 : (dist > 191 ? 191 : dist)) + 64;
                    float v = s[u][i] + tblg[idx];
                    if (MODE == M_WIN) v = (dist < 512) ? v : -INFINITY;
                    if (MODE == M_SEL) v = selbit ? v : -INFINITY;
                    s[u][i] = v;
                    if ((i & 3) == 3) asm volatile("" ::: "memory");
                }
        }
        if (PASS != 2) {
            float mx = fmaxf(s[0][0], s[1][0]);
#pragma unroll
            for (int i = 1; i < 16; ++i) mx = fmaxf(mx, fmaxf(s[0][i], s[1][i]));
            if (MODE == M_SEL && !selbit) mx = -INFINITY;
            if (__any(mx > NSA_THR || (!mset && mx > -INFINITY))) {
                const float mc = fmaxf(mx, __shfl_xor(mx, 32));
                const bool mv = (mc > NSA_THR) || (!mset && mc > -INFINITY);
                const float delta = mv ? mc : 0.f;
                const float alpha = mset ? fexp2(-delta) : 1.f;
                mset = mset || mv;
                m_ref += delta;
                const float cc = c31 - m_ref;
#pragma unroll
                for (int i = 0; i < 16; ++i) { cneg[i] = cc; lacc[i] *= alpha; }
#pragma unroll
                for (int u = 0; u < 2; ++u)
#pragma unroll
                    for (int i = 0; i < 16; ++i) s[u][i] -= delta;
                if (PASS == 0) {
#pragma unroll
                    for (int v = 0; v < 2; ++v)
#pragma unroll
                        for (int i = 0; i < 16; ++i) o[v][i] *= alpha;
                }
            }
        }
#pragma unroll
        for (int u = 0; u < 2; ++u)
#pragma unroll
            for (int i = 0; i < 16; ++i) s[u][i] = fexp2(s[u][i]);
        if (PASS == 2) {
            float mainv[8], halfv[8];
#pragma unroll
            for (int u = 0; u < 2; ++u)
#pragma unroll
                for (int c4 = 0; c4 < 4; ++c4) {
                    float hv = 0.5f * s[u][4 * c4 + 3] * inv_l;
                    float mv = ((s[u][4 * c4] + s[u][4 * c4 + 1]) + s[u][4 * c4 + 2]) * inv_l + hv;
                    mv += __builtin_bit_cast(float, __builtin_amdgcn_update_dpp(0, __builtin_bit_cast(int, mv), 0xB1, 0xF, 0xF, true));
                    hv += __builtin_bit_cast(float, __builtin_amdgcn_update_dpp(0, __builtin_bit_cast(int, hv), 0xB1, 0xF, 0xF, true));
                    mv += __builtin_bit_cast(float, __builtin_amdgcn_update_dpp(0, __builtin_bit_cast(int, mv), 0x4E, 0xF, 0xF, true));
                    hv += __builtin_bit_cast(float, __builtin_amdgcn_update_dpp(0, __builtin_bit_cast(int, hv), 0x4E, 0xF, 0xF, true));
                    mainv[u * 4 + c4] = mv; halfv[u * 4 + c4] = __shfl_xor(hv, 32);
                }
#pragma unroll
            for (int gi = 0; gi < 8; ++gi) {
                const float cin = h ? halfv[gi] : (gi ? halfv[gi - 1] : imp_carry);
                const unsigned ia = (unsigned)(size_t)(imp_row + 16 * ti + 2 * gi + h);
                const float val = mainv[gi] + cin;
                asm volatile("ds_write_b32 %0, %1" :: "v"(ia), "v"(val) : "memory");
            }
            imp_carry = halfv[7];
        }
        const unsigned pmask = (MODE == M_SEL && far && !selbit) ? 0u : 0xFFFFFFFFu;
#pragma unroll
        for (int u = 0; u < 2; ++u)
#pragma unroll
            for (int sI = 0; sI < 2; ++sI) {
                u32x4 pk;
                pk.x = cvt_pk_bf16(s[u][8 * sI + 0], s[u][8 * sI + 1]); pk.y = cvt_pk_bf16(s[u][8 * sI + 2], s[u][8 * sI + 3]);
                pk.z = cvt_pk_bf16(s[u][8 * sI + 4], s[u][8 * sI + 5]); pk.w = cvt_pk_bf16(s[u][8 * sI + 6], s[u][8 * sI + 7]);
                if (MODE == M_SEL) { pk.x &= pmask; pk.y &= pmask; pk.z &= pmask; pk.w &= pmask; }
                const bf16x8 pf = __builtin_bit_cast(bf16x8, pk);
                lacc = mfma32(ones, pf, lacc);
                if (PASS != 1) {
                    const int voff = ((2 * (2 * u + sI) + h) ^ xs) << 4;
                    o[0] = mfma32(*(const bf16x8*)(Vc + l31 * 128 + voff), pf, o[0]);
                    o[1] = mfma32(*(const bf16x8*)(Vc + (32 + l31) * 128 + voff), pf, o[1]);
                }
            }
        }
    }
    if (PASS == 2) {
        const int c = 16 * (t_hi + 1);
        if (h == 0 && c < 128) { const unsigned ia = (unsigned)(size_t)(imp_row + c); asm volatile("ds_write_b32 %0, %1" :: "v"(ia), "v"(imp_carry) : "memory"); }
        asm volatile("s_waitcnt lgkmcnt(0)" ::: "memory");
    }
#undef NSA_ISSUE_PAIR
    __syncthreads();
}

DEVI void phase_nsa(const Params& p, char* smem, int ctr_idx) {
    unsigned char* ws = p.ws;
    const int tid0 = threadIdx.x;
    float* imp = (float*)(smem + NSA_IMP);
    unsigned* tot = (unsigned*)(smem + NSA_IMP);
    float* tbl = (float*)(smem + NSA_TBL);
    unsigned* selm = (unsigned*)(smem + NSA_SEL);
    int* sunit = (int*)(smem + NSA_UNIT);
    unsigned* ctr = (unsigned*)(ws + WS_CTL) + CW_NSA + 256 * ctr_idx;
    unsigned* trc = (unsigned*)(ws + WS_CTL) + CW_TR;
    const bf16_t* Q = (const bf16_t*)(ws + WS_BUFB);
    const float* G = (const float*)(ws + WS_BUFC + C_GATES);
    bf16_t* CC = ctr_idx ? (bf16_t*)(p.out + 32 * 1024 * 1024) : (bf16_t*)(ws + WS_BUFA);
    for (;;) {
        int tid = tid0; asm volatile("" : "+v"(tid));
        const int lane = tid & 63, w = tid >> 6, l31 = lane & 31, h = lane >> 5;
        const int qi = l31 >> 2, g = l31 & 3, ql = 8 * w + qi;
        __syncthreads();
        if (tid == 0) {
            const unsigned x = xb_xcc_id() & 7u; int u = -1;
            for (unsigned k = 0; k < 8u && u < 0; ++k) { const unsigned xx = (x + k) & 7u; const unsigned i = atomicAdd(ctr + 16 * xx, 1u); if (i < 256u) u = (int)(i * 8u + xx); }
            *sunit = u;
        }
        __syncthreads();
        const int unit = *sunit;
        if (unit < 0) break;
        const int xq = unit & 7, iq = unit >> 3;
        const int qt = 127 - (iq >> 1), bh = 2 * xq + (iq & 1), b = bh >> 2, hkv = bh & 3, q0 = qt * 64, cur = qt;
        for (int i = tid; i < 4 * 256; i += 512) {
            const int gg = i >> 8, d = (i & 255) - 64;
            float val = -INFINITY;
            if (d >= 0) {
                int bucket;
                if (d < 16) bucket = d;
                else if (d >= 128) bucket = 31;
                else { const int lg = 16 + (int)(logf((float)d / 16.f) / 2.0794415416798357f * 16.f); bucket = lg < 31 ? lg : 31; }
                val = (p.in[11][bucket * 16 + hkv * 4 + gg] - p.in[11][31 * 16 + hkv * 4 + gg]) * LOG2E;
            }
            tbl[i] = val;
        }
        if (tid < 256) selm[tid] = 0u;
        const int tq = q0 + ql;
        const size_t trow = (size_t)b * 8192 + tq;
        bf16x8 qf[4];
        { const bf16_t* qrow = Q + trow * 1024 + hkv * 256 + g * 64;
#pragma unroll
          for (int ks = 0; ks < 4; ++ks) qf[ks] = *(const bf16x8*)(qrow + 16 * ks + 8 * h); }
        float c31 = p.in[11][31 * 16 + hkv * 4 + g] * LOG2E;
        asm volatile("" : "+v"(qf[0]), "+v"(qf[1]), "+v"(qf[2]), "+v"(qf[3]), "+v"(c31));
        const LAS float* tblg = (const LAS float*)(smem + NSA_TBL) + g * 256;
        const LAS unsigned* selrow = (const LAS unsigned*)(smem + NSA_SEL) + ql * 4;
        f32x16 o[2];
#pragma unroll
        for (int v = 0; v < 2; ++v)
#pragma unroll
            for (int i = 0; i < 16; ++i) o[v][i] = 0.f;
        __syncthreads();
        const bf16_t* kc = (const bf16_t*)(ws + WS_BUFC + C_KC) + (size_t)bh * 512 * 64;
        const bf16_t* vct = (const bf16_t*)(ws + WS_BUFC + C_VCT) + (size_t)bh * 64 * 512;
        const int ct_hi = (q0 + 32) >> 10, cfar_hi = (q0 >= 1167) ? ((q0 - 1167) >> 10) : -1;
        float m_ref = 0.f; bool mset = false;
        f32x16 lacc;
#pragma unroll
        for (int i = 0; i < 16; ++i) lacc[i] = 0.f;
        const int rmode = ctr_idx ? NSA_REP_MODE : 0;
        if (rmode != 2) nsa_branch<M_CMP, 1>(smem, kc, vct, 512, 0, ct_hi, 0, cfar_hi, qf, tq, c31, tblg, selrow, m_ref, mset, lacc, 0.f, o, (LAS float*)(smem + NSA_IMP) + ql * 132);
        { const float lt = lacc[0]; const float inv = lt > 0.f ? 1.f / lt : 0.f;
          if (rmode != 2 && rmode != 4) nsa_branch<M_CMP, 2>(smem, kc, vct, 512, 0, ct_hi, 0, cfar_hi, qf, tq, c31, tblg, selrow, m_ref, mset, lacc, inv, o, (LAS float*)(smem + NSA_IMP) + ql * 132);
#pragma unroll
          for (int v = 0; v < 2; ++v)
#pragma unroll
            for (int i = 0; i < 16; ++i) o[v][i] *= inv; }
        asm volatile("s_waitcnt lgkmcnt(0)" ::: "memory"); __syncthreads();
        if (rmode < 2) {
            const int q = tid >> 3, sub = tid & 7, t = q0 + q;
            unsigned key[16];
#pragma unroll
            for (int i = 0; i < 16; ++i) {
                const int j = sub * 16 + i;
                const bool forced = (j == 0) || (j == cur) || (j == cur - 1);
                const bool valid = (j * 64 <= t);
                const float v = imp[q * 132 + j];
                key[i] = forced ? 0xFFFFFFFFu : (valid ? (__float_as_uint(v) + 1u) : 0u);
            }
            unsigned tau = 0u;
            for (int bit = 31; bit >= 0; --bit) {
                const unsigned cand = tau | (1u << bit);
                int c = 0;
#pragma unroll
                for (int i = 0; i < 16; ++i) c += (key[i] >= cand) ? 1 : 0;
                c += __builtin_amdgcn_update_dpp(0, c, 0xB1, 0xF, 0xF, true); c += __builtin_amdgcn_update_dpp(0, c, 0x4E, 0xF, 0xF, true); c += __builtin_amdgcn_update_dpp(0, c, 0x141, 0xF, 0xF, true);
                if (c >= 16) tau = cand;
            }
            int gt = 0, eq = 0;
#pragma unroll
            for (int i = 0; i < 16; ++i) { gt += (key[i] > tau) ? 1 : 0; eq += (key[i] == tau) ? 1 : 0; }
            int gtt = gt; gtt += __builtin_amdgcn_update_dpp(0, gtt, 0xB1, 0xF, 0xF, true); gtt += __builtin_amdgcn_update_dpp(0, gtt, 0x4E, 0xF, 0xF, true); gtt += __builtin_amdgcn_update_dpp(0, gtt, 0x141, 0xF, 0xF, true);
            int pre = 0;
#pragma unroll
            for (int sI = 0; sI < 7; ++sI) { const int v = __shfl(eq, (lane & ~7) + sI); if (sI < sub) pre += v; }
            const int need = 16 - gtt;
            unsigned bits = 0u; int run = pre;
#pragma unroll
            for (int i = 0; i < 16; ++i) {
                bool sel = key[i] > tau;
                if (tau > 0u && key[i] == tau) { sel = run < need; ++run; }
                bits |= sel ? (1u << i) : 0u;
            }
            atomicOr(&selm[q * 4 + (sub >> 1)], bits << ((sub & 1) * 16));
        }
        __syncthreads();
        const float gc = G[((size_t)b * 8192 + tq) * 48 + hkv * 12 + g * 3 + 0];
#pragma unroll
        for (int v = 0; v < 2; ++v)
#pragma unroll
            for (int i = 0; i < 16; i += 2) { const float gcc = (PROBE == 1 ? 0.f : gc); tot[(v * 8 + (i >> 1)) * 512 + tid] = cvt_pk_bf16(gcc * o[v][i], gcc * o[v][i + 1]); o[v][i] = 0.f; o[v][i + 1] = 0.f; }
        {
            const bf16_t* ks = (const bf16_t*)(ws + WS_BUFC + C_KS) + (size_t)bh * 8192 * 64;
            const bf16_t* vst = (const bf16_t*)(ws + WS_BUFC + C_VST) + (size_t)bh * 64 * 8192;
            m_ref = 0.f; mset = false;
#pragma unroll
            for (int i = 0; i < 16; ++i) lacc[i] = 0.f;
            if (rmode == 0) nsa_branch<M_SEL, 0>(smem, ks, vst, 8192, 0, cur, 0, cur - 3, qf, tq, c31, tblg, selrow, m_ref, mset, lacc, 0.f, o, (LAS float*)nullptr);
            const float gs = G[((size_t)b * 8192 + tq) * 48 + hkv * 12 + g * 3 + 1];
            const float sc = (PROBE == 2 ? 0.f : gs) / lacc[0];
#pragma unroll
            for (int v = 0; v < 2; ++v)
#pragma unroll
                for (int i = 0; i < 16; i += 2) { const unsigned tv = tot[(v * 8 + (i >> 1)) * 512 + tid];
                    tot[(v * 8 + (i >> 1)) * 512 + tid] = cvt_pk_bf16(bf2f(tv & 0xffffu) + sc * o[v][i], bf2f(tv >> 16) + sc * o[v][i + 1]); o[v][i] = 0.f; o[v][i + 1] = 0.f; }
        }
        {
            const bf16_t* kw = (const bf16_t*)(ws + WS_BUFC + C_KW) + (size_t)bh * 8192 * 64;
            const bf16_t* vwt = (const bf16_t*)(ws + WS_BUFC + C_VWT) + (size_t)bh * 64 * 8192;
            m_ref = 0.f; mset = false;
#pragma unroll
            for (int i = 0; i < 16; ++i) lacc[i] = 0.f;
            const int w_lo = cur >= 8 ? cur - 8 : 0;
            if (rmode == 0 || rmode == 2) nsa_branch<M_WIN, 0>(smem, kw, vwt, 8192, w_lo, cur, cur - 7, cur - 3, qf, tq, c31, tblg, selrow, m_ref, mset, lacc, 0.f, o, (LAS float*)nullptr);
            const float gw = G[((size_t)b * 8192 + tq) * 48 + hkv * 12 + g * 3 + 2];
            const float sc = (PROBE == 3 ? 0.f : gw) / lacc[0];
            bf16_t* orow = CC + trow * 2048 + hkv * 256 + g * 64;
#pragma unroll
            for (int v = 0; v < 2; ++v)
#pragma unroll
                for (int c4 = 0; c4 < 4; ++c4) {
                    const unsigned ta = tot[(v * 8 + 2 * c4) * 512 + tid], tb = tot[(v * 8 + 2 * c4 + 1) * 512 + tid];
                    const float r0 = bf2f(ta & 0xffffu) + sc * o[v][4 * c4 + 0], r1 = bf2f(ta >> 16) + sc * o[v][4 * c4 + 1];
                    const float r2 = bf2f(tb & 0xffffu) + sc * o[v][4 * c4 + 2], r3 = bf2f(tb >> 16) + sc * o[v][4 * c4 + 3];
                    u32x2 ov; ov.x = cvt_pk_bf16(r0, r1); ov.y = cvt_pk_bf16(r2, r3);
                    *(u32x2*)(orow + 32 * v + 8 * c4 + 4 * h) = ov;
                }
        }
        if (ctr_idx == 0) {
            __syncthreads();
            for (int k = 0; k < 3; ++k) {
                int item = 0;
                if (lane == 0) item = (int)atomicAdd(trc, 1u);
                item = __builtin_amdgcn_readfirstlane(item);
                if (item >= MOE_W_ITEMS) break;
                moe_weight_item(p, smem, item);
            }
        }
    }
    if (ctr_idx == 0) {
        __syncthreads();
        for (;;) {
            int item = 0;
            if ((threadIdx.x & 63) == 0) item = (int)atomicAdd(trc, 1u);
            item = __builtin_amdgcn_readfirstlane(item);
            if (item >= MOE_W_ITEMS) break;
            moe_weight_item(p, smem, item);
        }
    }
}

template <int which>
DEVI void phase_ln(const Params& p) {
    unsigned char* ws = p.ws;
    int tid = threadIdx.x; asm volatile("" : "+v"(tid));
    const int lane = tid & 63, w = tid >> 6;
    for (int it = blockIdx.x; it < T_ / 8; it += gridDim.x) {
        const int t = it * 8 + w;
        float* row = p.out + (size_t)t * D_;
        f32x4 v[8]; row_load(row, lane, v);
        float mean, rstd; row_stats(v, mean, rstd);
        if (which == 0) {
            if (lane == 0) { float* st = (float*)(ws + WS_STATS); st[t * 2] = mean; st[t * 2 + 1] = rstd; }
            bf16_t* hi = (bf16_t*)(ws + WS_BUFB) + (size_t)t * D_;
#pragma unroll
            for (int c = 0; c < 8; ++c) {
                const int col = c * 256 + lane * 4;
                const f32x4 g = *(const f32x4*)(p.in[17] + col), b = *(const f32x4*)(p.in[18] + col);
                const f32x4 y = (v[c] - mean) * rstd * g + b;
                u32x2 o; o.x = cvt_pk_bf16(y.x, y.y); o.y = cvt_pk_bf16(y.z, y.w);
                *(u32x2*)(hi + col) = o;
            }
        } else if (which == 1) {
            bf16_t* hi = (bf16_t*)(ws + WS_BUFA) + (size_t)t * D_;
            bf16_t* lo = (bf16_t*)(ws + WS_BUFB) + (size_t)t * D_;
#pragma unroll
            for (int c = 0; c < 8; ++c) {
                const int col = c * 256 + lane * 4;
                const f32x4 g = *(const f32x4*)(p.in[24] + col), b = *(const f32x4*)(p.in[25] + col);
                const f32x4 y = (v[c] - mean) * rstd * g + b;
                u32x2 o; o.x = cvt_pk_bf16(y.x, y.y); o.y = cvt_pk_bf16(y.z, y.w);
                *(u32x2*)(hi + col) = o;
                u32x2 ol;
                ol.x = cvt_pk_bf16(y.x - bf2f(o.x & 0xffffu), y.y - bf2f(o.x >> 16));
                ol.y = cvt_pk_bf16(y.z - bf2f(o.y & 0xffffu), y.w - bf2f(o.y >> 16));
                *(u32x2*)(lo + col) = ol;
            }
        } else {
            const bf16_t* y0 = (const bf16_t*)(ws + WS_BUFC) + (size_t)t * 2 * D_;
#pragma unroll
            for (int c = 0; c < 8; ++c) {
                const int col = c * 256 + lane * 4;
                const f32x4 g = *(const f32x4*)(p.in[24] + col), b = *(const f32x4*)(p.in[25] + col);
                const f32x4 x2 = (v[c] - mean) * rstd * g + b;
                const u32x2 a = *(const u32x2*)(y0 + col), bq = *(const u32x2*)(y0 + D_ + col);
                v[c].x = x2.x * ALPHA + (bf2f(a.x & 0xffffu) + bf2f(bq.x & 0xffffu));
                v[c].y = x2.y * ALPHA + (bf2f(a.x >> 16) + bf2f(bq.x >> 16));
                v[c].z = x2.z * ALPHA + (bf2f(a.y & 0xffffu) + bf2f(bq.y & 0xffffu));
                v[c].w = x2.w * ALPHA + (bf2f(a.y >> 16) + bf2f(bq.y >> 16));
            }
            row_stats(v, mean, rstd);
#pragma unroll
            for (int c = 0; c < 8; ++c) {
                const int col = c * 256 + lane * 4;
                const f32x4 g = *(const f32x4*)(p.in[33] + col), b = *(const f32x4*)(p.in[34] + col);
                *(f32x4*)(row + col) = (v[c] - mean) * rstd * g + b;
            }
        }
    }
}

DEVI void phase_xattn(const Params& p, char* smem) {
    unsigned char* ws = p.ws;
    int tid = threadIdx.x; asm volatile("" : "+v"(tid));
    const int lane = tid & 63, w = tid >> 6, l31 = lane & 31, h = lane >> 5;
    const bf16_t* Qx = (const bf16_t*)(ws + WS_BUFC);
    const bf16_t* Kx = (const bf16_t*)(ws + WS_BUFD + 4 * MiB);
    const bf16_t* Vt = (const bf16_t*)(ws + WS_BUFD + 8 * MiB);
    bf16_t* Ox = (bf16_t*)(ws + WS_BUFA);
    bf16_t* Qs = (bf16_t*)smem;
    bf16_t* Ks = Qs + 256 * KSTR;
    bf16_t* Vs = (bf16_t*)smem;
    for (int unit = blockIdx.x; unit < 512; unit += gridDim.x) {
        const int qt = unit & 31, head = (unit >> 5) & 3, b = unit >> 7;
        const size_t t0 = (size_t)b * 8192 + qt * 256;
        const bf16_t* kbase = Kx + (size_t)(b * 4 + head) * 256 * 512;
        const bf16_t* vbase = Vt + (size_t)(b * 4 + head) * 512 * 256;
        f32x16 s[8];
#pragma unroll
        for (int u = 0; u < 8; ++u)
#pragma unroll
            for (int i = 0; i < 16; ++i) s[u][i] = 0.f;
        u32x4 pq[4], pk4[4];
#pragma unroll
        for (int i = 0; i < 4; ++i) { const int c = tid + 512 * i, row = c >> 3, ch = c & 7;
            pq[i] = *(const u32x4*)(Qx + (t0 + row) * 2048 + head * 512 + ch * 8); pk4[i] = *(const u32x4*)(kbase + (size_t)row * 512 + ch * 8); }
        for (int dc = 0; dc < 8; ++dc) {
            __syncthreads();
#pragma unroll
            for (int i = 0; i < 4; ++i) { const int c = tid + 512 * i, row = c >> 3, ch = c & 7;
                *(u32x4*)(Qs + row * KSTR + ch * 8) = pq[i]; *(u32x4*)(Ks + row * KSTR + ch * 8) = pk4[i]; }
            __syncthreads();
            if (dc + 1 < 8) {
#pragma unroll
                for (int i = 0; i < 4; ++i) { const int c = tid + 512 * i, row = c >> 3, ch = c & 7;
                    pq[i] = *(const u32x4*)(Qx + (t0 + row) * 2048 + head * 512 + (dc + 1) * 64 + ch * 8); pk4[i] = *(const u32x4*)(kbase + (size_t)row * 512 + (dc + 1) * 64 + ch * 8); }
            }
#pragma unroll
            for (int ks = 0; ks < 4; ++ks) {
                const bf16x8 qb = *(const bf16x8*)(Qs + (32 * w + l31) * KSTR + 16 * ks + 8 * h);
#pragma unroll
                for (int u = 0; u < 8; ++u) { const bf16x8 ka = *(const bf16x8*)(Ks + (32 * u + l31) * KSTR + 16 * ks + 8 * h); s[u] = mfma32(ka, qb, s[u]); }
            }
        }
        u32x4 pv[4];
#pragma unroll
        for (int i = 0; i < 4; ++i) { const int c = tid + 512 * i, row = c >> 5, ch = c & 31; pv[i] = *(const u32x4*)(vbase + (size_t)row * 256 + ch * 8); }
        float mx = -INFINITY;
#pragma unroll
        for (int u = 0; u < 8; ++u)
#pragma unroll
            for (int i = 0; i < 16; ++i) mx = fmaxf(mx, s[u][i]);
        mx = fmaxf(mx, __shfl_xor(mx, 32));
        float ls = 0.f;
        bf16x8 pf[8][2];
#pragma unroll
        for (int u = 0; u < 8; ++u) {
#pragma unroll
            for (int i = 0; i < 16; ++i) { s[u][i] = fexp2(s[u][i] - mx); ls += s[u][i]; }
#pragma unroll
            for (int sI = 0; sI < 2; ++sI) { u32x4 pk;
                pk.x = cvt_pk_bf16(s[u][8 * sI + 0], s[u][8 * sI + 1]); pk.y = cvt_pk_bf16(s[u][8 * sI + 2], s[u][8 * sI + 3]);
                pk.z = cvt_pk_bf16(s[u][8 * sI + 4], s[u][8 * sI + 5]); pk.w = cvt_pk_bf16(s[u][8 * sI + 6], s[u][8 * sI + 7]);
                pf[u][sI] = __builtin_bit_cast(bf16x8, pk); }
        }
        ls += __shfl_xor(ls, 32);
        const float inv = (PROBE == 4 ? 0.f : 1.f) / ls;
        bf16_t* orow = Ox + (t0 + 32 * w + l31) * 2048 + head * 512;
        for (int dc = 0; dc < 8; ++dc) {
            __syncthreads();
#pragma unroll
            for (int i = 0; i < 4; ++i) { const int c = tid + 512 * i, row = c >> 5, ch = c & 31; *(u32x4*)(Vs + row * 264 + ch * 8) = pv[i]; }
            __syncthreads();
            if (dc + 1 < 8) {
#pragma unroll
                for (int i = 0; i < 4; ++i) { const int c = tid + 512 * i, row = c >> 5, ch = c & 31; pv[i] = *(const u32x4*)(vbase + (size_t)((dc + 1) * 64 + row) * 256 + ch * 8); }
            }
            f32x16 o[2];
#pragma unroll
            for (int v = 0; v < 2; ++v)
#pragma unroll
                for (int i = 0; i < 16; ++i) o[v][i] = 0.f;
#pragma unroll
            for (int s4 = 0; s4 < 16; ++s4)
#pragma unroll
                for (int v = 0; v < 2; ++v) {
                    const bf16_t* vr = Vs + (32 * v + l31) * 264 + 16 * s4 + 4 * h;
                    const u32x2 a = *(const u32x2*)vr, bq = *(const u32x2*)(vr + 8);
                    u32x4 vv; vv.x = a.x; vv.y = a.y; vv.z = bq.x; vv.w = bq.y;
                    o[v] = mfma32(__builtin_bit_cast(bf16x8, vv), pf[s4 >> 1][s4 & 1], o[v]);
                }
#pragma unroll
            for (int v = 0; v < 2; ++v)
#pragma unroll
                for (int c4 = 0; c4 < 4; ++c4) {
                    u32x2 ov; ov.x = cvt_pk_bf16(o[v][4 * c4] * inv, o[v][4 * c4 + 1] * inv); ov.y = cvt_pk_bf16(o[v][4 * c4 + 2] * inv, o[v][4 * c4 + 3] * inv);
                    *(u32x2*)(orow + dc * 64 + 32 * v + 8 * c4 + 4 * h) = ov;
                }
        }
        __syncthreads();
    }
}

DEVI void phase_route(const Params& p) {
    unsigned char* ws = p.ws;
    const float* L = (const float*)(ws + WS_LOGITS);
    unsigned* cnt = (unsigned*)(ws + WS_CTL) + CW_CNT;
    int* list = (int*)(ws + WS_LIST);
    float* wt = (float*)(ws + WS_WTOK);
    int tid = threadIdx.x; asm volatile("" : "+v"(tid));
    for (int t = blockIdx.x * NTHREADS + tid; t < T_; t += gridDim.x * NTHREADS) {
        const f32x4 lgv = *(const f32x4*)(L + (size_t)t * 40);
        float lg[4] = {lgv.x + p.in[27][0], lgv.y + p.in[27][1], lgv.z + p.in[27][2], lgv.w + p.in[27][3]};
        int grp = 0; float best = lg[0];
#pragma unroll
        for (int i = 1; i < 4; ++i) if (lg[i] > best) { best = lg[i]; grp = i; }
        float se = 0.f;
#pragma unroll
        for (int i = 0; i < 4; ++i) se += expf(lg[i] - best);
        const float wgrp = 1.f / se;
        const f32x4 e0 = *(const f32x4*)(L + (size_t)t * 40 + 4 + grp * 8), e1 = *(const f32x4*)(L + (size_t)t * 40 + 8 + grp * 8);
        const f32x4 b0 = *(const f32x4*)(p.in[29] + grp * 8), b1 = *(const f32x4*)(p.in[29] + grp * 8 + 4);
        float le[8] = {e0.x + b0.x, e0.y + b0.y, e0.z + b0.z, e0.w + b0.w, e1.x + b1.x, e1.y + b1.y, e1.z + b1.z, e1.w + b1.w};
        int i0 = 0; float v0 = le[0];
#pragma unroll
        for (int i = 1; i < 8; ++i) if (le[i] > v0) { v0 = le[i]; i0 = i; }
        int i1 = -1; float v1 = -INFINITY;
#pragma unroll
        for (int i = 0; i < 8; ++i) if (i != i0 && le[i] > v1) { v1 = le[i]; i1 = i; }
        const float ex = expf(v1 - v0);
        const float w0 = wgrp / (1.f + ex), w1 = wgrp * ex / (1.f + ex);
        const int ea = grp * 8 + i0, eb = grp * 8 + i1;
        const unsigned pa = atomicAdd(cnt + ea, 1u); list[(size_t)ea * T_ + pa] = t * 2;
        const unsigned pb = atomicAdd(cnt + eb, 1u); list[(size_t)eb * T_ + pb] = t * 2 + 1;
        wt[t * 2] = w0; wt[t * 2 + 1] = w1;
    }
}

enum { PH_PREP = 0, PH_PROJ, PH_CMP1, PH_CMP2, PH_NSA, PH_OUT, PH_LN1, PH_WQ, PH_XATTN, PH_WO, PH_LN2, PH_ROUTER, PH_ROUTE, PH_MOE1, PH_MOE2, PH_LN3, PH_COUNT };

__global__ void __launch_bounds__(NTHREADS, 2) fwd_megakernel(Params p) {
    extern __shared__ __attribute__((aligned(16))) char smem[];
    cg::grid_group grid = cg::this_grid();
    volatile LAS unsigned* bar_st = (volatile LAS unsigned*)(smem + LDS_BYTES - 16);
    if (threadIdx.x < 2) bar_st[threadIdx.x] = 0u;
    __syncthreads();
    xcd_barrier_post((unsigned*)(p.ws + WS_CTL) + CW_BAR);
    const int lo = p.ph_lo, hi = p.ph_hi;
    unsigned long long ts0 = 0, ts1 = 0;
    if (TSTAMP_PHASE >= 0) ts0 = __builtin_amdgcn_s_memrealtime();
#ifndef PHMASK
#define PHMASK 0xFFFFFFFFu
#endif
#define IN(k) (lo <= (k) && (k) < hi && ((PHMASK >> (k)) & 1u))
#define SEAM(k) do { if (IN(k) && IN((k) + 1)) { if ((k) == 0) grid.sync(); else xcd_barrier((unsigned*)(p.ws + WS_CTL) + CW_BAR, (volatile LAS unsigned*)(smem + LDS_BYTES - 16)); } if ((k) == TSTAMP_PHASE) ts1 = __builtin_amdgcn_s_memrealtime(); } while (0)
    if (IN(PH_PREP)) for (int r = 0; r < REP_PREP; ++r) phase_prep(p, smem);
    SEAM(PH_PREP);
    if (IN(PH_PROJ)) { for (int r = 0; r < REP_PROJ; ++r) gemm_job<J_PROJ>(p, smem); for (int r = 0; r < REP_SMALL; ++r) gemm_job<J_MEMKV>(p, smem); }
    SEAM(PH_PROJ);
    if (IN(PH_CMP1)) { for (int r = 0; r < REP_SMALL; ++r) gemm_job<J_CMP1>(p, smem); for (int r = 0; r < REP_CONV; ++r) phase_conv(p); }
    SEAM(PH_CMP1);
    if (IN(PH_CMP2)) for (int r = 0; r < REP_SMALL; ++r) gemm_job<J_CMP2>(p, smem);
    SEAM(PH_CMP2);
    if (IN(PH_NSA)) { conv_finish(p); for (int r = 0; r < REP_NSA; ++r) phase_nsa(p, smem, r); }
    SEAM(PH_NSA);
    if (IN(PH_OUT)) for (int r = 0; r < REP_OUT; ++r) gemm_job<J_OUT>(p, smem);
    SEAM(PH_OUT);
    if (IN(PH_WQ)) { gemm_job<J_WQ>(p, smem); for (int r = 1; r < REP_WQ; ++r) gemm_job<J_WQ, WQ_VAR>(p, smem); }
    SEAM(PH_WQ);
    if (IN(PH_XATTN)) for (int r = 0; r < REP_XATTN; ++r) phase_xattn(p, smem);
    SEAM(PH_XATTN);
    if (IN(PH_WO)) gemm_job<J_WO>(p, smem);
    SEAM(PH_WO);
    if (IN(PH_LN2)) phase_ln<1>(p);
    SEAM(PH_LN2);
    if (IN(PH_ROUTER)) for (int r = 0; r < REP_SMALL; ++r) gemm_job<J_ROUTER>(p, smem);
    SEAM(PH_ROUTER);
    if (IN(PH_MOE1)) for (int r = 0; r < REP_MOE; ++r) gemm_job<J_MOE1>(p, smem);
    SEAM(PH_MOE1);
    if (IN(PH_MOE2)) for (int r = 0; r < REP_MOE; ++r) gemm_job<J_MOE2>(p, smem);
    SEAM(PH_MOE2);
    if (IN(PH_LN3)) phase_ln<2>(p);
    if (TSTAMP_PHASE >= 0 && blockIdx.x == 0 && threadIdx.x == 0) { const unsigned long long t2 = __builtin_amdgcn_s_memrealtime(); const unsigned long long wait = 4ull * (ts1 - ts0); while (__builtin_amdgcn_s_memrealtime() - t2 < wait) __builtin_amdgcn_s_sleep(32); }
#undef IN
#undef SEAM
}

#ifndef N_SPLIT
#define N_SPLIT 1
#endif

extern "C" void kernel_launch(void* const* d_in, const int* in_sizes, int n_in, void* d_out, int out_size, void* d_ws, size_t ws_size, hipStream_t stream) {
    static int grid_blocks = 0;
    if (grid_blocks == 0) {
        if (n_in != 35 || ws_size < WS_END || out_size != T_ * D_) { fprintf(stderr, "kernel_launch: unexpected sizes n_in %d ws %zu out %d\n", n_in, ws_size, out_size); grid_blocks = -1; return; }
        int dev = 0, cus = 0, per_cu = 0;
        hipGetDevice(&dev);
        hipDeviceGetAttribute(&cus, hipDeviceAttributeMultiprocessorCount, dev);
        hipFuncSetAttribute((const void*)fwd_megakernel, hipFuncAttributeMaxDynamicSharedMemorySize, LDS_BYTES);
        hipOccupancyMaxActiveBlocksPerMultiprocessor(&per_cu, (const void*)fwd_megakernel, NTHREADS, LDS_BYTES);
        if (per_cu < 1) { fprintf(stderr, "kernel_launch: occupancy query says %d blocks per CU\n", per_cu); grid_blocks = -1; return; }
        if (per_cu > 2) per_cu = 2;
        grid_blocks = cus * per_cu;
        fprintf(stderr, "kernel_launch: %d CUs x %d blocks\n", cus, per_cu);
    }
    if (grid_blocks < 0) return;
    hipMemsetAsync((char*)d_ws + WS_CTL, 0, 1 * MiB, stream);
    hipMemsetAsync((char*)d_ws + WS_RSUM1, 0, 1 * MiB, stream);
    Params p{};
    for (int i = 0; i < 35; ++i) p.in[i] = (const float*)d_in[i];
    p.out = (float*)d_out; p.ws = (unsigned char*)d_ws;
    if (N_SPLIT == 1) {
        p.ph_lo = 0; p.ph_hi = PH_COUNT;
        void* args[] = {&p};
        hipError_t e = hipLaunchCooperativeKernel((const void*)fwd_megakernel, dim3(grid_blocks), dim3(NTHREADS), args, LDS_BYTES, stream);
        if (e != hipSuccess) fprintf(stderr, "cooperative launch failed: %s (grid %d)\n", hipGetErrorString(e), grid_blocks);
    } else {
        for (int ph = 0; ph < PH_COUNT; ++ph) {
            p.ph_lo = ph; p.ph_hi = ph + 1;
            void* args[] = {&p};
            hipError_t e = hipLaunchCooperativeKernel((const void*)fwd_megakernel, dim3(grid_blocks), dim3(NTHREADS), args, LDS_BYTES, stream);
            if (e != hipSuccess) fprintf(stderr, "launch %d failed: %s\n", ph, hipGetErrorString(e));
        }
    }
}
```

```cpp
#include <hip/hip_runtime.h>
#include <hip/hip_cooperative_groups.h>
#include <cstdio>
#include <cstdint>
namespace cg = cooperative_groups;

#define DEVI __device__ __forceinline__
#ifndef REP_PREP
#define REP_PREP 1
#define REP_PROJ 1
#define REP_NSA 1
#define REP_WQ 1
#define WQ_VAR 3
#define REP_XATTN 1
#define REP_MOE 1
#define REP_LN3 1
#define REP_CONV 1
#define REP_OUT 1
#define REP_SMALL 1
#endif
#ifndef NSA_REP_MODE
#define NSA_REP_MODE 0
#endif
#ifndef TSTAMP_PHASE
#define TSTAMP_PHASE -1
#endif
#ifndef PROBE
#define PROBE 0
#endif
typedef unsigned short bf16_t;
typedef __attribute__((ext_vector_type(8))) short bf16x8;
typedef __attribute__((ext_vector_type(4))) float f32x4;
typedef __attribute__((ext_vector_type(16))) float f32x16;
typedef __attribute__((ext_vector_type(4))) unsigned u32x4;
typedef __attribute__((ext_vector_type(2))) unsigned u32x2;

constexpr int T_ = 32768, D_ = 2048, S_ = 8192, NB_ = 4;
constexpr int NPROJ = 4736;
constexpr int IN_COLS = 4656;
constexpr float ALPHA = 1.189207115002721f;
constexpr float LOG2E = 1.4426950408889634f;
constexpr float LN_EPS = 1e-5f;
constexpr int NTHREADS = 512;
constexpr int LDS_BYTES = 147968;

constexpr size_t MiB = 1ull << 20;
constexpr size_t WS_CTL = 0;
constexpr size_t WS_STATS = 1 * MiB;
constexpr size_t WS_C1BIAS = WS_STATS + 256 * 1024;
constexpr size_t WS_WTOK = WS_STATS + 512 * 1024;
constexpr size_t WS_LOGITS = 2 * MiB;
constexpr size_t WS_LIST = 7 * MiB;
constexpr size_t WS_WC1 = 11 * MiB;
constexpr size_t WS_WC2 = 13 * MiB;
constexpr size_t WS_WR = 14 * MiB;
constexpr size_t WS_WIN = 15 * MiB;
constexpr size_t WS_WOUT = 34 * MiB;
constexpr size_t WS_WQ = 42 * MiB;
constexpr size_t WS_WKV = 50 * MiB;
constexpr size_t WS_WO = 66 * MiB;
constexpr size_t WS_WGU = 74 * MiB;
constexpr size_t WS_WD = 202 * MiB;
constexpr size_t WS_BUFA = 266 * MiB;
constexpr size_t WS_BUFB = 394 * MiB;
constexpr size_t WS_BUFC = 522 * MiB;
constexpr size_t WS_BUFD = 650 * MiB;
constexpr size_t WS_END = 778 * MiB;
constexpr size_t C_KCMP = 0, C_VCMP = 16 * MiB, C_KS = 32 * MiB, C_VST = 48 * MiB, C_KW = 64 * MiB, C_VWT = 80 * MiB,
                 C_GATES = 96 * MiB, C_HID = 102 * MiB, C_KC = 110 * MiB, C_VCT = 111 * MiB;
constexpr int CW_CNT = 64;
constexpr int CW_NSA = 1024;
constexpr int CW_TR = 2048;
constexpr int CW_BAR = 4096;
constexpr size_t CTL_U1 = 65536, CTL_C1 = 73728;
constexpr size_t WS_RSUM1 = WS_LOGITS;

struct Params {
    const float* in[35];
    float* out;
    unsigned char* ws;
    int ph_lo, ph_hi;
};

DEVI unsigned cvt_pk_bf16(float lo, float hi) { unsigned r; asm("v_cvt_pk_bf16_f32 %0, %1, %2" : "=v"(r) : "v"(lo), "v"(hi)); return r; }
DEVI bf16_t f2bf(float x) { return (bf16_t)(cvt_pk_bf16(x, 0.f) & 0xffffu); }
DEVI float bf2f(unsigned b) { return __uint_as_float(b << 16); }
DEVI void glds16(const void* g, void* l) {
    __builtin_amdgcn_global_load_lds((const __attribute__((address_space(1))) void*)g, (__attribute__((address_space(3))) void*)l, 16, 0, 0);
}
DEVI f32x16 mfma32(bf16x8 a, bf16x8 b, f32x16 c) { return __builtin_amdgcn_mfma_f32_32x32x16_bf16(a, b, c, 0, 0, 0); }
DEVI f32x4 mfma16(bf16x8 a, bf16x8 b, f32x4 c) { return __builtin_amdgcn_mfma_f32_16x16x32_bf16(a, b, c, 0, 0, 0); }
DEVI float fexp2(float x) { return __builtin_amdgcn_exp2f(x); }
DEVI float wave_sum(float v) {
#pragma unroll
    for (int o = 1; o < 64; o <<= 1) v += __shfl_xor(v, o);
    return v;
}
DEVI float sigmoidf_(float x) { return 1.f / (1.f + __expf(-x)); }
DEVI float gelu_tanh(float x) {
    const float u = 0.7978845608028654f * (x + 0.044715f * x * x * x);
    const float e = __expf(2.f * u);
    const float th = 1.f - 2.f / (e + 1.f);
    return 0.5f * x * (1.f + th);
}

#define LAS __attribute__((address_space(3)))
#define XB_TMO      128
#define XB_XCNT(j)  (256  + 64 * (j))
#define XB_XSUB(j)  (1280 + 64 * (j))
#define XB_XGEN(j)  (2304 + 64 * (j))
#define XB_TOP      3328
#define XB_TOPGEN   3392
#define XB_SPIN_CAP (1u << 22)
DEVI unsigned xb_ld(unsigned* p) { return __hip_atomic_load(p, __ATOMIC_RELAXED, __HIP_MEMORY_SCOPE_AGENT); }
DEVI unsigned xb_add(unsigned* p, unsigned v) { return __hip_atomic_fetch_add(p, v, __ATOMIC_RELAXED, __HIP_MEMORY_SCOPE_AGENT); }
DEVI unsigned xb_xcc_id() { return (unsigned)__builtin_amdgcn_s_getreg((3 << 11) | 20) & 0xFu; }
#define XB_SPIN(cond, bar) do { unsigned _sp = 0; while (cond) { __builtin_amdgcn_s_sleep(1); \
    if ((++_sp & 255u) == 0u) { if (xb_ld(&(bar)[XB_TMO])) break; if (_sp > XB_SPIN_CAP) { atomicAdd(&(bar)[XB_TMO], 1u); break; } } } } while (0)
DEVI void xcd_barrier_post(unsigned* bar) {
    if (threadIdx.x == 0) (void)xb_add(&bar[XB_XCNT(xb_xcc_id())], 1u);
}
DEVI void xcd_barrier_complete(unsigned* bar, unsigned x, unsigned& nloc, unsigned& nx) {
    const unsigned G = gridDim.x * gridDim.y * gridDim.z;
    unsigned sum, cnt, mine, sp = 0u;
    for (;;) {
        sum = 0u; cnt = 0u; mine = 0u;
#pragma unroll
        for (unsigned j = 0; j < 16; ++j) { const unsigned c = xb_ld(&bar[XB_XCNT(j)]); sum += c; cnt += (c > 0u) ? 1u : 0u; mine = (j == x) ? c : mine; }
        if (sum == G) break;
        __builtin_amdgcn_s_sleep(1);
        if ((++sp & 255u) == 0u) { if (xb_ld(&bar[XB_TMO])) break; if (sp > XB_SPIN_CAP) { atomicAdd(&bar[XB_TMO], 1u); break; } }
    }
    nloc = mine > 0u ? mine : 1u; nx = cnt > 0u ? cnt : 1u;
}
DEVI void xcd_barrier(unsigned* bar, volatile LAS unsigned* st) {
    asm volatile("s_waitcnt vmcnt(0)" ::: "memory");
    __syncthreads();
    if (threadIdx.x == 0) {
        const unsigned x = xb_xcc_id();
        __builtin_amdgcn_s_waitcnt(0);
        unsigned nloc = st[0], nx = st[1];
        if (nloc == 0u) { xcd_barrier_complete(bar, x, nloc, nx); st[0] = nloc; st[1] = nx; }
        const unsigned old = xb_add(&bar[XB_XSUB(x)], 1u);
        const unsigned gen = old / nloc;
        if (old + 1u == (gen + 1u) * nloc) {
            __builtin_amdgcn_fence(__ATOMIC_RELEASE, "agent");
            asm volatile("s_waitcnt vmcnt(0)" ::: "memory");
            const unsigned og = xb_add(&bar[XB_TOP], 1u);
            const unsigned tg = og / nx;
            if (og + 1u == (tg + 1u) * nx) xb_add(&bar[XB_TOPGEN], 1u);
            else XB_SPIN(xb_ld(&bar[XB_TOPGEN]) == tg, bar);
            __builtin_amdgcn_fence(__ATOMIC_ACQUIRE, "agent");
            xb_add(&bar[XB_XGEN(x)], 1u);
            asm volatile("s_waitcnt vmcnt(0)" ::: "memory");
        } else {
            XB_SPIN(xb_ld(&bar[XB_XGEN(x)]) == gen, bar);
            __builtin_amdgcn_fence(__ATOMIC_ACQUIRE, "agent");
            asm volatile("s_waitcnt vmcnt(0)" ::: "memory");
        }
    }
    __syncthreads();
}

DEVI void row_load(const float* row, int lane, f32x4 (&v)[8]) {
#pragma unroll
    for (int c = 0; c < 8; ++c) v[c] = *(const f32x4*)(row + c * 256 + lane * 4);
}
DEVI void row_stats(const f32x4 (&v)[8], float& mean, float& rstd) {
    float s = 0.f;
#pragma unroll
    for (int c = 0; c < 8; ++c) s += (v[c].x + v[c].y) + (v[c].z + v[c].w);
    mean = wave_sum(s) * (1.f / D_);
    float q = 0.f;
#pragma unroll
    for (int c = 0; c < 8; ++c) { const f32x4 d = v[c] - mean; q += (d.x * d.x + d.y * d.y) + (d.z * d.z + d.w * d.w); }
    rstd = 1.f / sqrtf(wave_sum(q) * (1.f / D_) + LN_EPS);
}

DEVI const float* wsrc_col(const Params& p, int mat, int e, int n, int& ld) {
    switch (mat) {
    case 0: {
        ld = IN_COLS;
        if (n < 2560) return p.in[4] + n;
        if (n < 2688) { const int j = n - 2560; return j < 48 ? p.in[4] + 2560 + j : nullptr; }
        const int r = n - 2688, grp = r >> 6, within = r & 63;
        const int ch = grp * 32 + (within & 31), isg = within >> 5;
        return p.in[4] + 2608 + isg * 1024 + ch;
    }
    case 1: ld = 256; return p.in[6] + n;
    case 2: ld = 256; return p.in[9] + n;
    case 3: ld = 64; return n < 64 ? p.in[7] + n : nullptr;
    case 4: ld = 64; return n < 64 ? p.in[10] + n : nullptr;
    case 5: ld = 2048; return p.in[16] + n;
    case 6: ld = 2048; return p.in[21] + n;
    case 7: ld = 4096; return p.in[22] + n;
    case 8: ld = 2048; return p.in[23] + n;
    case 9: if (n < 4) { ld = 4; return p.in[26] + n; } if (n < 36) { ld = 32; return p.in[28] + (n - 4); } ld = 1; return nullptr;
    case 10: { ld = 512; const int grp = n >> 6, within = n & 63; const int ch = grp * 32 + (within & 31);
               return ((within >> 5) ? p.in[31] : p.in[30]) + (size_t)e * 2048 * 512 + ch; }
    default: ld = 2048; return p.in[32] + (size_t)e * 512 * 2048 + n;
    }
}
DEVI void wave_transpose_item(const Params& p, char* smem, int mat, int e, int ntile, int ktile, bf16_t* dst, bf16_t* dst_lo, int K,
                                const float* gvec = nullptr, const float* bvec = nullptr, float* U = nullptr, float* C = nullptr) {
    int tid = threadIdx.x; asm volatile("" : "+v"(tid));
    const int lane = tid & 63, w = tid >> 6;
    float* tile = (float*)smem + w * (64 * 65 + 32);
    const int k0 = ktile * 64;
    if (mat == 9) {
        int ld; const float* src = wsrc_col(p, mat, e, ntile * 64 + lane, ld);
#pragma unroll 8
        for (int k = 0; k < 64; ++k) tile[k * 65 + lane] = src ? src[(size_t)(k0 + k) * ld] : 0.f;
    } else {
        const int c4 = lane & 15, kr = lane >> 4;
        int ld; const float* src = wsrc_col(p, mat, e, ntile * 64 + c4 * 4, ld);
        f32x4 v[16];
#pragma unroll
        for (int i = 0; i < 16; ++i) v[i] = src ? *(const f32x4*)(src + (size_t)(k0 + kr + 4 * i) * ld) : (f32x4){0.f, 0.f, 0.f, 0.f};
#pragma unroll
        for (int i = 0; i < 16; ++i) { float* q = tile + (kr + 4 * i) * 65 + c4 * 4; q[0] = v[i].x; q[1] = v[i].y; q[2] = v[i].z; q[3] = v[i].w; }
    }
    asm volatile("s_waitcnt lgkmcnt(0)" ::: "memory");
    if (gvec) {
        float us = 0.f, cs = 0.f;
#pragma unroll 8
        for (int k = 0; k < 64; ++k) { const float wkn = tile[k * 65 + lane]; us += gvec[k0 + k] * wkn; cs += bvec[k0 + k] * wkn; }
        atomicAdd(U + ntile * 64 + lane, us); atomicAdd(C + ntile * 64 + lane, cs);
    }
    const int kc = lane & 7, nr = lane >> 3;
#pragma unroll
    for (int c = 0; c < 8; ++c) {
        const int n = nr + 8 * c;
        float wv[8];
#pragma unroll
        for (int j = 0; j < 8; ++j) wv[j] = tile[(kc * 8 + j) * 65 + n];
        if (gvec) {
#pragma unroll
            for (int j = 0; j < 8; ++j) wv[j] *= gvec[k0 + kc * 8 + j]; }
        u32x4 o; o.x = cvt_pk_bf16(wv[0], wv[1]); o.y = cvt_pk_bf16(wv[2], wv[3]); o.z = cvt_pk_bf16(wv[4], wv[5]); o.w = cvt_pk_bf16(wv[6], wv[7]);
        const size_t off = (size_t)(ntile * 64 + n) * K + k0 + kc * 8;
        if (!dst_lo) *(u32x4*)(dst + off) = o;
        else {
            float r[8];
#pragma unroll
            for (int j = 0; j < 8; ++j) r[j] = wv[j] - bf2f((unsigned)f2bf(wv[j]));
            u32x4 l; l.x = cvt_pk_bf16(r[0], r[1]); l.y = cvt_pk_bf16(r[2], r[3]); l.z = cvt_pk_bf16(r[4], r[5]); l.w = cvt_pk_bf16(r[6], r[7]);
            const size_t o0 = (size_t)n * K + k0 + kc * 8, o1 = (size_t)(64 + n) * K + k0 + kc * 8;
            if (ntile == 0) { *(u32x4*)(dst + o0) = o; *(u32x4*)(dst_lo + o0) = o; *(u32x4*)(dst + o1) = l; }
            else *(u32x4*)(dst_lo + o1) = (u32x4){0u, 0u, 0u, 0u};
        }
    }
    asm volatile("s_waitcnt lgkmcnt(0)" ::: "memory");
}

DEVI void phase_prep(const Params& p, char* smem) {
    int tid = threadIdx.x; asm volatile("" : "+v"(tid));
    const int lane = tid & 63, w = tid >> 6;
    unsigned char* ws = p.ws;
    for (int r = blockIdx.x; r < 8; r += gridDim.x) {
        const int type = r >> 2, n = (r & 3) * 64 + lane;
        const float* pe = p.in[type ? 8 : 5]; const float* w1 = p.in[type ? 9 : 6];
        float sacc = 0.f;
        for (int k = w * 256; k < (w + 1) * 256; ++k) sacc += pe[k] * w1[(size_t)k * 256 + n];
        float* red = (float*)smem;
        __syncthreads();
        red[w * 64 + lane] = sacc;
        __syncthreads();
        if (w == 0) ((float*)(ws + WS_C1BIAS))[type * 256 + n] = ((red[lane] + red[64 + lane]) + (red[128 + lane] + red[192 + lane])) + ((red[256 + lane] + red[320 + lane]) + (red[384 + lane] + red[448 + lane]));
        __syncthreads();
    }
    constexpr int I_LN = T_, I_MEM = 1024;
    constexpr int I_M0 = 74 * 32, I_M12 = 4 * 32, I_M34 = 2 * 4, I_SQ = 32 * 32, I_KV = 64 * 32, I_R = 2 * 32;
    constexpr int TOTAL = I_LN + I_MEM + I_M0 + 2 * I_M12 + 2 * I_M34 + 3 * I_SQ + I_KV + I_R;
    const int gw = blockIdx.x * 8 + w, NW = gridDim.x * 8;
    for (int it = gw; it < TOTAL; it += NW) {
        int r = it;
        if (r < I_LN) {
            const int t = r;
            f32x4 v[8]; row_load(p.in[0] + (size_t)t * D_, lane, v);
            float mean, rstd; row_stats(v, mean, rstd);
            bf16_t* hb = (bf16_t*)(ws + WS_BUFA) + (size_t)t * D_;
#pragma unroll
            for (int c = 0; c < 8; ++c) {
                const int col = c * 256 + lane * 4;
                const f32x4 g = *(const f32x4*)(p.in[2] + col), b = *(const f32x4*)(p.in[3] + col);
                const f32x4 y = (v[c] - mean) * rstd * g + b;
                u32x2 o; o.x = cvt_pk_bf16(y.x, y.y); o.y = cvt_pk_bf16(y.z, y.w);
                *(u32x2*)(hb + col) = o;
            }
            if (lane == 0) { float* st = (float*)(ws + WS_STATS); st[t * 2] = mean; st[t * 2 + 1] = rstd; }
            continue;
        }
        r -= I_LN;
        if (r < I_MEM) {
            const int t = r;
            f32x4 v[8]; row_load(p.in[1] + (size_t)t * D_, lane, v);
            float mean, rstd; row_stats(v, mean, rstd);
            bf16_t* hb = (bf16_t*)(ws + WS_BUFD) + (size_t)t * D_;
#pragma unroll
            for (int c = 0; c < 8; ++c) {
                const int col = c * 256 + lane * 4;
                const f32x4 g = *(const f32x4*)(p.in[19] + col), b = *(const f32x4*)(p.in[20] + col);
                const f32x4 y = (v[c] - mean) * rstd * g + b;
                u32x2 o; o.x = cvt_pk_bf16(y.x, y.y); o.y = cvt_pk_bf16(y.z, y.w);
                *(u32x2*)(hb + col) = o;
            }
            continue;
        }
        r -= I_MEM;
        if (r < I_M0) { wave_transpose_item(p, smem, 0, 0, r / 32, r % 32, (bf16_t*)(ws + WS_WIN), nullptr, 2048); continue; } r -= I_M0;
        if (r < I_M12) { wave_transpose_item(p, smem, 1, 0, r / 32, r % 32, (bf16_t*)(ws + WS_WC1), nullptr, 2048); continue; } r -= I_M12;
        if (r < I_M12) { wave_transpose_item(p, smem, 2, 0, r / 32, r % 32, (bf16_t*)(ws + WS_WC1) + 256 * 2048, nullptr, 2048); continue; } r -= I_M12;
        if (r < I_M34) { wave_transpose_item(p, smem, 3, 0, r / 4, r % 4, (bf16_t*)(ws + WS_WC2), nullptr, 256); continue; } r -= I_M34;
        if (r < I_M34) { wave_transpose_item(p, smem, 4, 0, r / 4, r % 4, (bf16_t*)(ws + WS_WC2) + 128 * 256, nullptr, 256); continue; } r -= I_M34;
        if (r < I_SQ) { wave_transpose_item(p, smem, 5, 0, r / 32, r % 32, (bf16_t*)(ws + WS_WOUT), nullptr, 2048); continue; } r -= I_SQ;
        if (r < I_SQ) { wave_transpose_item(p, smem, 6, 0, r / 32, r % 32, (bf16_t*)(ws + WS_WQ), nullptr, 2048, p.in[17], p.in[18], (float*)(ws + WS_CTL + CTL_U1), (float*)(ws + WS_CTL + CTL_C1)); continue; } r -= I_SQ;
        if (r < I_KV) { wave_transpose_item(p, smem, 7, 0, r / 32, r % 32, (bf16_t*)(ws + WS_WKV), nullptr, 2048); continue; } r -= I_KV;
        if (r < I_SQ) { wave_transpose_item(p, smem, 8, 0, r / 32, r % 32, (bf16_t*)(ws + WS_WO), nullptr, 2048); continue; } r -= I_SQ;
        wave_transpose_item(p, smem, 9, 0, r / 32, r % 32, (bf16_t*)(ws + WS_WR), (bf16_t*)(ws + WS_WR) + 128 * 2048, 2048);
    }
    __syncthreads();
}

constexpr int MOE_W_ITEMS = 32 * 16 * 32 + 32 * 32 * 8;
DEVI void moe_weight_item(const Params& p, char* smem, int r) {
    unsigned char* ws = p.ws;
    if (r < 32 * 16 * 32) { const int e = r / 512, q = r % 512; wave_transpose_item(p, smem, 10, e, q / 32, q % 32, (bf16_t*)(ws + WS_WGU) + (size_t)e * 1024 * 2048, nullptr, 2048); }
    else { r -= 32 * 16 * 32; const int e = r / 256, q = r % 256; wave_transpose_item(p, smem, 11, e, q / 8, q % 8, (bf16_t*)(ws + WS_WD) + (size_t)e * 2048 * 512, nullptr, 512); }
}

enum { J_PROJ = 0, J_MEMKV, J_CMP1, J_CMP2, J_OUT, J_WQ, J_WO, J_ROUTER, J_MOE1, J_MOE2 };
constexpr int GEMM_STAGE_BYTES = 49152;
constexpr int GEMM_TP = 3 * GEMM_STAGE_BYTES;

template <int job, int VAR = 0>
DEVI void gemm_job(const Params& p, char* smem) {
    unsigned char* ws = p.ws;
    int tid = threadIdx.x; asm volatile("" : "+v"(tid));
    const int lane = tid & 63, w = tid >> 6, wr = w >> 1, wc = w & 1, fr = lane & 15, fq = lane >> 4;
    const int srow = tid >> 3, schunk = (tid & 7) ^ ((tid >> 4) & 7);
    int* tp = (int*)(smem + GEMM_TP);
    int MT = 0, NT = 0, K = 2048, nseg = 1, ntiles = 0, RT = 0;
    switch (job) {
    case J_PROJ: MT = 128; NT = 37; break;
    case J_MEMKV: MT = 4; NT = 32; break;
    case J_CMP1: MT = 64; NT = 2; break;
    case J_CMP2: MT = 64; NT = 1; K = 256; break;
    case J_OUT: case J_WQ: case J_WO: MT = 128; NT = 16; break;
    case J_ROUTER: MT = 128; NT = 1; nseg = 2; break;
    default: break;
    }
    const unsigned* cntw = (const unsigned*)(ws + WS_CTL) + CW_CNT;
    if (job == J_MOE1 || job == J_MOE2) {
        __syncthreads();
        if (tid == 0) { int acc = 0; for (int e = 0; e < 32; ++e) { tp[e] = acc; const int c = (int)__hip_atomic_load(cntw + e, __ATOMIC_RELAXED, __HIP_MEMORY_SCOPE_AGENT); tp[33 + e] = c; acc += (c + 255) >> 8; } tp[32] = acc; }
        __syncthreads();
        RT = tp[32];
        NT = (job == J_MOE1) ? 8 : 16; K = (job == J_MOE1) ? 2048 : 512;
        { int mx = 0;
#pragma unroll
          for (int x = 0; x < 8; ++x) { int t = 0;
#pragma unroll
              for (int k = 0; k < 4; ++k) t += (tp[33 + x + 8 * k] + 255) >> 8;
              mx = t > mx ? t : mx; }
          ntiles = mx * NT * 8; }
    } else {
        const int nsr = (MT + 7) >> 3;
        ntiles = (MT < 64) ? MT * NT : ((nsr + 7) >> 3) * 8 * NT * 8;
    }
    int my_tp = 0, my_cnt = 0;
    if (job == J_MOE1 || job == J_MOE2) { my_tp = tp[lane & 31]; my_cnt = tp[33 + (lane & 31)]; }
    const int nk = K >> 6, ntot = nseg * nk;

    for (int ti = blockIdx.x; ti < ntiles; ti += gridDim.x) {
        int mt, nt, e = 0, rt = 0, ecnt = 0, etp = 0;
        if (job == J_MOE1 || job == J_MOE2) {
            const int x = ti & 7; int jj = ti >> 3; bool found = false; mt = 0; nt = 0;
#pragma unroll
            for (int k = 0; k < 4; ++k) {
                const int ee = x + 8 * k;
                const int c = __shfl(my_cnt, ee), rtc = (c + 255) >> 8, tot = rtc * NT;
                if (!found) { if (jj < tot) { found = true; e = ee; ecnt = c; etp = __shfl(my_tp, ee); const int per = 4 * rtc, ng = jj / per, r2 = jj - ng * per; nt = ng * 4 + r2 / rtc; rt = r2 - (r2 / rtc) * rtc; } else jj -= tot; }
            }
            if (!found) continue;
        } else {
            if (MT < 64) { nt = ti / MT; mt = ti - nt * MT; }
            else {
                const int x = ti & 7, jj = ti >> 3, per = 8 * NT, srl = jj / per, idx = jj - srl * per;
                mt = (srl * 8 + x) * 8 + (idx & 7); nt = idx >> 3;
                if (mt >= MT) continue;
            }
        }
        const bf16_t* ap[4]; const bf16_t* bp[2];
#pragma unroll
        for (int r = 0; r < 4; ++r) {
            const int row = r * 64 + srow;
            const bf16_t* a;
            switch (job) {
            case J_PROJ: a = (const bf16_t*)(ws + WS_BUFA) + (size_t)(mt * 256 + row) * 2048; break;
            case J_MEMKV: a = (const bf16_t*)(ws + WS_BUFD) + (size_t)(mt * 256 + row) * 2048; break;
            case J_CMP1: { const int gi = mt >> 1, i = (mt & 1) * 256 + row, ic = i < 510 ? i : 510; const int type = gi >> 4, bh = gi & 15;
                a = (const bf16_t*)(ws + WS_BUFC + (type ? C_VCMP : C_KCMP)) + ((size_t)bh * 8192 + 16 * ic) * 64; break; }
            case J_CMP2: a = (const bf16_t*)(ws + WS_BUFC + C_HID) + (size_t)(mt * 256 + row) * 256; break;
            case J_OUT: a = (const bf16_t*)(ws + WS_BUFA) + (size_t)(mt * 256 + row) * 2048; break;
            case J_WQ: a = (const bf16_t*)(ws + WS_BUFB) + (size_t)(mt * 256 + row) * 2048; break;
            case J_WO: a = (const bf16_t*)(ws + WS_BUFA) + (size_t)(mt * 256 + row) * 2048; break;
            case J_ROUTER: a = (const bf16_t*)(ws + WS_BUFA) + (size_t)(mt * 256 + row) * 2048; break;
            case J_MOE1: { int pos = rt * 256 + row; if (pos >= ecnt) pos = 0; const int aid = ((const int*)(ws + WS_LIST))[(size_t)e * T_ + pos];
                a = (const bf16_t*)(ws + WS_BUFA) + (size_t)(aid >> 1) * 2048; break; }
            default: a = (const bf16_t*)(ws + WS_BUFB) + (size_t)((etp + rt) * 256 + row) * 512; break;
            }
            ap[r] = a + schunk * 8;
        }
#pragma unroll
        for (int r = 0; r < 2; ++r) {
            const int row = r * 64 + srow;
            const bf16_t* b;
            switch (job) {
            case J_PROJ: b = (const bf16_t*)(ws + WS_WIN) + (size_t)(nt * 128 + row) * 2048; break;
            case J_MEMKV: b = (const bf16_t*)(ws + WS_WKV) + (size_t)(nt * 128 + row) * 2048; break;
            case J_CMP1: b = (const bf16_t*)(ws + WS_WC1) + (size_t)(mt >> 5) * 256 * 2048 + (size_t)(nt * 128 + row) * 2048; break;
            case J_CMP2: b = (const bf16_t*)(ws + WS_WC2) + (size_t)(mt >> 5) * 128 * 256 + (size_t)row * 256; break;
            case J_OUT: b = (const bf16_t*)(ws + WS_WOUT) + (size_t)(nt * 128 + row) * 2048; break;
            case J_WQ: b = (const bf16_t*)(ws + WS_WQ) + (size_t)(nt * 128 + row) * 2048; break;
            case J_WO: b = (const bf16_t*)(ws + WS_WO) + (size_t)(nt * 128 + row) * 2048; break;
            case J_ROUTER: b = (const bf16_t*)(ws + WS_WR) + (size_t)row * 2048; break;
            case J_MOE1: b = (const bf16_t*)(ws + WS_WGU) + (size_t)e * 1024 * 2048 + (size_t)(nt * 128 + row) * 2048; break;
            default: b = (const bf16_t*)(ws + WS_WD) + (size_t)e * 2048 * 512 + (size_t)(nt * 128 + row) * 512; break;
            }
            bp[r] = b + schunk * 8;
        }
        const long a_seg1 = (long)(WS_BUFB - WS_BUFA) / 2;
        const long b_seg2 = 128 * 2048;

        f32x4 acc[4][4];
#pragma unroll
        for (int i = 0; i < 4; ++i)
#pragma unroll
            for (int j = 0; j < 4; ++j) acc[i][j] = (f32x4){0.f, 0.f, 0.f, 0.f};

#define GEMM_STAGE(kt_) do { const int _kt = (kt_); int _seg = 0, _k0 = _kt << 6; if (nseg > 1) { _seg = _kt / nk; _k0 = (_kt - _seg * nk) << 6; } \
            const long _ao = (_seg == 1) ? a_seg1 : 0, _bo = (_seg == 1) ? b_seg2 : 0; \
            char* _A = smem + (_kt % 3) * GEMM_STAGE_BYTES; char* _B = _A + 32768; \
            _Pragma("unroll") for (int r = 0; r < 4; ++r) glds16(ap[r] + _ao + _k0, _A + (r * 512 + tid) * 16); \
            _Pragma("unroll") for (int r = 0; r < 2; ++r) glds16(bp[r] + _bo + _k0, _B + (r * 512 + tid) * 16); } while (0)

        f32x4 pre[8];
        if (job == J_OUT || job == J_WO) {
            const float* src = (job == J_OUT) ? p.in[0] : p.out;
#pragma unroll
            for (int i = 0; i < 8; ++i) pre[i] = *(const f32x4*)(src + (size_t)(mt * 256 + (tid >> 5) + 16 * i) * D_ + nt * 128 + (tid & 31) * 4);
        }
        GEMM_STAGE(0);
        if (ntot > 1) GEMM_STAGE(1);
        for (int kt = 0; kt < ntot; ++kt) {
            if (kt + 1 < ntot) asm volatile("s_waitcnt vmcnt(6)" ::: "memory"); else asm volatile("s_waitcnt vmcnt(0)" ::: "memory");
            __builtin_amdgcn_s_barrier();
            asm volatile("" ::: "memory");
            if (kt + 2 < ntot && VAR != 1) GEMM_STAGE(kt + 2);
            if (VAR == 2) continue;
            const char* A = smem + (kt % 3) * GEMM_STAGE_BYTES; const char* B = A + 32768;
#pragma unroll
            for (int ks = 0; ks < 2; ++ks) {
                bf16x8 af[4], bfr[4];
                const int coff = ((4 * ks + fq) ^ (fr >> 1)) * 16;
#pragma unroll
                for (int i = 0; i < 4; ++i) {
                    af[i] = *(const bf16x8*)(A + (wr * 64 + i * 16 + fr) * 128 + coff);
                    bfr[i] = *(const bf16x8*)(B + (wc * 64 + i * 16 + fr) * 128 + coff);
                }
                __builtin_amdgcn_s_setprio(1);
#pragma unroll
                for (int i = 0; i < 4; ++i)
#pragma unroll
                    for (int j = 0; j < 4; ++j) acc[i][j] = mfma16(bfr[j], af[i], acc[i][j]);
                __builtin_amdgcn_s_setprio(0);
            }
        }
#undef GEMM_STAGE
        if (VAR != 0 && VAR != 4) { if (acc[0][0].x == 123.456f) p.out[0] = acc[1][1].y + acc[2][2].z + acc[3][3].w; __syncthreads(); continue; }
        asm volatile("s_waitcnt lgkmcnt(0)" ::: "memory"); __builtin_amdgcn_s_barrier(); asm volatile("" ::: "memory");
        float* ep = (float*)smem;
#pragma unroll
        for (int mi = 0; mi < 4; ++mi)
#pragma unroll
            for (int ni = 0; ni < 4; ++ni) *(f32x4*)(ep + (wr * 64 + mi * 16 + fr) * 132 + wc * 64 + ni * 16 + fq * 4) = acc[mi][ni];
        asm volatile("s_waitcnt lgkmcnt(0)" ::: "memory"); __builtin_amdgcn_s_barrier(); asm volatile("" ::: "memory");
        const int row0 = mt * 256, col0 = nt * 128;
#define EP8(row_, c8_, v0_, v1_) const f32x4 v0_ = *(const f32x4*)(ep + (row_) * 132 + (c8_) * 8), v1_ = *(const f32x4*)(ep + (row_) * 132 + (c8_) * 8 + 4)
#define PK8(o_, v0_, v1_) u32x4 o_; o_.x = cvt_pk_bf16(v0_.x, v0_.y); o_.y = cvt_pk_bf16(v0_.z, v0_.w); o_.z = cvt_pk_bf16(v1_.x, v1_.y); o_.w = cvt_pk_bf16(v1_.z, v1_.w)
        switch (job) {
        case J_PROJ: {
            if (nt < 8) {
                bf16_t* Q = (bf16_t*)(ws + WS_BUFB);
#pragma unroll
                for (int i = 0; i < 8; ++i) { const int c = tid + 512 * i, row = c >> 4, c8 = c & 15; EP8(row, c8, a0, a1);
                    const f32x4 b0 = a0 * (0.125f * LOG2E), b1 = a1 * (0.125f * LOG2E); PK8(o, b0, b1);
                    *(u32x4*)(Q + (size_t)(row0 + row) * 1024 + col0 + c8 * 8) = o; }
            } else if (nt < 20) {
                const int reg = (nt - 8) >> 1;
                bf16_t* dst = (bf16_t*)(ws + WS_BUFC + (reg == 0 ? C_KCMP : reg == 1 ? C_VCMP : reg == 2 ? C_KS : reg == 3 ? C_VST : reg == 4 ? C_KW : C_VWT));
                const int b = row0 >> 13, s0 = row0 & 8191;
                if (reg != 3 && reg != 5) {
#pragma unroll
                    for (int i = 0; i < 8; ++i) { const int c = tid + 512 * i, row = c >> 4, c8 = c & 15; EP8(row, c8, a0, a1); PK8(o, a0, a1);
                        const int bh = b * 4 + ((nt - 8) & 1) * 2 + (c8 >> 3);
                        *(u32x4*)(dst + ((size_t)bh * 8192 + s0 + row) * 64 + (c8 & 7) * 8) = o; }
                } else {
#pragma unroll
                    for (int i = 0; i < 8; ++i) { const int c = tid + 512 * i, tg = c & 31, dcol = c >> 5;
                        const int rb = (tg >> 1) * 16 + (tg & 1) * 4;
                        float v[8];
#pragma unroll
                        for (int j = 0; j < 8; ++j) v[j] = ep[(rb + (j & 3) + (j >> 2) * 8) * 132 + dcol];
                        u32x4 o; o.x = cvt_pk_bf16(v[0], v[1]); o.y = cvt_pk_bf16(v[2], v[3]); o.z = cvt_pk_bf16(v[4], v[5]); o.w = cvt_pk_bf16(v[6], v[7]);
                        const int bh = b * 4 + ((nt - 8) & 1) * 2 + (dcol >> 6);
                        *(u32x4*)(dst + ((size_t)bh * 64 + (dcol & 63)) * 8192 + s0 + tg * 8) = o; }
                }
            } else if (nt == 20) {
                float* G = (float*)(ws + WS_BUFC + C_GATES);
#pragma unroll
                for (int i = 0; i < 6; ++i) { const int c = tid + 512 * i, row = c / 12, c4 = c - row * 12;
                    const f32x4 v = *(const f32x4*)(ep + row * 132 + c4 * 4); f32x4 o; o.x = sigmoidf_(v.x); o.y = sigmoidf_(v.y); o.z = sigmoidf_(v.z); o.w = sigmoidf_(v.w);
                    *(f32x4*)(G + (size_t)(row0 + row) * 48 + c4 * 4) = o; }
            } else {
                bf16_t* Hg = (bf16_t*)(ws + WS_BUFB + 64 * MiB);
#pragma unroll
                for (int i = 0; i < 4; ++i) { const int c = tid + 512 * i, row = c >> 3, c8 = c & 7, hh = c8 >> 2, cc = (c8 & 3) * 8;
                    const f32x4 a0 = *(const f32x4*)(ep + row * 132 + hh * 64 + cc), a1 = *(const f32x4*)(ep + row * 132 + hh * 64 + cc + 4);
                    const f32x4 g0 = *(const f32x4*)(ep + row * 132 + hh * 64 + 32 + cc), g1 = *(const f32x4*)(ep + row * 132 + hh * 64 + 32 + cc + 4);
                    u32x4 o; o.x = cvt_pk_bf16(a0.x * sigmoidf_(g0.x), a0.y * sigmoidf_(g0.y)); o.y = cvt_pk_bf16(a0.z * sigmoidf_(g0.z), a0.w * sigmoidf_(g0.w));
                    o.z = cvt_pk_bf16(a1.x * sigmoidf_(g1.x), a1.y * sigmoidf_(g1.y)); o.w = cvt_pk_bf16(a1.z * sigmoidf_(g1.z), a1.w * sigmoidf_(g1.w));
                    *(u32x4*)(Hg + (size_t)(row0 + row) * 1024 + ((nt - 21) * 2 + hh) * 32 + cc) = o; }
            }
        } break;
        case J_MEMKV: {
            const int b = mt;
            if (nt < 16) {
                bf16_t* Kx = (bf16_t*)(ws + WS_BUFD + 4 * MiB);
                const int head = col0 >> 9, d0 = col0 & 511;
#pragma unroll
                for (int i = 0; i < 8; ++i) { const int c = tid + 512 * i, row = c >> 4, c8 = c & 15; EP8(row, c8, a0, a1); PK8(o, a0, a1);
                    *(u32x4*)(Kx + ((size_t)(b * 4 + head) * 256 + row) * 512 + d0 + c8 * 8) = o; }
            } else {
                bf16_t* Vt = (bf16_t*)(ws + WS_BUFD + 8 * MiB);
                const int n2 = col0 - 2048, head = n2 >> 9, d0 = n2 & 511;
#pragma unroll
                for (int i = 0; i < 8; ++i) { const int c = tid + 512 * i, tg = c & 31, dcol = c >> 5;
                    float v[8];
#pragma unroll
                    for (int j = 0; j < 8; ++j) v[j] = ep[(tg * 8 + j) * 132 + dcol];
                    u32x4 o; o.x = cvt_pk_bf16(v[0], v[1]); o.y = cvt_pk_bf16(v[2], v[3]); o.z = cvt_pk_bf16(v[4], v[5]); o.w = cvt_pk_bf16(v[6], v[7]);
                    *(u32x4*)(Vt + ((size_t)(b * 4 + head) * 512 + d0 + dcol) * 256 + tg * 8) = o; }
            }
        } break;
        case J_CMP1: {
            const int type = mt >> 5;
            const float* bias = (const float*)(ws + WS_C1BIAS) + type * 256;
            bf16_t* Hd = (bf16_t*)(ws + WS_BUFC + C_HID);
            const f32x4 b0 = *(const f32x4*)(bias + col0 + (tid & 15) * 8), b1 = *(const f32x4*)(bias + col0 + (tid & 15) * 8 + 4);
#pragma unroll
            for (int i = 0; i < 8; ++i) { const int c = tid + 512 * i, row = c >> 4, c8 = c & 15; EP8(row, c8, a0, a1);
                u32x4 o; o.x = cvt_pk_bf16(gelu_tanh(a0.x + b0.x), gelu_tanh(a0.y + b0.y)); o.y = cvt_pk_bf16(gelu_tanh(a0.z + b0.z), gelu_tanh(a0.w + b0.w));
                o.z = cvt_pk_bf16(gelu_tanh(a1.x + b1.x), gelu_tanh(a1.y + b1.y)); o.w = cvt_pk_bf16(gelu_tanh(a1.z + b1.z), gelu_tanh(a1.w + b1.w));
                *(u32x4*)(Hd + (size_t)(row0 + row) * 256 + col0 + c8 * 8) = o; }
        } break;
        case J_CMP2: {
            const int gi = mt >> 1, type = gi >> 4, bh = gi & 15, i0 = (mt & 1) * 256;
            if (type == 0) {
                bf16_t* Kc = (bf16_t*)(ws + WS_BUFC + C_KC);
#pragma unroll
                for (int i = 0; i < 4; ++i) { const int c = tid + 512 * i, row = c >> 3, c8 = c & 7; EP8(row, c8, a0, a1); PK8(o, a0, a1);
                    if (i0 + row >= 511) o = (u32x4){0u, 0u, 0u, 0u};
                    *(u32x4*)(Kc + ((size_t)bh * 512 + i0 + row) * 64 + c8 * 8) = o; }
            } else {
                bf16_t* Vc = (bf16_t*)(ws + WS_BUFC + C_VCT);
#pragma unroll
                for (int i = 0; i < 4; ++i) { const int c = tid + 512 * i, tg = c & 31, d = c >> 5;
                    const int rb = (tg >> 1) * 16 + (tg & 1) * 4;
                    float v[8];
#pragma unroll
                    for (int j = 0; j < 8; ++j) { const int r = rb + (j & 3) + (j >> 2) * 8; v[j] = (i0 + r >= 511) ? 0.f : ep[r * 132 + d]; }
                    u32x4 o; o.x = cvt_pk_bf16(v[0], v[1]); o.y = cvt_pk_bf16(v[2], v[3]); o.z = cvt_pk_bf16(v[4], v[5]); o.w = cvt_pk_bf16(v[6], v[7]);
                    *(u32x4*)(Vc + ((size_t)bh * 64 + d) * 512 + i0 + tg * 8) = o; }
            }
        } break;
        case J_OUT: {
            const float* st = (const float*)(ws + WS_STATS);
            const int c4 = tid & 31, n = col0 + c4 * 4;
            const f32x4 g = *(const f32x4*)(p.in[2] + n), bb = *(const f32x4*)(p.in[3] + n);
#pragma unroll
            for (int hlf = 0; hlf < 2; ++hlf) {
                f32x4 xv[8]; float2 sm[8];
#pragma unroll
                for (int i = 0; i < 8; ++i) { const int row = (tid >> 5) + 16 * (hlf * 8 + i), t = row0 + row;
                    xv[i] = hlf ? *(const f32x4*)(p.in[0] + (size_t)t * D_ + n) : pre[i]; sm[i] = *(const float2*)(st + t * 2); }
#pragma unroll
                for (int i = 0; i < 8; ++i) { const int row = (tid >> 5) + 16 * (hlf * 8 + i), t = row0 + row;
                    const f32x4 v = *(const f32x4*)(ep + row * 132 + c4 * 4);
                    const f32x4 y = ((xv[i] - sm[i].x) * sm[i].y * g + bb) * ALPHA + v;
                    *(f32x4*)(p.out + (size_t)t * D_ + n) = y;
                    u32x2 yb; yb.x = cvt_pk_bf16(y.x, y.y); yb.y = cvt_pk_bf16(y.z, y.w);
                    *(u32x2*)((bf16_t*)(ws + WS_BUFB) + (size_t)t * D_ + n) = yb;
                    float rs = (y.x + y.y) + (y.z + y.w), rq = (y.x * y.x + y.y * y.y) + (y.z * y.z + y.w * y.w);
#pragma unroll
                    for (int o = 1; o < 32; o <<= 1) { rs += __shfl_xor(rs, o); rq += __shfl_xor(rq, o); }
                    if ((tid & 31) == 0) { float* rsum = (float*)(ws + WS_RSUM1) + (size_t)t * 2; atomicAdd(rsum, rs); atomicAdd(rsum + 1, rq); } }
            }
        } break;
        case J_WQ: {
            bf16_t* Qx = (bf16_t*)(ws + WS_BUFC);
            const float sc = 0.04419417382415922f * LOG2E;
            const float* U = (const float*)(ws + WS_CTL + CTL_U1); const float* Cv = (const float*)(ws + WS_CTL + CTL_C1);
            const float* rsum = (const float*)(ws + WS_RSUM1);
            const int c8 = tid & 15, n = col0 + c8 * 8;
            const f32x4 u0 = *(const f32x4*)(U + n), u1 = *(const f32x4*)(U + n + 4), c0 = *(const f32x4*)(Cv + n), c1 = *(const f32x4*)(Cv + n + 4);
            float2 rsq[8];
#pragma unroll
            for (int i = 0; i < 8; ++i) rsq[i] = *(const float2*)(rsum + (size_t)(row0 + (tid >> 4) + 32 * i) * 2);
#pragma unroll
            for (int i = 0; i < 8; ++i) { const int row = (tid >> 4) + 32 * i; EP8(row, c8, a0, a1);
                const int t = row0 + row;
                const float mean = rsq[i].x * (1.f / D_); float var = rsq[i].y * (1.f / D_) - mean * mean; var = var > 0.f ? var : 0.f;
                const float rstd = __builtin_amdgcn_rsqf(var + LN_EPS), mr = mean * rstd;
                const f32x4 b0 = (a0 * rstd - u0 * mr + c0) * sc, b1 = (a1 * rstd - u1 * mr + c1) * sc; PK8(o, b0, b1);
                *(u32x4*)(Qx + (size_t)t * 2048 + n) = o; }
        } break;
        case J_WO: {
            const float* st = (const float*)(ws + WS_STATS);
            const int c4 = tid & 31, n = col0 + c4 * 4;
            const f32x4 g = *(const f32x4*)(p.in[17] + n), bb = *(const f32x4*)(p.in[18] + n);
#pragma unroll
            for (int hlf = 0; hlf < 2; ++hlf) {
                f32x4 rv[8]; float2 sm[8];
#pragma unroll
                for (int i = 0; i < 8; ++i) { const int row = (tid >> 5) + 16 * (hlf * 8 + i), t = row0 + row;
                    rv[i] = hlf ? *(const f32x4*)(p.out + (size_t)t * D_ + n) : pre[i]; const float2 rsq = *(const float2*)((const float*)(ws + WS_RSUM1) + (size_t)t * 2);
                    const float mean = rsq.x * (1.f / D_); float var = rsq.y * (1.f / D_) - mean * mean; var = var > 0.f ? var : 0.f;
                    sm[i] = make_float2(mean, 1.f / sqrtf(var + LN_EPS)); }
#pragma unroll
                for (int i = 0; i < 8; ++i) { const int row = (tid >> 5) + 16 * (hlf * 8 + i), t = row0 + row;
                    const f32x4 v = *(const f32x4*)(ep + row * 132 + c4 * 4);
                    *(f32x4*)(p.out + (size_t)t * D_ + n) = ((rv[i] - sm[i].x) * sm[i].y * g + bb) * ALPHA + v; }
            }
        } break;
        case J_ROUTER: {
            if (tid < 256) {
                const int row = tid, t = row0 + row;
                const float* er = ep + row * 132;
                unsigned* cnt = (unsigned*)(ws + WS_CTL) + CW_CNT;
                int* list = (int*)(ws + WS_LIST);
                float* wt = (float*)(ws + WS_WTOK);
                float lg[4];
#pragma unroll
                for (int i = 0; i < 4; ++i) lg[i] = er[i] + er[64 + i] + p.in[27][i];
                int grp = 0; float best = lg[0];
#pragma unroll
                for (int i = 1; i < 4; ++i) if (lg[i] > best) { best = lg[i]; grp = i; }
                float se = 0.f;
#pragma unroll
                for (int i = 0; i < 4; ++i) se += expf(lg[i] - best);
                const float wgrp = 1.f / se;
                float le[8];
#pragma unroll
                for (int i = 0; i < 8; ++i) le[i] = er[4 + grp * 8 + i] + er[68 + grp * 8 + i] + p.in[29][grp * 8 + i];
                int i0 = 0; float v0 = le[0];
#pragma unroll
                for (int i = 1; i < 8; ++i) if (le[i] > v0) { v0 = le[i]; i0 = i; }
                int i1 = -1; float v1 = -INFINITY;
#pragma unroll
                for (int i = 0; i < 8; ++i) if (i != i0 && le[i] > v1) { v1 = le[i]; i1 = i; }
                const float ex = expf(v1 - v0);
                const float w0 = wgrp / (1.f + ex), w1 = wgrp * ex / (1.f + ex);
                const int ea = grp * 8 + i0, eb = grp * 8 + i1;
                const unsigned pa = atomicAdd(cnt + ea, 1u); list[(size_t)ea * T_ + pa] = t * 2;
                const unsigned pb = atomicAdd(cnt + eb, 1u); list[(size_t)eb * T_ + pb] = t * 2 + 1;
                wt[t * 2] = w0; wt[t * 2 + 1] = w1;
            }
        } break;
        case J_MOE1: {
            bf16_t* H = (bf16_t*)(ws + WS_BUFB);
#pragma unroll
            for (int i = 0; i < 4; ++i) { const int c = tid + 512 * i, row = c >> 3, c8 = c & 7, hh = c8 >> 2, cc = (c8 & 3) * 8;
                const f32x4 g0 = *(const f32x4*)(ep + row * 132 + hh * 64 + cc), g1 = *(const f32x4*)(ep + row * 132 + hh * 64 + cc + 4);
                const f32x4 u0 = *(const f32x4*)(ep + row * 132 + hh * 64 + 32 + cc), u1 = *(const f32x4*)(ep + row * 132 + hh * 64 + 32 + cc + 4);
                u32x4 o; o.x = cvt_pk_bf16(g0.x * sigmoidf_(g0.x) * u0.x, g0.y * sigmoidf_(g0.y) * u0.y); o.y = cvt_pk_bf16(g0.z * sigmoidf_(g0.z) * u0.z, g0.w * sigmoidf_(g0.w) * u0.w);
                o.z = cvt_pk_bf16(g1.x * sigmoidf_(g1.x) * u1.x, g1.y * sigmoidf_(g1.y) * u1.y); o.w = cvt_pk_bf16(g1.z * sigmoidf_(g1.z) * u1.z, g1.w * sigmoidf_(g1.w) * u1.w);
                *(u32x4*)(H + ((size_t)(etp + rt) * 256 + row) * 512 + (nt * 2 + hh) * 32 + cc) = o; }
        } break;
        default: {
            bf16_t* Y = (bf16_t*)(ws + WS_BUFC);
            const float* wt = (const float*)(ws + WS_WTOK);
            const int c8 = tid & 15;
            int aid[8]; float wv[8];
#pragma unroll
            for (int i = 0; i < 8; ++i) { const int pos = rt * 256 + (tid >> 4) + 32 * i; aid[i] = (pos < ecnt) ? ((const int*)(ws + WS_LIST))[(size_t)e * T_ + pos] : -1; }
#pragma unroll
            for (int i = 0; i < 8; ++i) wv[i] = (aid[i] >= 0) ? wt[aid[i]] : 0.f;
#pragma unroll
            for (int i = 0; i < 8; ++i) { const int row = (tid >> 4) + 32 * i;
                if (aid[i] >= 0) { EP8(row, c8, a0, a1); const f32x4 b0 = a0 * wv[i], b1 = a1 * wv[i]; PK8(o, b0, b1);
                    *(u32x4*)(Y + (size_t)aid[i] * 2048 + col0 + c8 * 8) = o; } }
        } break;
        }
#undef EP8
#undef PK8
        asm volatile("s_waitcnt lgkmcnt(0)" ::: "memory"); __builtin_amdgcn_s_barrier(); asm volatile("" ::: "memory");
    }
}

DEVI void phase_conv(const Params& p) {
    unsigned char* ws = p.ws;
    int tid = threadIdx.x; asm volatile("" : "+v"(tid));
    const int lane = tid & 63, w = tid >> 6;
    const int c0 = tid * 2;
    const bf16_t* Hg = (const bf16_t*)(ws + WS_BUFB + 64 * MiB);
    float* pre = p.out;
    float* cst = (float*)(ws + WS_LIST);
    float wgt[31][2];
    { const float* wp = p.in[12] + c0;
#pragma unroll
      for (int k = 0; k < 31; ++k) { const float2 v = *(const float2*)wp; wgt[k][0] = v.x; wgt[k][1] = v.y; wp += 1024; asm volatile("" : "+v"(wp)); } }
    const float2 cb = *(const float2*)(p.in[13] + c0);
    for (int it = blockIdx.x; it < T_ / 16; it += gridDim.x) {
        const int t0 = it * 16, s0 = t0 & 8191;
        float acc[16][2];
#pragma unroll
        for (int j = 0; j < 16; ++j) { acc[j][0] = cb.x; acc[j][1] = cb.y; }
        const bf16_t* xp = Hg + ((long)t0 - 30) * 1024 + c0;
#pragma unroll
        for (int i = 0; i < 46; ++i) {
            const int s = s0 - 30 + i;
            float x0 = 0.f, x1 = 0.f;
            if (s >= 0) { const unsigned u = *(const unsigned*)xp; x0 = bf2f(u & 0xffffu); x1 = bf2f(u >> 16); }
            xp += 1024; asm volatile("" : "+v"(xp));
#pragma unroll
            for (int j = 0; j < 16; ++j) { const int k = i - j; if (k >= 0 && k <= 30) { acc[j][0] += wgt[k][0] * x0; acc[j][1] += wgt[k][1] * x1; } }
        }
#pragma unroll
        for (int j = 0; j < 16; ++j) {
            *(float2*)(pre + (size_t)(t0 + j) * 1024 + c0) = make_float2(acc[j][0], acc[j][1]);
            const float sv = wave_sum(acc[j][0] + acc[j][1]);
            const float qv = wave_sum(acc[j][0] * acc[j][0] + acc[j][1] * acc[j][1]);
            if (lane == 0) *(float2*)(cst + ((size_t)(t0 + j) * 8 + w) * 2) = make_float2(sv, qv);
        }
    }
}
DEVI void conv_finish(const Params& p) {
    unsigned char* ws = p.ws;
    int tid = threadIdx.x; asm volatile("" : "+v"(tid));
    const int lane = tid & 63, w = tid >> 6;
    const float* pre = p.out;
    const float* cst = (const float*)(ws + WS_LIST);
    bf16_t* CC = (bf16_t*)(ws + WS_BUFA);
    for (int it = blockIdx.x; it < T_ / 8; it += gridDim.x) {
        const int t = it * 8 + w;
        float sv = 0.f, qv = 0.f;
#pragma unroll
        for (int k = 0; k < 8; ++k) { const float2 a = *(const float2*)(cst + ((size_t)t * 8 + k) * 2); sv += a.x; qv += a.y; }
        const float mean = sv * (1.f / 1024.f);
        float var = qv * (1.f / 1024.f) - mean * mean; var = var > 0.f ? var : 0.f;
        const float rstd = 1.f / sqrtf(var + LN_EPS);
#pragma unroll
        for (int c = 0; c < 4; ++c) {
            const int col = c * 256 + lane * 4;
            const f32x4 x = *(const f32x4*)(pre + (size_t)t * 1024 + col), g = *(const f32x4*)(p.in[14] + col), bb = *(const f32x4*)(p.in[15] + col);
            f32x4 y = (x - mean) * rstd * g + bb;
            y.x *= sigmoidf_(y.x); y.y *= sigmoidf_(y.y); y.z *= sigmoidf_(y.z); y.w *= sigmoidf_(y.w);
            u32x2 o; o.x = cvt_pk_bf16(y.x, y.y); o.y = cvt_pk_bf16(y.z, y.w);
            *(u32x2*)(CC + (size_t)t * 2048 + 1024 + col) = o;
        }
    }
}

enum { M_CMP = 0, M_SEL = 1, M_WIN = 2 };
constexpr int KSTR = 72;
constexpr int NSA_KBUF = 0, NSA_VBUF = 49152;
constexpr int NSA_IMP = 98304;
constexpr int NSA_TBL = 132096;
constexpr int NSA_SEL = NSA_TBL + 4096;
constexpr int NSA_UNIT = NSA_SEL + 1024;

DEVI void attn_issue(char* kdst, char* vdst, const bf16_t* kt, const bf16_t* vt, int vstride, int tid) {
    const int row = tid >> 3, c = (tid & 7) ^ ((row >> 1) & 7);
    glds16(kt + row * 64 + c * 8, kdst + tid * 16);
    glds16(vt + (size_t)row * vstride + c * 8, vdst + tid * 16);
}

constexpr float NSA_THR = 8.f;
template <int MODE, int PASS>
DEVI void nsa_branch(char* smem, const bf16_t* kg, const bf16_t* vg, int vstride, int t_lo, int t_hi, int far_lo, int far_hi, const bf16x8 (&qf)[4], int tq,
                     float c31, const LAS float* tblg, const LAS unsigned* selrow, float& m_ref, bool& mset, f32x16& lacc, float inv_l, f32x16 (&o)[2], LAS float* imp_row) {
    int tid = threadIdx.x; asm volatile("" : "+v"(tid));
    const int lane = tid & 63, l31 = lane & 31, h = lane >> 5, xs = (l31 >> 1) & 7;
    const int n = t_hi - t_lo + 1;
    f32x16 cneg;
    { const float cc = c31 - m_ref;
#pragma unroll
      for (int i = 0; i < 16; ++i) cneg[i] = cc; }
    u32x4 ones_u; ones_u.x = ones_u.y = ones_u.z = ones_u.w = 0x3F803F80u;
    const bf16x8 ones = __builtin_bit_cast(bf16x8, ones_u);
    float imp_carry = 0.f;
    const int nS = (n + 1) >> 1;
#define NSA_ISSUE_PAIR(js_) do { const int _sl = (js_) % 3; \
        _Pragma("unroll") for (int _sb = 0; _sb < 2; ++_sb) { int _t = t_lo + 2 * (js_) + _sb; _t = _t > t_hi ? t_hi : _t; \
            attn_issue(smem + NSA_KBUF + _sl * 16384 + _sb * 8192, smem + NSA_VBUF + _sl * 16384 + _sb * 8192, kg + (size_t)_t * 4096, vg + _t * 64, vstride, tid); } } while (0)
    NSA_ISSUE_PAIR(0);
    if (nS > 1) NSA_ISSUE_PAIR(1);
    for (int it = 0; it < n; ++it) {
        const int ti = t_lo + it, js = it >> 1, buf = (js % 3) * 2 + (it & 1);
        if ((it & 1) == 0) {
            if (js + 1 < nS) asm volatile("s_waitcnt vmcnt(4)" ::: "memory"); else asm volatile("s_waitcnt vmcnt(0)" ::: "memory");
            __builtin_amdgcn_s_barrier();
            asm volatile("" ::: "memory");
            if (js + 2 < nS) NSA_ISSUE_PAIR(js + 2);
        }
        bool selbit = true;
        if (MODE == M_SEL) { selbit = (selrow[ti >> 5] >> (ti & 31)) & 1u; if (!__any(selbit)) continue; }
        const char* Kc = smem + NSA_KBUF + buf * 8192; const char* Vc = smem + NSA_VBUF + buf * 8192;
        f32x16 s[2];
        __builtin_amdgcn_s_setprio(1);
        {
            const int off0 = (h ^ xs) << 4;
            s[0] = mfma32(*(const bf16x8*)(Kc + l31 * 128 + off0), qf[0], cneg);
            s[1] = mfma32(*(const bf16x8*)(Kc + (32 + l31) * 128 + off0), qf[0], cneg);
        }
#pragma unroll
        for (int ks = 1; ks < 4; ++ks) {
            const int off = ((2 * ks + h) ^ xs) << 4;
            s[0] = mfma32(*(const bf16x8*)(Kc + l31 * 128 + off), qf[ks], s[0]);
            s[1] = mfma32(*(const bf16x8*)(Kc + (32 + l31) * 128 + off), qf[ks], s[1]);
        }
        __builtin_amdgcn_s_setprio(0);
        const bool far = (ti >= far_lo) && (ti <= far_hi);
        {
        if (!far) {
            const int dbase = (MODE == M_CMP) ? (tq - 31 - 1024 * ti) : (tq - 64 * ti);
#pragma unroll
            for (int u = 0; u < 2; ++u)
#pragma unroll
                for (int i = 0; i < 16; ++i) {
                    const int kk = 32 * u + (i & 3) + 8 * (i >> 2) + 4 * h;
                    const int dist = dbase - ((MODE == M_CMP) ? 16 * kk : kk);
                    const int idx = (dist < -1 ? -1 : (dist > 191 ? 191 : dist)) + 64;
                    float v = s[u][i] + tblg[idx];
                    if (MODE == M_WIN) v = (dist < 512) ? v : -INFINITY;
                    if (MODE == M_SEL) v = selbit ? v : -INFINITY;
                    s[u][i] = v;
                    if ((i & 3) == 3) asm volatile("" ::: "memory");
                }
        }
        if (PASS != 2) {
            float mx = fmaxf(s[0][0], s[1][0]);
#pragma unroll
            for (int i = 1; i < 16; ++i) mx = fmaxf(mx, fmaxf(s[0][i], s[1][i]));
            if (MODE == M_SEL && !selbit) mx = -INFINITY;
            if (__any(mx > NSA_THR || (!mset && mx > -INFINITY))) {
                const float mc = fmaxf(mx, __shfl_xor(mx, 32));
                const bool mv = (mc > NSA_THR) || (!mset && mc > -INFINITY);
                const float delta = mv ? mc : 0.f;
                const float alpha = mset ? fexp2(-delta) : 1.f;
                mset = mset || mv;
                m_ref += delta;
                const float cc = c31 - m_ref;
#pragma unroll
                for (int i = 0; i < 16; ++i) { cneg[i] = cc; lacc[i] *= alpha; }
#pragma unroll
                for (int u = 0; u < 2; ++u)
#pragma unroll
                    for (int i = 0; i < 16; ++i) s[u][i] -= delta;
                if (PASS == 0) {
#pragma unroll
                    for (int v = 0; v < 2; ++v)
#pragma unroll
                        for (int i = 0; i < 16; ++i) o[v][i] *= alpha;
                }
            }
        }
#pragma unroll
        for (int u = 0; u < 2; ++u)
#pragma unroll
            for (int i = 0; i < 16; ++i) s[u][i] = fexp2(s[u][i]);
        if (PASS == 2) {
            float mainv[8], halfv[8];
#pragma unroll
            for (int u = 0; u < 2; ++u)
#pragma unroll
                for (int c4 = 0; c4 < 4; ++c4) {
                    float hv = 0.5f * s[u][4 * c4 + 3] * inv_l;
                    float mv = ((s[u][4 * c4] + s[u][4 * c4 + 1]) + s[u][4 * c4 + 2]) * inv_l + hv;
                    mv += __builtin_bit_cast(float, __builtin_amdgcn_update_dpp(0, __builtin_bit_cast(int, mv), 0xB1, 0xF, 0xF, true));
                    hv += __builtin_bit_cast(float, __builtin_amdgcn_update_dpp(0, __builtin_bit_cast(int, hv), 0xB1, 0xF, 0xF, true));
                    mv += __builtin_bit_cast(float, __builtin_amdgcn_update_dpp(0, __builtin_bit_cast(int, mv), 0x4E, 0xF, 0xF, true));
                    hv += __builtin_bit_cast(float, __builtin_amdgcn_update_dpp(0, __builtin_bit_cast(int, hv), 0x4E, 0xF, 0xF, true));
                    mainv[u * 4 + c4] = mv; halfv[u * 4 + c4] = __shfl_xor(hv, 32);
                }
#pragma unroll
            for (int gi = 0; gi < 8; ++gi) {
                const float cin = h ? halfv[gi] : (gi ? halfv[gi - 1] : imp_carry);
                const unsigned ia = (unsigned)(size_t)(imp_row + 16 * ti + 2 * gi + h);
                const float val = mainv[gi] + cin;
                asm volatile("ds_write_b32 %0, %1" :: "v"(ia), "v"(val) : "memory");
            }
            imp_carry = halfv[7];
        }
        const unsigned pmask = (MODE == M_SEL && far && !selbit) ? 0u : 0xFFFFFFFFu;
#pragma unroll
        for (int u = 0; u < 2; ++u)
#pragma unroll
            for (int sI = 0; sI < 2; ++sI) {
                u32x4 pk;
                pk.x = cvt_pk_bf16(s[u][8 * sI + 0], s[u][8 * sI + 1]); pk.y = cvt_pk_bf16(s[u][8 * sI + 2], s[u][8 * sI + 3]);
                pk.z = cvt_pk_bf16(s[u][8 * sI + 4], s[u][8 * sI + 5]); pk.w = cvt_pk_bf16(s[u][8 * sI + 6], s[u][8 * sI + 7]);
                if (MODE == M_SEL) { pk.x &= pmask; pk.y &= pmask; pk.z &= pmask; pk.w &= pmask; }
                const bf16x8 pf = __builtin_bit_cast(bf16x8, pk);
                lacc = mfma32(ones, pf, lacc);
                if (PASS != 1) {
                    const int voff = ((2 * (2 * u + sI) + h) ^ xs) << 4;
                    o[0] = mfma32(*(const bf16x8*)(Vc + l31 * 128 + voff), pf, o[0]);
                    o[1] = mfma32(*(const bf16x8*)(Vc + (32 + l31) * 128 + voff), pf, o[1]);
                }
            }
        }
    }
    if (PASS == 2) {
        const int c = 16 * (t_hi + 1);
        if (h == 0 && c < 128) { const unsigned ia = (unsigned)(size_t)(imp_row + c); asm volatile("ds_write_b32 %0, %1" :: "v"(ia), "v"(imp_carry) : "memory"); }
        asm volatile("s_waitcnt lgkmcnt(0)" ::: "memory");
    }
#undef NSA_ISSUE_PAIR
    __syncthreads();
}

DEVI void phase_nsa(const Params& p, char* smem, int ctr_idx) {
    unsigned char* ws = p.ws;
    const int tid0 = threadIdx.x;
    float* imp = (float*)(smem + NSA_IMP);
    unsigned* tot = (unsigned*)(smem + NSA_IMP);
    float* tbl = (float*)(smem + NSA_TBL);
    unsigned* selm = (unsigned*)(smem + NSA_SEL);
    int* sunit = (int*)(smem + NSA_UNIT);
    unsigned* ctr = (unsigned*)(ws + WS_CTL) + CW_NSA + 256 * ctr_idx;
    unsigned* trc = (unsigned*)(ws + WS_CTL) + CW_TR;
    const bf16_t* Q = (const bf16_t*)(ws + WS_BUFB);
    const float* G = (const float*)(ws + WS_BUFC + C_GATES);
    bf16_t* CC = ctr_idx ? (bf16_t*)(p.out + 32 * 1024 * 1024) : (bf16_t*)(ws + WS_BUFA);
    for (;;) {
        int tid = tid0; asm volatile("" : "+v"(tid));
        const int lane = tid & 63, w = tid >> 6, l31 = lane & 31, h = lane >> 5;
        const int qi = l31 >> 2, g = l31 & 3, ql = 8 * w + qi;
        __syncthreads();
        if (tid == 0) {
            const unsigned x = xb_xcc_id() & 7u; int u = -1;
            for (unsigned k = 0; k < 8u && u < 0; ++k) { const unsigned xx = (x + k) & 7u; const unsigned i = atomicAdd(ctr + 16 * xx, 1u); if (i < 256u) u = (int)(i * 8u + xx); }
            *sunit = u;
        }
        __syncthreads();
        const int unit = *sunit;
        if (unit < 0) break;
        const int xq = unit & 7, iq = unit >> 3;
        const int qt = 127 - (iq >> 1), bh = 2 * xq + (iq & 1), b = bh >> 2, hkv = bh & 3, q0 = qt * 64, cur = qt;
        for (int i = tid; i < 4 * 256; i += 512) {
            const int gg = i >> 8, d = (i & 255) - 64;
            float val = -INFINITY;
            if (d >= 0) {
                int bucket;
                if (d < 16) bucket = d;
                else if (d >= 128) bucket = 31;
                else { const int lg = 16 + (int)(logf((float)d / 16.f) / 2.0794415416798357f * 16.f); bucket = lg < 31 ? lg : 31; }
                val = (p.in[11][bucket * 16 + hkv * 4 + gg] - p.in[11][31 * 16 + hkv * 4 + gg]) * LOG2E;
            }
            tbl[i] = val;
        }
        if (tid < 256) selm[tid] = 0u;
        const int tq = q0 + ql;
        const size_t trow = (size_t)b * 8192 + tq;
        bf16x8 qf[4];
        { const bf16_t* qrow = Q + trow * 1024 + hkv * 256 + g * 64;
#pragma unroll
          for (int ks = 0; ks < 4; ++ks) qf[ks] = *(const bf16x8*)(qrow + 16 * ks + 8 * h); }
        float c31 = p.in[11][31 * 16 + hkv * 4 + g] * LOG2E;
        asm volatile("" : "+v"(qf[0]), "+v"(qf[1]), "+v"(qf[2]), "+v"(qf[3]), "+v"(c31));
        const LAS float* tblg = (const LAS float*)(smem + NSA_TBL) + g * 256;
        const LAS unsigned* selrow = (const LAS unsigned*)(smem + NSA_SEL) + ql * 4;
        f32x16 o[2];
#pragma unroll
        for (int v = 0; v < 2; ++v)
#pragma unroll
            for (int i = 0; i < 16; ++i) o[v][i] = 0.f;
        __syncthreads();
        const bf16_t* kc = (const bf16_t*)(ws + WS_BUFC + C_KC) + (size_t)bh * 512 * 64;
        const bf16_t* vct = (const bf16_t*)(ws + WS_BUFC + C_VCT) + (size_t)bh * 64 * 512;
        const int ct_hi = (q0 + 32) >> 10, cfar_hi = (q0 >= 1167) ? ((q0 - 1167) >> 10) : -1;
        float m_ref = 0.f; bool mset = false;
        f32x16 lacc;
#pragma unroll
        for (int i = 0; i < 16; ++i) lacc[i] = 0.f;
        const int rmode = ctr_idx ? NSA_REP_MODE : 0;
        if (rmode != 2) nsa_branch<M_CMP, 1>(smem, kc, vct, 512, 0, ct_hi, 0, cfar_hi, qf, tq, c31, tblg, selrow, m_ref, mset, lacc, 0.f, o, (LAS float*)(smem + NSA_IMP) + ql * 132);
        { const float lt = lacc[0]; const float inv = lt > 0.f ? 1.f / lt : 0.f;
          if (rmode != 2 && rmode != 4) nsa_branch<M_CMP, 2>(smem, kc, vct, 512, 0, ct_hi, 0, cfar_hi, qf, tq, c31, tblg, selrow, m_ref, mset, lacc, inv, o, (LAS float*)(smem + NSA_IMP) + ql * 132);
#pragma unroll
          for (int v = 0; v < 2; ++v)
#pragma unroll
            for (int i = 0; i < 16; ++i) o[v][i] *= inv; }
        asm volatile("s_waitcnt lgkmcnt(0)" ::: "memory"); __syncthreads();
        if (rmode < 2) {
            const int q = tid >> 3, sub = tid & 7, t = q0 + q;
            unsigned key[16];
#pragma unroll
            for (int i = 0; i < 16; ++i) {
                const int j = sub * 16 + i;
                const bool forced = (j == 0) || (j == cur) || (j == cur - 1);
                const bool valid = (j * 64 <= t);
                const float v = imp[q * 132 + j];
                key[i] = forced ? 0xFFFFFFFFu : (valid ? (__float_as_uint(v) + 1u) : 0u);
            }
            unsigned tau = 0u;
            for (int bit = 31; bit >= 0; --bit) {
                const unsigned cand = tau | (1u << bit);
                int c = 0;
#pragma unroll
                for (int i = 0; i < 16; ++i) c += (key[i] >= cand) ? 1 : 0;
                c += __builtin_amdgcn_update_dpp(0, c, 0xB1, 0xF, 0xF, true); c += __builtin_amdgcn_update_dpp(0, c, 0x4E, 0xF, 0xF, true); c += __builtin_amdgcn_update_dpp(0, c, 0x141, 0xF, 0xF, true);
                if (c >= 16) tau = cand;
            }
            int gt = 0, eq = 0;
#pragma unroll
            for (int i = 0; i < 16; ++i) { gt += (key[i] > tau) ? 1 : 0; eq += (key[i] == tau) ? 1 : 0; }
            int gtt = gt; gtt += __builtin_amdgcn_update_dpp(0, gtt, 0xB1, 0xF, 0xF, true); gtt += __builtin_amdgcn_update_dpp(0, gtt, 0x4E, 0xF, 0xF, true); gtt += __builtin_amdgcn_update_dpp(0, gtt, 0x141, 0xF, 0xF, true);
            int pre = 0;
#pragma unroll
            for (int sI = 0; sI < 7; ++sI) { const int v = __shfl(eq, (lane & ~7) + sI); if (sI < sub) pre += v; }
            const int need = 16 - gtt;
            unsigned bits = 0u; int run = pre;
#pragma unroll
            for (int i = 0; i < 16; ++i) {
                bool sel = key[i] > tau;
                if (tau > 0u && key[i] == tau) { sel = run < need; ++run; }
                bits |= sel ? (1u << i) : 0u;
            }
            atomicOr(&selm[q * 4 + (sub >> 1)], bits << ((sub & 1) * 16));
        }
        __syncthreads();
        const float gc = G[((size_t)b * 8192 + tq) * 48 + hkv * 12 + g * 3 + 0];
#pragma unroll
        for (int v = 0; v < 2; ++v)
#pragma unroll
            for (int i = 0; i < 16; i += 2) { const float gcc = (PROBE == 1 ? 0.f : gc); tot[(v * 8 + (i >> 1)) * 512 + tid] = cvt_pk_bf16(gcc * o[v][i], gcc * o[v][i + 1]); o[v][i] = 0.f; o[v][i + 1] = 0.f; }
        {
            const bf16_t* ks = (const bf16_t*)(ws + WS_BUFC + C_KS) + (size_t)bh * 8192 * 64;
            const bf16_t* vst = (const bf16_t*)(ws + WS_BUFC + C_VST) + (size_t)bh * 64 * 8192;
            m_ref = 0.f; mset = false;
#pragma unroll
            for (int i = 0; i < 16; ++i) lacc[i] = 0.f;
            if (rmode == 0) nsa_branch<M_SEL, 0>(smem, ks, vst, 8192, 0, cur, 0, cur - 3, qf, tq, c31, tblg, selrow, m_ref, mset, lacc, 0.f, o, (LAS float*)nullptr);
            const float gs = G[((size_t)b * 8192 + tq) * 48 + hkv * 12 + g * 3 + 1];
            const float sc = (PROBE == 2 ? 0.f : gs) / lacc[0];
#pragma unroll
            for (int v = 0; v < 2; ++v)
#pragma unroll
                for (int i = 0; i < 16; i += 2) { const unsigned tv = tot[(v * 8 + (i >> 1)) * 512 + tid];
                    tot[(v * 8 + (i >> 1)) * 512 + tid] = cvt_pk_bf16(bf2f(tv & 0xffffu) + sc * o[v][i], bf2f(tv >> 16) + sc * o[v][i + 1]); o[v][i] = 0.f; o[v][i + 1] = 0.f; }
        }
        {
            const bf16_t* kw = (const bf16_t*)(ws + WS_BUFC + C_KW) + (size_t)bh * 8192 * 64;
            const bf16_t* vwt = (const bf16_t*)(ws + WS_BUFC + C_VWT) + (size_t)bh * 64 * 8192;
            m_ref = 0.f; mset = false;
#pragma unroll
            for (int i = 0; i < 16; ++i) lacc[i] = 0.f;
            const int w_lo = cur >= 8 ? cur - 8 : 0;
            if (rmode == 0 || rmode == 2) nsa_branch<M_WIN, 0>(smem, kw, vwt, 8192, w_lo, cur, cur - 7, cur - 3, qf, tq, c31, tblg, selrow, m_ref, mset, lacc, 0.f, o, (LAS float*)nullptr);
            const float gw = G[((size_t)b * 8192 + tq) * 48 + hkv * 12 + g * 3 + 2];
            const float sc = (PROBE == 3 ? 0.f : gw) / lacc[0];
            bf16_t* orow = CC + trow * 2048 + hkv * 256 + g * 64;
#pragma unroll
            for (int v = 0; v < 2; ++v)
#pragma unroll
                for (int c4 = 0; c4 < 4; ++c4) {
                    const unsigned ta = tot[(v * 8 + 2 * c4) * 512 + tid], tb = tot[(v * 8 + 2 * c4 + 1) * 512 + tid];
                    const float r0 = bf2f(ta & 0xffffu) + sc * o[v][4 * c4 + 0], r1 = bf2f(ta >> 16) + sc * o[v][4 * c4 + 1];
                    const float r2 = bf2f(tb & 0xffffu) + sc * o[v][4 * c4 + 2], r3 = bf2f(tb >> 16) + sc * o[v][4 * c4 + 3];
                    u32x2 ov; ov.x = cvt_pk_bf16(r0, r1); ov.y = cvt_pk_bf16(r2, r3);
                    *(u32x2*)(orow + 32 * v + 8 * c4 + 4 * h) = ov;
                }
        }
        if (ctr_idx == 0) {
            __syncthreads();
            for (int k = 0; k < 3; ++k) {
                int item = 0;
                if (lane == 0) item = (int)atomicAdd(trc, 1u);
                item = __builtin_amdgcn_readfirstlane(item);
                if (item >= MOE_W_ITEMS) break;
                moe_weight_item(p, smem, item);
            }
        }
    }
    if (ctr_idx == 0) {
        __syncthreads();
        for (;;) {
            int item = 0;
            if ((threadIdx.x & 63) == 0) item = (int)atomicAdd(trc, 1u);
            item = __builtin_amdgcn_readfirstlane(item);
            if (item >= MOE_W_ITEMS) break;
            moe_weight_item(p, smem, item);
        }
    }
}

template <int which>
DEVI void phase_ln(const Params& p) {
    unsigned char* ws = p.ws;
    int tid = threadIdx.x; asm volatile("" : "+v"(tid));
    const int lane = tid & 63, w = tid >> 6;
    for (int it = blockIdx.x; it < T_ / 8; it += gridDim.x) {
        const int t = it * 8 + w;
        float* row = p.out + (size_t)t * D_;
        f32x4 v[8]; row_load(row, lane, v);
        float mean, rstd; row_stats(v, mean, rstd);
        if (which == 0) {
            if (lane == 0) { float* st = (float*)(ws + WS_STATS); st[t * 2] = mean; st[t * 2 + 1] = rstd; }
            bf16_t* hi = (bf16_t*)(ws + WS_BUFB) + (size_t)t * D_;
#pragma unroll
            for (int c = 0; c < 8; ++c) {
                const int col = c * 256 + lane * 4;
                const f32x4 g = *(const f32x4*)(p.in[17] + col), b = *(const f32x4*)(p.in[18] + col);
                const f32x4 y = (v[c] - mean) * rstd * g + b;
                u32x2 o; o.x = cvt_pk_bf16(y.x, y.y); o.y = cvt_pk_bf16(y.z, y.w);
                *(u32x2*)(hi + col) = o;
            }
        } else if (which == 1) {
            bf16_t* hi = (bf16_t*)(ws + WS_BUFA) + (size_t)t * D_;
            bf16_t* lo = (bf16_t*)(ws + WS_BUFB) + (size_t)t * D_;
#pragma unroll
            for (int c = 0; c < 8; ++c) {
                const int col = c * 256 + lane * 4;
                const f32x4 g = *(const f32x4*)(p.in[24] + col), b = *(const f32x4*)(p.in[25] + col);
                const f32x4 y = (v[c] - mean) * rstd * g + b;
                u32x2 o; o.x = cvt_pk_bf16(y.x, y.y); o.y = cvt_pk_bf16(y.z, y.w);
                *(u32x2*)(hi + col) = o;
                u32x2 ol;
                ol.x = cvt_pk_bf16(y.x - bf2f(o.x & 0xffffu), y.y - bf2f(o.x >> 16));
                ol.y = cvt_pk_bf16(y.z - bf2f(o.y & 0xffffu), y.w - bf2f(o.y >> 16));
                *(u32x2*)(lo + col) = ol;
            }
        } else {
            const bf16_t* y0 = (const bf16_t*)(ws + WS_BUFC) + (size_t)t * 2 * D_;
#pragma unroll
            for (int c = 0; c < 8; ++c) {
                const int col = c * 256 + lane * 4;
                const f32x4 g = *(const f32x4*)(p.in[24] + col), b = *(const f32x4*)(p.in[25] + col);
                const f32x4 x2 = (v[c] - mean) * rstd * g + b;
                const u32x2 a = *(const u32x2*)(y0 + col), bq = *(const u32x2*)(y0 + D_ + col);
                v[c].x = x2.x * ALPHA + (bf2f(a.x & 0xffffu) + bf2f(bq.x & 0xffffu));
                v[c].y = x2.y * ALPHA + (bf2f(a.x >> 16) + bf2f(bq.x >> 16));
                v[c].z = x2.z * ALPHA + (bf2f(a.y & 0xffffu) + bf2f(bq.y & 0xffffu));
                v[c].w = x2.w * ALPHA + (bf2f(a.y >> 16) + bf2f(bq.y >> 16));
            }
            row_stats(v, mean, rstd);
#pragma unroll
            for (int c = 0; c < 8; ++c) {
                const int col = c * 256 + lane * 4;
                const f32x4 g = *(const f32x4*)(p.in[33] + col), b = *(const f32x4*)(p.in[34] + col);
                *(f32x4*)(row + col) = (v[c] - mean) * rstd * g + b;
            }
        }
    }
}

DEVI void phase_xattn(const Params& p, char* smem) {
    unsigned char* ws = p.ws;
    int tid = threadIdx.x; asm volatile("" : "+v"(tid));
    const int lane = tid & 63, w = tid >> 6, l31 = lane & 31, h = lane >> 5;
    const bf16_t* Qx = (const bf16_t*)(ws + WS_BUFC);
    const bf16_t* Kx = (const bf16_t*)(ws + WS_BUFD + 4 * MiB);
    const bf16_t* Vt = (const bf16_t*)(ws + WS_BUFD + 8 * MiB);
    bf16_t* Ox = (bf16_t*)(ws + WS_BUFA);
    bf16_t* Qs = (bf16_t*)smem;
    bf16_t* Ks = Qs + 256 * KSTR;
    bf16_t* Vs = (bf16_t*)smem;
    for (int unit = blockIdx.x; unit < 512; unit += gridDim.x) {
        const int qt = unit & 31, head = (unit >> 5) & 3, b = unit >> 7;
        const size_t t0 = (size_t)b * 8192 + qt * 256;
        const bf16_t* kbase = Kx + (size_t)(b * 4 + head) * 256 * 512;
        const bf16_t* vbase = Vt + (size_t)(b * 4 + head) * 512 * 256;
        f32x16 s[8];
#pragma unroll
        for (int u = 0; u < 8; ++u)
#pragma unroll
            for (int i = 0; i < 16; ++i) s[u][i] = 0.f;
        u32x4 pq[4], pk4[4];
#pragma unroll
        for (int i = 0; i < 4; ++i) { const int c = tid + 512 * i, row = c >> 3, ch = c & 7;
            pq[i] = *(const u32x4*)(Qx + (t0 + row) * 2048 + head * 512 + ch * 8); pk4[i] = *(const u32x4*)(kbase + (size_t)row * 512 + ch * 8); }
        for (int dc = 0; dc < 8; ++dc) {
            __syncthreads();
#pragma unroll
            for (int i = 0; i < 4; ++i) { const int c = tid + 512 * i, row = c >> 3, ch = c & 7;
                *(u32x4*)(Qs + row * KSTR + ch * 8) = pq[i]; *(u32x4*)(Ks + row * KSTR + ch * 8) = pk4[i]; }
            __syncthreads();
            if (dc + 1 < 8) {
#pragma unroll
                for (int i = 0; i < 4; ++i) { const int c = tid + 512 * i, row = c >> 3, ch = c & 7;
                    pq[i] = *(const u32x4*)(Qx + (t0 + row) * 2048 + head * 512 + (dc + 1) * 64 + ch * 8); pk4[i] = *(const u32x4*)(kbase + (size_t)row * 512 + (dc + 1) * 64 + ch * 8); }
            }
#pragma unroll
            for (int ks = 0; ks < 4; ++ks) {
                const bf16x8 qb = *(const bf16x8*)(Qs + (32 * w + l31) * KSTR + 16 * ks + 8 * h);
#pragma unroll
                for (int u = 0; u < 8; ++u) { const bf16x8 ka = *(const bf16x8*)(Ks + (32 * u + l31) * KSTR + 16 * ks + 8 * h); s[u] = mfma32(ka, qb, s[u]); }
            }
        }
        u32x4 pv[4];
#pragma unroll
        for (int i = 0; i < 4; ++i) { const int c = tid + 512 * i, row = c >> 5, ch = c & 31; pv[i] = *(const u32x4*)(vbase + (size_t)row * 256 + ch * 8); }
        float mx = -INFINITY;
#pragma unroll
        for (int u = 0; u < 8; ++u)
#pragma unroll
            for (int i = 0; i < 16; ++i) mx = fmaxf(mx, s[u][i]);
        mx = fmaxf(mx, __shfl_xor(mx, 32));
        float ls = 0.f;
        bf16x8 pf[8][2];
#pragma unroll
        for (int u = 0; u < 8; ++u) {
#pragma unroll
            for (int i = 0; i < 16; ++i) { s[u][i] = fexp2(s[u][i] - mx); ls += s[u][i]; }
#pragma unroll
            for (int sI = 0; sI < 2; ++sI) { u32x4 pk;
                pk.x = cvt_pk_bf16(s[u][8 * sI + 0], s[u][8 * sI + 1]); pk.y = cvt_pk_bf16(s[u][8 * sI + 2], s[u][8 * sI + 3]);
                pk.z = cvt_pk_bf16(s[u][8 * sI + 4], s[u][8 * sI + 5]); pk.w = cvt_pk_bf16(s[u][8 * sI + 6], s[u][8 * sI + 7]);
                pf[u][sI] = __builtin_bit_cast(bf16x8, pk); }
        }
        ls += __shfl_xor(ls, 32);
        const float inv = (PROBE == 4 ? 0.f : 1.f) / ls;
        bf16_t* orow = Ox + (t0 + 32 * w + l31) * 2048 + head * 512;
        for (int dc = 0; dc < 8; ++dc) {
            __syncthreads();
#pragma unroll
            for (int i = 0; i < 4; ++i) { const int c = tid + 512 * i, row = c >> 5, ch = c & 31; *(u32x4*)(Vs + row * 264 + ch * 8) = pv[i]; }
            __syncthreads();
            if (dc + 1 < 8) {
#pragma unroll
                for (int i = 0; i < 4; ++i) { const int c = tid + 512 * i, row = c >> 5, ch = c & 31; pv[i] = *(const u32x4*)(vbase + (size_t)((dc + 1) * 64 + row) * 256 + ch * 8); }
            }
            f32x16 o[2];
#pragma unroll
            for (int v = 0; v < 2; ++v)
#pragma unroll
                for (int i = 0; i < 16; ++i) o[v][i] = 0.f;
#pragma unroll
            for (int s4 = 0; s4 < 16; ++s4)
#pragma unroll
                for (int v = 0; v < 2; ++v) {
                    const bf16_t* vr = Vs + (32 * v + l31) * 264 + 16 * s4 + 4 * h;
                    const u32x2 a = *(const u32x2*)vr, bq = *(const u32x2*)(vr + 8);
                    u32x4 vv; vv.x = a.x; vv.y = a.y; vv.z = bq.x; vv.w = bq.y;
                    o[v] = mfma32(__builtin_bit_cast(bf16x8, vv), pf[s4 >> 1][s4 & 1], o[v]);
                }
#pragma unroll
            for (int v = 0; v < 2; ++v)
#pragma unroll
                for (int c4 = 0; c4 < 4; ++c4) {
                    u32x2 ov; ov.x = cvt_pk_bf16(o[v][4 * c4] * inv, o[v][4 * c4 + 1] * inv); ov.y = cvt_pk_bf16(o[v][4 * c4 + 2] * inv, o[v][4 * c4 + 3] * inv);
                    *(u32x2*)(orow + dc * 64 + 32 * v + 8 * c4 + 4 * h) = ov;
                }
        }
        __syncthreads();
    }
}

DEVI void phase_route(const Params& p) {
    unsigned char* ws = p.ws;
    const float* L = (const float*)(ws + WS_LOGITS);
    unsigned* cnt = (unsigned*)(ws + WS_CTL) + CW_CNT;
    int* list = (int*)(ws + WS_LIST);
    float* wt = (float*)(ws + WS_WTOK);
    int tid = threadIdx.x; asm volatile("" : "+v"(tid));
    for (int t = blockIdx.x * NTHREADS + tid; t < T_; t += gridDim.x * NTHREADS) {
        const f32x4 lgv = *(const f32x4*)(L + (size_t)t * 40);
        float lg[4] = {lgv.x + p.in[27][0], lgv.y + p.in[27][1], lgv.z + p.in[27][2], lgv.w + p.in[27][3]};
        int grp = 0; float best = lg[0];
#pragma unroll
        for (int i = 1; i < 4; ++i) if (lg[i] > best) { best = lg[i]; grp = i; }
        float se = 0.f;
#pragma unroll
        for (int i = 0; i < 4; ++i) se += expf(lg[i] - best);
        const float wgrp = 1.f / se;
        const f32x4 e0 = *(const f32x4*)(L + (size_t)t * 40 + 4 + grp * 8), e1 = *(const f32x4*)(L + (size_t)t * 40 + 8 + grp * 8);
        const f32x4 b0 = *(const f32x4*)(p.in[29] + grp * 8), b1 = *(const f32x4*)(p.in[29] + grp * 8 + 4);
        float le[8] = {e0.x + b0.x, e0.y + b0.y, e0.z + b0.z, e0.w + b0.w, e1.x + b1.x, e1.y + b1.y, e1.z + b1.z, e1.w + b1.w};
        int i0 = 0; float v0 = le[0];
#pragma unroll
        for (int i = 1; i < 8; ++i) if (le[i] > v0) { v0 = le[i]; i0 = i; }
        int i1 = -1; float v1 = -INFINITY;
#pragma unroll
        for (int i = 0; i < 8; ++i) if (i != i0 && le[i] > v1) { v1 = le[i]; i1 = i; }
        const float ex = expf(v1 - v0);
        const float w0 = wgrp / (1.f + ex), w1 = wgrp * ex / (1.f + ex);
        const int ea = grp * 8 + i0, eb = grp * 8 + i1;
        const unsigned pa = atomicAdd(cnt + ea, 1u); list[(size_t)ea * T_ + pa] = t * 2;
        const unsigned pb = atomicAdd(cnt + eb, 1u); list[(size_t)eb * T_ + pb] = t * 2 + 1;
        wt[t * 2] = w0; wt[t * 2 + 1] = w1;
    }
}

enum { PH_PREP = 0, PH_PROJ, PH_CMP1, PH_CMP2, PH_NSA, PH_OUT, PH_LN1, PH_WQ, PH_XATTN, PH_WO, PH_LN2, PH_ROUTER, PH_ROUTE, PH_MOE1, PH_MOE2, PH_LN3, PH_COUNT };

__global__ void __launch_bounds__(NTHREADS, 2) fwd_megakernel(Params p) {
    extern __shared__ __attribute__((aligned(16))) char smem[];
    cg::grid_group grid = cg::this_grid();
    volatile LAS unsigned* bar_st = (volatile LAS unsigned*)(smem + LDS_BYTES - 16);
    if (threadIdx.x < 2) bar_st[threadIdx.x] = 0u;
    __syncthreads();
    xcd_barrier_post((unsigned*)(p.ws + WS_CTL) + CW_BAR);
    const int lo = p.ph_lo, hi = p.ph_hi;
    unsigned long long ts0 = 0, ts1 = 0;
    if (TSTAMP_PHASE >= 0) ts0 = __builtin_amdgcn_s_memrealtime();
#ifndef PHMASK
#define PHMASK 0xFFFFFFFFu
#endif
#define IN(k) (lo <= (k) && (k) < hi && ((PHMASK >> (k)) & 1u))
#define SEAM(k) do { if (IN(k) && IN((k) + 1)) { if ((k) == 0) grid.sync(); else xcd_barrier((unsigned*)(p.ws + WS_CTL) + CW_BAR, (volatile LAS unsigned*)(smem + LDS_BYTES - 16)); } if ((k) == TSTAMP_PHASE) ts1 = __builtin_amdgcn_s_memrealtime(); } while (0)
    if (IN(PH_PREP)) for (int r = 0; r < REP_PREP; ++r) phase_prep(p, smem);
    SEAM(PH_PREP);
    if (IN(PH_PROJ)) { for (int r = 0; r < REP_PROJ; ++r) gemm_job<J_PROJ>(p, smem); for (int r = 0; r < REP_SMALL; ++r) gemm_job<J_MEMKV>(p, smem); }
    SEAM(PH_PROJ);
    if (IN(PH_CMP1)) { for (int r = 0; r < REP_SMALL; ++r) gemm_job<J_CMP1>(p, smem); for (int r = 0; r < REP_CONV; ++r) phase_conv(p); }
    SEAM(PH_CMP1);
    if (IN(PH_CMP2)) for (int r = 0; r < REP_SMALL; ++r) gemm_job<J_CMP2>(p, smem);
    SEAM(PH_CMP2);
    if (IN(PH_NSA)) { conv_finish(p); for (int r = 0; r < REP_NSA; ++r) phase_nsa(p, smem, r); }
    SEAM(PH_NSA);
    if (IN(PH_OUT)) for (int r = 0; r < REP_OUT; ++r) gemm_job<J_OUT>(p, smem);
    SEAM(PH_OUT);
    if (IN(PH_WQ)) { gemm_job<J_WQ>(p, smem); for (int r = 1; r < REP_WQ; ++r) gemm_job<J_WQ, WQ_VAR>(p, smem); }
    SEAM(PH_WQ);
    if (IN(PH_XATTN)) for (int r = 0; r < REP_XATTN; ++r) phase_xattn(p, smem);
    SEAM(PH_XATTN);
    if (IN(PH_WO)) gemm_job<J_WO>(p, smem);
    SEAM(PH_WO);
    if (IN(PH_LN2)) phase_ln<1>(p);
    SEAM(PH_LN2);
    if (IN(PH_ROUTER)) for (int r = 0; r < REP_SMALL; ++r) gemm_job<J_ROUTER>(p, smem);
    SEAM(PH_ROUTER);
    if (IN(PH_MOE1)) for (int r = 0; r < REP_MOE; ++r) gemm_job<J_MOE1>(p, smem);
    SEAM(PH_MOE1);
    if (IN(PH_MOE2)) for (int r = 0; r < REP_MOE; ++r) gemm_job<J_MOE2>(p, smem);
    SEAM(PH_MOE2);
    if (IN(PH_LN3)) phase_ln<2>(p);
    if (TSTAMP_PHASE >= 0 && blockIdx.x == 0 && threadIdx.x == 0) { const unsigned long long t2 = __builtin_amdgcn_s_memrealtime(); const unsigned long long wait = 4ull * (ts1 - ts0); while (__builtin_amdgcn_s_memrealtime() - t2 < wait) __builtin_amdgcn_s_sleep(32); }
#undef IN
#undef SEAM
}

#ifndef N_SPLIT
#define N_SPLIT 1
#endif

extern "C" void kernel_launch(void* const* d_in, const int* in_sizes, int n_in, void* d_out, int out_size, void* d_ws, size_t ws_size, hipStream_t stream) {
    static int grid_blocks = 0;
    if (grid_blocks == 0) {
        if (n_in != 35 || ws_size < WS_END || out_size != T_ * D_) { fprintf(stderr, "kernel_launch: unexpected sizes n_in %d ws %zu out %d\n", n_in, ws_size, out_size); grid_blocks = -1; return; }
        int dev = 0, cus = 0, per_cu = 0;
        hipGetDevice(&dev);
        hipDeviceGetAttribute(&cus, hipDeviceAttributeMultiprocessorCount, dev);
        hipFuncSetAttribute((const void*)fwd_megakernel, hipFuncAttributeMaxDynamicSharedMemorySize, LDS_BYTES);
        hipOccupancyMaxActiveBlocksPerMultiprocessor(&per_cu, (const void*)fwd_megakernel, NTHREADS, LDS_BYTES);
        if (per_cu < 1) { fprintf(stderr, "kernel_launch: occupancy query says %d blocks per CU\n", per_cu); grid_blocks = -1; return; }
        if (per_cu > 2) per_cu = 2;
        grid_blocks = cus * per_cu;
        fprintf(stderr, "kernel_launch: %d CUs x %d blocks\n", cus, per_cu);
    }
    if (grid_blocks < 0) return;
    hipMemsetAsync((char*)d_ws + WS_CTL, 0, 1 * MiB, stream);
    hipMemsetAsync((char*)d_ws + WS_RSUM1, 0, 1 * MiB, stream);
    Params p{};
    for (int i = 0; i < 35; ++i) p.in[i] = (const float*)d_in[i];
    p.out = (float*)d_out; p.ws = (unsigned char*)d_ws;
    if (N_SPLIT == 1) {
        p.ph_lo = 0; p.ph_hi = PH_COUNT;
        void* args[] = {&p};
        hipError_t e = hipLaunchCooperativeKernel((const void*)fwd_megakernel, dim3(grid_blocks), dim3(NTHREADS), args, LDS_BYTES, stream);
        if (e != hipSuccess) fprintf(stderr, "cooperative launch failed: %s (grid %d)\n", hipGetErrorString(e), grid_blocks);
    } else {
        for (int ph = 0; ph < PH_COUNT; ++ph) {
            p.ph_lo = ph; p.ph_hi = ph + 1;
            void* args[] = {&p};
            hipError_t e = hipLaunchCooperativeKernel((const void*)fwd_megakernel, dim3(grid_blocks), dim3(NTHREADS), args, LDS_BYTES, stream);
            if (e != hipSuccess) fprintf(stderr, "launch %d failed: %s\n", ph, hipGetErrorString(e));
        }
    }
}
```

```cpp
#include <hip/hip_runtime.h>
#include <hip/hip_cooperative_groups.h>
#include <cstdio>
#include <cstdint>
namespace cg = cooperative_groups;

#define DEVI __device__ __forceinline__
#ifndef REP_PREP
#define REP_PREP 1
#define REP_PROJ 1
#define REP_NSA 1
#define REP_WQ 1
#define WQ_VAR 3
#define REP_XATTN 1
#define REP_MOE 1
#define REP_LN3 1
#define REP_CONV 1
#define REP_OUT 1
#define REP_SMALL 1
#endif
#ifndef NSA_REP_MODE
#define NSA_REP_MODE 0
#endif
#ifndef TSTAMP_PHASE
#define TSTAMP_PHASE -1
#endif
#ifndef PROBE
#define PROBE 0
#endif
typedef unsigned short bf16_t;
typedef __attribute__((ext_vector_type(8))) short bf16x8;
typedef __attribute__((ext_vector_type(4))) float f32x4;
typedef __attribute__((ext_vector_type(16))) float f32x16;
typedef __attribute__((ext_vector_type(4))) unsigned u32x4;
typedef __attribute__((ext_vector_type(2))) unsigned u32x2;

constexpr int T_ = 32768, D_ = 2048, S_ = 8192, NB_ = 4;
constexpr int NPROJ = 4736;
constexpr int IN_COLS = 4656;
constexpr float ALPHA = 1.189207115002721f;
constexpr float LOG2E = 1.4426950408889634f;
constexpr float LN_EPS = 1e-5f;
constexpr int NTHREADS = 512;
constexpr int LDS_BYTES = 147968;

constexpr size_t MiB = 1ull << 20;
constexpr size_t WS_CTL = 0;
constexpr size_t WS_STATS = 1 * MiB;
constexpr size_t WS_C1BIAS = WS_STATS + 256 * 1024;
constexpr size_t WS_WTOK = WS_STATS + 512 * 1024;
constexpr size_t WS_LOGITS = 2 * MiB;
constexpr size_t WS_LIST = 7 * MiB;
constexpr size_t WS_WC1 = 11 * MiB;
constexpr size_t WS_WC2 = 13 * MiB;
constexpr size_t WS_WR = 14 * MiB;
constexpr size_t WS_WIN = 15 * MiB;
constexpr size_t WS_WOUT = 34 * MiB;
constexpr size_t WS_WQ = 42 * MiB;
constexpr size_t WS_WKV = 50 * MiB;
constexpr size_t WS_WO = 66 * MiB;
constexpr size_t WS_WGU = 74 * MiB;
constexpr size_t WS_WD = 202 * MiB;
constexpr size_t WS_BUFA = 266 * MiB;
constexpr size_t WS_BUFB = 394 * MiB;
constexpr size_t WS_BUFC = 522 * MiB;
constexpr size_t WS_BUFD = 650 * MiB;
constexpr size_t WS_END = 778 * MiB;
constexpr size_t C_KCMP = 0, C_VCMP = 16 * MiB, C_KS = 32 * MiB, C_VST = 48 * MiB, C_KW = 64 * MiB, C_VWT = 80 * MiB,
                 C_GATES = 96 * MiB, C_HID = 102 * MiB, C_KC = 110 * MiB, C_VCT = 111 * MiB;
constexpr int CW_CNT = 64;
constexpr int CW_NSA = 1024;
constexpr int CW_TR = 2048;
constexpr int CW_BAR = 4096;
constexpr size_t CTL_U1 = 65536, CTL_C1 = 73728;
constexpr size_t WS_RSUM1 = WS_LOGITS;

struct Params {
    const float* in[35];
    float* out;
    unsigned char* ws;
    int ph_lo, ph_hi;
};

DEVI unsigned cvt_pk_bf16(float lo, float hi) { unsigned r; asm("v_cvt_pk_bf16_f32 %0, %1, %2" : "=v"(r) : "v"(lo), "v"(hi)); return r; }
DEVI bf16_t f2bf(float x) { return (bf16_t)(cvt_pk_bf16(x, 0.f) & 0xffffu); }
DEVI float bf2f(unsigned b) { return __uint_as_float(b << 16); }
DEVI void glds16(const void* g, void* l) {
    __builtin_amdgcn_global_load_lds((const __attribute__((address_space(1))) void*)g, (__attribute__((address_space(3))) void*)l, 16, 0, 0);
}
DEVI f32x16 mfma32(bf16x8 a, bf16x8 b, f32x16 c) { return __builtin_amdgcn_mfma_f32_32x32x16_bf16(a, b, c, 0, 0, 0); }
DEVI f32x4 mfma16(bf16x8 a, bf16x8 b, f32x4 c) { return __builtin_amdgcn_mfma_f32_16x16x32_bf16(a, b, c, 0, 0, 0); }
DEVI float fexp2(float x) { return __builtin_amdgcn_exp2f(x); }
DEVI float max3f(float a, float b, float c) { float r; asm("v_max3_f32 %0, %1, %2, %3" : "=v"(r) : "v"(a), "v"(b), "v"(c)); return r; }
DEVI float wave_sum(float v) {
#pragma unroll
    for (int o = 1; o < 64; o <<= 1) v += __shfl_xor(v, o);
    return v;
}
DEVI float sigmoidf_(float x) { return 1.f / (1.f + __expf(-x)); }
DEVI float gelu_tanh(float x) {
    const float u = 0.7978845608028654f * (x + 0.044715f * x * x * x);
    const float e = __expf(2.f * u);
    const float th = 1.f - 2.f / (e + 1.f);
    return 0.5f * x * (1.f + th);
}

#define LAS __attribute__((address_space(3)))
#define XB_TMO      128
#define XB_XCNT(j)  (256  + 64 * (j))
#define XB_XSUB(j)  (1280 + 64 * (j))
#define XB_XGEN(j)  (2304 + 64 * (j))
#define XB_TOP      3328
#define XB_TOPGEN   3392
#define XB_SPIN_CAP (1u << 22)
DEVI unsigned xb_ld(unsigned* p) { return __hip_atomic_load(p, __ATOMIC_RELAXED, __HIP_MEMORY_SCOPE_AGENT); }
DEVI unsigned xb_add(unsigned* p, unsigned v) { return __hip_atomic_fetch_add(p, v, __ATOMIC_RELAXED, __HIP_MEMORY_SCOPE_AGENT); }
DEVI unsigned xb_xcc_id() { return (unsigned)__builtin_amdgcn_s_getreg((3 << 11) | 20) & 0xFu; }
#define XB_SPIN(cond, bar) do { unsigned _sp = 0; while (cond) { __builtin_amdgcn_s_sleep(1); \
    if ((++_sp & 255u) == 0u) { if (xb_ld(&(bar)[XB_TMO])) break; if (_sp > XB_SPIN_CAP) { atomicAdd(&(bar)[XB_TMO], 1u); break; } } } } while (0)
DEVI void xcd_barrier_post(unsigned* bar) {
    if (threadIdx.x == 0) (void)xb_add(&bar[XB_XCNT(xb_xcc_id())], 1u);
}
DEVI void xcd_barrier_complete(unsigned* bar, unsigned x, unsigned& nloc, unsigned& nx) {
    const unsigned G = gridDim.x * gridDim.y * gridDim.z;
    unsigned sum, cnt, mine, sp = 0u;
    for (;;) {
        sum = 0u; cnt = 0u; mine = 0u;
#pragma unroll
        for (unsigned j = 0; j < 16; ++j) { const unsigned c = xb_ld(&bar[XB_XCNT(j)]); sum += c; cnt += (c > 0u) ? 1u : 0u; mine = (j == x) ? c : mine; }
        if (sum == G) break;
        __builtin_amdgcn_s_sleep(1);
        if ((++sp & 255u) == 0u) { if (xb_ld(&bar[XB_TMO])) break; if (sp > XB_SPIN_CAP) { atomicAdd(&bar[XB_TMO], 1u); break; } }
    }
    nloc = mine > 0u ? mine : 1u; nx = cnt > 0u ? cnt : 1u;
}
DEVI void xcd_barrier(unsigned* bar, volatile LAS unsigned* st) {
    asm volatile("s_waitcnt vmcnt(0)" ::: "memory");
    __syncthreads();
    if (threadIdx.x == 0) {
        const unsigned x = xb_xcc_id();
        __builtin_amdgcn_s_waitcnt(0);
        unsigned nloc = st[0], nx = st[1];
        if (nloc == 0u) { xcd_barrier_complete(bar, x, nloc, nx); st[0] = nloc; st[1] = nx; }
        const unsigned old = xb_add(&bar[XB_XSUB(x)], 1u);
        const unsigned gen = old / nloc;
        if (old + 1u == (gen + 1u) * nloc) {
            __builtin_amdgcn_fence(__ATOMIC_RELEASE, "agent");
            asm volatile("s_waitcnt vmcnt(0)" ::: "memory");
            const unsigned og = xb_add(&bar[XB_TOP], 1u);
            const unsigned tg = og / nx;
            if (og + 1u == (tg + 1u) * nx) xb_add(&bar[XB_TOPGEN], 1u);
            else XB_SPIN(xb_ld(&bar[XB_TOPGEN]) == tg, bar);
            __builtin_amdgcn_fence(__ATOMIC_ACQUIRE, "agent");
            xb_add(&bar[XB_XGEN(x)], 1u);
            asm volatile("s_waitcnt vmcnt(0)" ::: "memory");
        } else {
            XB_SPIN(xb_ld(&bar[XB_XGEN(x)]) == gen, bar);
            __builtin_amdgcn_fence(__ATOMIC_ACQUIRE, "agent");
            asm volatile("s_waitcnt vmcnt(0)" ::: "memory");
        }
    }
    __syncthreads();
}

DEVI void row_load(const float* row, int lane, f32x4 (&v)[8]) {
#pragma unroll
    for (int c = 0; c < 8; ++c) v[c] = *(const f32x4*)(row + c * 256 + lane * 4);
}
DEVI void row_stats(const f32x4 (&v)[8], float& mean, float& rstd) {
    float s = 0.f;
#pragma unroll
    for (int c = 0; c < 8; ++c) s += (v[c].x + v[c].y) + (v[c].z + v[c].w);
    mean = wave_sum(s) * (1.f / D_);
    float q = 0.f;
#pragma unroll
    for (int c = 0; c < 8; ++c) { const f32x4 d = v[c] - mean; q += (d.x * d.x + d.y * d.y) + (d.z * d.z + d.w * d.w); }
    rstd = 1.f / sqrtf(wave_sum(q) * (1.f / D_) + LN_EPS);
}

DEVI const float* wsrc_col(const Params& p, int mat, int e, int n, int& ld) {
    switch (mat) {
    case 0: {
        ld = IN_COLS;
        if (n < 2560) return p.in[4] + n;
        if (n < 2688) { const int j = n - 2560; return j < 48 ? p.in[4] + 2560 + j : nullptr; }
        const int r = n - 2688, grp = r >> 6, within = r & 63;
        const int ch = grp * 32 + (within & 31), isg = within >> 5;
        return p.in[4] + 2608 + isg * 1024 + ch;
    }
    case 1: ld = 256; return p.in[6] + n;
    case 2: ld = 256; return p.in[9] + n;
    case 3: ld = 64; return n < 64 ? p.in[7] + n : nullptr;
    case 4: ld = 64; return n < 64 ? p.in[10] + n : nullptr;
    case 5: ld = 2048; return p.in[16] + n;
    case 6: ld = 2048; return p.in[21] + n;
    case 7: ld = 4096; return p.in[22] + n;
    case 8: ld = 2048; return p.in[23] + n;
    case 9: if (n < 4) { ld = 4; return p.in[26] + n; } if (n < 36) { ld = 32; return p.in[28] + (n - 4); } ld = 1; return nullptr;
    case 10: { ld = 512; const int grp = n >> 6, within = n & 63; const int ch = grp * 32 + (within & 31);
               return ((within >> 5) ? p.in[31] : p.in[30]) + (size_t)e * 2048 * 512 + ch; }
    default: ld = 2048; return p.in[32] + (size_t)e * 512 * 2048 + n;
    }
}
DEVI void wave_transpose_item(const Params& p, char* smem, int mat, int e, int ntile, int ktile, bf16_t* dst, bf16_t* dst_lo, int K,
                                const float* gvec = nullptr, const float* bvec = nullptr, float* U = nullptr, float* C = nullptr) {
    int tid = threadIdx.x; asm volatile("" : "+v"(tid));
    const int lane = tid & 63, w = tid >> 6;
    float* tile = (float*)smem + w * (64 * 65 + 32);
    const int k0 = ktile * 64;
    if (mat == 9) {
        int ld; const float* src = wsrc_col(p, mat, e, ntile * 64 + lane, ld);
#pragma unroll 8
        for (int k = 0; k < 64; ++k) tile[k * 65 + lane] = src ? src[(size_t)(k0 + k) * ld] : 0.f;
    } else {
        const int c4 = lane & 15, kr = lane >> 4;
        int ld; const float* src = wsrc_col(p, mat, e, ntile * 64 + c4 * 4, ld);
        f32x4 v[16];
#pragma unroll
        for (int i = 0; i < 16; ++i) v[i] = src ? *(const f32x4*)(src + (size_t)(k0 + kr + 4 * i) * ld) : (f32x4){0.f, 0.f, 0.f, 0.f};
#pragma unroll
        for (int i = 0; i < 16; ++i) { float* q = tile + (kr + 4 * i) * 65 + c4 * 4; q[0] = v[i].x; q[1] = v[i].y; q[2] = v[i].z; q[3] = v[i].w; }
    }
    asm volatile("s_waitcnt lgkmcnt(0)" ::: "memory");
    if (gvec) {
        float us = 0.f, cs = 0.f;
#pragma unroll 8
        for (int k = 0; k < 64; ++k) { const float wkn = tile[k * 65 + lane]; us += gvec[k0 + k] * wkn; cs += bvec[k0 + k] * wkn; }
        atomicAdd(U + ntile * 64 + lane, us); atomicAdd(C + ntile * 64 + lane, cs);
    }
    const int kc = lane & 7, nr = lane >> 3;
#pragma unroll
    for (int c = 0; c < 8; ++c) {
        const int n = nr + 8 * c;
        float wv[8];
#pragma unroll
        for (int j = 0; j < 8; ++j) wv[j] = tile[(kc * 8 + j) * 65 + n];
        if (gvec) {
#pragma unroll
            for (int j = 0; j < 8; ++j) wv[j] *= gvec[k0 + kc * 8 + j]; }
        u32x4 o; o.x = cvt_pk_bf16(wv[0], wv[1]); o.y = cvt_pk_bf16(wv[2], wv[3]); o.z = cvt_pk_bf16(wv[4], wv[5]); o.w = cvt_pk_bf16(wv[6], wv[7]);
        const size_t off = (size_t)(ntile * 64 + n) * K + k0 + kc * 8;
        if (!dst_lo) *(u32x4*)(dst + off) = o;
        else {
            float r[8];
#pragma unroll
            for (int j = 0; j < 8; ++j) r[j] = wv[j] - bf2f((unsigned)f2bf(wv[j]));
            u32x4 l; l.x = cvt_pk_bf16(r[0], r[1]); l.y = cvt_pk_bf16(r[2], r[3]); l.z = cvt_pk_bf16(r[4], r[5]); l.w = cvt_pk_bf16(r[6], r[7]);
            const size_t o0 = (size_t)n * K + k0 + kc * 8, o1 = (size_t)(64 + n) * K + k0 + kc * 8;
            if (ntile == 0) { *(u32x4*)(dst + o0) = o; *(u32x4*)(dst_lo + o0) = o; *(u32x4*)(dst + o1) = l; }
            else *(u32x4*)(dst_lo + o1) = (u32x4){0u, 0u, 0u, 0u};
        }
    }
    asm volatile("s_waitcnt lgkmcnt(0)" ::: "memory");
}

DEVI void phase_prep(const Params& p, char* smem) {
    int tid = threadIdx.x; asm volatile("" : "+v"(tid));
    const int lane = tid & 63, w = tid >> 6;
    unsigned char* ws = p.ws;
    for (int r = blockIdx.x; r < 8; r += gridDim.x) {
        const int type = r >> 2, n = (r & 3) * 64 + lane;
        const float* pe = p.in[type ? 8 : 5]; const float* w1 = p.in[type ? 9 : 6];
        float sacc = 0.f;
        for (int k = w * 256; k < (w + 1) * 256; ++k) sacc += pe[k] * w1[(size_t)k * 256 + n];
        float* red = (float*)smem;
        __syncthreads();
        red[w * 64 + lane] = sacc;
        __syncthreads();
        if (w == 0) ((float*)(ws + WS_C1BIAS))[type * 256 + n] = ((red[lane] + red[64 + lane]) + (red[128 + lane] + red[192 + lane])) + ((red[256 + lane] + red[320 + lane]) + (red[384 + lane] + red[448 + lane]));
        __syncthreads();
    }
    constexpr int I_LN = T_, I_MEM = 1024;
    constexpr int I_M0 = 74 * 32, I_M12 = 4 * 32, I_M34 = 2 * 4, I_SQ = 32 * 32, I_KV = 64 * 32, I_R = 2 * 32;
    constexpr int TOTAL = I_LN + I_MEM + I_M0 + 2 * I_M12 + 2 * I_M34 + 3 * I_SQ + I_KV + I_R;
    const int gw = blockIdx.x * 8 + w, NW = gridDim.x * 8;
    for (int it = gw; it < TOTAL; it += NW) {
        int r = it;
        if (r < I_LN) {
            const int t = r;
            f32x4 v[8]; row_load(p.in[0] + (size_t)t * D_, lane, v);
            float mean, rstd; row_stats(v, mean, rstd);
            bf16_t* hb = (bf16_t*)(ws + WS_BUFA) + (size_t)t * D_;
#pragma unroll
            for (int c = 0; c < 8; ++c) {
                const int col = c * 256 + lane * 4;
                const f32x4 g = *(const f32x4*)(p.in[2] + col), b = *(const f32x4*)(p.in[3] + col);
                const f32x4 y = (v[c] - mean) * rstd * g + b;
                u32x2 o; o.x = cvt_pk_bf16(y.x, y.y); o.y = cvt_pk_bf16(y.z, y.w);
                *(u32x2*)(hb + col) = o;
            }
            if (lane == 0) { float* st = (float*)(ws + WS_STATS); st[t * 2] = mean; st[t * 2 + 1] = rstd; }
            continue;
        }
        r -= I_LN;
        if (r < I_MEM) {
            const int t = r;
            f32x4 v[8]; row_load(p.in[1] + (size_t)t * D_, lane, v);
            float mean, rstd; row_stats(v, mean, rstd);
            bf16_t* hb = (bf16_t*)(ws + WS_BUFD) + (size_t)t * D_;
#pragma unroll
            for (int c = 0; c < 8; ++c) {
                const int col = c * 256 + lane * 4;
                const f32x4 g = *(const f32x4*)(p.in[19] + col), b = *(const f32x4*)(p.in[20] + col);
                const f32x4 y = (v[c] - mean) * rstd * g + b;
                u32x2 o; o.x = cvt_pk_bf16(y.x, y.y); o.y = cvt_pk_bf16(y.z, y.w);
                *(u32x2*)(hb + col) = o;
            }
            continue;
        }
        r -= I_MEM;
        if (r < I_M0) { wave_transpose_item(p, smem, 0, 0, r / 32, r % 32, (bf16_t*)(ws + WS_WIN), nullptr, 2048); continue; } r -= I_M0;
        if (r < I_M12) { wave_transpose_item(p, smem, 1, 0, r / 32, r % 32, (bf16_t*)(ws + WS_WC1), nullptr, 2048); continue; } r -= I_M12;
        if (r < I_M12) { wave_transpose_item(p, smem, 2, 0, r / 32, r % 32, (bf16_t*)(ws + WS_WC1) + 256 * 2048, nullptr, 2048); continue; } r -= I_M12;
        if (r < I_M34) { wave_transpose_item(p, smem, 3, 0, r / 4, r % 4, (bf16_t*)(ws + WS_WC2), nullptr, 256); continue; } r -= I_M34;
        if (r < I_M34) { wave_transpose_item(p, smem, 4, 0, r / 4, r % 4, (bf16_t*)(ws + WS_WC2) + 128 * 256, nullptr, 256); continue; } r -= I_M34;
        if (r < I_SQ) { wave_transpose_item(p, smem, 5, 0, r / 32, r % 32, (bf16_t*)(ws + WS_WOUT), nullptr, 2048); continue; } r -= I_SQ;
        if (r < I_SQ) { wave_transpose_item(p, smem, 6, 0, r / 32, r % 32, (bf16_t*)(ws + WS_WQ), nullptr, 2048, p.in[17], p.in[18], (float*)(ws + WS_CTL + CTL_U1), (float*)(ws + WS_CTL + CTL_C1)); continue; } r -= I_SQ;
        if (r < I_KV) { wave_transpose_item(p, smem, 7, 0, r / 32, r % 32, (bf16_t*)(ws + WS_WKV), nullptr, 2048); continue; } r -= I_KV;
        if (r < I_SQ) { wave_transpose_item(p, smem, 8, 0, r / 32, r % 32, (bf16_t*)(ws + WS_WO), nullptr, 2048); continue; } r -= I_SQ;
        wave_transpose_item(p, smem, 9, 0, r / 32, r % 32, (bf16_t*)(ws + WS_WR), (bf16_t*)(ws + WS_WR) + 128 * 2048, 2048);
    }
    __syncthreads();
}

constexpr int MOE_W_ITEMS = 32 * 16 * 32 + 32 * 32 * 8;
DEVI void moe_weight_item(const Params& p, char* smem, int r) {
    unsigned char* ws = p.ws;
    if (r < 32 * 16 * 32) { const int e = r / 512, q = r % 512; wave_transpose_item(p, smem, 10, e, q / 32, q % 32, (bf16_t*)(ws + WS_WGU) + (size_t)e * 1024 * 2048, nullptr, 2048); }
    else { r -= 32 * 16 * 32; const int e = r / 256, q = r % 256; wave_transpose_item(p, smem, 11, e, q / 8, q % 8, (bf16_t*)(ws + WS_WD) + (size_t)e * 2048 * 512, nullptr, 512); }
}

enum { J_PROJ = 0, J_MEMKV, J_CMP1, J_CMP2, J_OUT, J_WQ, J_WO, J_ROUTER, J_MOE1, J_MOE2 };
constexpr int GEMM_STAGE_BYTES = 49152;
constexpr int GEMM_TP = 3 * GEMM_STAGE_BYTES;

template <int job, int VAR = 0>
DEVI void gemm_job(const Params& p, char* smem) {
    unsigned char* ws = p.ws;
    int tid = threadIdx.x; asm volatile("" : "+v"(tid));
    const int lane = tid & 63, w = tid >> 6, wr = w >> 1, wc = w & 1, fr = lane & 15, fq = lane >> 4;
    const int srow = tid >> 3, schunk = (tid & 7) ^ ((tid >> 4) & 7);
    int* tp = (int*)(smem + GEMM_TP);
    int MT = 0, NT = 0, K = 2048, nseg = 1, ntiles = 0, RT = 0;
    switch (job) {
    case J_PROJ: MT = 128; NT = 37; break;
    case J_MEMKV: MT = 4; NT = 32; break;
    case J_CMP1: MT = 64; NT = 2; break;
    case J_CMP2: MT = 64; NT = 1; K = 256; break;
    case J_OUT: case J_WQ: case J_WO: MT = 128; NT = 16; break;
    case J_ROUTER: MT = 128; NT = 1; nseg = 2; break;
    default: break;
    }
    const unsigned* cntw = (const unsigned*)(ws + WS_CTL) + CW_CNT;
    if (job == J_MOE1 || job == J_MOE2) {
        __syncthreads();
        if (tid == 0) { int acc = 0; for (int e = 0; e < 32; ++e) { tp[e] = acc; const int c = (int)__hip_atomic_load(cntw + e, __ATOMIC_RELAXED, __HIP_MEMORY_SCOPE_AGENT); tp[33 + e] = c; acc += (c + 255) >> 8; } tp[32] = acc; }
        __syncthreads();
        RT = tp[32];
        NT = (job == J_MOE1) ? 8 : 16; K = (job == J_MOE1) ? 2048 : 512;
        { int mx = 0;
#pragma unroll
          for (int x = 0; x < 8; ++x) { int t = 0;
#pragma unroll
              for (int k = 0; k < 4; ++k) t += (tp[33 + x + 8 * k] + 255) >> 8;
              mx = t > mx ? t : mx; }
          ntiles = mx * NT * 8; }
    } else {
        const int nsr = (MT + 7) >> 3;
        ntiles = (MT < 64) ? MT * NT : ((nsr + 7) >> 3) * 8 * NT * 8;
    }
    int my_tp = 0, my_cnt = 0;
    if (job == J_MOE1 || job == J_MOE2) { my_tp = tp[lane & 31]; my_cnt = tp[33 + (lane & 31)]; }
    const int nk = K >> 6, ntot = nseg * nk;

    for (int ti = blockIdx.x; ti < ntiles; ti += gridDim.x) {
        int mt, nt, e = 0, rt = 0, ecnt = 0, etp = 0;
        if (job == J_MOE1 || job == J_MOE2) {
            const int x = ti & 7; int jj = ti >> 3; bool found = false; mt = 0; nt = 0;
#pragma unroll
            for (int k = 0; k < 4; ++k) {
                const int ee = x + 8 * k;
                const int c = __shfl(my_cnt, ee), rtc = (c + 255) >> 8, tot = rtc * NT;
                if (!found) { if (jj < tot) { found = true; e = ee; ecnt = c; etp = __shfl(my_tp, ee); const int per = 4 * rtc, ng = jj / per, r2 = jj - ng * per; nt = ng * 4 + r2 / rtc; rt = r2 - (r2 / rtc) * rtc; } else jj -= tot; }
            }
            if (!found) continue;
        } else {
            if (MT < 64) { nt = ti / MT; mt = ti - nt * MT; }
            else {
                const int x = ti & 7, jj = ti >> 3, per = 8 * NT, srl = jj / per, idx = jj - srl * per;
                mt = (srl * 8 + x) * 8 + (idx & 7); nt = idx >> 3;
                if (mt >= MT) continue;
            }
        }
        const bf16_t* ap[4]; const bf16_t* bp[2];
#pragma unroll
        for (int r = 0; r < 4; ++r) {
            const int row = r * 64 + srow;
            const bf16_t* a;
            switch (job) {
            case J_PROJ: a = (const bf16_t*)(ws + WS_BUFA) + (size_t)(mt * 256 + row) * 2048; break;
            case J_MEMKV: a = (const bf16_t*)(ws + WS_BUFD) + (size_t)(mt * 256 + row) * 2048; break;
            case J_CMP1: { const int gi = mt >> 1, i = (mt & 1) * 256 + row, ic = i < 510 ? i : 510; const int type = gi >> 4, bh = gi & 15;
                a = (const bf16_t*)(ws + WS_BUFC + (type ? C_VCMP : C_KCMP)) + ((size_t)bh * 8192 + 16 * ic) * 64; break; }
            case J_CMP2: a = (const bf16_t*)(ws + WS_BUFC + C_HID) + (size_t)(mt * 256 + row) * 256; break;
            case J_OUT: a = (const bf16_t*)(ws + WS_BUFA) + (size_t)(mt * 256 + row) * 2048; break;
            case J_WQ: a = (const bf16_t*)(ws + WS_BUFB) + (size_t)(mt * 256 + row) * 2048; break;
            case J_WO: a = (const bf16_t*)(ws + WS_BUFA) + (size_t)(mt * 256 + row) * 2048; break;
            case J_ROUTER: a = (const bf16_t*)(ws + WS_BUFA) + (size_t)(mt * 256 + row) * 2048; break;
            case J_MOE1: { int pos = rt * 256 + row; if (pos >= ecnt) pos = 0; const int aid = ((const int*)(ws + WS_LIST))[(size_t)e * T_ + pos];
                a = (const bf16_t*)(ws + WS_BUFA) + (size_t)(aid >> 1) * 2048; break; }
            default: a = (const bf16_t*)(ws + WS_BUFB) + (size_t)((etp + rt) * 256 + row) * 512; break;
            }
            ap[r] = a + schunk * 8;
        }
#pragma unroll
        for (int r = 0; r < 2; ++r) {
            const int row = r * 64 + srow;
            const bf16_t* b;
            switch (job) {
            case J_PROJ: b = (const bf16_t*)(ws + WS_WIN) + (size_t)(nt * 128 + row) * 2048; break;
            case J_MEMKV: b = (const bf16_t*)(ws + WS_WKV) + (size_t)(nt * 128 + row) * 2048; break;
            case J_CMP1: b = (const bf16_t*)(ws + WS_WC1) + (size_t)(mt >> 5) * 256 * 2048 + (size_t)(nt * 128 + row) * 2048; break;
            case J_CMP2: b = (const bf16_t*)(ws + WS_WC2) + (size_t)(mt >> 5) * 128 * 256 + (size_t)row * 256; break;
            case J_OUT: b = (const bf16_t*)(ws + WS_WOUT) + (size_t)(nt * 128 + row) * 2048; break;
            case J_WQ: b = (const bf16_t*)(ws + WS_WQ) + (size_t)(nt * 128 + row) * 2048; break;
            case J_WO: b = (const bf16_t*)(ws + WS_WO) + (size_t)(nt * 128 + row) * 2048; break;
            case J_ROUTER: b = (const bf16_t*)(ws + WS_WR) + (size_t)row * 2048; break;
            case J_MOE1: b = (const bf16_t*)(ws + WS_WGU) + (size_t)e * 1024 * 2048 + (size_t)(nt * 128 + row) * 2048; break;
            default: b = (const bf16_t*)(ws + WS_WD) + (size_t)e * 2048 * 512 + (size_t)(nt * 128 + row) * 512; break;
            }
            bp[r] = b + schunk * 8;
        }
        const long a_seg1 = (long)(WS_BUFB - WS_BUFA) / 2;
        const long b_seg2 = 128 * 2048;

        f32x4 acc[4][4];
#pragma unroll
        for (int i = 0; i < 4; ++i)
#pragma unroll
            for (int j = 0; j < 4; ++j) acc[i][j] = (f32x4){0.f, 0.f, 0.f, 0.f};

#define GEMM_STAGE(kt_) do { const int _kt = (kt_); int _seg = 0, _k0 = _kt << 6; if (nseg > 1) { _seg = _kt / nk; _k0 = (_kt - _seg * nk) << 6; } \
            const long _ao = (_seg == 1) ? a_seg1 : 0, _bo = (_seg == 1) ? b_seg2 : 0; \
            char* _A = smem + (_kt % 3) * GEMM_STAGE_BYTES; char* _B = _A + 32768; \
            _Pragma("unroll") for (int r = 0; r < 4; ++r) glds16(ap[r] + _ao + _k0, _A + (r * 512 + tid) * 16); \
            _Pragma("unroll") for (int r = 0; r < 2; ++r) glds16(bp[r] + _bo + _k0, _B + (r * 512 + tid) * 16); } while (0)

        f32x4 pre[8];
        if (job == J_OUT || job == J_WO) {
            const float* src = (job == J_OUT) ? p.in[0] : p.out;
#pragma unroll
            for (int i = 0; i < 8; ++i) pre[i] = *(const f32x4*)(src + (size_t)(mt * 256 + (tid >> 5) + 16 * i) * D_ + nt * 128 + (tid & 31) * 4);
        }
        GEMM_STAGE(0);
        if (ntot > 1) GEMM_STAGE(1);
        for (int kt = 0; kt < ntot; ++kt) {
            if (kt + 1 < ntot) asm volatile("s_waitcnt vmcnt(6)" ::: "memory"); else asm volatile("s_waitcnt vmcnt(0)" ::: "memory");
            __builtin_amdgcn_s_barrier();
            asm volatile("" ::: "memory");
            if (kt + 2 < ntot && VAR != 1) GEMM_STAGE(kt + 2);
            if (VAR == 2) continue;
            const char* A = smem + (kt % 3) * GEMM_STAGE_BYTES; const char* B = A + 32768;
#pragma unroll
            for (int ks = 0; ks < 2; ++ks) {
                bf16x8 af[4], bfr[4];
                const int coff = ((4 * ks + fq) ^ (fr >> 1)) * 16;
#pragma unroll
                for (int i = 0; i < 4; ++i) {
                    af[i] = *(const bf16x8*)(A + (wr * 64 + i * 16 + fr) * 128 + coff);
                    bfr[i] = *(const bf16x8*)(B + (wc * 64 + i * 16 + fr) * 128 + coff);
                }
                __builtin_amdgcn_s_setprio(1);
#pragma unroll
                for (int i = 0; i < 4; ++i)
#pragma unroll
                    for (int j = 0; j < 4; ++j) acc[i][j] = mfma16(bfr[j], af[i], acc[i][j]);
                __builtin_amdgcn_s_setprio(0);
            }
        }
#undef GEMM_STAGE
        if (VAR != 0 && VAR != 4) { if (acc[0][0].x == 123.456f) p.out[0] = acc[1][1].y + acc[2][2].z + acc[3][3].w; __syncthreads(); continue; }
        asm volatile("s_waitcnt lgkmcnt(0)" ::: "memory"); __builtin_amdgcn_s_barrier(); asm volatile("" ::: "memory");
        float* ep = (float*)smem;
#pragma unroll
        for (int mi = 0; mi < 4; ++mi)
#pragma unroll
            for (int ni = 0; ni < 4; ++ni) *(f32x4*)(ep + (wr * 64 + mi * 16 + fr) * 132 + wc * 64 + ni * 16 + fq * 4) = acc[mi][ni];
        asm volatile("s_waitcnt lgkmcnt(0)" ::: "memory"); __builtin_amdgcn_s_barrier(); asm volatile("" ::: "memory");
        const int row0 = mt * 256, col0 = nt * 128;
#define EP8(row_, c8_, v0_, v1_) const f32x4 v0_ = *(const f32x4*)(ep + (row_) * 132 + (c8_) * 8), v1_ = *(const f32x4*)(ep + (row_) * 132 + (c8_) * 8 + 4)
#define PK8(o_, v0_, v1_) u32x4 o_; o_.x = cvt_pk_bf16(v0_.x, v0_.y); o_.y = cvt_pk_bf16(v0_.z, v0_.w); o_.z = cvt_pk_bf16(v1_.x, v1_.y); o_.w = cvt_pk_bf16(v1_.z, v1_.w)
        switch (job) {
        case J_PROJ: {
            if (nt < 8) {
                bf16_t* Q = (bf16_t*)(ws + WS_BUFB);
#pragma unroll
                for (int i = 0; i < 8; ++i) { const int c = tid + 512 * i, row = c >> 4, c8 = c & 15; EP8(row, c8, a0, a1);
                    const f32x4 b0 = a0 * (0.125f * LOG2E), b1 = a1 * (0.125f * LOG2E); PK8(o, b0, b1);
                    *(u32x4*)(Q + (size_t)(row0 + row) * 1024 + col0 + c8 * 8) = o; }
            } else if (nt < 20) {
                const int reg = (nt - 8) >> 1;
                bf16_t* dst = (bf16_t*)(ws + WS_BUFC + (reg == 0 ? C_KCMP : reg == 1 ? C_VCMP : reg == 2 ? C_KS : reg == 3 ? C_VST : reg == 4 ? C_KW : C_VWT));
                const int b = row0 >> 13, s0 = row0 & 8191;
                if (reg != 3 && reg != 5) {
#pragma unroll
                    for (int i = 0; i < 8; ++i) { const int c = tid + 512 * i, row = c >> 4, c8 = c & 15; EP8(row, c8, a0, a1); PK8(o, a0, a1);
                        const int bh = b * 4 + ((nt - 8) & 1) * 2 + (c8 >> 3);
                        *(u32x4*)(dst + ((size_t)bh * 8192 + s0 + row) * 64 + (c8 & 7) * 8) = o; }
                } else {
#pragma unroll
                    for (int i = 0; i < 8; ++i) { const int c = tid + 512 * i, tg = c & 31, dcol = c >> 5;
                        const int rb = (tg >> 1) * 16 + (tg & 1) * 4;
                        float v[8];
#pragma unroll
                        for (int j = 0; j < 8; ++j) v[j] = ep[(rb + (j & 3) + (j >> 2) * 8) * 132 + dcol];
                        u32x4 o; o.x = cvt_pk_bf16(v[0], v[1]); o.y = cvt_pk_bf16(v[2], v[3]); o.z = cvt_pk_bf16(v[4], v[5]); o.w = cvt_pk_bf16(v[6], v[7]);
                        const int bh = b * 4 + ((nt - 8) & 1) * 2 + (dcol >> 6);
                        *(u32x4*)(dst + ((size_t)bh * 64 + (dcol & 63)) * 8192 + s0 + tg * 8) = o; }
                }
            } else if (nt == 20) {
                float* G = (float*)(ws + WS_BUFC + C_GATES);
#pragma unroll
                for (int i = 0; i < 6; ++i) { const int c = tid + 512 * i, row = c / 12, c4 = c - row * 12;
                    const f32x4 v = *(const f32x4*)(ep + row * 132 + c4 * 4); f32x4 o; o.x = sigmoidf_(v.x); o.y = sigmoidf_(v.y); o.z = sigmoidf_(v.z); o.w = sigmoidf_(v.w);
                    *(f32x4*)(G + (size_t)(row0 + row) * 48 + c4 * 4) = o; }
            } else {
                bf16_t* Hg = (bf16_t*)(ws + WS_BUFB + 64 * MiB);
#pragma unroll
                for (int i = 0; i < 4; ++i) { const int c = tid + 512 * i, row = c >> 3, c8 = c & 7, hh = c8 >> 2, cc = (c8 & 3) * 8;
                    const f32x4 a0 = *(const f32x4*)(ep + row * 132 + hh * 64 + cc), a1 = *(const f32x4*)(ep + row * 132 + hh * 64 + cc + 4);
                    const f32x4 g0 = *(const f32x4*)(ep + row * 132 + hh * 64 + 32 + cc), g1 = *(const f32x4*)(ep + row * 132 + hh * 64 + 32 + cc + 4);
                    u32x4 o; o.x = cvt_pk_bf16(a0.x * sigmoidf_(g0.x), a0.y * sigmoidf_(g0.y)); o.y = cvt_pk_bf16(a0.z * sigmoidf_(g0.z), a0.w * sigmoidf_(g0.w));
                    o.z = cvt_pk_bf16(a1.x * sigmoidf_(g1.x), a1.y * sigmoidf_(g1.y)); o.w = cvt_pk_bf16(a1.z * sigmoidf_(g1.z), a1.w * sigmoidf_(g1.w));
                    *(u32x4*)(Hg + (size_t)(row0 + row) * 1024 + ((nt - 21) * 2 + hh) * 32 + cc) = o; }
            }
        } break;
        case J_MEMKV: {
            const int b = mt;
            if (nt < 16) {
                bf16_t* Kx = (bf16_t*)(ws + WS_BUFD + 4 * MiB);
                const int head = col0 >> 9, d0 = col0 & 511;
#pragma unroll
                for (int i = 0; i < 8; ++i) { const int c = tid + 512 * i, row = c >> 4, c8 = c & 15; EP8(row, c8, a0, a1); PK8(o, a0, a1);
                    *(u32x4*)(Kx + ((size_t)(b * 4 + head) * 256 + row) * 512 + d0 + c8 * 8) = o; }
            } else {
                bf16_t* Vt = (bf16_t*)(ws + WS_BUFD + 8 * MiB);
                const int n2 = col0 - 2048, head = n2 >> 9, d0 = n2 & 511;
#pragma unroll
                for (int i = 0; i < 8; ++i) { const int c = tid + 512 * i, tg = c & 31, dcol = c >> 5;
                    float v[8];
#pragma unroll
                    for (int j = 0; j < 8; ++j) v[j] = ep[(tg * 8 + j) * 132 + dcol];
                    u32x4 o; o.x = cvt_pk_bf16(v[0], v[1]); o.y = cvt_pk_bf16(v[2], v[3]); o.z = cvt_pk_bf16(v[4], v[5]); o.w = cvt_pk_bf16(v[6], v[7]);
                    *(u32x4*)(Vt + ((size_t)(b * 4 + head) * 512 + d0 + dcol) * 256 + tg * 8) = o; }
            }
        } break;
        case J_CMP1: {
            const int type = mt >> 5;
            const float* bias = (const float*)(ws + WS_C1BIAS) + type * 256;
            bf16_t* Hd = (bf16_t*)(ws + WS_BUFC + C_HID);
            const f32x4 b0 = *(const f32x4*)(bias + col0 + (tid & 15) * 8), b1 = *(const f32x4*)(bias + col0 + (tid & 15) * 8 + 4);
#pragma unroll
            for (int i = 0; i < 8; ++i) { const int c = tid + 512 * i, row = c >> 4, c8 = c & 15; EP8(row, c8, a0, a1);
                u32x4 o; o.x = cvt_pk_bf16(gelu_tanh(a0.x + b0.x), gelu_tanh(a0.y + b0.y)); o.y = cvt_pk_bf16(gelu_tanh(a0.z + b0.z), gelu_tanh(a0.w + b0.w));
                o.z = cvt_pk_bf16(gelu_tanh(a1.x + b1.x), gelu_tanh(a1.y + b1.y)); o.w = cvt_pk_bf16(gelu_tanh(a1.z + b1.z), gelu_tanh(a1.w + b1.w));
                *(u32x4*)(Hd + (size_t)(row0 + row) * 256 + col0 + c8 * 8) = o; }
        } break;
        case J_CMP2: {
            const int gi = mt >> 1, type = gi >> 4, bh = gi & 15, i0 = (mt & 1) * 256;
            if (type == 0) {
                bf16_t* Kc = (bf16_t*)(ws + WS_BUFC + C_KC);
#pragma unroll
                for (int i = 0; i < 4; ++i) { const int c = tid + 512 * i, row = c >> 3, c8 = c & 7; EP8(row, c8, a0, a1); PK8(o, a0, a1);
                    if (i0 + row >= 511) o = (u32x4){0u, 0u, 0u, 0u};
                    *(u32x4*)(Kc + ((size_t)bh * 512 + i0 + row) * 64 + c8 * 8) = o; }
            } else {
                bf16_t* Vc = (bf16_t*)(ws + WS_BUFC + C_VCT);
#pragma unroll
                for (int i = 0; i < 4; ++i) { const int c = tid + 512 * i, tg = c & 31, d = c >> 5;
                    const int rb = (tg >> 1) * 16 + (tg & 1) * 4;
                    float v[8];
#pragma unroll
                    for (int j = 0; j < 8; ++j) { const int r = rb + (j & 3) + (j >> 2) * 8; v[j] = (i0 + r >= 511) ? 0.f : ep[r * 132 + d]; }
                    u32x4 o; o.x = cvt_pk_bf16(v[0], v[1]); o.y = cvt_pk_bf16(v[2], v[3]); o.z = cvt_pk_bf16(v[4], v[5]); o.w = cvt_pk_bf16(v[6], v[7]);
                    *(u32x4*)(Vc + ((size_t)bh * 64 + d) * 512 + i0 + tg * 8) = o; }
            }
        } break;
        case J_OUT: {
            const float* st = (const float*)(ws + WS_STATS);
            const int c4 = tid & 31, n = col0 + c4 * 4;
            const f32x4 g = *(const f32x4*)(p.in[2] + n), bb = *(const f32x4*)(p.in[3] + n);
#pragma unroll
            for (int hlf = 0; hlf < 2; ++hlf) {
                f32x4 xv[8]; float2 sm[8];
#pragma unroll
                for (int i = 0; i < 8; ++i) { const int row = (tid >> 5) + 16 * (hlf * 8 + i), t = row0 + row;
                    xv[i] = hlf ? *(const f32x4*)(p.in[0] + (size_t)t * D_ + n) : pre[i]; sm[i] = *(const float2*)(st + t * 2); }
#pragma unroll
                for (int i = 0; i < 8; ++i) { const int row = (tid >> 5) + 16 * (hlf * 8 + i), t = row0 + row;
                    const f32x4 v = *(const f32x4*)(ep + row * 132 + c4 * 4);
                    const f32x4 y = ((xv[i] - sm[i].x) * sm[i].y * g + bb) * ALPHA + v;
                    *(f32x4*)(p.out + (size_t)t * D_ + n) = y;
                    u32x2 yb; yb.x = cvt_pk_bf16(y.x, y.y); yb.y = cvt_pk_bf16(y.z, y.w);
                    *(u32x2*)((bf16_t*)(ws + WS_BUFB) + (size_t)t * D_ + n) = yb;
                    float rs = (y.x + y.y) + (y.z + y.w), rq = (y.x * y.x + y.y * y.y) + (y.z * y.z + y.w * y.w);
#pragma unroll
                    for (int o = 1; o < 32; o <<= 1) { rs += __shfl_xor(rs, o); rq += __shfl_xor(rq, o); }
                    if ((tid & 31) == 0) { float* rsum = (float*)(ws + WS_RSUM1) + (size_t)t * 2; atomicAdd(rsum, rs); atomicAdd(rsum + 1, rq); } }
            }
        } break;
        case J_WQ: {
            bf16_t* Qx = (bf16_t*)(ws + WS_BUFC);
            const float sc = 0.04419417382415922f * LOG2E;
            const float* U = (const float*)(ws + WS_CTL + CTL_U1); const float* Cv = (const float*)(ws + WS_CTL + CTL_C1);
            const float* rsum = (const float*)(ws + WS_RSUM1);
            const int c8 = tid & 15, n = col0 + c8 * 8;
            const f32x4 u0 = *(const f32x4*)(U + n), u1 = *(const f32x4*)(U + n + 4), c0 = *(const f32x4*)(Cv + n), c1 = *(const f32x4*)(Cv + n + 4);
            float2 rsq[8];
#pragma unroll
            for (int i = 0; i < 8; ++i) rsq[i] = *(const float2*)(rsum + (size_t)(row0 + (tid >> 4) + 32 * i) * 2);
#pragma unroll
            for (int i = 0; i < 8; ++i) { const int row = (tid >> 4) + 32 * i; EP8(row, c8, a0, a1);
                const int t = row0 + row;
                const float mean = rsq[i].x * (1.f / D_); float var = rsq[i].y * (1.f / D_) - mean * mean; var = var > 0.f ? var : 0.f;
                const float rstd = __builtin_amdgcn_rsqf(var + LN_EPS), mr = mean * rstd;
                const f32x4 b0 = (a0 * rstd - u0 * mr + c0) * sc, b1 = (a1 * rstd - u1 * mr + c1) * sc; PK8(o, b0, b1);
                *(u32x4*)(Qx + (size_t)t * 2048 + n) = o; }
        } break;
        case J_WO: {
            const float* st = (const float*)(ws + WS_STATS);
            const int c4 = tid & 31, n = col0 + c4 * 4;
            const f32x4 g = *(const f32x4*)(p.in[17] + n), bb = *(const f32x4*)(p.in[18] + n);
#pragma unroll
            for (int hlf = 0; hlf < 2; ++hlf) {
                f32x4 rv[8]; float2 sm[8];
#pragma unroll
                for (int i = 0; i < 8; ++i) { const int row = (tid >> 5) + 16 * (hlf * 8 + i), t = row0 + row;
                    rv[i] = hlf ? *(const f32x4*)(p.out + (size_t)t * D_ + n) : pre[i]; const float2 rsq = *(const float2*)((const float*)(ws + WS_RSUM1) + (size_t)t * 2);
                    const float mean = rsq.x * (1.f / D_); float var = rsq.y * (1.f / D_) - mean * mean; var = var > 0.f ? var : 0.f;
                    sm[i] = make_float2(mean, 1.f / sqrtf(var + LN_EPS)); }
#pragma unroll
                for (int i = 0; i < 8; ++i) { const int row = (tid >> 5) + 16 * (hlf * 8 + i), t = row0 + row;
                    const f32x4 v = *(const f32x4*)(ep + row * 132 + c4 * 4);
                    *(f32x4*)(p.out + (size_t)t * D_ + n) = ((rv[i] - sm[i].x) * sm[i].y * g + bb) * ALPHA + v; }
            }
        } break;
        case J_ROUTER: {
            if (tid < 256) {
                const int row = tid, t = row0 + row;
                const float* er = ep + row * 132;
                unsigned* cnt = (unsigned*)(ws + WS_CTL) + CW_CNT;
                int* list = (int*)(ws + WS_LIST);
                float* wt = (float*)(ws + WS_WTOK);
                float lg[4];
#pragma unroll
                for (int i = 0; i < 4; ++i) lg[i] = er[i] + er[64 + i] + p.in[27][i];
                int grp = 0; float best = lg[0];
#pragma unroll
                for (int i = 1; i < 4; ++i) if (lg[i] > best) { best = lg[i]; grp = i; }
                float se = 0.f;
#pragma unroll
                for (int i = 0; i < 4; ++i) se += expf(lg[i] - best);
                const float wgrp = 1.f / se;
                float le[8];
#pragma unroll
                for (int i = 0; i < 8; ++i) le[i] = er[4 + grp * 8 + i] + er[68 + grp * 8 + i] + p.in[29][grp * 8 + i];
                int i0 = 0; float v0 = le[0];
#pragma unroll
                for (int i = 1; i < 8; ++i) if (le[i] > v0) { v0 = le[i]; i0 = i; }
                int i1 = -1; float v1 = -INFINITY;
#pragma unroll
                for (int i = 0; i < 8; ++i) if (i != i0 && le[i] > v1) { v1 = le[i]; i1 = i; }
                const float ex = expf(v1 - v0);
                const float w0 = wgrp / (1.f + ex), w1 = wgrp * ex / (1.f + ex);
                const int ea = grp * 8 + i0, eb = grp * 8 + i1;
                const unsigned pa = atomicAdd(cnt + ea, 1u); list[(size_t)ea * T_ + pa] = t * 2;
                const unsigned pb = atomicAdd(cnt + eb, 1u); list[(size_t)eb * T_ + pb] = t * 2 + 1;
                wt[t * 2] = w0; wt[t * 2 + 1] = w1;
            }
        } break;
        case J_MOE1: {
            bf16_t* H = (bf16_t*)(ws + WS_BUFB);
#pragma unroll
            for (int i = 0; i < 4; ++i) { const int c = tid + 512 * i, row = c >> 3, c8 = c & 7, hh = c8 >> 2, cc = (c8 & 3) * 8;
                const f32x4 g0 = *(const f32x4*)(ep + row * 132 + hh * 64 + cc), g1 = *(const f32x4*)(ep + row * 132 + hh * 64 + cc + 4);
                const f32x4 u0 = *(const f32x4*)(ep + row * 132 + hh * 64 + 32 + cc), u1 = *(const f32x4*)(ep + row * 132 + hh * 64 + 32 + cc + 4);
                u32x4 o; o.x = cvt_pk_bf16(g0.x * sigmoidf_(g0.x) * u0.x, g0.y * sigmoidf_(g0.y) * u0.y); o.y = cvt_pk_bf16(g0.z * sigmoidf_(g0.z) * u0.z, g0.w * sigmoidf_(g0.w) * u0.w);
                o.z = cvt_pk_bf16(g1.x * sigmoidf_(g1.x) * u1.x, g1.y * sigmoidf_(g1.y) * u1.y); o.w = cvt_pk_bf16(g1.z * sigmoidf_(g1.z) * u1.z, g1.w * sigmoidf_(g1.w) * u1.w);
                *(u32x4*)(H + ((size_t)(etp + rt) * 256 + row) * 512 + (nt * 2 + hh) * 32 + cc) = o; }
        } break;
        default: {
            bf16_t* Y = (bf16_t*)(ws + WS_BUFC);
            const float* wt = (const float*)(ws + WS_WTOK);
            const int c8 = tid & 15;
            int aid[8]; float wv[8];
#pragma unroll
            for (int i = 0; i < 8; ++i) { const int pos = rt * 256 + (tid >> 4) + 32 * i; aid[i] = (pos < ecnt) ? ((const int*)(ws + WS_LIST))[(size_t)e * T_ + pos] : -1; }
#pragma unroll
            for (int i = 0; i < 8; ++i) wv[i] = (aid[i] >= 0) ? wt[aid[i]] : 0.f;
#pragma unroll
            for (int i = 0; i < 8; ++i) { const int row = (tid >> 4) + 32 * i;
                if (aid[i] >= 0) { EP8(row, c8, a0, a1); const f32x4 b0 = a0 * wv[i], b1 = a1 * wv[i]; PK8(o, b0, b1);
                    *(u32x4*)(Y + (size_t)aid[i] * 2048 + col0 + c8 * 8) = o; } }
        } break;
        }
#undef EP8
#undef PK8
        asm volatile("s_waitcnt lgkmcnt(0)" ::: "memory"); __builtin_amdgcn_s_barrier(); asm volatile("" ::: "memory");
    }
}

DEVI void phase_conv(const Params& p) {
    unsigned char* ws = p.ws;
    int tid = threadIdx.x; asm volatile("" : "+v"(tid));
    const int lane = tid & 63, w = tid >> 6;
    const int c0 = tid * 2;
    const bf16_t* Hg = (const bf16_t*)(ws + WS_BUFB + 64 * MiB);
    float* pre = p.out;
    float* cst = (float*)(ws + WS_LIST);
    float wgt[31][2];
    { const float* wp = p.in[12] + c0;
#pragma unroll
      for (int k = 0; k < 31; ++k) { const float2 v = *(const float2*)wp; wgt[k][0] = v.x; wgt[k][1] = v.y; wp += 1024; asm volatile("" : "+v"(wp)); } }
    const float2 cb = *(const float2*)(p.in[13] + c0);
    for (int it = blockIdx.x; it < T_ / 16; it += gridDim.x) {
        const int t0 = it * 16, s0 = t0 & 8191;
        float acc[16][2];
#pragma unroll
        for (int j = 0; j < 16; ++j) { acc[j][0] = cb.x; acc[j][1] = cb.y; }
        const bf16_t* xp = Hg + ((long)t0 - 30) * 1024 + c0;
#pragma unroll
        for (int i = 0; i < 46; ++i) {
            const int s = s0 - 30 + i;
            float x0 = 0.f, x1 = 0.f;
            if (s >= 0) { const unsigned u = *(const unsigned*)xp; x0 = bf2f(u & 0xffffu); x1 = bf2f(u >> 16); }
            xp += 1024; asm volatile("" : "+v"(xp));
#pragma unroll
            for (int j = 0; j < 16; ++j) { const int k = i - j; if (k >= 0 && k <= 30) { acc[j][0] += wgt[k][0] * x0; acc[j][1] += wgt[k][1] * x1; } }
        }
#pragma unroll
        for (int j = 0; j < 16; ++j) {
            *(float2*)(pre + (size_t)(t0 + j) * 1024 + c0) = make_float2(acc[j][0], acc[j][1]);
            const float sv = wave_sum(acc[j][0] + acc[j][1]);
            const float qv = wave_sum(acc[j][0] * acc[j][0] + acc[j][1] * acc[j][1]);
            if (lane == 0) *(float2*)(cst + ((size_t)(t0 + j) * 8 + w) * 2) = make_float2(sv, qv);
        }
    }
}
DEVI void conv_finish(const Params& p) {
    unsigned char* ws = p.ws;
    int tid = threadIdx.x; asm volatile("" : "+v"(tid));
    const int lane = tid & 63, w = tid >> 6;
    const float* pre = p.out;
    const float* cst = (const float*)(ws + WS_LIST);
    bf16_t* CC = (bf16_t*)(ws + WS_BUFA);
    for (int it = blockIdx.x; it < T_ / 8; it += gridDim.x) {
        const int t = it * 8 + w;
        float sv = 0.f, qv = 0.f;
#pragma unroll
        for (int k = 0; k < 8; ++k) { const float2 a = *(const float2*)(cst + ((size_t)t * 8 + k) * 2); sv += a.x; qv += a.y; }
        const float mean = sv * (1.f / 1024.f);
        float var = qv * (1.f / 1024.f) - mean * mean; var = var > 0.f ? var : 0.f;
        const float rstd = 1.f / sqrtf(var + LN_EPS);
#pragma unroll
        for (int c = 0; c < 4; ++c) {
            const int col = c * 256 + lane * 4;
            const f32x4 x = *(const f32x4*)(pre + (size_t)t * 1024 + col), g = *(const f32x4*)(p.in[14] + col), bb = *(const f32x4*)(p.in[15] + col);
            f32x4 y = (x - mean) * rstd * g + bb;
            y.x *= sigmoidf_(y.x); y.y *= sigmoidf_(y.y); y.z *= sigmoidf_(y.z); y.w *= sigmoidf_(y.w);
            u32x2 o; o.x = cvt_pk_bf16(y.x, y.y); o.y = cvt_pk_bf16(y.z, y.w);
            *(u32x2*)(CC + (size_t)t * 2048 + 1024 + col) = o;
        }
    }
}

enum { M_CMP = 0, M_SEL = 1, M_WIN = 2 };
constexpr int KSTR = 72;
constexpr int NSA_KBUF = 0, NSA_VBUF = 49152;
constexpr int NSA_IMP = 98304;
constexpr int NSA_TBL = 132096;
constexpr int NSA_SEL = NSA_TBL + 4096;
constexpr int NSA_UNIT = NSA_SEL + 1024;

DEVI void attn_issue(char* kdst, char* vdst, const bf16_t* kt, const bf16_t* vt, int vstride, int tid) {
    const int row = tid >> 3, c = (tid & 7) ^ ((row >> 1) & 7);
    glds16(kt + row * 64 + c * 8, kdst + tid * 16);
    glds16(vt + (size_t)row * vstride + c * 8, vdst + tid * 16);
}

constexpr float NSA_THR = 8.f;
template <int MODE, int PASS>
DEVI void nsa_branch(char* smem, const bf16_t* kg, const bf16_t* vg, int vstride, int t_lo, int t_hi, int far_lo, int far_hi, const bf16x8 (&qf)[4], int tq,
                     float c31, const LAS float* tblg, const LAS unsigned* selrow, float& m_ref, bool& mset, float& lsum, float inv_l, f32x16 (&o)[2], LAS float* imp_row) {
    int tid = threadIdx.x; asm volatile("" : "+v"(tid));
    const int lane = tid & 63, l31 = lane & 31, h = lane >> 5, xs = (l31 >> 1) & 7;
    const int n = t_hi - t_lo + 1;
    f32x16 cneg;
    { const float cc = c31 - m_ref;
#pragma unroll
      for (int i = 0; i < 16; ++i) cneg[i] = cc; }
    float imp_carry = 0.f;
    const int nS = (n + 1) >> 1;
#define NSA_ISSUE_PAIR(js_) do { const int _sl = (js_) % 3; \
        _Pragma("unroll") for (int _sb = 0; _sb < 2; ++_sb) { int _t = t_lo + 2 * (js_) + _sb; _t = _t > t_hi ? t_hi : _t; \
            attn_issue(smem + NSA_KBUF + _sl * 16384 + _sb * 8192, smem + NSA_VBUF + _sl * 16384 + _sb * 8192, kg + (size_t)_t * 4096, vg + _t * 64, vstride, tid); } } while (0)
    NSA_ISSUE_PAIR(0);
    if (nS > 1) NSA_ISSUE_PAIR(1);
    for (int it = 0; it < n; ++it) {
        const int ti = t_lo + it, js = it >> 1, buf = (js % 3) * 2 + (it & 1);
        if ((it & 1) == 0) {
            if (js + 1 < nS) asm volatile("s_waitcnt vmcnt(4)" ::: "memory"); else asm volatile("s_waitcnt vmcnt(0)" ::: "memory");
            __builtin_amdgcn_s_barrier();
            asm volatile("" ::: "memory");
            if (js + 2 < nS) NSA_ISSUE_PAIR(js + 2);
        }
        bool selbit = true;
        if (MODE == M_SEL) { selbit = (selrow[ti >> 5] >> (ti & 31)) & 1u; if (!__any(selbit)) continue; }
        const char* Kc = smem + NSA_KBUF + buf * 8192; const char* Vc = smem + NSA_VBUF + buf * 8192;
        f32x16 s[2];
        __builtin_amdgcn_s_setprio(1);
        {
            const int off0 = (h ^ xs) << 4;
            s[0] = mfma32(*(const bf16x8*)(Kc + l31 * 128 + off0), qf[0], cneg);
            s[1] = mfma32(*(const bf16x8*)(Kc + (32 + l31) * 128 + off0), qf[0], cneg);
        }
#pragma unroll
        for (int ks = 1; ks < 4; ++ks) {
            const int off = ((2 * ks + h) ^ xs) << 4;
            s[0] = mfma32(*(const bf16x8*)(Kc + l31 * 128 + off), qf[ks], s[0]);
            s[1] = mfma32(*(const bf16x8*)(Kc + (32 + l31) * 128 + off), qf[ks], s[1]);
        }
        __builtin_amdgcn_s_setprio(0);
        const bool far = (ti >= far_lo) && (ti <= far_hi);
        {
        if (!far) {
            const int dbase = (MODE == M_CMP) ? (tq - 31 - 1024 * ti) : (tq - 64 * ti);
#pragma unroll
            for (int u = 0; u < 2; ++u)
#pragma unroll
                for (int i = 0; i < 16; ++i) {
                    const int kk = 32 * u + (i & 3) + 8 * (i >> 2) + 4 * h;
                    const int dist = dbase - ((MODE == M_CMP) ? 16 * kk : kk);
                    const int idx = (dist < -1 ? -1 : (dist > 191 ? 191 : dist)) + 64;
                    float v = s[u][i] + tblg[idx];
                    if (MODE == M_WIN) v = (dist < 512) ? v : -INFINITY;
                    if (MODE == M_SEL) v = selbit ? v : -INFINITY;
                    s[u][i] = v;
                    if ((i & 3) == 3) asm volatile("" ::: "memory");
                }
        }
        if (PASS != 2) {
            float mxa = max3f(s[0][0], s[0][1], s[0][2]), mxb = max3f(s[1][0], s[1][1], s[1][2]);
#pragma unroll
            for (int i = 3; i < 15; i += 2) { mxa = max3f(mxa, s[0][i], s[0][i + 1]); mxb = max3f(mxb, s[1][i], s[1][i + 1]); }
            float mx = max3f(mxa, mxb, s[0][15]); mx = max3f(mx, s[1][15], s[1][15]);
            if (MODE == M_SEL && !selbit) mx = -INFINITY;
            if (__any(mx > NSA_THR || (!mset && mx > -INFINITY))) {
                const float mc = fmaxf(mx, __shfl_xor(mx, 32));
                const bool mv = (mc > NSA_THR) || (!mset && mc > -INFINITY);
                const float delta = mv ? mc : 0.f;
                const float alpha = mset ? fexp2(-delta) : 1.f;
                mset = mset || mv;
                m_ref += delta;
                const float cc = c31 - m_ref;
#pragma unroll
                for (int i = 0; i < 16; ++i) cneg[i] = cc;
                lsum *= alpha;
#pragma unroll
                for (int u = 0; u < 2; ++u)
#pragma unroll
                    for (int i = 0; i < 16; ++i) s[u][i] -= delta;
                if (PASS == 0) {
#pragma unroll
                    for (int v = 0; v < 2; ++v)
#pragma unroll
                        for (int i = 0; i < 16; ++i) o[v][i] *= alpha;
                }
            }
        }
        float ps0 = 0.f, ps1 = 0.f, ps2 = 0.f, ps3 = 0.f;
#pragma unroll
        for (int u = 0; u < 2; ++u)
#pragma unroll
            for (int i = 0; i < 16; i += 4) {
                s[u][i] = fexp2(s[u][i]); s[u][i + 1] = fexp2(s[u][i + 1]); s[u][i + 2] = fexp2(s[u][i + 2]); s[u][i + 3] = fexp2(s[u][i + 3]);
                ps0 += s[u][i]; ps1 += s[u][i + 1]; ps2 += s[u][i + 2]; ps3 += s[u][i + 3];
            }
        { const float ps = (ps0 + ps1) + (ps2 + ps3); lsum += (MODE == M_SEL && far && !selbit) ? 0.f : ps; }
        if (PASS == 2) {
            float mainv[8], halfv[8];
#pragma unroll
            for (int u = 0; u < 2; ++u)
#pragma unroll
                for (int c4 = 0; c4 < 4; ++c4) {
                    float hv = 0.5f * s[u][4 * c4 + 3] * inv_l;
                    float mv = ((s[u][4 * c4] + s[u][4 * c4 + 1]) + s[u][4 * c4 + 2]) * inv_l + hv;
                    mv += __builtin_bit_cast(float, __builtin_amdgcn_update_dpp(0, __builtin_bit_cast(int, mv), 0xB1, 0xF, 0xF, true));
                    hv += __builtin_bit_cast(float, __builtin_amdgcn_update_dpp(0, __builtin_bit_cast(int, hv), 0xB1, 0xF, 0xF, true));
                    mv += __builtin_bit_cast(float, __builtin_amdgcn_update_dpp(0, __builtin_bit_cast(int, mv), 0x4E, 0xF, 0xF, true));
                    hv += __builtin_bit_cast(float, __builtin_amdgcn_update_dpp(0, __builtin_bit_cast(int, hv), 0x4E, 0xF, 0xF, true));
                    mainv[u * 4 + c4] = mv; halfv[u * 4 + c4] = __shfl_xor(hv, 32);
                }
#pragma unroll
            for (int gi = 0; gi < 8; ++gi) {
                const float cin = h ? halfv[gi] : (gi ? halfv[gi - 1] : imp_carry);
                const unsigned ia = (unsigned)(size_t)(imp_row + 16 * ti + 2 * gi + h);
                const float val = mainv[gi] + cin;
                asm volatile("ds_write_b32 %0, %1" :: "v"(ia), "v"(val) : "memory");
            }
            imp_carry = halfv[7];
        }
        const unsigned pmask = (MODE == M_SEL && far && !selbit) ? 0u : 0xFFFFFFFFu;
#pragma unroll
        for (int u = 0; u < 2; ++u)
#pragma unroll
            for (int sI = 0; sI < 2; ++sI) {
                u32x4 pk;
                pk.x = cvt_pk_bf16(s[u][8 * sI + 0], s[u][8 * sI + 1]); pk.y = cvt_pk_bf16(s[u][8 * sI + 2], s[u][8 * sI + 3]);
                pk.z = cvt_pk_bf16(s[u][8 * sI + 4], s[u][8 * sI + 5]); pk.w = cvt_pk_bf16(s[u][8 * sI + 6], s[u][8 * sI + 7]);
                if (MODE == M_SEL) { pk.x &= pmask; pk.y &= pmask; pk.z &= pmask; pk.w &= pmask; }
                const bf16x8 pf = __builtin_bit_cast(bf16x8, pk);
                if (PASS != 1) {
                    const int voff = ((2 * (2 * u + sI) + h) ^ xs) << 4;
                    o[0] = mfma32(*(const bf16x8*)(Vc + l31 * 128 + voff), pf, o[0]);
                    o[1] = mfma32(*(const bf16x8*)(Vc + (32 + l31) * 128 + voff), pf, o[1]);
                }
            }
        }
    }
    if (PASS == 2) {
        const int c = 16 * (t_hi + 1);
        if (h == 0 && c < 128) { const unsigned ia = (unsigned)(size_t)(imp_row + c); asm volatile("ds_write_b32 %0, %1" :: "v"(ia), "v"(imp_carry) : "memory"); }
        asm volatile("s_waitcnt lgkmcnt(0)" ::: "memory");
    }
#undef NSA_ISSUE_PAIR
    __syncthreads();
}

DEVI void phase_nsa(const Params& p, char* smem, int ctr_idx) {
    unsigned char* ws = p.ws;
    const int tid0 = threadIdx.x;
    float* imp = (float*)(smem + NSA_IMP);
    unsigned* tot = (unsigned*)(smem + NSA_IMP);
    float* tbl = (float*)(smem + NSA_TBL);
    unsigned* selm = (unsigned*)(smem + NSA_SEL);
    int* sunit = (int*)(smem + NSA_UNIT);
    unsigned* ctr = (unsigned*)(ws + WS_CTL) + CW_NSA + 256 * ctr_idx;
    unsigned* trc = (unsigned*)(ws + WS_CTL) + CW_TR;
    const bf16_t* Q = (const bf16_t*)(ws + WS_BUFB);
    const float* G = (const float*)(ws + WS_BUFC + C_GATES);
    bf16_t* CC = ctr_idx ? (bf16_t*)(p.out + 32 * 1024 * 1024) : (bf16_t*)(ws + WS_BUFA);
    for (;;) {
        int tid = tid0; asm volatile("" : "+v"(tid));
        const int lane = tid & 63, w = tid >> 6, l31 = lane & 31, h = lane >> 5;
        const int qi = l31 >> 2, g = l31 & 3, ql = 8 * w + qi;
        __syncthreads();
        if (tid == 0) {
            const unsigned x = xb_xcc_id() & 7u; int u = -1;
            for (unsigned k = 0; k < 8u && u < 0; ++k) { const unsigned xx = (x + k) & 7u; const unsigned i = atomicAdd(ctr + 16 * xx, 1u); if (i < 256u) u = (int)(i * 8u + xx); }
            *sunit = u;
        }
        __syncthreads();
        const int unit = *sunit;
        if (unit < 0) break;
        const int xq = unit & 7, iq = unit >> 3;
        const int qt = 127 - (iq >> 1), bh = 2 * xq + (iq & 1), b = bh >> 2, hkv = bh & 3, q0 = qt * 64, cur = qt;
        for (int i = tid; i < 4 * 256; i += 512) {
            const int gg = i >> 8, d = (i & 255) - 64;
            float val = -INFINITY;
            if (d >= 0) {
                int bucket;
                if (d < 16) bucket = d;
                else if (d >= 128) bucket = 31;
                else { const int lg = 16 + (int)(logf((float)d / 16.f) / 2.0794415416798357f * 16.f); bucket = lg < 31 ? lg : 31; }
                val = (p.in[11][bucket * 16 + hkv * 4 + gg] - p.in[11][31 * 16 + hkv * 4 + gg]) * LOG2E;
            }
            tbl[i] = val;
        }
        if (tid < 256) selm[tid] = 0u;
        const int tq = q0 + ql;
        const size_t trow = (size_t)b * 8192 + tq;
        bf16x8 qf[4];
        { const bf16_t* qrow = Q + trow * 1024 + hkv * 256 + g * 64;
#pragma unroll
          for (int ks = 0; ks < 4; ++ks) qf[ks] = *(const bf16x8*)(qrow + 16 * ks + 8 * h); }
        float c31 = p.in[11][31 * 16 + hkv * 4 + g] * LOG2E;
        asm volatile("" : "+v"(qf[0]), "+v"(qf[1]), "+v"(qf[2]), "+v"(qf[3]), "+v"(c31));
        const LAS float* tblg = (const LAS float*)(smem + NSA_TBL) + g * 256;
        const LAS unsigned* selrow = (const LAS unsigned*)(smem + NSA_SEL) + ql * 4;
        f32x16 o[2];
#pragma unroll
        for (int v = 0; v < 2; ++v)
#pragma unroll
            for (int i = 0; i < 16; ++i) o[v][i] = 0.f;
        __syncthreads();
        const bf16_t* kc = (const bf16_t*)(ws + WS_BUFC + C_KC) + (size_t)bh * 512 * 64;
        const bf16_t* vct = (const bf16_t*)(ws + WS_BUFC + C_VCT) + (size_t)bh * 64 * 512;
        const int ct_hi = (q0 + 32) >> 10, cfar_hi = (q0 >= 1167) ? ((q0 - 1167) >> 10) : -1;
        float m_ref = 0.f; bool mset = false;
        float lsum = 0.f;
        const int rmode = ctr_idx ? NSA_REP_MODE : 0;
        if (rmode != 2) nsa_branch<M_CMP, 1>(smem, kc, vct, 512, 0, ct_hi, 0, cfar_hi, qf, tq, c31, tblg, selrow, m_ref, mset, lsum, 0.f, o, (LAS float*)(smem + NSA_IMP) + ql * 132);
        { const float lt = lsum + __shfl_xor(lsum, 32); const float inv = lt > 0.f ? 1.f / lt : 0.f;
          if (rmode != 2 && rmode != 4) nsa_branch<M_CMP, 2>(smem, kc, vct, 512, 0, ct_hi, 0, cfar_hi, qf, tq, c31, tblg, selrow, m_ref, mset, lsum, inv, o, (LAS float*)(smem + NSA_IMP) + ql * 132);
#pragma unroll
          for (int v = 0; v < 2; ++v)
#pragma unroll
            for (int i = 0; i < 16; ++i) o[v][i] *= inv; }
        asm volatile("s_waitcnt lgkmcnt(0)" ::: "memory"); __syncthreads();
        if (rmode < 2) {
            const int q = tid >> 3, sub = tid & 7, t = q0 + q;
            unsigned key[16];
#pragma unroll
            for (int i = 0; i < 16; ++i) {
                const int j = sub * 16 + i;
                const bool forced = (j == 0) || (j == cur) || (j == cur - 1);
                const bool valid = (j * 64 <= t);
                const float v = imp[q * 132 + j];
                key[i] = forced ? 0xFFFFFFFFu : (valid ? (__float_as_uint(v) + 1u) : 0u);
            }
            unsigned tau = 0u;
            for (int bit = 31; bit >= 0; --bit) {
                const unsigned cand = tau | (1u << bit);
                int c = 0;
#pragma unroll
                for (int i = 0; i < 16; ++i) c += (key[i] >= cand) ? 1 : 0;
                c += __builtin_amdgcn_update_dpp(0, c, 0xB1, 0xF, 0xF, true); c += __builtin_amdgcn_update_dpp(0, c, 0x4E, 0xF, 0xF, true); c += __builtin_amdgcn_update_dpp(0, c, 0x141, 0xF, 0xF, true);
                if (c >= 16) tau = cand;
            }
            int gt = 0, eq = 0;
#pragma unroll
            for (int i = 0; i < 16; ++i) { gt += (key[i] > tau) ? 1 : 0; eq += (key[i] == tau) ? 1 : 0; }
            int gtt = gt; gtt += __builtin_amdgcn_update_dpp(0, gtt, 0xB1, 0xF, 0xF, true); gtt += __builtin_amdgcn_update_dpp(0, gtt, 0x4E, 0xF, 0xF, true); gtt += __builtin_amdgcn_update_dpp(0, gtt, 0x141, 0xF, 0xF, true);
            int pre = 0;
#pragma unroll
            for (int sI = 0; sI < 7; ++sI) { const int v = __shfl(eq, (lane & ~7) + sI); if (sI < sub) pre += v; }
            const int need = 16 - gtt;
            unsigned bits = 0u; int run = pre;
#pragma unroll
            for (int i = 0; i < 16; ++i) {
                bool sel = key[i] > tau;
                if (tau > 0u && key[i] == tau) { sel = run < need; ++run; }
                bits |= sel ? (1u << i) : 0u;
            }
            atomicOr(&selm[q * 4 + (sub >> 1)], bits << ((sub & 1) * 16));
        }
        __syncthreads();
        const float gc = G[((size_t)b * 8192 + tq) * 48 + hkv * 12 + g * 3 + 0];
#pragma unroll
        for (int v = 0; v < 2; ++v)
#pragma unroll
            for (int i = 0; i < 16; i += 2) { const float gcc = (PROBE == 1 ? 0.f : gc); tot[(v * 8 + (i >> 1)) * 512 + tid] = cvt_pk_bf16(gcc * o[v][i], gcc * o[v][i + 1]); o[v][i] = 0.f; o[v][i + 1] = 0.f; }
        {
            const bf16_t* ks = (const bf16_t*)(ws + WS_BUFC + C_KS) + (size_t)bh * 8192 * 64;
            const bf16_t* vst = (const bf16_t*)(ws + WS_BUFC + C_VST) + (size_t)bh * 64 * 8192;
            m_ref = 0.f; mset = false;
            lsum = 0.f;
            if (rmode == 0) nsa_branch<M_SEL, 0>(smem, ks, vst, 8192, 0, cur, 0, cur - 3, qf, tq, c31, tblg, selrow, m_ref, mset, lsum, 0.f, o, (LAS float*)nullptr);
            const float gs = G[((size_t)b * 8192 + tq) * 48 + hkv * 12 + g * 3 + 1];
            const float sc = (PROBE == 2 ? 0.f : gs) / (lsum + __shfl_xor(lsum, 32));
#pragma unroll
            for (int v = 0; v < 2; ++v)
#pragma unroll
                for (int i = 0; i < 16; i += 2) { const unsigned tv = tot[(v * 8 + (i >> 1)) * 512 + tid];
                    tot[(v * 8 + (i >> 1)) * 512 + tid] = cvt_pk_bf16(bf2f(tv & 0xffffu) + sc * o[v][i], bf2f(tv >> 16) + sc * o[v][i + 1]); o[v][i] = 0.f; o[v][i + 1] = 0.f; }
        }
        {
            const bf16_t* kw = (const bf16_t*)(ws + WS_BUFC + C_KW) + (size_t)bh * 8192 * 64;
            const bf16_t* vwt = (const bf16_t*)(ws + WS_BUFC + C_VWT) + (size_t)bh * 64 * 8192;
            m_ref = 0.f; mset = false;
            lsum = 0.f;
            const int w_lo = cur >= 8 ? cur - 8 : 0;
            if (rmode == 0 || rmode == 2) nsa_branch<M_WIN, 0>(smem, kw, vwt, 8192, w_lo, cur, cur - 7, cur - 3, qf, tq, c31, tblg, selrow, m_ref, mset, lsum, 0.f, o, (LAS float*)nullptr);
            const float gw = G[((size_t)b * 8192 + tq) * 48 + hkv * 12 + g * 3 + 2];
            const float sc = (PROBE == 3 ? 0.f : gw) / (lsum + __shfl_xor(lsum, 32));
            bf16_t* orow = CC + trow * 2048 + hkv * 256 + g * 64;
#pragma unroll
            for (int v = 0; v < 2; ++v)
#pragma unroll
                for (int c4 = 0; c4 < 4; ++c4) {
                    const unsigned ta = tot[(v * 8 + 2 * c4) * 512 + tid], tb = tot[(v * 8 + 2 * c4 + 1) * 512 + tid];
                    const float r0 = bf2f(ta & 0xffffu) + sc * o[v][4 * c4 + 0], r1 = bf2f(ta >> 16) + sc * o[v][4 * c4 + 1];
                    const float r2 = bf2f(tb & 0xffffu) + sc * o[v][4 * c4 + 2], r3 = bf2f(tb >> 16) + sc * o[v][4 * c4 + 3];
                    u32x2 ov; ov.x = cvt_pk_bf16(r0, r1); ov.y = cvt_pk_bf16(r2, r3);
                    *(u32x2*)(orow + 32 * v + 8 * c4 + 4 * h) = ov;
                }
        }
        if (ctr_idx == 0) {
            __syncthreads();
            for (int k = 0; k < 3; ++k) {
                int item = 0;
                if (lane == 0) item = (int)atomicAdd(trc, 1u);
                item = __builtin_amdgcn_readfirstlane(item);
                if (item >= MOE_W_ITEMS) break;
                moe_weight_item(p, smem, item);
            }
        }
    }
    if (ctr_idx == 0) {
        __syncthreads();
        for (;;) {
            int item = 0;
            if ((threadIdx.x & 63) == 0) item = (int)atomicAdd(trc, 1u);
            item = __builtin_amdgcn_readfirstlane(item);
            if (item >= MOE_W_ITEMS) break;
            moe_weight_item(p, smem, item);
        }
    }
}

template <int which>
DEVI void phase_ln(const Params& p) {
    unsigned char* ws = p.ws;
    int tid = threadIdx.x; asm volatile("" : "+v"(tid));
    const int lane = tid & 63, w = tid >> 6;
    for (int it = blockIdx.x; it < T_ / 8; it += gridDim.x) {
        const int t = it * 8 + w;
        float* row = p.out + (size_t)t * D_;
        f32x4 v[8]; row_load(row, lane, v);
        float mean, rstd; row_stats(v, mean, rstd);
        if (which == 0) {
            if (lane == 0) { float* st = (float*)(ws + WS_STATS); st[t * 2] = mean; st[t * 2 + 1] = rstd; }
            bf16_t* hi = (bf16_t*)(ws + WS_BUFB) + (size_t)t * D_;
#pragma unroll
            for (int c = 0; c < 8; ++c) {
                const int col = c * 256 + lane * 4;
                const f32x4 g = *(const f32x4*)(p.in[17] + col), b = *(const f32x4*)(p.in[18] + col);
                const f32x4 y = (v[c] - mean) * rstd * g + b;
                u32x2 o; o.x = cvt_pk_bf16(y.x, y.y); o.y = cvt_pk_bf16(y.z, y.w);
                *(u32x2*)(hi + col) = o;
            }
        } else if (which == 1) {
            bf16_t* hi = (bf16_t*)(ws + WS_BUFA) + (size_t)t * D_;
            bf16_t* lo = (bf16_t*)(ws + WS_BUFB) + (size_t)t * D_;
#pragma unroll
            for (int c = 0; c < 8; ++c) {
                const int col = c * 256 + lane * 4;
                const f32x4 g = *(const f32x4*)(p.in[24] + col), b = *(const f32x4*)(p.in[25] + col);
                const f32x4 y = (v[c] - mean) * rstd * g + b;
                u32x2 o; o.x = cvt_pk_bf16(y.x, y.y); o.y = cvt_pk_bf16(y.z, y.w);
                *(u32x2*)(hi + col) = o;
                u32x2 ol;
                ol.x = cvt_pk_bf16(y.x - bf2f(o.x & 0xffffu), y.y - bf2f(o.x >> 16));
                ol.y = cvt_pk_bf16(y.z - bf2f(o.y & 0xffffu), y.w - bf2f(o.y >> 16));
                *(u32x2*)(lo + col) = ol;
            }
        } else {
            const bf16_t* y0 = (const bf16_t*)(ws + WS_BUFC) + (size_t)t * 2 * D_;
#pragma unroll
            for (int c = 0; c < 8; ++c) {
                const int col = c * 256 + lane * 4;
                const f32x4 g = *(const f32x4*)(p.in[24] + col), b = *(const f32x4*)(p.in[25] + col);
                const f32x4 x2 = (v[c] - mean) * rstd * g + b;
                const u32x2 a = *(const u32x2*)(y0 + col), bq = *(const u32x2*)(y0 + D_ + col);
                v[c].x = x2.x * ALPHA + (bf2f(a.x & 0xffffu) + bf2f(bq.x & 0xffffu));
                v[c].y = x2.y * ALPHA + (bf2f(a.x >> 16) + bf2f(bq.x >> 16));
                v[c].z = x2.z * ALPHA + (bf2f(a.y & 0xffffu) + bf2f(bq.y & 0xffffu));
                v[c].w = x2.w * ALPHA + (bf2f(a.y >> 16) + bf2f(bq.y >> 16));
            }
            row_stats(v, mean, rstd);
#pragma unroll
            for (int c = 0; c < 8; ++c) {
                const int col = c * 256 + lane * 4;
                const f32x4 g = *(const f32x4*)(p.in[33] + col), b = *(const f32x4*)(p.in[34] + col);
                *(f32x4*)(row + col) = (v[c] - mean) * rstd * g + b;
            }
        }
    }
}

DEVI void phase_xattn(const Params& p, char* smem) {
    unsigned char* ws = p.ws;
    int tid = threadIdx.x; asm volatile("" : "+v"(tid));
    const int lane = tid & 63, w = tid >> 6, l31 = lane & 31, h = lane >> 5;
    const bf16_t* Qx = (const bf16_t*)(ws + WS_BUFC);
    const bf16_t* Kx = (const bf16_t*)(ws + WS_BUFD + 4 * MiB);
    const bf16_t* Vt = (const bf16_t*)(ws + WS_BUFD + 8 * MiB);
    bf16_t* Ox = (bf16_t*)(ws + WS_BUFA);
    bf16_t* Qs = (bf16_t*)smem;
    bf16_t* Ks = Qs + 256 * KSTR;
    bf16_t* Vs = (bf16_t*)smem;
    for (int unit = blockIdx.x; unit < 512; unit += gridDim.x) {
        const int qt = unit & 31, head = (unit >> 5) & 3, b = unit >> 7;
        const size_t t0 = (size_t)b * 8192 + qt * 256;
        const bf16_t* kbase = Kx + (size_t)(b * 4 + head) * 256 * 512;
        const bf16_t* vbase = Vt + (size_t)(b * 4 + head) * 512 * 256;
        f32x16 s[8];
#pragma unroll
        for (int u = 0; u < 8; ++u)
#pragma unroll
            for (int i = 0; i < 16; ++i) s[u][i] = 0.f;
        u32x4 pq[4], pk4[4];
#pragma unroll
        for (int i = 0; i < 4; ++i) { const int c = tid + 512 * i, row = c >> 3, ch = c & 7;
            pq[i] = *(const u32x4*)(Qx + (t0 + row) * 2048 + head * 512 + ch * 8); pk4[i] = *(const u32x4*)(kbase + (size_t)row * 512 + ch * 8); }
        for (int dc = 0; dc < 8; ++dc) {
            __syncthreads();
#pragma unroll
            for (int i = 0; i < 4; ++i) { const int c = tid + 512 * i, row = c >> 3, ch = c & 7;
                *(u32x4*)(Qs + row * KSTR + ch * 8) = pq[i]; *(u32x4*)(Ks + row * KSTR + ch * 8) = pk4[i]; }
            __syncthreads();
            if (dc + 1 < 8) {
#pragma unroll
                for (int i = 0; i < 4; ++i) { const int c = tid + 512 * i, row = c >> 3, ch = c & 7;
                    pq[i] = *(const u32x4*)(Qx + (t0 + row) * 2048 + head * 512 + (dc + 1) * 64 + ch * 8); pk4[i] = *(const u32x4*)(kbase + (size_t)row * 512 + (dc + 1) * 64 + ch * 8); }
            }
#pragma unroll
            for (int ks = 0; ks < 4; ++ks) {
                const bf16x8 qb = *(const bf16x8*)(Qs + (32 * w + l31) * KSTR + 16 * ks + 8 * h);
#pragma unroll
                for (int u = 0; u < 8; ++u) { const bf16x8 ka = *(const bf16x8*)(Ks + (32 * u + l31) * KSTR + 16 * ks + 8 * h); s[u] = mfma32(ka, qb, s[u]); }
            }
        }
        u32x4 pv[4];
#pragma unroll
        for (int i = 0; i < 4; ++i) { const int c = tid + 512 * i, row = c >> 5, ch = c & 31; pv[i] = *(const u32x4*)(vbase + (size_t)row * 256 + ch * 8); }
        float mx = -INFINITY;
#pragma unroll
        for (int u = 0; u < 8; ++u)
#pragma unroll
            for (int i = 0; i < 16; i += 2) mx = max3f(mx, s[u][i], s[u][i + 1]);
        mx = fmaxf(mx, __shfl_xor(mx, 32));
        float ls = 0.f;
        bf16x8 pf[8][2];
#pragma unroll
        for (int u = 0; u < 8; ++u) {
#pragma unroll
            for (int i = 0; i < 16; ++i) { s[u][i] = fexp2(s[u][i] - mx); ls += s[u][i]; }
#pragma unroll
            for (int sI = 0; sI < 2; ++sI) { u32x4 pk;
                pk.x = cvt_pk_bf16(s[u][8 * sI + 0], s[u][8 * sI + 1]); pk.y = cvt_pk_bf16(s[u][8 * sI + 2], s[u][8 * sI + 3]);
                pk.z = cvt_pk_bf16(s[u][8 * sI + 4], s[u][8 * sI + 5]); pk.w = cvt_pk_bf16(s[u][8 * sI + 6], s[u][8 * sI + 7]);
                pf[u][sI] = __builtin_bit_cast(bf16x8, pk); }
        }
        ls += __shfl_xor(ls, 32);
        const float inv = (PROBE == 4 ? 0.f : 1.f) / ls;
        bf16_t* orow = Ox + (t0 + 32 * w + l31) * 2048 + head * 512;
        for (int dc = 0; dc < 8; ++dc) {
            __syncthreads();
#pragma unroll
            for (int i = 0; i < 4; ++i) { const int c = tid + 512 * i, row = c >> 5, ch = c & 31; *(u32x4*)(Vs + row * 264 + ch * 8) = pv[i]; }
            __syncthreads();
            if (dc + 1 < 8) {
#pragma unroll
                for (int i = 0; i < 4; ++i) { const int c = tid + 512 * i, row = c >> 5, ch = c & 31; pv[i] = *(const u32x4*)(vbase + (size_t)((dc + 1) * 64 + row) * 256 + ch * 8); }
            }
            f32x16 o[2];
#pragma unroll
            for (int v = 0; v < 2; ++v)
#pragma unroll
                for (int i = 0; i < 16; ++i) o[v][i] = 0.f;
#pragma unroll
            for (int s4 = 0; s4 < 16; ++s4)
#pragma unroll
                for (int v = 0; v < 2; ++v) {
                    const bf16_t* vr = Vs + (32 * v + l31) * 264 + 16 * s4 + 4 * h;
                    const u32x2 a = *(const u32x2*)vr, bq = *(const u32x2*)(vr + 8);
                    u32x4 vv; vv.x = a.x; vv.y = a.y; vv.z = bq.x; vv.w = bq.y;
                    o[v] = mfma32(__builtin_bit_cast(bf16x8, vv), pf[s4 >> 1][s4 & 1], o[v]);
                }
#pragma unroll
            for (int v = 0; v < 2; ++v)
#pragma unroll
                for (int c4 = 0; c4 < 4; ++c4) {
                    u32x2 ov; ov.x = cvt_pk_bf16(o[v][4 * c4] * inv, o[v][4 * c4 + 1] * inv); ov.y = cvt_pk_bf16(o[v][4 * c4 + 2] * inv, o[v][4 * c4 + 3] * inv);
                    *(u32x2*)(orow + dc * 64 + 32 * v + 8 * c4 + 4 * h) = ov;
                }
        }
        __syncthreads();
    }
}

DEVI void phase_route(const Params& p) {
    unsigned char* ws = p.ws;
    const float* L = (const float*)(ws + WS_LOGITS);
    unsigned* cnt = (unsigned*)(ws + WS_CTL) + CW_CNT;
    int* list = (int*)(ws + WS_LIST);
    float* wt = (float*)(ws + WS_WTOK);
    int tid = threadIdx.x; asm volatile("" : "+v"(tid));
    for (int t = blockIdx.x * NTHREADS + tid; t < T_; t += gridDim.x * NTHREADS) {
        const f32x4 lgv = *(const f32x4*)(L + (size_t)t * 40);
        float lg[4] = {lgv.x + p.in[27][0], lgv.y + p.in[27][1], lgv.z + p.in[27][2], lgv.w + p.in[27][3]};
        int grp = 0; float best = lg[0];
#pragma unroll
        for (int i = 1; i < 4; ++i) if (lg[i] > best) { best = lg[i]; grp = i; }
        float se = 0.f;
#pragma unroll
        for (int i = 0; i < 4; ++i) se += expf(lg[i] - best);
        const float wgrp = 1.f / se;
        const f32x4 e0 = *(const f32x4*)(L + (size_t)t * 40 + 4 + grp * 8), e1 = *(const f32x4*)(L + (size_t)t * 40 + 8 + grp * 8);
        const f32x4 b0 = *(const f32x4*)(p.in[29] + grp * 8), b1 = *(const f32x4*)(p.in[29] + grp * 8 + 4);
        float le[8] = {e0.x + b0.x, e0.y + b0.y, e0.z + b0.z, e0.w + b0.w, e1.x + b1.x, e1.y + b1.y, e1.z + b1.z, e1.w + b1.w};
        int i0 = 0; float v0 = le[0];
#pragma unroll
        for (int i = 1; i < 8; ++i) if (le[i] > v0) { v0 = le[i]; i0 = i; }
        int i1 = -1; float v1 = -INFINITY;
#pragma unroll
        for (int i = 0; i < 8; ++i) if (i != i0 && le[i] > v1) { v1 = le[i]; i1 = i; }
        const float ex = expf(v1 - v0);
        const float w0 = wgrp / (1.f + ex), w1 = wgrp * ex / (1.f + ex);
        const int ea = grp * 8 + i0, eb = grp * 8 + i1;
        const unsigned pa = atomicAdd(cnt + ea, 1u); list[(size_t)ea * T_ + pa] = t * 2;
        const unsigned pb = atomicAdd(cnt + eb, 1u); list[(size_t)eb * T_ + pb] = t * 2 + 1;
        wt[t * 2] = w0; wt[t * 2 + 1] = w1;
    }
}

enum { PH_PREP = 0, PH_PROJ, PH_CMP1, PH_CMP2, PH_NSA, PH_OUT, PH_LN1, PH_WQ, PH_XATTN, PH_WO, PH_LN2, PH_ROUTER, PH_ROUTE, PH_MOE1, PH_MOE2, PH_LN3, PH_COUNT };

__global__ void __launch_bounds__(NTHREADS, 2) fwd_megakernel(Params p) {
    extern __shared__ __attribute__((aligned(16))) char smem[];
    cg::grid_group grid = cg::this_grid();
    volatile LAS unsigned* bar_st = (volatile LAS unsigned*)(smem + LDS_BYTES - 16);
    if (threadIdx.x < 2) bar_st[threadIdx.x] = 0u;
    __syncthreads();
    xcd_barrier_post((unsigned*)(p.ws + WS_CTL) + CW_BAR);
    const int lo = p.ph_lo, hi = p.ph_hi;
    unsigned long long ts0 = 0, ts1 = 0;
    if (TSTAMP_PHASE >= 0) ts0 = __builtin_amdgcn_s_memrealtime();
#ifndef PHMASK
#define PHMASK 0xFFFFFFFFu
#endif
#define IN(k) (lo <= (k) && (k) < hi && ((PHMASK >> (k)) & 1u))
#define SEAM(k) do { if (IN(k) && IN((k) + 1)) { if ((k) == 0) grid.sync(); else xcd_barrier((unsigned*)(p.ws + WS_CTL) + CW_BAR, (volatile LAS unsigned*)(smem + LDS_BYTES - 16)); } if ((k) == TSTAMP_PHASE) ts1 = __builtin_amdgcn_s_memrealtime(); } while (0)
    if (IN(PH_PREP)) for (int r = 0; r < REP_PREP; ++r) phase_prep(p, smem);
    SEAM(PH_PREP);
    if (IN(PH_PROJ)) { for (int r = 0; r < REP_PROJ; ++r) gemm_job<J_PROJ>(p, smem); for (int r = 0; r < REP_SMALL; ++r) gemm_job<J_MEMKV>(p, smem); }
    SEAM(PH_PROJ);
    if (IN(PH_CMP1)) { for (int r = 0; r < REP_SMALL; ++r) gemm_job<J_CMP1>(p, smem); for (int r = 0; r < REP_CONV; ++r) phase_conv(p); }
    SEAM(PH_CMP1);
    if (IN(PH_CMP2)) for (int r = 0; r < REP_SMALL; ++r) gemm_job<J_CMP2>(p, smem);
    SEAM(PH_CMP2);
    if (IN(PH_NSA)) { conv_finish(p); for (int r = 0; r < REP_NSA; ++r) phase_nsa(p, smem, r); }
    SEAM(PH_NSA);
    if (IN(PH_OUT)) for (int r = 0; r < REP_OUT; ++r) gemm_job<J_OUT>(p, smem);
    SEAM(PH_OUT);
    if (IN(PH_WQ)) { gemm_job<J_WQ>(p, smem); for (int r = 1; r < REP_WQ; ++r) gemm_job<J_WQ, WQ_VAR>(p, smem); }
    SEAM(PH_WQ);
    if (IN(PH_XATTN)) for (int r = 0; r < REP_XATTN; ++r) phase_xattn(p, smem);
    SEAM(PH_XATTN);
    if (IN(PH_WO)) gemm_job<J_WO>(p, smem);
    SEAM(PH_WO);
    if (IN(PH_LN2)) phase_ln<1>(p);
    SEAM(PH_LN2);
    if (IN(PH_ROUTER)) for (int r = 0; r < REP_SMALL; ++r) gemm_job<J_ROUTER>(p, smem);
    SEAM(PH_ROUTER);
    if (IN(PH_MOE1)) for (int r = 0; r < REP_MOE; ++r) gemm_job<J_MOE1>(p, smem);
    SEAM(PH_MOE1);
    if (IN(PH_MOE2)) for (int r = 0; r < REP_MOE; ++r) gemm_job<J_MOE2>(p, smem);
    SEAM(PH_MOE2);
    if (IN(PH_LN3)) phase_ln<2>(p);
    if (TSTAMP_PHASE >= 0 && blockIdx.x == 0 && threadIdx.x == 0) { const unsigned long long t2 = __builtin_amdgcn_s_memrealtime(); const unsigned long long wait = 4ull * (ts1 - ts0); while (__builtin_amdgcn_s_memrealtime() - t2 < wait) __builtin_amdgcn_s_sleep(32); }
#undef IN
#undef SEAM
}

#ifndef N_SPLIT
#define N_SPLIT 1
#endif

extern "C" void kernel_launch(void* const* d_in, const int* in_sizes, int n_in, void* d_out, int out_size, void* d_ws, size_t ws_size, hipStream_t stream) {
    static int grid_blocks = 0;
    if (grid_blocks == 0) {
        if (n_in != 35 || ws_size < WS_END || out_size != T_ * D_) { fprintf(stderr, "kernel_launch: unexpected sizes n_in %d ws %zu out %d\n", n_in, ws_size, out_size); grid_blocks = -1; return; }
        int dev = 0, cus = 0, per_cu = 0;
        hipGetDevice(&dev);
        hipDeviceGetAttribute(&cus, hipDeviceAttributeMultiprocessorCount, dev);
        hipFuncSetAttribute((const void*)fwd_megakernel, hipFuncAttributeMaxDynamicSharedMemorySize, LDS_BYTES);
        hipOccupancyMaxActiveBlocksPerMultiprocessor(&per_cu, (const void*)fwd_megakernel, NTHREADS, LDS_BYTES);
        if (per_cu < 1) { fprintf(stderr, "kernel_launch: occupancy query says %d blocks per CU\n", per_cu); grid_blocks = -1; return; }
        if (per_cu > 2) per_cu = 2;
        grid_blocks = cus * per_cu;
        fprintf(stderr, "kernel_launch: %d CUs x %d blocks\n", cus, per_cu);
    }
    if (grid_blocks < 0) return;
    hipMemsetAsync((char*)d_ws + WS_CTL, 0, 1 * MiB, stream);
    hipMemsetAsync((char*)d_ws + WS_RSUM1, 0, 1 * MiB, stream);
    Params p{};
    for (int i = 0; i < 35; ++i) p.in[i] = (const float*)d_in[i];
    p.out = (float*)d_out; p.ws = (unsigned char*)d_ws;
    if (N_SPLIT == 1) {
        p.ph_lo = 0; p.ph_hi = PH_COUNT;
        void* args[] = {&p};
        hipError_t e = hipLaunchCooperativeKernel((const void*)fwd_megakernel, dim3(grid_blocks), dim3(NTHREADS), args, LDS_BYTES, stream);
        if (e != hipSuccess) fprintf(stderr, "cooperative launch failed: %s (grid %d)\n", hipGetErrorString(e), grid_blocks);
    } else {
        for (int ph = 0; ph < PH_COUNT; ++ph) {
            p.ph_lo = ph; p.ph_hi = ph + 1;
            void* args[] = {&p};
            hipError_t e = hipLaunchCooperativeKernel((const void*)fwd_megakernel, dim3(grid_blocks), dim3(NTHREADS), args, LDS_BYTES, stream);
            if (e != hipSuccess) fprintf(stderr, "launch %d failed: %s\n", ph, hipGetErrorString(e));
        }
    }
}
```

```cpp
#include <hip/hip_runtime.h>
#include <hip/hip_cooperative_groups.h>
#include <cstdio>
#include <cstdint>
namespace cg = cooperative_groups;

#define DEVI __device__ __forceinline__
#ifndef REP_PREP
#define REP_PREP 1
#define REP_PROJ 1
#define REP_NSA 1
#define REP_WQ 1
#define WQ_VAR 3
#define REP_XATTN 1
#define REP_MOE 1
#define REP_LN3 1
#define REP_CONV 1
#define REP_OUT 1
#define REP_SMALL 1
#endif
#ifndef NSA_REP_MODE
#define NSA_REP_MODE 0
#endif
#ifndef TSTAMP_PHASE
#define TSTAMP_PHASE -1
#endif
#ifndef PROBE
#define PROBE 0
#endif
typedef unsigned short bf16_t;
typedef __attribute__((ext_vector_type(8))) short bf16x8;
typedef __attribute__((ext_vector_type(4))) float f32x4;
typedef __attribute__((ext_vector_type(16))) float f32x16;
typedef __attribute__((ext_vector_type(4))) unsigned u32x4;
typedef __attribute__((ext_vector_type(2))) unsigned u32x2;

constexpr int T_ = 32768, D_ = 2048, S_ = 8192, NB_ = 4;
constexpr int NPROJ = 4736;
constexpr int IN_COLS = 4656;
constexpr float ALPHA = 1.189207115002721f;
constexpr float LOG2E = 1.4426950408889634f;
constexpr float LN_EPS = 1e-5f;
constexpr int NTHREADS = 512;
constexpr int LDS_BYTES = 147968;

constexpr size_t MiB = 1ull << 20;
constexpr size_t WS_CTL = 0;
constexpr size_t WS_STATS = 1 * MiB;
constexpr size_t WS_C1BIAS = WS_STATS + 256 * 1024;
constexpr size_t WS_WTOK = WS_STATS + 512 * 1024;
constexpr size_t WS_LOGITS = 2 * MiB;
constexpr size_t WS_LIST = 7 * MiB;
constexpr size_t WS_WC1 = 11 * MiB;
constexpr size_t WS_WC2 = 13 * MiB;
constexpr size_t WS_WR = 14 * MiB;
constexpr size_t WS_WIN = 15 * MiB;
constexpr size_t WS_WOUT = 34 * MiB;
constexpr size_t WS_WQ = 42 * MiB;
constexpr size_t WS_WKV = 50 * MiB;
constexpr size_t WS_WO = 66 * MiB;
constexpr size_t WS_WGU = 74 * MiB;
constexpr size_t WS_WD = 202 * MiB;
constexpr size_t WS_BUFA = 266 * MiB;
constexpr size_t WS_BUFB = 394 * MiB;
constexpr size_t WS_BUFC = 522 * MiB;
constexpr size_t WS_BUFD = 650 * MiB;
constexpr size_t WS_BUFE = 778 * MiB;
constexpr size_t WS_END = 906 * MiB;
constexpr size_t C_KCMP = 0, C_VCMP = 16 * MiB, C_KS = 32 * MiB, C_VST = 48 * MiB, C_KW = 64 * MiB, C_VWT = 80 * MiB,
                 C_GATES = 96 * MiB, C_HID = 102 * MiB, C_KC = 110 * MiB, C_VCT = 111 * MiB;
constexpr int CW_CNT = 64;
constexpr int CW_NSA = 1024;
constexpr int CW_TR = 2048;
constexpr int CW_BAR = 4096;
constexpr size_t CTL_U1 = 65536, CTL_C1 = 73728;
constexpr size_t WS_RSUM1 = WS_LOGITS;

struct Params {
    const float* in[35];
    float* out;
    unsigned char* ws;
    int ph_lo, ph_hi;
};

DEVI unsigned cvt_pk_bf16(float lo, float hi) { unsigned r; asm("v_cvt_pk_bf16_f32 %0, %1, %2" : "=v"(r) : "v"(lo), "v"(hi)); return r; }
DEVI bf16_t f2bf(float x) { return (bf16_t)(cvt_pk_bf16(x, 0.f) & 0xffffu); }
DEVI float bf2f(unsigned b) { return __uint_as_float(b << 16); }
DEVI void glds16(const void* g, void* l) {
    __builtin_amdgcn_global_load_lds((const __attribute__((address_space(1))) void*)g, (__attribute__((address_space(3))) void*)l, 16, 0, 0);
}
DEVI f32x16 mfma32(bf16x8 a, bf16x8 b, f32x16 c) { return __builtin_amdgcn_mfma_f32_32x32x16_bf16(a, b, c, 0, 0, 0); }
DEVI f32x4 mfma16(bf16x8 a, bf16x8 b, f32x4 c) { return __builtin_amdgcn_mfma_f32_16x16x32_bf16(a, b, c, 0, 0, 0); }
DEVI float fexp2(float x) { return __builtin_amdgcn_exp2f(x); }
DEVI float max3f(float a, float b, float c) { float r; asm("v_max3_f32 %0, %1, %2, %3" : "=v"(r) : "v"(a), "v"(b), "v"(c)); return r; }
DEVI float wave_sum(float v) {
#pragma unroll
    for (int o = 1; o < 64; o <<= 1) v += __shfl_xor(v, o);
    return v;
}
DEVI float sigmoidf_(float x) { return 1.f / (1.f + __expf(-x)); }
DEVI float gelu_tanh(float x) {
    const float u = 0.7978845608028654f * (x + 0.044715f * x * x * x);
    const float e = __expf(2.f * u);
    const float th = 1.f - 2.f / (e + 1.f);
    return 0.5f * x * (1.f + th);
}

#define LAS __attribute__((address_space(3)))
#define XB_TMO      128
#define XB_XCNT(j)  (256  + 64 * (j))
#define XB_XSUB(j)  (1280 + 64 * (j))
#define XB_XGEN(j)  (2304 + 64 * (j))
#define XB_TOP      3328
#define XB_TOPGEN   3392
#define XB_SPIN_CAP (1u << 22)
DEVI unsigned xb_ld(unsigned* p) { return __hip_atomic_load(p, __ATOMIC_RELAXED, __HIP_MEMORY_SCOPE_AGENT); }
DEVI unsigned xb_add(unsigned* p, unsigned v) { return __hip_atomic_fetch_add(p, v, __ATOMIC_RELAXED, __HIP_MEMORY_SCOPE_AGENT); }
DEVI unsigned xb_xcc_id() { return (unsigned)__builtin_amdgcn_s_getreg((3 << 11) | 20) & 0xFu; }
#define XB_SPIN(cond, bar) do { unsigned _sp = 0; while (cond) { __builtin_amdgcn_s_sleep(1); \
    if ((++_sp & 255u) == 0u) { if (xb_ld(&(bar)[XB_TMO])) break; if (_sp > XB_SPIN_CAP) { atomicAdd(&(bar)[XB_TMO], 1u); break; } } } } while (0)
DEVI void xcd_barrier_post(unsigned* bar) {
    if (threadIdx.x == 0) (void)xb_add(&bar[XB_XCNT(xb_xcc_id())], 1u);
}
DEVI void xcd_barrier_complete(unsigned* bar, unsigned x, unsigned& nloc, unsigned& nx) {
    const unsigned G = gridDim.x * gridDim.y * gridDim.z;
    unsigned sum, cnt, mine, sp = 0u;
    for (;;) {
        sum = 0u; cnt = 0u; mine = 0u;
#pragma unroll
        for (unsigned j = 0; j < 16; ++j) { const unsigned c = xb_ld(&bar[XB_XCNT(j)]); sum += c; cnt += (c > 0u) ? 1u : 0u; mine = (j == x) ? c : mine; }
        if (sum == G) break;
        __builtin_amdgcn_s_sleep(1);
        if ((++sp & 255u) == 0u) { if (xb_ld(&bar[XB_TMO])) break; if (sp > XB_SPIN_CAP) { atomicAdd(&bar[XB_TMO], 1u); break; } }
    }
    nloc = mine > 0u ? mine : 1u; nx = cnt > 0u ? cnt : 1u;
}
DEVI void xcd_barrier(unsigned* bar, volatile LAS unsigned* st) {
    asm volatile("s_waitcnt vmcnt(0)" ::: "memory");
    __syncthreads();
    if (threadIdx.x == 0) {
        const unsigned x = xb_xcc_id();
        __builtin_amdgcn_s_waitcnt(0);
        unsigned nloc = st[0], nx = st[1];
        if (nloc == 0u) { xcd_barrier_complete(bar, x, nloc, nx); st[0] = nloc; st[1] = nx; }
        const unsigned old = xb_add(&bar[XB_XSUB(x)], 1u);
        const unsigned gen = old / nloc;
        if (old + 1u == (gen + 1u) * nloc) {
            __builtin_amdgcn_fence(__ATOMIC_RELEASE, "agent");
            asm volatile("s_waitcnt vmcnt(0)" ::: "memory");
            const unsigned og = xb_add(&bar[XB_TOP], 1u);
            const unsigned tg = og / nx;
            if (og + 1u == (tg + 1u) * nx) xb_add(&bar[XB_TOPGEN], 1u);
            else XB_SPIN(xb_ld(&bar[XB_TOPGEN]) == tg, bar);
            __builtin_amdgcn_fence(__ATOMIC_ACQUIRE, "agent");
            xb_add(&bar[XB_XGEN(x)], 1u);
            asm volatile("s_waitcnt vmcnt(0)" ::: "memory");
        } else {
            XB_SPIN(xb_ld(&bar[XB_XGEN(x)]) == gen, bar);
            __builtin_amdgcn_fence(__ATOMIC_ACQUIRE, "agent");
            asm volatile("s_waitcnt vmcnt(0)" ::: "memory");
        }
    }
    __syncthreads();
}

DEVI void row_load(const float* row, int lane, f32x4 (&v)[8]) {
#pragma unroll
    for (int c = 0; c < 8; ++c) v[c] = *(const f32x4*)(row + c * 256 + lane * 4);
}
DEVI void row_stats(const f32x4 (&v)[8], float& mean, float& rstd) {
    float s = 0.f;
#pragma unroll
    for (int c = 0; c < 8; ++c) s += (v[c].x + v[c].y) + (v[c].z + v[c].w);
    mean = wave_sum(s) * (1.f / D_);
    float q = 0.f;
#pragma unroll
    for (int c = 0; c < 8; ++c) { const f32x4 d = v[c] - mean; q += (d.x * d.x + d.y * d.y) + (d.z * d.z + d.w * d.w); }
    rstd = 1.f / sqrtf(wave_sum(q) * (1.f / D_) + LN_EPS);
}

DEVI const float* wsrc_col(const Params& p, int mat, int e, int n, int& ld) {
    switch (mat) {
    case 0: {
        ld = IN_COLS;
        if (n < 2560) return p.in[4] + n;
        if (n < 2688) { const int j = n - 2560; return j < 48 ? p.in[4] + 2560 + j : nullptr; }
        const int r = n - 2688, grp = r >> 6, within = r & 63;
        const int ch = grp * 32 + (within & 31), isg = within >> 5;
        return p.in[4] + 2608 + isg * 1024 + ch;
    }
    case 1: ld = 256; return p.in[6] + n;
    case 2: ld = 256; return p.in[9] + n;
    case 3: ld = 64; return n < 64 ? p.in[7] + n : nullptr;
    case 4: ld = 64; return n < 64 ? p.in[10] + n : nullptr;
    case 5: ld = 2048; return p.in[16] + n;
    case 6: ld = 2048; return p.in[21] + n;
    case 7: ld = 4096; return p.in[22] + n;
    case 8: ld = 2048; return p.in[23] + n;
    case 9: if (n < 4) { ld = 4; return p.in[26] + n; } if (n < 36) { ld = 32; return p.in[28] + (n - 4); } ld = 1; return nullptr;
    case 10: { ld = 512; const int grp = n >> 6, within = n & 63; const int ch = grp * 32 + (within & 31);
               return ((within >> 5) ? p.in[31] : p.in[30]) + (size_t)e * 2048 * 512 + ch; }
    default: ld = 2048; return p.in[32] + (size_t)e * 512 * 2048 + n;
    }
}
DEVI void wave_transpose_item(const Params& p, char* smem, int mat, int e, int ntile, int ktile, bf16_t* dst, bf16_t* dst_lo, int K,
                                const float* gvec = nullptr, const float* bvec = nullptr, float* U = nullptr, float* C = nullptr) {
    int tid = threadIdx.x; asm volatile("" : "+v"(tid));
    const int lane = tid & 63, w = tid >> 6;
    float* tile = (float*)smem + w * (64 * 65 + 32);
    const int k0 = ktile * 64;
    if (mat == 9) {
        int ld; const float* src = wsrc_col(p, mat, e, ntile * 64 + lane, ld);
#pragma unroll 8
        for (int k = 0; k < 64; ++k) tile[k * 65 + lane] = src ? src[(size_t)(k0 + k) * ld] : 0.f;
    } else {
        const int c4 = lane & 15, kr = lane >> 4;
        int ld; const float* src = wsrc_col(p, mat, e, ntile * 64 + c4 * 4, ld);
        f32x4 v[16];
#pragma unroll
        for (int i = 0; i < 16; ++i) v[i] = src ? *(const f32x4*)(src + (size_t)(k0 + kr + 4 * i) * ld) : (f32x4){0.f, 0.f, 0.f, 0.f};
#pragma unroll
        for (int i = 0; i < 16; ++i) { float* q = tile + (kr + 4 * i) * 65 + c4 * 4; q[0] = v[i].x; q[1] = v[i].y; q[2] = v[i].z; q[3] = v[i].w; }
    }
    asm volatile("s_waitcnt lgkmcnt(0)" ::: "memory");
    if (gvec) {
        float us = 0.f, cs = 0.f;
#pragma unroll 8
        for (int k = 0; k < 64; ++k) { const float wkn = tile[k * 65 + lane]; us += gvec[k0 + k] * wkn; cs += bvec[k0 + k] * wkn; }
        atomicAdd(U + ntile * 64 + lane, us); atomicAdd(C + ntile * 64 + lane, cs);
    }
    const int kc = lane & 7, nr = lane >> 3;
#pragma unroll
    for (int c = 0; c < 8; ++c) {
        const int n = nr + 8 * c;
        float wv[8];
#pragma unroll
        for (int j = 0; j < 8; ++j) wv[j] = tile[(kc * 8 + j) * 65 + n];
        if (gvec) {
#pragma unroll
            for (int j = 0; j < 8; ++j) wv[j] *= gvec[k0 + kc * 8 + j]; }
        u32x4 o; o.x = cvt_pk_bf16(wv[0], wv[1]); o.y = cvt_pk_bf16(wv[2], wv[3]); o.z = cvt_pk_bf16(wv[4], wv[5]); o.w = cvt_pk_bf16(wv[6], wv[7]);
        const size_t off = (size_t)(ntile * 64 + n) * K + k0 + kc * 8;
        if (!dst_lo) *(u32x4*)(dst + off) = o;
        else {
            float r[8];
#pragma unroll
            for (int j = 0; j < 8; ++j) r[j] = wv[j] - bf2f((unsigned)f2bf(wv[j]));
            u32x4 l; l.x = cvt_pk_bf16(r[0], r[1]); l.y = cvt_pk_bf16(r[2], r[3]); l.z = cvt_pk_bf16(r[4], r[5]); l.w = cvt_pk_bf16(r[6], r[7]);
            const size_t o0 = (size_t)n * K + k0 + kc * 8, o1 = (size_t)(64 + n) * K + k0 + kc * 8;
            if (ntile == 0) { *(u32x4*)(dst + o0) = o; *(u32x4*)(dst_lo + o0) = o; *(u32x4*)(dst + o1) = l; }
            else *(u32x4*)(dst_lo + o1) = (u32x4){0u, 0u, 0u, 0u};
        }
    }
    asm volatile("s_waitcnt lgkmcnt(0)" ::: "memory");
}

DEVI void phase_prep(const Params& p, char* smem) {
    int tid = threadIdx.x; asm volatile("" : "+v"(tid));
    const int lane = tid & 63, w = tid >> 6;
    unsigned char* ws = p.ws;
    for (int r = blockIdx.x; r < 8; r += gridDim.x) {
        const int type = r >> 2, n = (r & 3) * 64 + lane;
        const float* pe = p.in[type ? 8 : 5]; const float* w1 = p.in[type ? 9 : 6];
        float sacc = 0.f;
        for (int k = w * 256; k < (w + 1) * 256; ++k) sacc += pe[k] * w1[(size_t)k * 256 + n];
        float* red = (float*)smem;
        __syncthreads();
        red[w * 64 + lane] = sacc;
        __syncthreads();
        if (w == 0) ((float*)(ws + WS_C1BIAS))[type * 256 + n] = ((red[lane] + red[64 + lane]) + (red[128 + lane] + red[192 + lane])) + ((red[256 + lane] + red[320 + lane]) + (red[384 + lane] + red[448 + lane]));
        __syncthreads();
    }
    constexpr int I_LN = T_, I_MEM = 1024;
    constexpr int I_M0 = 74 * 32, I_M12 = 4 * 32, I_M34 = 2 * 4, I_SQ = 32 * 32, I_KV = 64 * 32, I_R = 2 * 32;
    constexpr int TOTAL = I_LN + I_MEM + I_M0 + 2 * I_M12 + 2 * I_M34 + 3 * I_SQ + I_KV + I_R;
    const int gw = blockIdx.x * 8 + w, NW = gridDim.x * 8;
    for (int it = gw; it < TOTAL; it += NW) {
        int r = it;
        if (r < I_LN) {
            const int t = r;
            f32x4 v[8]; row_load(p.in[0] + (size_t)t * D_, lane, v);
            float mean, rstd; row_stats(v, mean, rstd);
            bf16_t* hb = (bf16_t*)(ws + WS_BUFA) + (size_t)t * D_;
#pragma unroll
            for (int c = 0; c < 8; ++c) {
                const int col = c * 256 + lane * 4;
                const f32x4 g = *(const f32x4*)(p.in[2] + col), b = *(const f32x4*)(p.in[3] + col);
                const f32x4 y = (v[c] - mean) * rstd * g + b;
                u32x2 o; o.x = cvt_pk_bf16(y.x, y.y); o.y = cvt_pk_bf16(y.z, y.w);
                *(u32x2*)(hb + col) = o;
            }
            if (lane == 0) { float* st = (float*)(ws + WS_STATS); st[t * 2] = mean; st[t * 2 + 1] = rstd; }
            continue;
        }
        r -= I_LN;
        if (r < I_MEM) {
            const int t = r;
            f32x4 v[8]; row_load(p.in[1] + (size_t)t * D_, lane, v);
            float mean, rstd; row_stats(v, mean, rstd);
            bf16_t* hb = (bf16_t*)(ws + WS_BUFD) + (size_t)t * D_;
#pragma unroll
            for (int c = 0; c < 8; ++c) {
                const int col = c * 256 + lane * 4;
                const f32x4 g = *(const f32x4*)(p.in[19] + col), b = *(const f32x4*)(p.in[20] + col);
                const f32x4 y = (v[c] - mean) * rstd * g + b;
                u32x2 o; o.x = cvt_pk_bf16(y.x, y.y); o.y = cvt_pk_bf16(y.z, y.w);
                *(u32x2*)(hb + col) = o;
            }
            continue;
        }
        r -= I_MEM;
        if (r < I_M0) { wave_transpose_item(p, smem, 0, 0, r / 32, r % 32, (bf16_t*)(ws + WS_WIN), nullptr, 2048); continue; } r -= I_M0;
        if (r < I_M12) { wave_transpose_item(p, smem, 1, 0, r / 32, r % 32, (bf16_t*)(ws + WS_WC1), nullptr, 2048); continue; } r -= I_M12;
        if (r < I_M12) { wave_transpose_item(p, smem, 2, 0, r / 32, r % 32, (bf16_t*)(ws + WS_WC1) + 256 * 2048, nullptr, 2048); continue; } r -= I_M12;
        if (r < I_M34) { wave_transpose_item(p, smem, 3, 0, r / 4, r % 4, (bf16_t*)(ws + WS_WC2), nullptr, 256); continue; } r -= I_M34;
        if (r < I_M34) { wave_transpose_item(p, smem, 4, 0, r / 4, r % 4, (bf16_t*)(ws + WS_WC2) + 128 * 256, nullptr, 256); continue; } r -= I_M34;
        if (r < I_SQ) { wave_transpose_item(p, smem, 5, 0, r / 32, r % 32, (bf16_t*)(ws + WS_WOUT), nullptr, 2048); continue; } r -= I_SQ;
        if (r < I_SQ) { wave_transpose_item(p, smem, 6, 0, r / 32, r % 32, (bf16_t*)(ws + WS_WQ), nullptr, 2048, p.in[17], p.in[18], (float*)(ws + WS_CTL + CTL_U1), (float*)(ws + WS_CTL + CTL_C1)); continue; } r -= I_SQ;
        if (r < I_KV) { wave_transpose_item(p, smem, 7, 0, r / 32, r % 32, (bf16_t*)(ws + WS_WKV), nullptr, 2048); continue; } r -= I_KV;
        if (r < I_SQ) { wave_transpose_item(p, smem, 8, 0, r / 32, r % 32, (bf16_t*)(ws + WS_WO), nullptr, 2048); continue; } r -= I_SQ;
        wave_transpose_item(p, smem, 9, 0, r / 32, r % 32, (bf16_t*)(ws + WS_WR), (bf16_t*)(ws + WS_WR) + 128 * 2048, 2048);
    }
    __syncthreads();
}

constexpr int MOE_W_ITEMS = 32 * 16 * 32 + 32 * 32 * 8;
DEVI void moe_weight_item(const Params& p, char* smem, int r) {
    unsigned char* ws = p.ws;
    if (r < 32 * 16 * 32) { const int e = r / 512, q = r % 512; wave_transpose_item(p, smem, 10, e, q / 32, q % 32, (bf16_t*)(ws + WS_WGU) + (size_t)e * 1024 * 2048, nullptr, 2048); }
    else { r -= 32 * 16 * 32; const int e = r / 256, q = r % 256; wave_transpose_item(p, smem, 11, e, q / 8, q % 8, (bf16_t*)(ws + WS_WD) + (size_t)e * 2048 * 512, nullptr, 512); }
}

enum { J_PROJ = 0, J_MEMKV, J_CMP1, J_CMP2, J_OUT, J_WQ, J_WO, J_ROUTER, J_MOE1, J_MOE2 };
constexpr int GEMM_STAGE_BYTES = 49152;
constexpr int GEMM_TP = 3 * GEMM_STAGE_BYTES;

template <int job, int VAR = 0>
DEVI void gemm_job(const Params& p, char* smem) {
    unsigned char* ws = p.ws;
    int tid = threadIdx.x; asm volatile("" : "+v"(tid));
    const int lane = tid & 63, w = tid >> 6, wr = w >> 1, wc = w & 1, fr = lane & 15, fq = lane >> 4;
    const int srow = tid >> 3, schunk = (tid & 7) ^ ((tid >> 4) & 7);
    int* tp = (int*)(smem + GEMM_TP);
    int MT = 0, NT = 0, K = 2048, nseg = 1, ntiles = 0, RT = 0;
    switch (job) {
    case J_PROJ: MT = 128; NT = 37; break;
    case J_MEMKV: MT = 4; NT = 32; break;
    case J_CMP1: MT = 64; NT = 2; break;
    case J_CMP2: MT = 64; NT = 1; K = 256; break;
    case J_OUT: case J_WQ: case J_WO: MT = 128; NT = 16; break;
    case J_ROUTER: MT = 128; NT = 1; nseg = 2; break;
    default: break;
    }
    const unsigned* cntw = (const unsigned*)(ws + WS_CTL) + CW_CNT;
    if (job == J_MOE1 || job == J_MOE2) {
        __syncthreads();
        if (tid == 0) { int acc = 0; for (int e = 0; e < 32; ++e) { tp[e] = acc; const int c = (int)__hip_atomic_load(cntw + e, __ATOMIC_RELAXED, __HIP_MEMORY_SCOPE_AGENT); tp[33 + e] = c; acc += (c + 255) >> 8; } tp[32] = acc; }
        __syncthreads();
        RT = tp[32];
        NT = (job == J_MOE1) ? 8 : 16; K = (job == J_MOE1) ? 2048 : 512;
        { int mx = 0;
#pragma unroll
          for (int x = 0; x < 8; ++x) { int t = 0;
#pragma unroll
              for (int k = 0; k < 4; ++k) t += (tp[33 + x + 8 * k] + 255) >> 8;
              mx = t > mx ? t : mx; }
          ntiles = mx * NT * 8; }
    } else {
        const int nsr = (MT + 7) >> 3;
        ntiles = (MT < 64) ? MT * NT : ((nsr + 7) >> 3) * 8 * NT * 8;
    }
    int my_tp = 0, my_cnt = 0;
    if (job == J_MOE1 || job == J_MOE2) { my_tp = tp[lane & 31]; my_cnt = tp[33 + (lane & 31)]; }
    const int nk = K >> 6, ntot = nseg * nk;

    for (int ti = blockIdx.x; ti < ntiles; ti += gridDim.x) {
        int mt, nt, e = 0, rt = 0, ecnt = 0, etp = 0;
        if (job == J_MOE1 || job == J_MOE2) {
            const int x = ti & 7; int jj = ti >> 3; bool found = false; mt = 0; nt = 0;
#pragma unroll
            for (int k = 0; k < 4; ++k) {
                const int ee = x + 8 * k;
                const int c = __shfl(my_cnt, ee), rtc = (c + 255) >> 8, tot = rtc * NT;
                if (!found) { if (jj < tot) { found = true; e = ee; ecnt = c; etp = __shfl(my_tp, ee); const int per = 4 * rtc, ng = jj / per, r2 = jj - ng * per; nt = ng * 4 + r2 / rtc; rt = r2 - (r2 / rtc) * rtc; } else jj -= tot; }
            }
            if (!found) continue;
        } else {
            if (MT < 64) { nt = ti / MT; mt = ti - nt * MT; }
            else {
                const int x = ti & 7, jj = ti >> 3, per = 8 * NT, srl = jj / per, idx = jj - srl * per;
                mt = (srl * 8 + x) * 8 + (idx & 7); nt = idx >> 3;
                if (mt >= MT) continue;
            }
        }
        const bf16_t* ap[4]; const bf16_t* bp[2];
#pragma unroll
        for (int r = 0; r < 4; ++r) {
            const int row = r * 64 + srow;
            const bf16_t* a;
            switch (job) {
            case J_PROJ: a = (const bf16_t*)(ws + WS_BUFA) + (size_t)(mt * 256 + row) * 2048; break;
            case J_MEMKV: a = (const bf16_t*)(ws + WS_BUFD) + (size_t)(mt * 256 + row) * 2048; break;
            case J_CMP1: { const int gi = mt >> 1, i = (mt & 1) * 256 + row, ic = i < 510 ? i : 510; const int type = gi >> 4, bh = gi & 15;
                a = (const bf16_t*)(ws + WS_BUFC + (type ? C_VCMP : C_KCMP)) + ((size_t)bh * 8192 + 16 * ic) * 64; break; }
            case J_CMP2: a = (const bf16_t*)(ws + WS_BUFC + C_HID) + (size_t)(mt * 256 + row) * 256; break;
            case J_OUT: a = (const bf16_t*)(ws + WS_BUFE) + (size_t)(mt * 256 + row) * 2048; break;
            case J_WQ: a = (const bf16_t*)(ws + WS_BUFB) + (size_t)(mt * 256 + row) * 2048; break;
            case J_WO: a = (const bf16_t*)(ws + WS_BUFA) + (size_t)(mt * 256 + row) * 2048; break;
            case J_ROUTER: a = (const bf16_t*)(ws + WS_BUFA) + (size_t)(mt * 256 + row) * 2048; break;
            case J_MOE1: { int pos = rt * 256 + row; if (pos >= ecnt) pos = 0; const int aid = ((const int*)(ws + WS_LIST))[(size_t)e * T_ + pos];
                a = (const bf16_t*)(ws + WS_BUFA) + (size_t)(aid >> 1) * 2048; break; }
            default: a = (const bf16_t*)(ws + WS_BUFB) + (size_t)((etp + rt) * 256 + row) * 512; break;
            }
            ap[r] = a + schunk * 8;
        }
#pragma unroll
        for (int r = 0; r < 2; ++r) {
            const int row = r * 64 + srow;
            const bf16_t* b;
            switch (job) {
            case J_PROJ: b = (const bf16_t*)(ws + WS_WIN) + (size_t)(nt * 128 + row) * 2048; break;
            case J_MEMKV: b = (const bf16_t*)(ws + WS_WKV) + (size_t)(nt * 128 + row) * 2048; break;
            case J_CMP1: b = (const bf16_t*)(ws + WS_WC1) + (size_t)(mt >> 5) * 256 * 2048 + (size_t)(nt * 128 + row) * 2048; break;
            case J_CMP2: b = (const bf16_t*)(ws + WS_WC2) + (size_t)(mt >> 5) * 128 * 256 + (size_t)row * 256; break;
            case J_OUT: b = (const bf16_t*)(ws + WS_WOUT) + (size_t)(nt * 128 + row) * 2048; break;
            case J_WQ: b = (const bf16_t*)(ws + WS_WQ) + (size_t)(nt * 128 + row) * 2048; break;
            case J_WO: b = (const bf16_t*)(ws + WS_WO) + (size_t)(nt * 128 + row) * 2048; break;
            case J_ROUTER: b = (const bf16_t*)(ws + WS_WR) + (size_t)row * 2048; break;
            case J_MOE1: b = (const bf16_t*)(ws + WS_WGU) + (size_t)e * 1024 * 2048 + (size_t)(nt * 128 + row) * 2048; break;
            default: b = (const bf16_t*)(ws + WS_WD) + (size_t)e * 2048 * 512 + (size_t)(nt * 128 + row) * 512; break;
            }
            bp[r] = b + schunk * 8;
        }
        const long a_seg1 = (long)(WS_BUFB - WS_BUFA) / 2;
        const long b_seg2 = 128 * 2048;

        f32x4 acc[4][4];
#pragma unroll
        for (int i = 0; i < 4; ++i)
#pragma unroll
            for (int j = 0; j < 4; ++j) acc[i][j] = (f32x4){0.f, 0.f, 0.f, 0.f};

#define GEMM_STAGE(kt_) do { const int _kt = (kt_); int _seg = 0, _k0 = _kt << 6; if (nseg > 1) { _seg = _kt / nk; _k0 = (_kt - _seg * nk) << 6; } \
            const long _ao = (_seg == 1) ? a_seg1 : 0, _bo = (_seg == 1) ? b_seg2 : 0; \
            char* _A = smem + (_kt % 3) * GEMM_STAGE_BYTES; char* _B = _A + 32768; \
            _Pragma("unroll") for (int r = 0; r < 4; ++r) glds16(ap[r] + _ao + _k0, _A + (r * 512 + tid) * 16); \
            _Pragma("unroll") for (int r = 0; r < 2; ++r) glds16(bp[r] + _bo + _k0, _B + (r * 512 + tid) * 16); } while (0)

        u32x2 preb[16];
        if (job == J_OUT || job == J_WO) {
            const bf16_t* src = (const bf16_t*)(ws + (job == J_OUT ? WS_BUFA : WS_BUFB));
#pragma unroll
            for (int i = 0; i < 16; ++i) preb[i] = *(const u32x2*)(src + (size_t)(mt * 256 + (tid >> 5) + 16 * i) * D_ + nt * 128 + (tid & 31) * 4);
        }
        GEMM_STAGE(0);
        if (ntot > 1) GEMM_STAGE(1);
        for (int kt = 0; kt < ntot; ++kt) {
            if (kt + 1 < ntot) asm volatile("s_waitcnt vmcnt(6)" ::: "memory"); else asm volatile("s_waitcnt vmcnt(0)" ::: "memory");
            __builtin_amdgcn_s_barrier();
            asm volatile("" ::: "memory");
            if (kt + 2 < ntot && VAR != 1) GEMM_STAGE(kt + 2);
            if (VAR == 2) continue;
            const char* A = smem + (kt % 3) * GEMM_STAGE_BYTES; const char* B = A + 32768;
#pragma unroll
            for (int ks = 0; ks < 2; ++ks) {
                bf16x8 af[4], bfr[4];
                const int coff = ((4 * ks + fq) ^ (fr >> 1)) * 16;
#pragma unroll
                for (int i = 0; i < 4; ++i) {
                    af[i] = *(const bf16x8*)(A + (wr * 64 + i * 16 + fr) * 128 + coff);
                    bfr[i] = *(const bf16x8*)(B + (wc * 64 + i * 16 + fr) * 128 + coff);
                }
                __builtin_amdgcn_s_setprio(1);
#pragma unroll
                for (int i = 0; i < 4; ++i)
#pragma unroll
                    for (int j = 0; j < 4; ++j) acc[i][j] = mfma16(bfr[j], af[i], acc[i][j]);
                __builtin_amdgcn_s_setprio(0);
            }
        }
#undef GEMM_STAGE
        if (VAR != 0 && VAR != 4) { if (acc[0][0].x == 123.456f) p.out[0] = acc[1][1].y + acc[2][2].z + acc[3][3].w; __syncthreads(); continue; }
        asm volatile("s_waitcnt lgkmcnt(0)" ::: "memory"); __builtin_amdgcn_s_barrier(); asm volatile("" ::: "memory");
        float* ep = (float*)smem;
#pragma unroll
        for (int mi = 0; mi < 4; ++mi)
#pragma unroll
            for (int ni = 0; ni < 4; ++ni) *(f32x4*)(ep + (wr * 64 + mi * 16 + fr) * 132 + wc * 64 + ni * 16 + fq * 4) = acc[mi][ni];
        asm volatile("s_waitcnt lgkmcnt(0)" ::: "memory"); __builtin_amdgcn_s_barrier(); asm volatile("" ::: "memory");
        const int row0 = mt * 256, col0 = nt * 128;
#define EP8(row_, c8_, v0_, v1_) const f32x4 v0_ = *(const f32x4*)(ep + (row_) * 132 + (c8_) * 8), v1_ = *(const f32x4*)(ep + (row_) * 132 + (c8_) * 8 + 4)
#define PK8(o_, v0_, v1_) u32x4 o_; o_.x = cvt_pk_bf16(v0_.x, v0_.y); o_.y = cvt_pk_bf16(v0_.z, v0_.w); o_.z = cvt_pk_bf16(v1_.x, v1_.y); o_.w = cvt_pk_bf16(v1_.z, v1_.w)
        switch (job) {
        case J_PROJ: {
            if (nt < 8) {
                bf16_t* Q = (bf16_t*)(ws + WS_BUFB);
#pragma unroll
                for (int i = 0; i < 8; ++i) { const int c = tid + 512 * i, row = c >> 4, c8 = c & 15; EP8(row, c8, a0, a1);
                    const f32x4 b0 = a0 * (0.125f * LOG2E), b1 = a1 * (0.125f * LOG2E); PK8(o, b0, b1);
                    *(u32x4*)(Q + (size_t)(row0 + row) * 1024 + col0 + c8 * 8) = o; }
            } else if (nt < 20) {
                const int reg = (nt - 8) >> 1;
                bf16_t* dst = (bf16_t*)(ws + WS_BUFC + (reg == 0 ? C_KCMP : reg == 1 ? C_VCMP : reg == 2 ? C_KS : reg == 3 ? C_VST : reg == 4 ? C_KW : C_VWT));
                const int b = row0 >> 13, s0 = row0 & 8191;
                if (reg != 3 && reg != 5) {
#pragma unroll
                    for (int i = 0; i < 8; ++i) { const int c = tid + 512 * i, row = c >> 4, c8 = c & 15; EP8(row, c8, a0, a1); PK8(o, a0, a1);
                        const int bh = b * 4 + ((nt - 8) & 1) * 2 + (c8 >> 3);
                        *(u32x4*)(dst + ((size_t)bh * 8192 + s0 + row) * 64 + (c8 & 7) * 8) = o; }
                } else {
#pragma unroll
                    for (int i = 0; i < 8; ++i) { const int c = tid + 512 * i, tg = c & 31, dcol = c >> 5;
                        const int rb = (tg >> 1) * 16 + (tg & 1) * 4;
                        float v[8];
#pragma unroll
                        for (int j = 0; j < 8; ++j) v[j] = ep[(rb + (j & 3) + (j >> 2) * 8) * 132 + dcol];
                        u32x4 o; o.x = cvt_pk_bf16(v[0], v[1]); o.y = cvt_pk_bf16(v[2], v[3]); o.z = cvt_pk_bf16(v[4], v[5]); o.w = cvt_pk_bf16(v[6], v[7]);
                        const int bh = b * 4 + ((nt - 8) & 1) * 2 + (dcol >> 6);
                        *(u32x4*)(dst + ((size_t)bh * 64 + (dcol & 63)) * 8192 + s0 + tg * 8) = o; }
                }
            } else if (nt == 20) {
                float* G = (float*)(ws + WS_BUFC + C_GATES);
#pragma unroll
                for (int i = 0; i < 6; ++i) { const int c = tid + 512 * i, row = c / 12, c4 = c - row * 12;
                    const f32x4 v = *(const f32x4*)(ep + row * 132 + c4 * 4); f32x4 o; o.x = sigmoidf_(v.x); o.y = sigmoidf_(v.y); o.z = sigmoidf_(v.z); o.w = sigmoidf_(v.w);
                    *(f32x4*)(G + (size_t)(row0 + row) * 48 + c4 * 4) = o; }
            } else {
                bf16_t* Hg = (bf16_t*)(ws + WS_BUFB + 64 * MiB);
#pragma unroll
                for (int i = 0; i < 4; ++i) { const int c = tid + 512 * i, row = c >> 3, c8 = c & 7, hh = c8 >> 2, cc = (c8 & 3) * 8;
                    const f32x4 a0 = *(const f32x4*)(ep + row * 132 + hh * 64 + cc), a1 = *(const f32x4*)(ep + row * 132 + hh * 64 + cc + 4);
                    const f32x4 g0 = *(const f32x4*)(ep + row * 132 + hh * 64 + 32 + cc), g1 = *(const f32x4*)(ep + row * 132 + hh * 64 + 32 + cc + 4);
                    u32x4 o; o.x = cvt_pk_bf16(a0.x * sigmoidf_(g0.x), a0.y * sigmoidf_(g0.y)); o.y = cvt_pk_bf16(a0.z * sigmoidf_(g0.z), a0.w * sigmoidf_(g0.w));
                    o.z = cvt_pk_bf16(a1.x * sigmoidf_(g1.x), a1.y * sigmoidf_(g1.y)); o.w = cvt_pk_bf16(a1.z * sigmoidf_(g1.z), a1.w * sigmoidf_(g1.w));
                    *(u32x4*)(Hg + (size_t)(row0 + row) * 1024 + ((nt - 21) * 2 + hh) * 32 + cc) = o; }
            }
        } break;
        case J_MEMKV: {
            const int b = mt;
            if (nt < 16) {
                bf16_t* Kx = (bf16_t*)(ws + WS_BUFD + 4 * MiB);
                const int head = col0 >> 9, d0 = col0 & 511;
#pragma unroll
                for (int i = 0; i < 8; ++i) { const int c = tid + 512 * i, row = c >> 4, c8 = c & 15; EP8(row, c8, a0, a1); PK8(o, a0, a1);
                    *(u32x4*)(Kx + ((size_t)(b * 4 + head) * 256 + row) * 512 + d0 + c8 * 8) = o; }
            } else {
                bf16_t* Vt = (bf16_t*)(ws + WS_BUFD + 8 * MiB);
                const int n2 = col0 - 2048, head = n2 >> 9, d0 = n2 & 511;
#pragma unroll
                for (int i = 0; i < 8; ++i) { const int c = tid + 512 * i, tg = c & 31, dcol = c >> 5;
                    float v[8];
#pragma unroll
                    for (int j = 0; j < 8; ++j) v[j] = ep[(tg * 8 + j) * 132 + dcol];
                    u32x4 o; o.x = cvt_pk_bf16(v[0], v[1]); o.y = cvt_pk_bf16(v[2], v[3]); o.z = cvt_pk_bf16(v[4], v[5]); o.w = cvt_pk_bf16(v[6], v[7]);
                    *(u32x4*)(Vt + ((size_t)(b * 4 + head) * 512 + d0 + dcol) * 256 + tg * 8) = o; }
            }
        } break;
        case J_CMP1: {
            const int type = mt >> 5;
            const float* bias = (const float*)(ws + WS_C1BIAS) + type * 256;
            bf16_t* Hd = (bf16_t*)(ws + WS_BUFC + C_HID);
            const f32x4 b0 = *(const f32x4*)(bias + col0 + (tid & 15) * 8), b1 = *(const f32x4*)(bias + col0 + (tid & 15) * 8 + 4);
#pragma unroll
            for (int i = 0; i < 8; ++i) { const int c = tid + 512 * i, row = c >> 4, c8 = c & 15; EP8(row, c8, a0, a1);
                u32x4 o; o.x = cvt_pk_bf16(gelu_tanh(a0.x + b0.x), gelu_tanh(a0.y + b0.y)); o.y = cvt_pk_bf16(gelu_tanh(a0.z + b0.z), gelu_tanh(a0.w + b0.w));
                o.z = cvt_pk_bf16(gelu_tanh(a1.x + b1.x), gelu_tanh(a1.y + b1.y)); o.w = cvt_pk_bf16(gelu_tanh(a1.z + b1.z), gelu_tanh(a1.w + b1.w));
                *(u32x4*)(Hd + (size_t)(row0 + row) * 256 + col0 + c8 * 8) = o; }
        } break;
        case J_CMP2: {
            const int gi = mt >> 1, type = gi >> 4, bh = gi & 15, i0 = (mt & 1) * 256;
            if (type == 0) {
                bf16_t* Kc = (bf16_t*)(ws + WS_BUFC + C_KC);
#pragma unroll
                for (int i = 0; i < 4; ++i) { const int c = tid + 512 * i, row = c >> 3, c8 = c & 7; EP8(row, c8, a0, a1); PK8(o, a0, a1);
                    if (i0 + row >= 511) o = (u32x4){0u, 0u, 0u, 0u};
                    *(u32x4*)(Kc + ((size_t)bh * 512 + i0 + row) * 64 + c8 * 8) = o; }
            } else {
                bf16_t* Vc = (bf16_t*)(ws + WS_BUFC + C_VCT);
#pragma unroll
                for (int i = 0; i < 4; ++i) { const int c = tid + 512 * i, tg = c & 31, d = c >> 5;
                    const int rb = (tg >> 1) * 16 + (tg & 1) * 4;
                    float v[8];
#pragma unroll
                    for (int j = 0; j < 8; ++j) { const int r = rb + (j & 3) + (j >> 2) * 8; v[j] = (i0 + r >= 511) ? 0.f : ep[r * 132 + d]; }
                    u32x4 o; o.x = cvt_pk_bf16(v[0], v[1]); o.y = cvt_pk_bf16(v[2], v[3]); o.z = cvt_pk_bf16(v[4], v[5]); o.w = cvt_pk_bf16(v[6], v[7]);
                    *(u32x4*)(Vc + ((size_t)bh * 64 + d) * 512 + i0 + tg * 8) = o; }
            }
        } break;
        case J_OUT: {
            const int c4 = tid & 31, n = col0 + c4 * 4;
#pragma unroll
            for (int i = 0; i < 16; ++i) { const int row = (tid >> 5) + 16 * i, t = row0 + row;
                const f32x4 v = *(const f32x4*)(ep + row * 132 + c4 * 4);
                f32x4 y; y.x = bf2f(preb[i].x & 0xffffu) * ALPHA + v.x; y.y = bf2f(preb[i].x >> 16) * ALPHA + v.y;
                y.z = bf2f(preb[i].y & 0xffffu) * ALPHA + v.z; y.w = bf2f(preb[i].y >> 16) * ALPHA + v.w;
                u32x2 yb; yb.x = cvt_pk_bf16(y.x, y.y); yb.y = cvt_pk_bf16(y.z, y.w);
                *(u32x2*)((bf16_t*)(ws + WS_BUFB) + (size_t)t * D_ + n) = yb;
                float rs = (y.x + y.y) + (y.z + y.w), rq = (y.x * y.x + y.y * y.y) + (y.z * y.z + y.w * y.w);
#pragma unroll
                for (int o = 1; o < 32; o <<= 1) { rs += __shfl_xor(rs, o); rq += __shfl_xor(rq, o); }
                if ((tid & 31) == 0) { float* rsum = (float*)(ws + WS_RSUM1) + (size_t)t * 2; atomicAdd(rsum, rs); atomicAdd(rsum + 1, rq); } }
        } break;
        case J_WQ: {
            bf16_t* Qx = (bf16_t*)(ws + WS_BUFC);
            const float sc = 0.04419417382415922f * LOG2E;
            const float* U = (const float*)(ws + WS_CTL + CTL_U1); const float* Cv = (const float*)(ws + WS_CTL + CTL_C1);
            const float* rsum = (const float*)(ws + WS_RSUM1);
            const int c8 = tid & 15, n = col0 + c8 * 8;
            const f32x4 u0 = *(const f32x4*)(U + n), u1 = *(const f32x4*)(U + n + 4), c0 = *(const f32x4*)(Cv + n), c1 = *(const f32x4*)(Cv + n + 4);
            float2 rsq[8];
#pragma unroll
            for (int i = 0; i < 8; ++i) rsq[i] = *(const float2*)(rsum + (size_t)(row0 + (tid >> 4) + 32 * i) * 2);
#pragma unroll
            for (int i = 0; i < 8; ++i) { const int row = (tid >> 4) + 32 * i; EP8(row, c8, a0, a1);
                const int t = row0 + row;
                const float mean = rsq[i].x * (1.f / D_); float var = rsq[i].y * (1.f / D_) - mean * mean; var = var > 0.f ? var : 0.f;
                const float rstd = __builtin_amdgcn_rsqf(var + LN_EPS), mr = mean * rstd;
                const f32x4 b0 = (a0 * rstd - u0 * mr + c0) * sc, b1 = (a1 * rstd - u1 * mr + c1) * sc; PK8(o, b0, b1);
                *(u32x4*)(Qx + (size_t)t * 2048 + n) = o; }
        } break;
        case J_WO: {
            const int c4 = tid & 31, n = col0 + c4 * 4;
            const f32x4 g = *(const f32x4*)(p.in[17] + n), bb = *(const f32x4*)(p.in[18] + n);
#pragma unroll
            for (int hlf = 0; hlf < 2; ++hlf) {
                float2 sm[8];
#pragma unroll
                for (int i = 0; i < 8; ++i) { const int row = (tid >> 5) + 16 * (hlf * 8 + i), t = row0 + row;
                    const float2 rsq = *(const float2*)((const float*)(ws + WS_RSUM1) + (size_t)t * 2);
                    const float mean = rsq.x * (1.f / D_); float var = rsq.y * (1.f / D_) - mean * mean; var = var > 0.f ? var : 0.f;
                    sm[i] = make_float2(mean, 1.f / sqrtf(var + LN_EPS)); }
#pragma unroll
                for (int i = 0; i < 8; ++i) { const int row = (tid >> 5) + 16 * (hlf * 8 + i), t = row0 + row;
                    const f32x4 v = *(const f32x4*)(ep + row * 132 + c4 * 4);
                    const u32x2 pb = preb[hlf * 8 + i];
                    f32x4 rv; rv.x = bf2f(pb.x & 0xffffu); rv.y = bf2f(pb.x >> 16); rv.z = bf2f(pb.y & 0xffffu); rv.w = bf2f(pb.y >> 16);
                    *(f32x4*)(p.out + (size_t)t * D_ + n) = ((rv - sm[i].x) * sm[i].y * g + bb) * ALPHA + v; }
            }
        } break;
        case J_ROUTER: {
            if (tid < 256) {
                const int row = tid, t = row0 + row;
                const float* er = ep + row * 132;
                unsigned* cnt = (unsigned*)(ws + WS_CTL) + CW_CNT;
                int* list = (int*)(ws + WS_LIST);
                float* wt = (float*)(ws + WS_WTOK);
                float lg[4];
#pragma unroll
                for (int i = 0; i < 4; ++i) lg[i] = er[i] + er[64 + i] + p.in[27][i];
                int grp = 0; float best = lg[0];
#pragma unroll
                for (int i = 1; i < 4; ++i) if (lg[i] > best) { best = lg[i]; grp = i; }
                float se = 0.f;
#pragma unroll
                for (int i = 0; i < 4; ++i) se += expf(lg[i] - best);
                const float wgrp = 1.f / se;
                float le[8];
#pragma unroll
                for (int i = 0; i < 8; ++i) le[i] = er[4 + grp * 8 + i] + er[68 + grp * 8 + i] + p.in[29][grp * 8 + i];
                int i0 = 0; float v0 = le[0];
#pragma unroll
                for (int i = 1; i < 8; ++i) if (le[i] > v0) { v0 = le[i]; i0 = i; }
                int i1 = -1; float v1 = -INFINITY;
#pragma unroll
                for (int i = 0; i < 8; ++i) if (i != i0 && le[i] > v1) { v1 = le[i]; i1 = i; }
                const float ex = expf(v1 - v0);
                const float w0 = wgrp / (1.f + ex), w1 = wgrp * ex / (1.f + ex);
                const int ea = grp * 8 + i0, eb = grp * 8 + i1;
                const unsigned pa = atomicAdd(cnt + ea, 1u); list[(size_t)ea * T_ + pa] = t * 2;
                const unsigned pb = atomicAdd(cnt + eb, 1u); list[(size_t)eb * T_ + pb] = t * 2 + 1;
                wt[t * 2] = w0; wt[t * 2 + 1] = w1;
            }
        } break;
        case J_MOE1: {
            bf16_t* H = (bf16_t*)(ws + WS_BUFB);
#pragma unroll
            for (int i = 0; i < 4; ++i) { const int c = tid + 512 * i, row = c >> 3, c8 = c & 7, hh = c8 >> 2, cc = (c8 & 3) * 8;
                const f32x4 g0 = *(const f32x4*)(ep + row * 132 + hh * 64 + cc), g1 = *(const f32x4*)(ep + row * 132 + hh * 64 + cc + 4);
                const f32x4 u0 = *(const f32x4*)(ep + row * 132 + hh * 64 + 32 + cc), u1 = *(const f32x4*)(ep + row * 132 + hh * 64 + 32 + cc + 4);
                u32x4 o; o.x = cvt_pk_bf16(g0.x * sigmoidf_(g0.x) * u0.x, g0.y * sigmoidf_(g0.y) * u0.y); o.y = cvt_pk_bf16(g0.z * sigmoidf_(g0.z) * u0.z, g0.w * sigmoidf_(g0.w) * u0.w);
                o.z = cvt_pk_bf16(g1.x * sigmoidf_(g1.x) * u1.x, g1.y * sigmoidf_(g1.y) * u1.y); o.w = cvt_pk_bf16(g1.z * sigmoidf_(g1.z) * u1.z, g1.w * sigmoidf_(g1.w) * u1.w);
                *(u32x4*)(H + ((size_t)(etp + rt) * 256 + row) * 512 + (nt * 2 + hh) * 32 + cc) = o; }
        } break;
        default: {
            bf16_t* Y = (bf16_t*)(ws + WS_BUFC);
            const float* wt = (const float*)(ws + WS_WTOK);
            const int c8 = tid & 15;
            int aid[8]; float wv[8];
#pragma unroll
            for (int i = 0; i < 8; ++i) { const int pos = rt * 256 + (tid >> 4) + 32 * i; aid[i] = (pos < ecnt) ? ((const int*)(ws + WS_LIST))[(size_t)e * T_ + pos] : -1; }
#pragma unroll
            for (int i = 0; i < 8; ++i) wv[i] = (aid[i] >= 0) ? wt[aid[i]] : 0.f;
#pragma unroll
            for (int i = 0; i < 8; ++i) { const int row = (tid >> 4) + 32 * i;
                if (aid[i] >= 0) { EP8(row, c8, a0, a1); const f32x4 b0 = a0 * wv[i], b1 = a1 * wv[i]; PK8(o, b0, b1);
                    *(u32x4*)(Y + (size_t)aid[i] * 2048 + col0 + c8 * 8) = o; } }
        } break;
        }
#undef EP8
#undef PK8
        asm volatile("s_waitcnt lgkmcnt(0)" ::: "memory"); __builtin_amdgcn_s_barrier(); asm volatile("" ::: "memory");
    }
}

DEVI void phase_conv(const Params& p) {
    unsigned char* ws = p.ws;
    int tid = threadIdx.x; asm volatile("" : "+v"(tid));
    const int lane = tid & 63, w = tid >> 6;
    const int c0 = tid * 2;
    const bf16_t* Hg = (const bf16_t*)(ws + WS_BUFB + 64 * MiB);
    float* pre = p.out;
    float* cst = (float*)(ws + WS_LIST);
    float wgt[31][2];
    { const float* wp = p.in[12] + c0;
#pragma unroll
      for (int k = 0; k < 31; ++k) { const float2 v = *(const float2*)wp; wgt[k][0] = v.x; wgt[k][1] = v.y; wp += 1024; asm volatile("" : "+v"(wp)); } }
    const float2 cb = *(const float2*)(p.in[13] + c0);
    for (int it = blockIdx.x; it < T_ / 16; it += gridDim.x) {
        const int t0 = it * 16, s0 = t0 & 8191;
        float acc[16][2];
#pragma unroll
        for (int j = 0; j < 16; ++j) { acc[j][0] = cb.x; acc[j][1] = cb.y; }
        const bf16_t* xp = Hg + ((long)t0 - 30) * 1024 + c0;
#pragma unroll
        for (int i = 0; i < 46; ++i) {
            const int s = s0 - 30 + i;
            float x0 = 0.f, x1 = 0.f;
            if (s >= 0) { const unsigned u = *(const unsigned*)xp; x0 = bf2f(u & 0xffffu); x1 = bf2f(u >> 16); }
            xp += 1024; asm volatile("" : "+v"(xp));
#pragma unroll
            for (int j = 0; j < 16; ++j) { const int k = i - j; if (k >= 0 && k <= 30) { acc[j][0] += wgt[k][0] * x0; acc[j][1] += wgt[k][1] * x1; } }
        }
#pragma unroll
        for (int j = 0; j < 16; ++j) {
            *(float2*)(pre + (size_t)(t0 + j) * 1024 + c0) = make_float2(acc[j][0], acc[j][1]);
            const float sv = wave_sum(acc[j][0] + acc[j][1]);
            const float qv = wave_sum(acc[j][0] * acc[j][0] + acc[j][1] * acc[j][1]);
            if (lane == 0) *(float2*)(cst + ((size_t)(t0 + j) * 8 + w) * 2) = make_float2(sv, qv);
        }
    }
}
DEVI void conv_finish(const Params& p) {
    unsigned char* ws = p.ws;
    int tid = threadIdx.x; asm volatile("" : "+v"(tid));
    const int lane = tid & 63, w = tid >> 6;
    const float* pre = p.out;
    const float* cst = (const float*)(ws + WS_LIST);
    bf16_t* CC = (bf16_t*)(ws + WS_BUFE);
    for (int it = blockIdx.x; it < T_ / 8; it += gridDim.x) {
        const int t = it * 8 + w;
        float sv = 0.f, qv = 0.f;
#pragma unroll
        for (int k = 0; k < 8; ++k) { const float2 a = *(const float2*)(cst + ((size_t)t * 8 + k) * 2); sv += a.x; qv += a.y; }
        const float mean = sv * (1.f / 1024.f);
        float var = qv * (1.f / 1024.f) - mean * mean; var = var > 0.f ? var : 0.f;
        const float rstd = 1.f / sqrtf(var + LN_EPS);
#pragma unroll
        for (int c = 0; c < 4; ++c) {
            const int col = c * 256 + lane * 4;
            const f32x4 x = *(const f32x4*)(pre + (size_t)t * 1024 + col), g = *(const f32x4*)(p.in[14] + col), bb = *(const f32x4*)(p.in[15] + col);
            f32x4 y = (x - mean) * rstd * g + bb;
            y.x *= sigmoidf_(y.x); y.y *= sigmoidf_(y.y); y.z *= sigmoidf_(y.z); y.w *= sigmoidf_(y.w);
            u32x2 o; o.x = cvt_pk_bf16(y.x, y.y); o.y = cvt_pk_bf16(y.z, y.w);
            *(u32x2*)(CC + (size_t)t * 2048 + 1024 + col) = o;
        }
    }
}

enum { M_CMP = 0, M_SEL = 1, M_WIN = 2 };
constexpr int KSTR = 72;
constexpr int NSA_KBUF = 0, NSA_VBUF = 49152;
constexpr int NSA_IMP = 98304;
constexpr int NSA_TBL = 132096;
constexpr int NSA_SEL = NSA_TBL + 4096;
constexpr int NSA_UNIT = NSA_SEL + 1024;

DEVI void attn_issue(char* kdst, char* vdst, const bf16_t* kt, const bf16_t* vt, int vstride, int tid) {
    const int row = tid >> 3, c = (tid & 7) ^ ((row >> 1) & 7);
    glds16(kt + row * 64 + c * 8, kdst + tid * 16);
    glds16(vt + (size_t)row * vstride + c * 8, vdst + tid * 16);
}

constexpr float NSA_THR = 8.f;
template <int MODE, int PASS>
DEVI void nsa_branch(char* smem, const bf16_t* kg, const bf16_t* vg, int vstride, int t_lo, int t_hi, int far_lo, int far_hi, const bf16x8 (&qf)[4], int tq,
                     float c31, const LAS float* tblg, const LAS unsigned* selrow, float& m_ref, bool& mset, float& lsum, float inv_l, f32x16 (&o)[2], LAS float* imp_row) {
    int tid = threadIdx.x; asm volatile("" : "+v"(tid));
    const int lane = tid & 63, l31 = lane & 31, h = lane >> 5, xs = (l31 >> 1) & 7;
    const int n = t_hi - t_lo + 1;
    f32x16 cneg;
    { const float cc = c31 - m_ref;
#pragma unroll
      for (int i = 0; i < 16; ++i) cneg[i] = cc; }
    float imp_carry = 0.f;
    const int nS = (n + 1) >> 1;
#define NSA_ISSUE_PAIR(js_) do { const int _sl = (js_) % 3; \
        _Pragma("unroll") for (int _sb = 0; _sb < 2; ++_sb) { int _t = t_lo + 2 * (js_) + _sb; _t = _t > t_hi ? t_hi : _t; \
            attn_issue(smem + NSA_KBUF + _sl * 16384 + _sb * 8192, smem + NSA_VBUF + _sl * 16384 + _sb * 8192, kg + (size_t)_t * 4096, vg + _t * 64, vstride, tid); } } while (0)
    NSA_ISSUE_PAIR(0);
    if (nS > 1) NSA_ISSUE_PAIR(1);
    for (int it = 0; it < n; ++it) {
        const int ti = t_lo + it, js = it >> 1, buf = (js % 3) * 2 + (it & 1);
        if ((it & 1) == 0) {
            if (js + 1 < nS) asm volatile("s_waitcnt vmcnt(4)" ::: "memory"); else asm volatile("s_waitcnt vmcnt(0)" ::: "memory");
            __builtin_amdgcn_s_barrier();
            asm volatile("" ::: "memory");
            if (js + 2 < nS) NSA_ISSUE_PAIR(js + 2);
        }
        bool selbit = true;
        if (MODE == M_SEL) { selbit = (selrow[ti >> 5] >> (ti & 31)) & 1u; if (!__any(selbit)) continue; }
        const char* Kc = smem + NSA_KBUF + buf * 8192; const char* Vc = smem + NSA_VBUF + buf * 8192;
        f32x16 s[2];
        __builtin_amdgcn_s_setprio(1);
        {
            const int off0 = (h ^ xs) << 4;
            s[0] = mfma32(*(const bf16x8*)(Kc + l31 * 128 + off0), qf[0], cneg);
            s[1] = mfma32(*(const bf16x8*)(Kc + (32 + l31) * 128 + off0), qf[0], cneg);
        }
#pragma unroll
        for (int ks = 1; ks < 4; ++ks) {
            const int off = ((2 * ks + h) ^ xs) << 4;
            s[0] = mfma32(*(const bf16x8*)(Kc + l31 * 128 + off), qf[ks], s[0]);
            s[1] = mfma32(*(const bf16x8*)(Kc + (32 + l31) * 128 + off), qf[ks], s[1]);
        }
        __builtin_amdgcn_s_setprio(0);
        const bool far = (ti >= far_lo) && (ti <= far_hi);
        {
        if (!far) {
            const int dbase = (MODE == M_CMP) ? (tq - 31 - 1024 * ti) : (tq - 64 * ti);
#pragma unroll
            for (int u = 0; u < 2; ++u)
#pragma unroll
                for (int i = 0; i < 16; ++i) {
                    const int kk = 32 * u + (i & 3) + 8 * (i >> 2) + 4 * h;
                    const int dist = dbase - ((MODE == M_CMP) ? 16 * kk : kk);
                    const int idx = (dist < -1 ? -1 : (dist > 191 ? 191 : dist)) + 64;
                    float v = s[u][i] + tblg[idx];
                    if (MODE == M_WIN) v = (dist < 512) ? v : -INFINITY;
                    if (MODE == M_SEL) v = selbit ? v : -INFINITY;
                    s[u][i] = v;
                    if ((i & 3) == 3) asm volatile("" ::: "memory");
                }
        }
        if (PASS != 2) {
            float mxa = max3f(s[0][0], s[0][1], s[0][2]), mxb = max3f(s[1][0], s[1][1], s[1][2]);
#pragma unroll
            for (int i = 3; i < 15; i += 2) { mxa = max3f(mxa, s[0][i], s[0][i + 1]); mxb = max3f(mxb, s[1][i], s[1][i + 1]); }
            float mx = max3f(mxa, mxb, s[0][15]); mx = max3f(mx, s[1][15], s[1][15]);
            if (MODE == M_SEL && !selbit) mx = -INFINITY;
            if (__any(mx > NSA_THR || (!mset && mx > -INFINITY))) {
                const float mc = fmaxf(mx, __shfl_xor(mx, 32));
                const bool mv = (mc > NSA_THR) || (!mset && mc > -INFINITY);
                const float delta = mv ? mc : 0.f;
                const float alpha = mset ? fexp2(-delta) : 1.f;
                mset = mset || mv;
                m_ref += delta;
                const float cc = c31 - m_ref;
#pragma unroll
                for (int i = 0; i < 16; ++i) cneg[i] = cc;
                lsum *= alpha;
#pragma unroll
                for (int u = 0; u < 2; ++u)
#pragma unroll
                    for (int i = 0; i < 16; ++i) s[u][i] -= delta;
                if (PASS == 0) {
#pragma unroll
                    for (int v = 0; v < 2; ++v)
#pragma unroll
                        for (int i = 0; i < 16; ++i) o[v][i] *= alpha;
                }
            }
        }
        float ps0 = 0.f, ps1 = 0.f, ps2 = 0.f, ps3 = 0.f;
#pragma unroll
        for (int u = 0; u < 2; ++u)
#pragma unroll
            for (int i = 0; i < 16; i += 4) {
                s[u][i] = fexp2(s[u][i]); s[u][i + 1] = fexp2(s[u][i + 1]); s[u][i + 2] = fexp2(s[u][i + 2]); s[u][i + 3] = fexp2(s[u][i + 3]);
                ps0 += s[u][i]; ps1 += s[u][i + 1]; ps2 += s[u][i + 2]; ps3 += s[u][i + 3];
            }
        { const float ps = (ps0 + ps1) + (ps2 + ps3); lsum += (MODE == M_SEL && far && !selbit) ? 0.f : ps; }
        if (PASS == 2) {
            float mainv[8], halfv[8];
#pragma unroll
            for (int u = 0; u < 2; ++u)
#pragma unroll
                for (int c4 = 0; c4 < 4; ++c4) {
                    float hv = 0.5f * s[u][4 * c4 + 3] * inv_l;
                    float mv = ((s[u][4 * c4] + s[u][4 * c4 + 1]) + s[u][4 * c4 + 2]) * inv_l + hv;
                    mv += __builtin_bit_cast(float, __builtin_amdgcn_update_dpp(0, __builtin_bit_cast(int, mv), 0xB1, 0xF, 0xF, true));
                    hv += __builtin_bit_cast(float, __builtin_amdgcn_update_dpp(0, __builtin_bit_cast(int, hv), 0xB1, 0xF, 0xF, true));
                    mv += __builtin_bit_cast(float, __builtin_amdgcn_update_dpp(0, __builtin_bit_cast(int, mv), 0x4E, 0xF, 0xF, true));
                    hv += __builtin_bit_cast(float, __builtin_amdgcn_update_dpp(0, __builtin_bit_cast(int, hv), 0x4E, 0xF, 0xF, true));
                    mainv[u * 4 + c4] = mv; halfv[u * 4 + c4] = __shfl_xor(hv, 32);
                }
#pragma unroll
            for (int gi = 0; gi < 8; ++gi) {
                const float cin = h ? halfv[gi] : (gi ? halfv[gi - 1] : imp_carry);
                const unsigned ia = (unsigned)(size_t)(imp_row + 16 * ti + 2 * gi + h);
                const float val = mainv[gi] + cin;
                asm volatile("ds_write_b32 %0, %1" :: "v"(ia), "v"(val) : "memory");
            }
            imp_carry = halfv[7];
        }
        const unsigned pmask = (MODE == M_SEL && far && !selbit) ? 0u : 0xFFFFFFFFu;
#pragma unroll
        for (int u = 0; u < 2; ++u)
#pragma unroll
            for (int sI = 0; sI < 2; ++sI) {
                u32x4 pk;
                pk.x = cvt_pk_bf16(s[u][8 * sI + 0], s[u][8 * sI + 1]); pk.y = cvt_pk_bf16(s[u][8 * sI + 2], s[u][8 * sI + 3]);
                pk.z = cvt_pk_bf16(s[u][8 * sI + 4], s[u][8 * sI + 5]); pk.w = cvt_pk_bf16(s[u][8 * sI + 6], s[u][8 * sI + 7]);
                if (MODE == M_SEL) { pk.x &= pmask; pk.y &= pmask; pk.z &= pmask; pk.w &= pmask; }
                const bf16x8 pf = __builtin_bit_cast(bf16x8, pk);
                if (PASS != 1) {
                    const int voff = ((2 * (2 * u + sI) + h) ^ xs) << 4;
                    o[0] = mfma32(*(const bf16x8*)(Vc + l31 * 128 + voff), pf, o[0]);
                    o[1] = mfma32(*(const bf16x8*)(Vc + (32 + l31) * 128 + voff), pf, o[1]);
                }
            }
        }
    }
    if (PASS == 2) {
        const int c = 16 * (t_hi + 1);
        if (h == 0 && c < 128) { const unsigned ia = (unsigned)(size_t)(imp_row + c); asm volatile("ds_write_b32 %0, %1" :: "v"(ia), "v"(imp_carry) : "memory"); }
        asm volatile("s_waitcnt lgkmcnt(0)" ::: "memory");
    }
#undef NSA_ISSUE_PAIR
    __syncthreads();
}

DEVI void phase_nsa(const Params& p, char* smem, int ctr_idx) {
    unsigned char* ws = p.ws;
    const int tid0 = threadIdx.x;
    float* imp = (float*)(smem + NSA_IMP);
    unsigned* tot = (unsigned*)(smem + NSA_IMP);
    float* tbl = (float*)(smem + NSA_TBL);
    unsigned* selm = (unsigned*)(smem + NSA_SEL);
    int* sunit = (int*)(smem + NSA_UNIT);
    unsigned* ctr = (unsigned*)(ws + WS_CTL) + CW_NSA + 256 * ctr_idx;
    unsigned* trc = (unsigned*)(ws + WS_CTL) + CW_TR;
    const bf16_t* Q = (const bf16_t*)(ws + WS_BUFB);
    const float* G = (const float*)(ws + WS_BUFC + C_GATES);
    bf16_t* CC = ctr_idx ? (bf16_t*)(p.out + 32 * 1024 * 1024) : (bf16_t*)(ws + WS_BUFE);
    for (;;) {
        int tid = tid0; asm volatile("" : "+v"(tid));
        const int lane = tid & 63, w = tid >> 6, l31 = lane & 31, h = lane >> 5;
        const int qi = l31 >> 2, g = l31 & 3, ql = 8 * w + qi;
        __syncthreads();
        if (tid == 0) {
            const unsigned x = xb_xcc_id() & 7u; int u = -1;
            for (unsigned k = 0; k < 8u && u < 0; ++k) { const unsigned xx = (x + k) & 7u; const unsigned i = atomicAdd(ctr + 16 * xx, 1u); if (i < 256u) u = (int)(i * 8u + xx); }
            *sunit = u;
        }
        __syncthreads();
        const int unit = *sunit;
        if (unit < 0) break;
        const int xq = unit & 7, iq = unit >> 3;
        const int qt = 127 - (iq >> 1), bh = 2 * xq + (iq & 1), b = bh >> 2, hkv = bh & 3, q0 = qt * 64, cur = qt;
        for (int i = tid; i < 4 * 256; i += 512) {
            const int gg = i >> 8, d = (i & 255) - 64;
            float val = -INFINITY;
            if (d >= 0) {
                int bucket;
                if (d < 16) bucket = d;
                else if (d >= 128) bucket = 31;
                else { const int lg = 16 + (int)(logf((float)d / 16.f) / 2.0794415416798357f * 16.f); bucket = lg < 31 ? lg : 31; }
                val = (p.in[11][bucket * 16 + hkv * 4 + gg] - p.in[11][31 * 16 + hkv * 4 + gg]) * LOG2E;
            }
            tbl[i] = val;
        }
        if (tid < 256) selm[tid] = 0u;
        const int tq = q0 + ql;
        const size_t trow = (size_t)b * 8192 + tq;
        bf16x8 qf[4];
        { const bf16_t* qrow = Q + trow * 1024 + hkv * 256 + g * 64;
#pragma unroll
          for (int ks = 0; ks < 4; ++ks) qf[ks] = *(const bf16x8*)(qrow + 16 * ks + 8 * h); }
        float c31 = p.in[11][31 * 16 + hkv * 4 + g] * LOG2E;
        asm volatile("" : "+v"(qf[0]), "+v"(qf[1]), "+v"(qf[2]), "+v"(qf[3]), "+v"(c31));
        const LAS float* tblg = (const LAS float*)(smem + NSA_TBL) + g * 256;
        const LAS unsigned* selrow = (const LAS unsigned*)(smem + NSA_SEL) + ql * 4;
        f32x16 o[2];
#pragma unroll
        for (int v = 0; v < 2; ++v)
#pragma unroll
            for (int i = 0; i < 16; ++i) o[v][i] = 0.f;
        __syncthreads();
        const bf16_t* kc = (const bf16_t*)(ws + WS_BUFC + C_KC) + (size_t)bh * 512 * 64;
        const bf16_t* vct = (const bf16_t*)(ws + WS_BUFC + C_VCT) + (size_t)bh * 64 * 512;
        const int ct_hi = (q0 + 32) >> 10, cfar_hi = (q0 >= 1167) ? ((q0 - 1167) >> 10) : -1;
        float m_ref = 0.f; bool mset = false;
        float lsum = 0.f;
        const int rmode = ctr_idx ? NSA_REP_MODE : 0;
        if (rmode != 2) nsa_branch<M_CMP, 1>(smem, kc, vct, 512, 0, ct_hi, 0, cfar_hi, qf, tq, c31, tblg, selrow, m_ref, mset, lsum, 0.f, o, (LAS float*)(smem + NSA_IMP) + ql * 132);
        { const float lt = lsum + __shfl_xor(lsum, 32); const float inv = lt > 0.f ? 1.f / lt : 0.f;
          if (rmode != 2 && rmode != 4) nsa_branch<M_CMP, 2>(smem, kc, vct, 512, 0, ct_hi, 0, cfar_hi, qf, tq, c31, tblg, selrow, m_ref, mset, lsum, inv, o, (LAS float*)(smem + NSA_IMP) + ql * 132);
#pragma unroll
          for (int v = 0; v < 2; ++v)
#pragma unroll
            for (int i = 0; i < 16; ++i) o[v][i] *= inv; }
        asm volatile("s_waitcnt lgkmcnt(0)" ::: "memory"); __syncthreads();
        if (rmode < 2) {
            const int q = tid >> 3, sub = tid & 7, t = q0 + q;
            unsigned key[16];
#pragma unroll
            for (int i = 0; i < 16; ++i) {
                const int j = sub * 16 + i;
                const bool forced = (j == 0) || (j == cur) || (j == cur - 1);
                const bool valid = (j * 64 <= t);
                const float v = imp[q * 132 + j];
                key[i] = forced ? 0xFFFFFFFFu : (valid ? (__float_as_uint(v) + 1u) : 0u);
            }
            unsigned tau = 0u;
            for (int bit = 31; bit >= 0; --bit) {
                const unsigned cand = tau | (1u << bit);
                int c = 0;
#pragma unroll
                for (int i = 0; i < 16; ++i) c += (key[i] >= cand) ? 1 : 0;
                c += __builtin_amdgcn_update_dpp(0, c, 0xB1, 0xF, 0xF, true); c += __builtin_amdgcn_update_dpp(0, c, 0x4E, 0xF, 0xF, true); c += __builtin_amdgcn_update_dpp(0, c, 0x141, 0xF, 0xF, true);
                if (c >= 16) tau = cand;
            }
            int gt = 0, eq = 0;
#pragma unroll
            for (int i = 0; i < 16; ++i) { gt += (key[i] > tau) ? 1 : 0; eq += (key[i] == tau) ? 1 : 0; }
            int gtt = gt; gtt += __builtin_amdgcn_update_dpp(0, gtt, 0xB1, 0xF, 0xF, true); gtt += __builtin_amdgcn_update_dpp(0, gtt, 0x4E, 0xF, 0xF, true); gtt += __builtin_amdgcn_update_dpp(0, gtt, 0x141, 0xF, 0xF, true);
            int pre = 0;
#pragma unroll
            for (int sI = 0; sI < 7; ++sI) { const int v = __shfl(eq, (lane & ~7) + sI); if (sI < sub) pre += v; }
            const int need = 16 - gtt;
            unsigned bits = 0u; int run = pre;
#pragma unroll
            for (int i = 0; i < 16; ++i) {
                bool sel = key[i] > tau;
                if (tau > 0u && key[i] == tau) { sel = run < need; ++run; }
                bits |= sel ? (1u << i) : 0u;
            }
            atomicOr(&selm[q * 4 + (sub >> 1)], bits << ((sub & 1) * 16));
        }
        __syncthreads();
        const float gc = G[((size_t)b * 8192 + tq) * 48 + hkv * 12 + g * 3 + 0];
#pragma unroll
        for (int v = 0; v < 2; ++v)
#pragma unroll
            for (int i = 0; i < 16; i += 2) { const float gcc = (PROBE == 1 ? 0.f : gc); tot[(v * 8 + (i >> 1)) * 512 + tid] = cvt_pk_bf16(gcc * o[v][i], gcc * o[v][i + 1]); o[v][i] = 0.f; o[v][i + 1] = 0.f; }
        {
            const bf16_t* ks = (const bf16_t*)(ws + WS_BUFC + C_KS) + (size_t)bh * 8192 * 64;
            const bf16_t* vst = (const bf16_t*)(ws + WS_BUFC + C_VST) + (size_t)bh * 64 * 8192;
            m_ref = 0.f; mset = false;
            lsum = 0.f;
            if (rmode == 0) nsa_branch<M_SEL, 0>(smem, ks, vst, 8192, 0, cur, 0, cur - 3, qf, tq, c31, tblg, selrow, m_ref, mset, lsum, 0.f, o, (LAS float*)nullptr);
            const float gs = G[((size_t)b * 8192 + tq) * 48 + hkv * 12 + g * 3 + 1];
            const float sc = (PROBE == 2 ? 0.f : gs) / (lsum + __shfl_xor(lsum, 32));
#pragma unroll
            for (int v = 0; v < 2; ++v)
#pragma unroll
                for (int i = 0; i < 16; i += 2) { const unsigned tv = tot[(v * 8 + (i >> 1)) * 512 + tid];
                    tot[(v * 8 + (i >> 1)) * 512 + tid] = cvt_pk_bf16(bf2f(tv & 0xffffu) + sc * o[v][i], bf2f(tv >> 16) + sc * o[v][i + 1]); o[v][i] = 0.f; o[v][i + 1] = 0.f; }
        }
        {
            const bf16_t* kw = (const bf16_t*)(ws + WS_BUFC + C_KW) + (size_t)bh * 8192 * 64;
            const bf16_t* vwt = (const bf16_t*)(ws + WS_BUFC + C_VWT) + (size_t)bh * 64 * 8192;
            m_ref = 0.f; mset = false;
            lsum = 0.f;
            const int w_lo = cur >= 8 ? cur - 8 : 0;
            if (rmode == 0 || rmode == 2) nsa_branch<M_WIN, 0>(smem, kw, vwt, 8192, w_lo, cur, cur - 7, cur - 3, qf, tq, c31, tblg, selrow, m_ref, mset, lsum, 0.f, o, (LAS float*)nullptr);
            const float gw = G[((size_t)b * 8192 + tq) * 48 + hkv * 12 + g * 3 + 2];
            const float sc = (PROBE == 3 ? 0.f : gw) / (lsum + __shfl_xor(lsum, 32));
            bf16_t* orow = CC + trow * 2048 + hkv * 256 + g * 64;
#pragma unroll
            for (int v = 0; v < 2; ++v)
#pragma unroll
                for (int c4 = 0; c4 < 4; ++c4) {
                    const unsigned ta = tot[(v * 8 + 2 * c4) * 512 + tid], tb = tot[(v * 8 + 2 * c4 + 1) * 512 + tid];
                    const float r0 = bf2f(ta & 0xffffu) + sc * o[v][4 * c4 + 0], r1 = bf2f(ta >> 16) + sc * o[v][4 * c4 + 1];
                    const float r2 = bf2f(tb & 0xffffu) + sc * o[v][4 * c4 + 2], r3 = bf2f(tb >> 16) + sc * o[v][4 * c4 + 3];
                    u32x2 ov; ov.x = cvt_pk_bf16(r0, r1); ov.y = cvt_pk_bf16(r2, r3);
                    *(u32x2*)(orow + 32 * v + 8 * c4 + 4 * h) = ov;
                }
        }
        if (ctr_idx == 0) {
            __syncthreads();
            for (int k = 0; k < 3; ++k) {
                int item = 0;
                if (lane == 0) item = (int)atomicAdd(trc, 1u);
                item = __builtin_amdgcn_readfirstlane(item);
                if (item >= MOE_W_ITEMS) break;
                moe_weight_item(p, smem, item);
            }
        }
    }
    if (ctr_idx == 0) {
        __syncthreads();
        for (;;) {
            int item = 0;
            if ((threadIdx.x & 63) == 0) item = (int)atomicAdd(trc, 1u);
            item = __builtin_amdgcn_readfirstlane(item);
            if (item >= MOE_W_ITEMS) break;
            moe_weight_item(p, smem, item);
        }
    }
}

template <int which>
DEVI void phase_ln(const Params& p) {
    unsigned char* ws = p.ws;
    int tid = threadIdx.x; asm volatile("" : "+v"(tid));
    const int lane = tid & 63, w = tid >> 6;
    for (int it = blockIdx.x; it < T_ / 8; it += gridDim.x) {
        const int t = it * 8 + w;
        float* row = p.out + (size_t)t * D_;
        f32x4 v[8]; row_load(row, lane, v);
        float mean, rstd; row_stats(v, mean, rstd);
        if (which == 0) {
            if (lane == 0) { float* st = (float*)(ws + WS_STATS); st[t * 2] = mean; st[t * 2 + 1] = rstd; }
            bf16_t* hi = (bf16_t*)(ws + WS_BUFB) + (size_t)t * D_;
#pragma unroll
            for (int c = 0; c < 8; ++c) {
                const int col = c * 256 + lane * 4;
                const f32x4 g = *(const f32x4*)(p.in[17] + col), b = *(const f32x4*)(p.in[18] + col);
                const f32x4 y = (v[c] - mean) * rstd * g + b;
                u32x2 o; o.x = cvt_pk_bf16(y.x, y.y); o.y = cvt_pk_bf16(y.z, y.w);
                *(u32x2*)(hi + col) = o;
            }
        } else if (which == 1) {
            bf16_t* hi = (bf16_t*)(ws + WS_BUFA) + (size_t)t * D_;
            bf16_t* lo = (bf16_t*)(ws + WS_BUFB) + (size_t)t * D_;
#pragma unroll
            for (int c = 0; c < 8; ++c) {
                const int col = c * 256 + lane * 4;
                const f32x4 g = *(const f32x4*)(p.in[24] + col), b = *(const f32x4*)(p.in[25] + col);
                const f32x4 y = (v[c] - mean) * rstd * g + b;
                u32x2 o; o.x = cvt_pk_bf16(y.x, y.y); o.y = cvt_pk_bf16(y.z, y.w);
                *(u32x2*)(hi + col) = o;
                u32x2 ol;
                ol.x = cvt_pk_bf16(y.x - bf2f(o.x & 0xffffu), y.y - bf2f(o.x >> 16));
                ol.y = cvt_pk_bf16(y.z - bf2f(o.y & 0xffffu), y.w - bf2f(o.y >> 16));
                *(u32x2*)(lo + col) = ol;
            }
        } else {
            const bf16_t* y0 = (const bf16_t*)(ws + WS_BUFC) + (size_t)t * 2 * D_;
#pragma unroll
            for (int c = 0; c < 8; ++c) {
                const int col = c * 256 + lane * 4;
                const f32x4 g = *(const f32x4*)(p.in[24] + col), b = *(const f32x4*)(p.in[25] + col);
                const f32x4 x2 = (v[c] - mean) * rstd * g + b;
                const u32x2 a = *(const u32x2*)(y0 + col), bq = *(const u32x2*)(y0 + D_ + col);
                v[c].x = x2.x * ALPHA + (bf2f(a.x & 0xffffu) + bf2f(bq.x & 0xffffu));
                v[c].y = x2.y * ALPHA + (bf2f(a.x >> 16) + bf2f(bq.x >> 16));
                v[c].z = x2.z * ALPHA + (bf2f(a.y & 0xffffu) + bf2f(bq.y & 0xffffu));
                v[c].w = x2.w * ALPHA + (bf2f(a.y >> 16) + bf2f(bq.y >> 16));
            }
            row_stats(v, mean, rstd);
#pragma unroll
            for (int c = 0; c < 8; ++c) {
                const int col = c * 256 + lane * 4;
                const f32x4 g = *(const f32x4*)(p.in[33] + col), b = *(const f32x4*)(p.in[34] + col);
                *(f32x4*)(row + col) = (v[c] - mean) * rstd * g + b;
            }
        }
    }
}

DEVI void phase_xattn(const Params& p, char* smem) {
    unsigned char* ws = p.ws;
    int tid = threadIdx.x; asm volatile("" : "+v"(tid));
    const int lane = tid & 63, w = tid >> 6, l31 = lane & 31, h = lane >> 5;
    const bf16_t* Qx = (const bf16_t*)(ws + WS_BUFC);
    const bf16_t* Kx = (const bf16_t*)(ws + WS_BUFD + 4 * MiB);
    const bf16_t* Vt = (const bf16_t*)(ws + WS_BUFD + 8 * MiB);
    bf16_t* Ox = (bf16_t*)(ws + WS_BUFA);
    bf16_t* Qs = (bf16_t*)smem;
    bf16_t* Ks = Qs + 256 * KSTR;
    bf16_t* Vs = (bf16_t*)smem;
    for (int unit = blockIdx.x; unit < 512; unit += gridDim.x) {
        const int qt = unit & 31, head = (unit >> 5) & 3, b = unit >> 7;
        const size_t t0 = (size_t)b * 8192 + qt * 256;
        const bf16_t* kbase = Kx + (size_t)(b * 4 + head) * 256 * 512;
        const bf16_t* vbase = Vt + (size_t)(b * 4 + head) * 512 * 256;
        f32x16 s[8];
#pragma unroll
        for (int u = 0; u < 8; ++u)
#pragma unroll
            for (int i = 0; i < 16; ++i) s[u][i] = 0.f;
        u32x4 pq[4], pk4[4];
#pragma unroll
        for (int i = 0; i < 4; ++i) { const int c = tid + 512 * i, row = c >> 3, ch = c & 7;
            pq[i] = *(const u32x4*)(Qx + (t0 + row) * 2048 + head * 512 + ch * 8); pk4[i] = *(const u32x4*)(kbase + (size_t)row * 512 + ch * 8); }
        for (int dc = 0; dc < 8; ++dc) {
            __syncthreads();
#pragma unroll
            for (int i = 0; i < 4; ++i) { const int c = tid + 512 * i, row = c >> 3, ch = c & 7;
                *(u32x4*)(Qs + row * KSTR + ch * 8) = pq[i]; *(u32x4*)(Ks + row * KSTR + ch * 8) = pk4[i]; }
            __syncthreads();
            if (dc + 1 < 8) {
#pragma unroll
                for (int i = 0; i < 4; ++i) { const int c = tid + 512 * i, row = c >> 3, ch = c & 7;
                    pq[i] = *(const u32x4*)(Qx + (t0 + row) * 2048 + head * 512 + (dc + 1) * 64 + ch * 8); pk4[i] = *(const u32x4*)(kbase + (size_t)row * 512 + (dc + 1) * 64 + ch * 8); }
            }
#pragma unroll
            for (int ks = 0; ks < 4; ++ks) {
                const bf16x8 qb = *(const bf16x8*)(Qs + (32 * w + l31) * KSTR + 16 * ks + 8 * h);
#pragma unroll
                for (int u = 0; u < 8; ++u) { const bf16x8 ka = *(const bf16x8*)(Ks + (32 * u + l31) * KSTR + 16 * ks + 8 * h); s[u] = mfma32(ka, qb, s[u]); }
            }
        }
        u32x4 pv[4];
#pragma unroll
        for (int i = 0; i < 4; ++i) { const int c = tid + 512 * i, row = c >> 5, ch = c & 31; pv[i] = *(const u32x4*)(vbase + (size_t)row * 256 + ch * 8); }
        float mx = -INFINITY;
#pragma unroll
        for (int u = 0; u < 8; ++u)
#pragma unroll
            for (int i = 0; i < 16; i += 2) mx = max3f(mx, s[u][i], s[u][i + 1]);
        mx = fmaxf(mx, __shfl_xor(mx, 32));
        float ls = 0.f;
        bf16x8 pf[8][2];
#pragma unroll
        for (int u = 0; u < 8; ++u) {
#pragma unroll
            for (int i = 0; i < 16; ++i) { s[u][i] = fexp2(s[u][i] - mx); ls += s[u][i]; }
#pragma unroll
            for (int sI = 0; sI < 2; ++sI) { u32x4 pk;
                pk.x = cvt_pk_bf16(s[u][8 * sI + 0], s[u][8 * sI + 1]); pk.y = cvt_pk_bf16(s[u][8 * sI + 2], s[u][8 * sI + 3]);
                pk.z = cvt_pk_bf16(s[u][8 * sI + 4], s[u][8 * sI + 5]); pk.w = cvt_pk_bf16(s[u][8 * sI + 6], s[u][8 * sI + 7]);
                pf[u][sI] = __builtin_bit_cast(bf16x8, pk); }
        }
        ls += __shfl_xor(ls, 32);
        const float inv = (PROBE == 4 ? 0.f : 1.f) / ls;
        bf16_t* orow = Ox + (t0 + 32 * w + l31) * 2048 + head * 512;
        for (int dc = 0; dc < 8; ++dc) {
            __syncthreads();
#pragma unroll
            for (int i = 0; i < 4; ++i) { const int c = tid + 512 * i, row = c >> 5, ch = c & 31; *(u32x4*)(Vs + row * 264 + ch * 8) = pv[i]; }
            __syncthreads();
            if (dc + 1 < 8) {
#pragma unroll
                for (int i = 0; i < 4; ++i) { const int c = tid + 512 * i, row = c >> 5, ch = c & 31; pv[i] = *(const u32x4*)(vbase + (size_t)((dc + 1) * 64 + row) * 256 + ch * 8); }
            }
            f32x16 o[2];
#pragma unroll
            for (int v = 0; v < 2; ++v)
#pragma unroll
                for (int i = 0; i < 16; ++i) o[v][i] = 0.f;
#pragma unroll
            for (int s4 = 0; s4 < 16; ++s4)
#pragma unroll
                for (int v = 0; v < 2; ++v) {
                    const bf16_t* vr = Vs + (32 * v + l31) * 264 + 16 * s4 + 4 * h;
                    const u32x2 a = *(const u32x2*)vr, bq = *(const u32x2*)(vr + 8);
                    u32x4 vv; vv.x = a.x; vv.y = a.y; vv.z = bq.x; vv.w = bq.y;
                    o[v] = mfma32(__builtin_bit_cast(bf16x8, vv), pf[s4 >> 1][s4 & 1], o[v]);
                }
#pragma unroll
            for (int v = 0; v < 2; ++v)
#pragma unroll
                for (int c4 = 0; c4 < 4; ++c4) {
                    u32x2 ov; ov.x = cvt_pk_bf16(o[v][4 * c4] * inv, o[v][4 * c4 + 1] * inv); ov.y = cvt_pk_bf16(o[v][4 * c4 + 2] * inv, o[v][4 * c4 + 3] * inv);
                    *(u32x2*)(orow + dc * 64 + 32 * v + 8 * c4 + 4 * h) = ov;
                }
        }
        __syncthreads();
    }
}

DEVI void phase_route(const Params& p) {
    unsigned char* ws = p.ws;
    const float* L = (const float*)(ws + WS_LOGITS);
    unsigned* cnt = (unsigned*)(ws + WS_CTL) + CW_CNT;
    int* list = (int*)(ws + WS_LIST);
    float* wt = (float*)(ws + WS_WTOK);
    int tid = threadIdx.x; asm volatile("" : "+v"(tid));
    for (int t = blockIdx.x * NTHREADS + tid; t < T_; t += gridDim.x * NTHREADS) {
        const f32x4 lgv = *(const f32x4*)(L + (size_t)t * 40);
        float lg[4] = {lgv.x + p.in[27][0], lgv.y + p.in[27][1], lgv.z + p.in[27][2], lgv.w + p.in[27][3]};
        int grp = 0; float best = lg[0];
#pragma unroll
        for (int i = 1; i < 4; ++i) if (lg[i] > best) { best = lg[i]; grp = i; }
        float se = 0.f;
#pragma unroll
        for (int i = 0; i < 4; ++i) se += expf(lg[i] - best);
        const float wgrp = 1.f / se;
        const f32x4 e0 = *(const f32x4*)(L + (size_t)t * 40 + 4 + grp * 8), e1 = *(const f32x4*)(L + (size_t)t * 40 + 8 + grp * 8);
        const f32x4 b0 = *(const f32x4*)(p.in[29] + grp * 8), b1 = *(const f32x4*)(p.in[29] + grp * 8 + 4);
        float le[8] = {e0.x + b0.x, e0.y + b0.y, e0.z + b0.z, e0.w + b0.w, e1.x + b1.x, e1.y + b1.y, e1.z + b1.z, e1.w + b1.w};
        int i0 = 0; float v0 = le[0];
#pragma unroll
        for (int i = 1; i < 8; ++i) if (le[i] > v0) { v0 = le[i]; i0 = i; }
        int i1 = -1; float v1 = -INFINITY;
#pragma unroll
        for (int i = 0; i < 8; ++i) if (i != i0 && le[i] > v1) { v1 = le[i]; i1 = i; }
        const float ex = expf(v1 - v0);
        const float w0 = wgrp / (1.f + ex), w1 = wgrp * ex / (1.f + ex);
        const int ea = grp * 8 + i0, eb = grp * 8 + i1;
        const unsigned pa = atomicAdd(cnt + ea, 1u); list[(size_t)ea * T_ + pa] = t * 2;
        const unsigned pb = atomicAdd(cnt + eb, 1u); list[(size_t)eb * T_ + pb] = t * 2 + 1;
        wt[t * 2] = w0; wt[t * 2 + 1] = w1;
    }
}

enum { PH_PREP = 0, PH_PROJ, PH_CMP1, PH_CMP2, PH_NSA, PH_OUT, PH_LN1, PH_WQ, PH_XATTN, PH_WO, PH_LN2, PH_ROUTER, PH_ROUTE, PH_MOE1, PH_MOE2, PH_LN3, PH_COUNT };

__global__ void __launch_bounds__(NTHREADS, 2) fwd_megakernel(Params p) {
    extern __shared__ __attribute__((aligned(16))) char smem[];
    cg::grid_group grid = cg::this_grid();
    volatile LAS unsigned* bar_st = (volatile LAS unsigned*)(smem + LDS_BYTES - 16);
    if (threadIdx.x < 2) bar_st[threadIdx.x] = 0u;
    __syncthreads();
    xcd_barrier_post((unsigned*)(p.ws + WS_CTL) + CW_BAR);
    const int lo = p.ph_lo, hi = p.ph_hi;
    unsigned long long ts0 = 0, ts1 = 0;
    if (TSTAMP_PHASE >= 0) ts0 = __builtin_amdgcn_s_memrealtime();
#ifndef PHMASK
#define PHMASK 0xFFFFFFFFu
#endif
#define IN(k) (lo <= (k) && (k) < hi && ((PHMASK >> (k)) & 1u))
#define SEAM(k) do { if (IN(k) && IN((k) + 1)) { if ((k) == 0) grid.sync(); else xcd_barrier((unsigned*)(p.ws + WS_CTL) + CW_BAR, (volatile LAS unsigned*)(smem + LDS_BYTES - 16)); } if ((k) == TSTAMP_PHASE) ts1 = __builtin_amdgcn_s_memrealtime(); } while (0)
    if (IN(PH_PREP)) for (int r = 0; r < REP_PREP; ++r) phase_prep(p, smem);
    SEAM(PH_PREP);
    if (IN(PH_PROJ)) { for (int r = 0; r < REP_PROJ; ++r) gemm_job<J_PROJ>(p, smem); for (int r = 0; r < REP_SMALL; ++r) gemm_job<J_MEMKV>(p, smem); }
    SEAM(PH_PROJ);
    if (IN(PH_CMP1)) { for (int r = 0; r < REP_SMALL; ++r) gemm_job<J_CMP1>(p, smem); for (int r = 0; r < REP_CONV; ++r) phase_conv(p); }
    SEAM(PH_CMP1);
    if (IN(PH_CMP2)) for (int r = 0; r < REP_SMALL; ++r) gemm_job<J_CMP2>(p, smem);
    SEAM(PH_CMP2);
    if (IN(PH_NSA)) { conv_finish(p); for (int r = 0; r < REP_NSA; ++r) phase_nsa(p, smem, r); }
    SEAM(PH_NSA);
    if (IN(PH_OUT)) for (int r = 0; r < REP_OUT; ++r) gemm_job<J_OUT>(p, smem);
    SEAM(PH_OUT);
    if (IN(PH_WQ)) { gemm_job<J_WQ>(p, smem); for (int r = 1; r < REP_WQ; ++r) gemm_job<J_WQ, WQ_VAR>(p, smem); }
    SEAM(PH_WQ);
    if (IN(PH_XATTN)) for (int r = 0; r < REP_XATTN; ++r) phase_xattn(p, smem);
    SEAM(PH_XATTN);
    if (IN(PH_WO)) gemm_job<J_WO>(p, smem);
    SEAM(PH_WO);
    if (IN(PH_LN2)) phase_ln<1>(p);
    SEAM(PH_LN2);
    if (IN(PH_ROUTER)) for (int r = 0; r < REP_SMALL; ++r) gemm_job<J_ROUTER>(p, smem);
    SEAM(PH_ROUTER);
    if (IN(PH_MOE1)) for (int r = 0; r < REP_MOE; ++r) gemm_job<J_MOE1>(p, smem);
    SEAM(PH_MOE1);
    if (IN(PH_MOE2)) for (int r = 0; r < REP_MOE; ++r) gemm_job<J_MOE2>(p, smem);
    SEAM(PH_MOE2);
    if (IN(PH_LN3)) phase_ln<2>(p);
    if (TSTAMP_PHASE >= 0 && blockIdx.x == 0 && threadIdx.x == 0) { const unsigned long long t2 = __builtin_amdgcn_s_memrealtime(); const unsigned long long wait = 4ull * (ts1 - ts0); while (__builtin_amdgcn_s_memrealtime() - t2 < wait) __builtin_amdgcn_s_sleep(32); }
#undef IN
#undef SEAM
}

#ifndef N_SPLIT
#define N_SPLIT 1
#endif

extern "C" void kernel_launch(void* const* d_in, const int* in_sizes, int n_in, void* d_out, int out_size, void* d_ws, size_t ws_size, hipStream_t stream) {
    static int grid_blocks = 0;
    if (grid_blocks == 0) {
        if (n_in != 35 || ws_size < WS_END || out_size != T_ * D_) { fprintf(stderr, "kernel_launch: unexpected sizes n_in %d ws %zu out %d\n", n_in, ws_size, out_size); grid_blocks = -1; return; }
        int dev = 0, cus = 0, per_cu = 0;
        hipGetDevice(&dev);
        hipDeviceGetAttribute(&cus, hipDeviceAttributeMultiprocessorCount, dev);
        hipFuncSetAttribute((const void*)fwd_megakernel, hipFuncAttributeMaxDynamicSharedMemorySize, LDS_BYTES);
        hipOccupancyMaxActiveBlocksPerMultiprocessor(&per_cu, (const void*)fwd_megakernel, NTHREADS, LDS_BYTES);
        if (per_cu < 1) { fprintf(stderr, "kernel_launch: occupancy query says %d blocks per CU\n", per_cu); grid_blocks = -1; return; }
        if (per_cu > 2) per_cu = 2;
        grid_blocks = cus * per_cu;
        fprintf(stderr, "kernel_launch: %d CUs x %d blocks\n", cus, per_cu);
    }
    if (grid_blocks < 0) return;
    hipMemsetAsync((char*)d_ws + WS_CTL, 0, 1 * MiB, stream);
    hipMemsetAsync((char*)d_ws + WS_RSUM1, 0, 1 * MiB, stream);
    Params p{};
    for (int i = 0; i < 35; ++i) p.in[i] = (const float*)d_in[i];
    p.out = (float*)d_out; p.ws = (unsigned char*)d_ws;
    if (N_SPLIT == 1) {
        p.ph_lo = 0; p.ph_hi = PH_COUNT;
        void* args[] = {&p};
        hipError_t e = hipLaunchCooperativeKernel((const void*)fwd_megakernel, dim3(grid_blocks), dim3(NTHREADS), args, LDS_BYTES, stream);
        if (e != hipSuccess) fprintf(stderr, "cooperative launch failed: %s (grid %d)\n", hipGetErrorString(e), grid_blocks);
    } else {
        for (int ph = 0; ph < PH_COUNT; ++ph) {
            p.ph_lo = ph; p.ph_hi = ph + 1;
            void* args[] = {&p};
            hipError_t e = hipLaunchCooperativeKernel((const void*)fwd_megakernel, dim3(grid_blocks), dim3(NTHREADS), args, LDS_BYTES, stream);
            if (e != hipSuccess) fprintf(stderr, "launch %d failed: %s\n", ph, hipGetErrorString(e));
        }
    }
}
```

```cpp
#include <hip/hip_runtime.h>
#include <hip/hip_cooperative_groups.h>
#include <cstdio>
#include <cstdint>
namespace cg = cooperative_groups;

#define DEVI __device__ __forceinline__
#ifndef REP_PREP
#define REP_PREP 1
#define REP_PROJ 1
#define REP_NSA 1
#define REP_WQ 1
#define WQ_VAR 3
#define REP_XATTN 1
#define REP_MOE 1
#define REP_LN3 1
#define REP_CONV 1
#define REP_OUT 1
#define REP_SMALL 1
#endif
#ifndef NSA_REP_MODE
#define NSA_REP_MODE 0
#endif
#ifndef TSTAMP_PHASE
#define TSTAMP_PHASE -1
#endif
#ifndef PROBE
#define PROBE 0
#endif
typedef unsigned short bf16_t;
typedef __attribute__((ext_vector_type(8))) short bf16x8;
typedef __attribute__((ext_vector_type(4))) float f32x4;
typedef __attribute__((ext_vector_type(16))) float f32x16;
typedef __attribute__((ext_vector_type(4))) unsigned u32x4;
typedef __attribute__((ext_vector_type(2))) unsigned u32x2;

constexpr int T_ = 32768, D_ = 2048, S_ = 8192, NB_ = 4;
constexpr int NPROJ = 4736;
constexpr int IN_COLS = 4656;
constexpr float ALPHA = 1.189207115002721f;
constexpr float LOG2E = 1.4426950408889634f;
constexpr float LN_EPS = 1e-5f;
constexpr int NTHREADS = 512;
constexpr int LDS_BYTES = 147968;

constexpr size_t MiB = 1ull << 20;
constexpr size_t WS_CTL = 0;
constexpr size_t WS_STATS = 1 * MiB;
constexpr size_t WS_C1BIAS = WS_STATS + 256 * 1024;
constexpr size_t WS_WTOK = WS_STATS + 512 * 1024;
constexpr size_t WS_LOGITS = 2 * MiB;
constexpr size_t WS_LIST = 7 * MiB;
constexpr size_t WS_WC1 = 11 * MiB;
constexpr size_t WS_WC2 = 13 * MiB;
constexpr size_t WS_WR = 14 * MiB;
constexpr size_t WS_WIN = 15 * MiB;
constexpr size_t WS_WOUT = 34 * MiB;
constexpr size_t WS_WQ = 42 * MiB;
constexpr size_t WS_WKV = 50 * MiB;
constexpr size_t WS_WO = 66 * MiB;
constexpr size_t WS_WGU = 74 * MiB;
constexpr size_t WS_WD = 202 * MiB;
constexpr size_t WS_BUFA = 266 * MiB;
constexpr size_t WS_BUFB = 394 * MiB;
constexpr size_t WS_BUFC = 522 * MiB;
constexpr size_t WS_BUFD = 650 * MiB;
constexpr size_t WS_BUFE = 778 * MiB;
constexpr size_t WS_END = 906 * MiB;
constexpr size_t C_KCMP = 0, C_VCMP = 16 * MiB, C_KS = 32 * MiB, C_VST = 48 * MiB, C_KW = 64 * MiB, C_VWT = 80 * MiB,
                 C_GATES = 96 * MiB, C_HID = 102 * MiB, C_KC = 110 * MiB, C_VCT = 111 * MiB;
constexpr int CW_CNT = 64;
constexpr int CW_NSA = 1024;
constexpr int CW_TR = 2048;
constexpr int CW_BAR = 4096;
constexpr size_t CTL_U1 = 65536, CTL_C1 = 73728;
constexpr size_t WS_RSUM1 = WS_LOGITS;

struct Params {
    const float* in[35];
    float* out;
    unsigned char* ws;
    int ph_lo, ph_hi;
};

DEVI unsigned cvt_pk_bf16(float lo, float hi) { unsigned r; asm("v_cvt_pk_bf16_f32 %0, %1, %2" : "=v"(r) : "v"(lo), "v"(hi)); return r; }
DEVI bf16_t f2bf(float x) { return (bf16_t)(cvt_pk_bf16(x, 0.f) & 0xffffu); }
DEVI float bf2f(unsigned b) { return __uint_as_float(b << 16); }
DEVI void glds16(const void* g, void* l) {
    __builtin_amdgcn_global_load_lds((const __attribute__((address_space(1))) void*)g, (__attribute__((address_space(3))) void*)l, 16, 0, 0);
}
DEVI f32x16 mfma32(bf16x8 a, bf16x8 b, f32x16 c) { return __builtin_amdgcn_mfma_f32_32x32x16_bf16(a, b, c, 0, 0, 0); }
DEVI u32x2 gload8_asm(const void* g) { u32x2 r; asm volatile("global_load_dwordx2 %0, %1, off" : "=v"(r) : "v"(g) : "memory"); return r; }
DEVI f32x4 gload16_asm(const void* g) { f32x4 r; asm volatile("global_load_dwordx4 %0, %1, off" : "=v"(r) : "v"(g) : "memory"); return r; }
DEVI f32x4 mfma16(bf16x8 a, bf16x8 b, f32x4 c) { return __builtin_amdgcn_mfma_f32_16x16x32_bf16(a, b, c, 0, 0, 0); }
DEVI float fexp2(float x) { return __builtin_amdgcn_exp2f(x); }
DEVI float max3f(float a, float b, float c) { float r; asm("v_max3_f32 %0, %1, %2, %3" : "=v"(r) : "v"(a), "v"(b), "v"(c)); return r; }
DEVI float wave_sum(float v) {
#pragma unroll
    for (int o = 1; o < 64; o <<= 1) v += __shfl_xor(v, o);
    return v;
}
DEVI float sigmoidf_(float x) { return 1.f / (1.f + __expf(-x)); }
DEVI float gelu_tanh(float x) {
    const float u = 0.7978845608028654f * (x + 0.044715f * x * x * x);
    const float e = __expf(2.f * u);
    const float th = 1.f - 2.f / (e + 1.f);
    return 0.5f * x * (1.f + th);
}

#define LAS __attribute__((address_space(3)))
#define XB_TMO      128
#define XB_XCNT(j)  (256  + 64 * (j))
#define XB_XSUB(j)  (1280 + 64 * (j))
#define XB_XGEN(j)  (2304 + 64 * (j))
#define XB_TOP      3328
#define XB_TOPGEN   3392
#define XB_SPIN_CAP (1u << 22)
DEVI unsigned xb_ld(unsigned* p) { return __hip_atomic_load(p, __ATOMIC_RELAXED, __HIP_MEMORY_SCOPE_AGENT); }
DEVI unsigned xb_add(unsigned* p, unsigned v) { return __hip_atomic_fetch_add(p, v, __ATOMIC_RELAXED, __HIP_MEMORY_SCOPE_AGENT); }
DEVI unsigned xb_xcc_id() { return (unsigned)__builtin_amdgcn_s_getreg((3 << 11) | 20) & 0xFu; }
#define XB_SPIN(cond, bar) do { unsigned _sp = 0; while (cond) { __builtin_amdgcn_s_sleep(1); \
    if ((++_sp & 255u) == 0u) { if (xb_ld(&(bar)[XB_TMO])) break; if (_sp > XB_SPIN_CAP) { atomicAdd(&(bar)[XB_TMO], 1u); break; } } } } while (0)
DEVI void xcd_barrier_post(unsigned* bar) {
    if (threadIdx.x == 0) (void)xb_add(&bar[XB_XCNT(xb_xcc_id())], 1u);
}
DEVI void xcd_barrier_complete(unsigned* bar, unsigned x, unsigned& nloc, unsigned& nx) {
    const unsigned G = gridDim.x * gridDim.y * gridDim.z;
    unsigned sum, cnt, mine, sp = 0u;
    for (;;) {
        sum = 0u; cnt = 0u; mine = 0u;
#pragma unroll
        for (unsigned j = 0; j < 16; ++j) { const unsigned c = xb_ld(&bar[XB_XCNT(j)]); sum += c; cnt += (c > 0u) ? 1u : 0u; mine = (j == x) ? c : mine; }
        if (sum == G) break;
        __builtin_amdgcn_s_sleep(1);
        if ((++sp & 255u) == 0u) { if (xb_ld(&bar[XB_TMO])) break; if (sp > XB_SPIN_CAP) { atomicAdd(&bar[XB_TMO], 1u); break; } }
    }
    nloc = mine > 0u ? mine : 1u; nx = cnt > 0u ? cnt : 1u;
}
DEVI void xcd_barrier(unsigned* bar, volatile LAS unsigned* st) {
    asm volatile("s_waitcnt vmcnt(0)" ::: "memory");
    __syncthreads();
    if (threadIdx.x == 0) {
        const unsigned x = xb_xcc_id();
        __builtin_amdgcn_s_waitcnt(0);
        unsigned nloc = st[0], nx = st[1];
        if (nloc == 0u) { xcd_barrier_complete(bar, x, nloc, nx); st[0] = nloc; st[1] = nx; }
        const unsigned old = xb_add(&bar[XB_XSUB(x)], 1u);
        const unsigned gen = old / nloc;
        if (old + 1u == (gen + 1u) * nloc) {
            __builtin_amdgcn_fence(__ATOMIC_RELEASE, "agent");
            asm volatile("s_waitcnt vmcnt(0)" ::: "memory");
            const unsigned og = xb_add(&bar[XB_TOP], 1u);
            const unsigned tg = og / nx;
            if (og + 1u == (tg + 1u) * nx) xb_add(&bar[XB_TOPGEN], 1u);
            else XB_SPIN(xb_ld(&bar[XB_TOPGEN]) == tg, bar);
            __builtin_amdgcn_fence(__ATOMIC_ACQUIRE, "agent");
            xb_add(&bar[XB_XGEN(x)], 1u);
            asm volatile("s_waitcnt vmcnt(0)" ::: "memory");
        } else {
            XB_SPIN(xb_ld(&bar[XB_XGEN(x)]) == gen, bar);
            __builtin_amdgcn_fence(__ATOMIC_ACQUIRE, "agent");
            asm volatile("s_waitcnt vmcnt(0)" ::: "memory");
        }
    }
    __syncthreads();
}

DEVI void row_load(const float* row, int lane, f32x4 (&v)[8]) {
#pragma unroll
    for (int c = 0; c < 8; ++c) v[c] = *(const f32x4*)(row + c * 256 + lane * 4);
}
DEVI void row_stats(const f32x4 (&v)[8], float& mean, float& rstd) {
    float s = 0.f;
#pragma unroll
    for (int c = 0; c < 8; ++c) s += (v[c].x + v[c].y) + (v[c].z + v[c].w);
    mean = wave_sum(s) * (1.f / D_);
    float q = 0.f;
#pragma unroll
    for (int c = 0; c < 8; ++c) { const f32x4 d = v[c] - mean; q += (d.x * d.x + d.y * d.y) + (d.z * d.z + d.w * d.w); }
    rstd = 1.f / sqrtf(wave_sum(q) * (1.f / D_) + LN_EPS);
}

DEVI const float* wsrc_col(const Params& p, int mat, int e, int n, int& ld) {
    switch (mat) {
    case 0: {
        ld = IN_COLS;
        if (n < 2560) return p.in[4] + n;
        if (n < 2688) { const int j = n - 2560; return j < 48 ? p.in[4] + 2560 + j : nullptr; }
        const int r = n - 2688, grp = r >> 6, within = r & 63;
        const int ch = grp * 32 + (within & 31), isg = within >> 5;
        return p.in[4] + 2608 + isg * 1024 + ch;
    }
    case 1: ld = 256; return p.in[6] + n;
    case 2: ld = 256; return p.in[9] + n;
    case 3: ld = 64; return n < 64 ? p.in[7] + n : nullptr;
    case 4: ld = 64; return n < 64 ? p.in[10] + n : nullptr;
    case 5: ld = 2048; return p.in[16] + n;
    case 6: ld = 2048; return p.in[21] + n;
    case 7: ld = 4096; return p.in[22] + n;
    case 8: ld = 2048; return p.in[23] + n;
    case 9: if (n < 4) { ld = 4; return p.in[26] + n; } if (n < 36) { ld = 32; return p.in[28] + (n - 4); } ld = 1; return nullptr;
    case 10: { ld = 512; const int grp = n >> 6, within = n & 63; const int ch = grp * 32 + (within & 31);
               return ((within >> 5) ? p.in[31] : p.in[30]) + (size_t)e * 2048 * 512 + ch; }
    default: ld = 2048; return p.in[32] + (size_t)e * 512 * 2048 + n;
    }
}
DEVI void wave_transpose_item(const Params& p, char* smem, int mat, int e, int ntile, int ktile, bf16_t* dst, bf16_t* dst_lo, int K,
                                const float* gvec = nullptr, const float* bvec = nullptr, float* U = nullptr, float* C = nullptr) {
    int tid = threadIdx.x; asm volatile("" : "+v"(tid));
    const int lane = tid & 63, w = tid >> 6;
    float* tile = (float*)smem + w * (64 * 65 + 32);
    const int k0 = ktile * 64;
    if (mat == 9) {
        int ld; const float* src = wsrc_col(p, mat, e, ntile * 64 + lane, ld);
#pragma unroll 8
        for (int k = 0; k < 64; ++k) tile[k * 65 + lane] = src ? src[(size_t)(k0 + k) * ld] : 0.f;
    } else {
        const int c4 = lane & 15, kr = lane >> 4;
        int ld; const float* src = wsrc_col(p, mat, e, ntile * 64 + c4 * 4, ld);
        f32x4 v[16];
#pragma unroll
        for (int i = 0; i < 16; ++i) v[i] = src ? *(const f32x4*)(src + (size_t)(k0 + kr + 4 * i) * ld) : (f32x4){0.f, 0.f, 0.f, 0.f};
#pragma unroll
        for (int i = 0; i < 16; ++i) { float* q = tile + (kr + 4 * i) * 65 + c4 * 4; q[0] = v[i].x; q[1] = v[i].y; q[2] = v[i].z; q[3] = v[i].w; }
    }
    asm volatile("s_waitcnt lgkmcnt(0)" ::: "memory");
    if (gvec) {
        float us = 0.f, cs = 0.f;
#pragma unroll 8
        for (int k = 0; k < 64; ++k) { const float wkn = tile[k * 65 + lane]; us += gvec[k0 + k] * wkn; cs += bvec[k0 + k] * wkn; }
        atomicAdd(U + ntile * 64 + lane, us); atomicAdd(C + ntile * 64 + lane, cs);
    }
    const int kc = lane & 7, nr = lane >> 3;
#pragma unroll
    for (int c = 0; c < 8; ++c) {
        const int n = nr + 8 * c;
        float wv[8];
#pragma unroll
        for (int j = 0; j < 8; ++j) wv[j] = tile[(kc * 8 + j) * 65 + n];
        if (gvec) {
#pragma unroll
            for (int j = 0; j < 8; ++j) wv[j] *= gvec[k0 + kc * 8 + j]; }
        u32x4 o; o.x = cvt_pk_bf16(wv[0], wv[1]); o.y = cvt_pk_bf16(wv[2], wv[3]); o.z = cvt_pk_bf16(wv[4], wv[5]); o.w = cvt_pk_bf16(wv[6], wv[7]);
        const size_t off = (size_t)(ntile * 64 + n) * K + k0 + kc * 8;
        if (!dst_lo) *(u32x4*)(dst + off) = o;
        else {
            float r[8];
#pragma unroll
            for (int j = 0; j < 8; ++j) r[j] = wv[j] - bf2f((unsigned)f2bf(wv[j]));
            u32x4 l; l.x = cvt_pk_bf16(r[0], r[1]); l.y = cvt_pk_bf16(r[2], r[3]); l.z = cvt_pk_bf16(r[4], r[5]); l.w = cvt_pk_bf16(r[6], r[7]);
            const size_t o0 = (size_t)n * K + k0 + kc * 8, o1 = (size_t)(64 + n) * K + k0 + kc * 8;
            if (ntile == 0) { *(u32x4*)(dst + o0) = o; *(u32x4*)(dst_lo + o0) = o; *(u32x4*)(dst + o1) = l; }
            else *(u32x4*)(dst_lo + o1) = (u32x4){0u, 0u, 0u, 0u};
        }
    }
    asm volatile("s_waitcnt lgkmcnt(0)" ::: "memory");
}

DEVI void phase_prep(const Params& p, char* smem) {
    int tid = threadIdx.x; asm volatile("" : "+v"(tid));
    const int lane = tid & 63, w = tid >> 6;
    unsigned char* ws = p.ws;
    for (int r = blockIdx.x; r < 8; r += gridDim.x) {
        const int type = r >> 2, n = (r & 3) * 64 + lane;
        const float* pe = p.in[type ? 8 : 5]; const float* w1 = p.in[type ? 9 : 6];
        float sacc = 0.f;
        for (int k = w * 256; k < (w + 1) * 256; ++k) sacc += pe[k] * w1[(size_t)k * 256 + n];
        float* red = (float*)smem;
        __syncthreads();
        red[w * 64 + lane] = sacc;
        __syncthreads();
        if (w == 0) ((float*)(ws + WS_C1BIAS))[type * 256 + n] = ((red[lane] + red[64 + lane]) + (red[128 + lane] + red[192 + lane])) + ((red[256 + lane] + red[320 + lane]) + (red[384 + lane] + red[448 + lane]));
        __syncthreads();
    }
    constexpr int I_LN = T_, I_MEM = 1024;
    constexpr int I_M0 = 74 * 32, I_M12 = 4 * 32, I_M34 = 2 * 4, I_SQ = 32 * 32, I_KV = 64 * 32, I_R = 2 * 32;
    constexpr int TOTAL = I_LN + I_MEM + I_M0 + 2 * I_M12 + 2 * I_M34 + 3 * I_SQ + I_KV + I_R;
    const int gw = blockIdx.x * 8 + w, NW = gridDim.x * 8;
    for (int it = gw; it < TOTAL; it += NW) {
        int r = it;
        if (r < I_LN) {
            const int t = r;
            f32x4 v[8]; row_load(p.in[0] + (size_t)t * D_, lane, v);
            float mean, rstd; row_stats(v, mean, rstd);
            bf16_t* hb = (bf16_t*)(ws + WS_BUFA) + (size_t)t * D_;
#pragma unroll
            for (int c = 0; c < 8; ++c) {
                const int col = c * 256 + lane * 4;
                const f32x4 g = *(const f32x4*)(p.in[2] + col), b = *(const f32x4*)(p.in[3] + col);
                const f32x4 y = (v[c] - mean) * rstd * g + b;
                u32x2 o; o.x = cvt_pk_bf16(y.x, y.y); o.y = cvt_pk_bf16(y.z, y.w);
                *(u32x2*)(hb + col) = o;
            }
            if (lane == 0) { float* st = (float*)(ws + WS_STATS); st[t * 2] = mean; st[t * 2 + 1] = rstd; }
            continue;
        }
        r -= I_LN;
        if (r < I_MEM) {
            const int t = r;
            f32x4 v[8]; row_load(p.in[1] + (size_t)t * D_, lane, v);
            float mean, rstd; row_stats(v, mean, rstd);
            bf16_t* hb = (bf16_t*)(ws + WS_BUFD) + (size_t)t * D_;
#pragma unroll
            for (int c = 0; c < 8; ++c) {
                const int col = c * 256 + lane * 4;
                const f32x4 g = *(const f32x4*)(p.in[19] + col), b = *(const f32x4*)(p.in[20] + col);
                const f32x4 y = (v[c] - mean) * rstd * g + b;
                u32x2 o; o.x = cvt_pk_bf16(y.x, y.y); o.y = cvt_pk_bf16(y.z, y.w);
                *(u32x2*)(hb + col) = o;
            }
            continue;
        }
        r -= I_MEM;
        if (r < I_M0) { wave_transpose_item(p, smem, 0, 0, r / 32, r % 32, (bf16_t*)(ws + WS_WIN), nullptr, 2048); continue; } r -= I_M0;
        if (r < I_M12) { wave_transpose_item(p, smem, 1, 0, r / 32, r % 32, (bf16_t*)(ws + WS_WC1), nullptr, 2048); continue; } r -= I_M12;
        if (r < I_M12) { wave_transpose_item(p, smem, 2, 0, r / 32, r % 32, (bf16_t*)(ws + WS_WC1) + 256 * 2048, nullptr, 2048); continue; } r -= I_M12;
        if (r < I_M34) { wave_transpose_item(p, smem, 3, 0, r / 4, r % 4, (bf16_t*)(ws + WS_WC2), nullptr, 256); continue; } r -= I_M34;
        if (r < I_M34) { wave_transpose_item(p, smem, 4, 0, r / 4, r % 4, (bf16_t*)(ws + WS_WC2) + 128 * 256, nullptr, 256); continue; } r -= I_M34;
        if (r < I_SQ) { wave_transpose_item(p, smem, 5, 0, r / 32, r % 32, (bf16_t*)(ws + WS_WOUT), nullptr, 2048); continue; } r -= I_SQ;
        if (r < I_SQ) { wave_transpose_item(p, smem, 6, 0, r / 32, r % 32, (bf16_t*)(ws + WS_WQ), nullptr, 2048, p.in[17], p.in[18], (float*)(ws + WS_CTL + CTL_U1), (float*)(ws + WS_CTL + CTL_C1)); continue; } r -= I_SQ;
        if (r < I_KV) { wave_transpose_item(p, smem, 7, 0, r / 32, r % 32, (bf16_t*)(ws + WS_WKV), nullptr, 2048); continue; } r -= I_KV;
        if (r < I_SQ) { wave_transpose_item(p, smem, 8, 0, r / 32, r % 32, (bf16_t*)(ws + WS_WO), nullptr, 2048); continue; } r -= I_SQ;
        wave_transpose_item(p, smem, 9, 0, r / 32, r % 32, (bf16_t*)(ws + WS_WR), (bf16_t*)(ws + WS_WR) + 128 * 2048, 2048);
    }
    __syncthreads();
}

constexpr int MOE_W_ITEMS = 32 * 16 * 32 + 32 * 32 * 8;
DEVI void moe_weight_item(const Params& p, char* smem, int r) {
    unsigned char* ws = p.ws;
    if (r < 32 * 16 * 32) { const int e = r / 512, q = r % 512; wave_transpose_item(p, smem, 10, e, q / 32, q % 32, (bf16_t*)(ws + WS_WGU) + (size_t)e * 1024 * 2048, nullptr, 2048); }
    else { r -= 32 * 16 * 32; const int e = r / 256, q = r % 256; wave_transpose_item(p, smem, 11, e, q / 8, q % 8, (bf16_t*)(ws + WS_WD) + (size_t)e * 2048 * 512, nullptr, 512); }
}

enum { J_PROJ = 0, J_MEMKV, J_CMP1, J_CMP2, J_OUT, J_WQ, J_WO, J_ROUTER, J_MOE1, J_MOE2 };
constexpr int GEMM_STAGE_BYTES = 49152;
constexpr int GEMM_TP = 3 * GEMM_STAGE_BYTES;

template <int job, int VAR = 0>
DEVI void gemm_job(const Params& p, char* smem) {
    unsigned char* ws = p.ws;
    int tid = threadIdx.x; asm volatile("" : "+v"(tid));
    const int lane = tid & 63, w = tid >> 6, wr = w >> 1, wc = w & 1, fr = lane & 15, fq = lane >> 4;
    const int srow = tid >> 3, schunk = (tid & 7) ^ ((tid >> 4) & 7);
    int* tp = (int*)(smem + GEMM_TP);
    int MT = 0, NT = 0, K = 2048, nseg = 1, ntiles = 0, RT = 0;
    switch (job) {
    case J_PROJ: MT = 128; NT = 37; break;
    case J_MEMKV: MT = 4; NT = 32; break;
    case J_CMP1: MT = 64; NT = 2; break;
    case J_CMP2: MT = 64; NT = 1; K = 256; break;
    case J_OUT: case J_WQ: case J_WO: MT = 128; NT = 16; break;
    case J_ROUTER: MT = 128; NT = 1; nseg = 2; break;
    default: break;
    }
    const unsigned* cntw = (const unsigned*)(ws + WS_CTL) + CW_CNT;
    if (job == J_MOE1 || job == J_MOE2) {
        __syncthreads();
        if (tid == 0) { int acc = 0; for (int e = 0; e < 32; ++e) { tp[e] = acc; const int c = (int)__hip_atomic_load(cntw + e, __ATOMIC_RELAXED, __HIP_MEMORY_SCOPE_AGENT); tp[33 + e] = c; acc += (c + 255) >> 8; } tp[32] = acc; }
        __syncthreads();
        RT = tp[32];
        NT = (job == J_MOE1) ? 8 : 16; K = (job == J_MOE1) ? 2048 : 512;
        { int mx = 0;
#pragma unroll
          for (int x = 0; x < 8; ++x) { int t = 0;
#pragma unroll
              for (int k = 0; k < 4; ++k) t += (tp[33 + x + 8 * k] + 255) >> 8;
              mx = t > mx ? t : mx; }
          ntiles = mx * NT * 8; }
    } else {
        const int nsr = (MT + 7) >> 3;
        ntiles = (MT < 64) ? MT * NT : ((nsr + 7) >> 3) * 8 * NT * 8;
    }
    int my_tp = 0, my_cnt = 0;
    if (job == J_MOE1 || job == J_MOE2) { my_tp = tp[lane & 31]; my_cnt = tp[33 + (lane & 31)]; }
    const int nk = K >> 6, ntot = nseg * nk;

    for (int ti = blockIdx.x; ti < ntiles; ti += gridDim.x) {
        int mt, nt, e = 0, rt = 0, ecnt = 0, etp = 0;
        if (job == J_MOE1 || job == J_MOE2) {
            const int x = ti & 7; int jj = ti >> 3; bool found = false; mt = 0; nt = 0;
#pragma unroll
            for (int k = 0; k < 4; ++k) {
                const int ee = x + 8 * k;
                const int c = __shfl(my_cnt, ee), rtc = (c + 255) >> 8, tot = rtc * NT;
                if (!found) { if (jj < tot) { found = true; e = ee; ecnt = c; etp = __shfl(my_tp, ee); const int per = 4 * rtc, ng = jj / per, r2 = jj - ng * per; nt = ng * 4 + r2 / rtc; rt = r2 - (r2 / rtc) * rtc; } else jj -= tot; }
            }
            if (!found) continue;
        } else {
            if (MT < 64) { nt = ti / MT; mt = ti - nt * MT; }
            else {
                const int x = ti & 7, jj = ti >> 3, per = 8 * NT, srl = jj / per, idx = jj - srl * per;
                mt = (srl * 8 + x) * 8 + (idx & 7); nt = idx >> 3;
                if (mt >= MT) continue;
            }
        }
        const bf16_t* ap[4]; const bf16_t* bp[2];
#pragma unroll
        for (int r = 0; r < 4; ++r) {
            const int row = r * 64 + srow;
            const bf16_t* a;
            switch (job) {
            case J_PROJ: a = (const bf16_t*)(ws + WS_BUFA) + (size_t)(mt * 256 + row) * 2048; break;
            case J_MEMKV: a = (const bf16_t*)(ws + WS_BUFD) + (size_t)(mt * 256 + row) * 2048; break;
            case J_CMP1: { const int gi = mt >> 1, i = (mt & 1) * 256 + row, ic = i < 510 ? i : 510; const int type = gi >> 4, bh = gi & 15;
                a = (const bf16_t*)(ws + WS_BUFC + (type ? C_VCMP : C_KCMP)) + ((size_t)bh * 8192 + 16 * ic) * 64; break; }
            case J_CMP2: a = (const bf16_t*)(ws + WS_BUFC + C_HID) + (size_t)(mt * 256 + row) * 256; break;
            case J_OUT: a = (const bf16_t*)(ws + WS_BUFE) + (size_t)(mt * 256 + row) * 2048; break;
            case J_WQ: a = (const bf16_t*)(ws + WS_BUFB) + (size_t)(mt * 256 + row) * 2048; break;
            case J_WO: a = (const bf16_t*)(ws + WS_BUFA) + (size_t)(mt * 256 + row) * 2048; break;
            case J_ROUTER: a = (const bf16_t*)(ws + WS_BUFA) + (size_t)(mt * 256 + row) * 2048; break;
            case J_MOE1: { int pos = rt * 256 + row; if (pos >= ecnt) pos = 0; const int aid = ((const int*)(ws + WS_LIST))[(size_t)e * T_ + pos];
                a = (const bf16_t*)(ws + WS_BUFA) + (size_t)(aid >> 1) * 2048; break; }
            default: a = (const bf16_t*)(ws + WS_BUFB) + (size_t)((etp + rt) * 256 + row) * 512; break;
            }
            ap[r] = a + schunk * 8;
        }
#pragma unroll
        for (int r = 0; r < 2; ++r) {
            const int row = r * 64 + srow;
            const bf16_t* b;
            switch (job) {
            case J_PROJ: b = (const bf16_t*)(ws + WS_WIN) + (size_t)(nt * 128 + row) * 2048; break;
            case J_MEMKV: b = (const bf16_t*)(ws + WS_WKV) + (size_t)(nt * 128 + row) * 2048; break;
            case J_CMP1: b = (const bf16_t*)(ws + WS_WC1) + (size_t)(mt >> 5) * 256 * 2048 + (size_t)(nt * 128 + row) * 2048; break;
            case J_CMP2: b = (const bf16_t*)(ws + WS_WC2) + (size_t)(mt >> 5) * 128 * 256 + (size_t)row * 256; break;
            case J_OUT: b = (const bf16_t*)(ws + WS_WOUT) + (size_t)(nt * 128 + row) * 2048; break;
            case J_WQ: b = (const bf16_t*)(ws + WS_WQ) + (size_t)(nt * 128 + row) * 2048; break;
            case J_WO: b = (const bf16_t*)(ws + WS_WO) + (size_t)(nt * 128 + row) * 2048; break;
            case J_ROUTER: b = (const bf16_t*)(ws + WS_WR) + (size_t)row * 2048; break;
            case J_MOE1: b = (const bf16_t*)(ws + WS_WGU) + (size_t)e * 1024 * 2048 + (size_t)(nt * 128 + row) * 2048; break;
            default: b = (const bf16_t*)(ws + WS_WD) + (size_t)e * 2048 * 512 + (size_t)(nt * 128 + row) * 512; break;
            }
            bp[r] = b + schunk * 8;
        }
        const long a_seg1 = (long)(WS_BUFB - WS_BUFA) / 2;
        const long b_seg2 = 128 * 2048;

        f32x4 acc[4][4];
#pragma unroll
        for (int i = 0; i < 4; ++i)
#pragma unroll
            for (int j = 0; j < 4; ++j) acc[i][j] = (f32x4){0.f, 0.f, 0.f, 0.f};

#define GEMM_STAGE(kt_) do { const int _kt = (kt_); int _seg = 0, _k0 = _kt << 6; if (nseg > 1) { _seg = _kt / nk; _k0 = (_kt - _seg * nk) << 6; } \
            const long _ao = (_seg == 1) ? a_seg1 : 0, _bo = (_seg == 1) ? b_seg2 : 0; \
            char* _A = smem + (_kt % 3) * GEMM_STAGE_BYTES; char* _B = _A + 32768; \
            _Pragma("unroll") for (int r = 0; r < 4; ++r) glds16(ap[r] + _ao + _k0, _A + (r * 512 + tid) * 16); \
            _Pragma("unroll") for (int r = 0; r < 2; ++r) glds16(bp[r] + _bo + _k0, _B + (r * 512 + tid) * 16); } while (0)

        u32x2 preb[16];
        if (job == J_OUT || job == J_WO) {
            const bf16_t* src = (const bf16_t*)(ws + (job == J_OUT ? WS_BUFA : WS_BUFB));
#pragma unroll
            for (int i = 0; i < 16; ++i) preb[i] = *(const u32x2*)(src + (size_t)(mt * 256 + (tid >> 5) + 16 * i) * D_ + nt * 128 + (tid & 31) * 4);
        }
        GEMM_STAGE(0);
        if (ntot > 1) GEMM_STAGE(1);
        for (int kt = 0; kt < ntot; ++kt) {
            if (kt + 1 < ntot) asm volatile("s_waitcnt vmcnt(6)" ::: "memory"); else asm volatile("s_waitcnt vmcnt(0)" ::: "memory");
            __builtin_amdgcn_s_barrier();
            asm volatile("" ::: "memory");
            if (kt + 2 < ntot && VAR != 1) GEMM_STAGE(kt + 2);
            if (VAR == 2) continue;
            const char* A = smem + (kt % 3) * GEMM_STAGE_BYTES; const char* B = A + 32768;
#pragma unroll
            for (int ks = 0; ks < 2; ++ks) {
                bf16x8 af[4], bfr[4];
                const int coff = ((4 * ks + fq) ^ (fr >> 1)) * 16;
#pragma unroll
                for (int i = 0; i < 4; ++i) {
                    af[i] = *(const bf16x8*)(A + (wr * 64 + i * 16 + fr) * 128 + coff);
                    bfr[i] = *(const bf16x8*)(B + (wc * 64 + i * 16 + fr) * 128 + coff);
                }
                __builtin_amdgcn_s_setprio(1);
#pragma unroll
                for (int i = 0; i < 4; ++i)
#pragma unroll
                    for (int j = 0; j < 4; ++j) acc[i][j] = mfma16(bfr[j], af[i], acc[i][j]);
                __builtin_amdgcn_s_setprio(0);
            }
        }
#undef GEMM_STAGE
        if (VAR != 0 && VAR != 4) { if (acc[0][0].x == 123.456f) p.out[0] = acc[1][1].y + acc[2][2].z + acc[3][3].w; __syncthreads(); continue; }
        asm volatile("s_waitcnt lgkmcnt(0)" ::: "memory"); __builtin_amdgcn_s_barrier(); asm volatile("" ::: "memory");
        float* ep = (float*)smem;
#pragma unroll
        for (int mi = 0; mi < 4; ++mi)
#pragma unroll
            for (int ni = 0; ni < 4; ++ni) *(f32x4*)(ep + (wr * 64 + mi * 16 + fr) * 132 + wc * 64 + ni * 16 + fq * 4) = acc[mi][ni];
        asm volatile("s_waitcnt lgkmcnt(0)" ::: "memory"); __builtin_amdgcn_s_barrier(); asm volatile("" ::: "memory");
        const int row0 = mt * 256, col0 = nt * 128;
#define EP8(row_, c8_, v0_, v1_) const f32x4 v0_ = *(const f32x4*)(ep + (row_) * 132 + (c8_) * 8), v1_ = *(const f32x4*)(ep + (row_) * 132 + (c8_) * 8 + 4)
#define PK8(o_, v0_, v1_) u32x4 o_; o_.x = cvt_pk_bf16(v0_.x, v0_.y); o_.y = cvt_pk_bf16(v0_.z, v0_.w); o_.z = cvt_pk_bf16(v1_.x, v1_.y); o_.w = cvt_pk_bf16(v1_.z, v1_.w)
        switch (job) {
        case J_PROJ: {
            if (nt < 8) {
                bf16_t* Q = (bf16_t*)(ws + WS_BUFB);
#pragma unroll
                for (int i = 0; i < 8; ++i) { const int c = tid + 512 * i, row = c >> 4, c8 = c & 15; EP8(row, c8, a0, a1);
                    const f32x4 b0 = a0 * (0.125f * LOG2E), b1 = a1 * (0.125f * LOG2E); PK8(o, b0, b1);
                    *(u32x4*)(Q + (size_t)(row0 + row) * 1024 + col0 + c8 * 8) = o; }
            } else if (nt < 20) {
                const int reg = (nt - 8) >> 1;
                bf16_t* dst = (bf16_t*)(ws + WS_BUFC + (reg == 0 ? C_KCMP : reg == 1 ? C_VCMP : reg == 2 ? C_KS : reg == 3 ? C_VST : reg == 4 ? C_KW : C_VWT));
                const int b = row0 >> 13, s0 = row0 & 8191;
                if (reg != 3 && reg != 5) {
#pragma unroll
                    for (int i = 0; i < 8; ++i) { const int c = tid + 512 * i, row = c >> 4, c8 = c & 15; EP8(row, c8, a0, a1); PK8(o, a0, a1);
                        const int bh = b * 4 + ((nt - 8) & 1) * 2 + (c8 >> 3);
                        *(u32x4*)(dst + ((size_t)bh * 8192 + s0 + row) * 64 + (c8 & 7) * 8) = o; }
                } else {
#pragma unroll
                    for (int i = 0; i < 8; ++i) { const int c = tid + 512 * i, tg = c & 31, dcol = c >> 5;
                        const int rb = (tg >> 1) * 16 + (tg & 1) * 4;
                        float v[8];
#pragma unroll
                        for (int j = 0; j < 8; ++j) v[j] = ep[(rb + (j & 3) + (j >> 2) * 8) * 132 + dcol];
                        u32x4 o; o.x = cvt_pk_bf16(v[0], v[1]); o.y = cvt_pk_bf16(v[2], v[3]); o.z = cvt_pk_bf16(v[4], v[5]); o.w = cvt_pk_bf16(v[6], v[7]);
                        const int bh = b * 4 + ((nt - 8) & 1) * 2 + (dcol >> 6);
                        *(u32x4*)(dst + ((size_t)bh * 64 + (dcol & 63)) * 8192 + s0 + tg * 8) = o; }
                }
            } else if (nt == 20) {
                float* G = (float*)(ws + WS_BUFC + C_GATES);
#pragma unroll
                for (int i = 0; i < 6; ++i) { const int c = tid + 512 * i, row = c / 12, c4 = c - row * 12;
                    const f32x4 v = *(const f32x4*)(ep + row * 132 + c4 * 4); f32x4 o; o.x = sigmoidf_(v.x); o.y = sigmoidf_(v.y); o.z = sigmoidf_(v.z); o.w = sigmoidf_(v.w);
                    *(f32x4*)(G + (size_t)(row0 + row) * 48 + c4 * 4) = o; }
            } else {
                bf16_t* Hg = (bf16_t*)(ws + WS_BUFB + 64 * MiB);
#pragma unroll
                for (int i = 0; i < 4; ++i) { const int c = tid + 512 * i, row = c >> 3, c8 = c & 7, hh = c8 >> 2, cc = (c8 & 3) * 8;
                    const f32x4 a0 = *(const f32x4*)(ep + row * 132 + hh * 64 + cc), a1 = *(const f32x4*)(ep + row * 132 + hh * 64 + cc + 4);
                    const f32x4 g0 = *(const f32x4*)(ep + row * 132 + hh * 64 + 32 + cc), g1 = *(const f32x4*)(ep + row * 132 + hh * 64 + 32 + cc + 4);
                    u32x4 o; o.x = cvt_pk_bf16(a0.x * sigmoidf_(g0.x), a0.y * sigmoidf_(g0.y)); o.y = cvt_pk_bf16(a0.z * sigmoidf_(g0.z), a0.w * sigmoidf_(g0.w));
                    o.z = cvt_pk_bf16(a1.x * sigmoidf_(g1.x), a1.y * sigmoidf_(g1.y)); o.w = cvt_pk_bf16(a1.z * sigmoidf_(g1.z), a1.w * sigmoidf_(g1.w));
                    *(u32x4*)(Hg + (size_t)(row0 + row) * 1024 + ((nt - 21) * 2 + hh) * 32 + cc) = o; }
            }
        } break;
        case J_MEMKV: {
            const int b = mt;
            if (nt < 16) {
                bf16_t* Kx = (bf16_t*)(ws + WS_BUFD + 4 * MiB);
                const int head = col0 >> 9, d0 = col0 & 511;
#pragma unroll
                for (int i = 0; i < 8; ++i) { const int c = tid + 512 * i, row = c >> 4, c8 = c & 15; EP8(row, c8, a0, a1); PK8(o, a0, a1);
                    *(u32x4*)(Kx + ((size_t)(b * 4 + head) * 256 + row) * 512 + d0 + c8 * 8) = o; }
            } else {
                bf16_t* Vt = (bf16_t*)(ws + WS_BUFD + 8 * MiB);
                const int n2 = col0 - 2048, head = n2 >> 9, d0 = n2 & 511;
#pragma unroll
                for (int i = 0; i < 8; ++i) { const int c = tid + 512 * i, tg = c & 31, dcol = c >> 5;
                    float v[8];
#pragma unroll
                    for (int j = 0; j < 8; ++j) v[j] = ep[(tg * 8 + j) * 132 + dcol];
                    u32x4 o; o.x = cvt_pk_bf16(v[0], v[1]); o.y = cvt_pk_bf16(v[2], v[3]); o.z = cvt_pk_bf16(v[4], v[5]); o.w = cvt_pk_bf16(v[6], v[7]);
                    *(u32x4*)(Vt + ((size_t)(b * 4 + head) * 512 + d0 + dcol) * 256 + tg * 8) = o; }
            }
        } break;
        case J_CMP1: {
            const int type = mt >> 5;
            const float* bias = (const float*)(ws + WS_C1BIAS) + type * 256;
            bf16_t* Hd = (bf16_t*)(ws + WS_BUFC + C_HID);
            const f32x4 b0 = *(const f32x4*)(bias + col0 + (tid & 15) * 8), b1 = *(const f32x4*)(bias + col0 + (tid & 15) * 8 + 4);
#pragma unroll
            for (int i = 0; i < 8; ++i) { const int c = tid + 512 * i, row = c >> 4, c8 = c & 15; EP8(row, c8, a0, a1);
                u32x4 o; o.x = cvt_pk_bf16(gelu_tanh(a0.x + b0.x), gelu_tanh(a0.y + b0.y)); o.y = cvt_pk_bf16(gelu_tanh(a0.z + b0.z), gelu_tanh(a0.w + b0.w));
                o.z = cvt_pk_bf16(gelu_tanh(a1.x + b1.x), gelu_tanh(a1.y + b1.y)); o.w = cvt_pk_bf16(gelu_tanh(a1.z + b1.z), gelu_tanh(a1.w + b1.w));
                *(u32x4*)(Hd + (size_t)(row0 + row) * 256 + col0 + c8 * 8) = o; }
        } break;
        case J_CMP2: {
            const int gi = mt >> 1, type = gi >> 4, bh = gi & 15, i0 = (mt & 1) * 256;
            if (type == 0) {
                bf16_t* Kc = (bf16_t*)(ws + WS_BUFC + C_KC);
#pragma unroll
                for (int i = 0; i < 4; ++i) { const int c = tid + 512 * i, row = c >> 3, c8 = c & 7; EP8(row, c8, a0, a1); PK8(o, a0, a1);
                    if (i0 + row >= 511) o = (u32x4){0u, 0u, 0u, 0u};
                    *(u32x4*)(Kc + ((size_t)bh * 512 + i0 + row) * 64 + c8 * 8) = o; }
            } else {
                bf16_t* Vc = (bf16_t*)(ws + WS_BUFC + C_VCT);
#pragma unroll
                for (int i = 0; i < 4; ++i) { const int c = tid + 512 * i, tg = c & 31, d = c >> 5;
                    const int rb = (tg >> 1) * 16 + (tg & 1) * 4;
                    float v[8];
#pragma unroll
                    for (int j = 0; j < 8; ++j) { const int r = rb + (j & 3) + (j >> 2) * 8; v[j] = (i0 + r >= 511) ? 0.f : ep[r * 132 + d]; }
                    u32x4 o; o.x = cvt_pk_bf16(v[0], v[1]); o.y = cvt_pk_bf16(v[2], v[3]); o.z = cvt_pk_bf16(v[4], v[5]); o.w = cvt_pk_bf16(v[6], v[7]);
                    *(u32x4*)(Vc + ((size_t)bh * 64 + d) * 512 + i0 + tg * 8) = o; }
            }
        } break;
        case J_OUT: {
            const int c4 = tid & 31, n = col0 + c4 * 4;
#pragma unroll
            for (int i = 0; i < 16; ++i) { const int row = (tid >> 5) + 16 * i, t = row0 + row;
                const f32x4 v = *(const f32x4*)(ep + row * 132 + c4 * 4);
                f32x4 y; y.x = bf2f(preb[i].x & 0xffffu) * ALPHA + v.x; y.y = bf2f(preb[i].x >> 16) * ALPHA + v.y;
                y.z = bf2f(preb[i].y & 0xffffu) * ALPHA + v.z; y.w = bf2f(preb[i].y >> 16) * ALPHA + v.w;
                u32x2 yb; yb.x = cvt_pk_bf16(y.x, y.y); yb.y = cvt_pk_bf16(y.z, y.w);
                *(u32x2*)((bf16_t*)(ws + WS_BUFB) + (size_t)t * D_ + n) = yb;
                float rs = (y.x + y.y) + (y.z + y.w), rq = (y.x * y.x + y.y * y.y) + (y.z * y.z + y.w * y.w);
#pragma unroll
                for (int o = 1; o < 32; o <<= 1) { rs += __shfl_xor(rs, o); rq += __shfl_xor(rq, o); }
                if ((tid & 31) == 0) { float* rsum = (float*)(ws + WS_RSUM1) + (size_t)t * 2; atomicAdd(rsum, rs); atomicAdd(rsum + 1, rq); } }
        } break;
        case J_WQ: {
            bf16_t* Qx = (bf16_t*)(ws + WS_BUFC);
            const float sc = 0.04419417382415922f * LOG2E;
            const float* U = (const float*)(ws + WS_CTL + CTL_U1); const float* Cv = (const float*)(ws + WS_CTL + CTL_C1);
            const float* rsum = (const float*)(ws + WS_RSUM1);
            const int c8 = tid & 15, n = col0 + c8 * 8;
            const f32x4 u0 = *(const f32x4*)(U + n), u1 = *(const f32x4*)(U + n + 4), c0 = *(const f32x4*)(Cv + n), c1 = *(const f32x4*)(Cv + n + 4);
            float2 rsq[8];
#pragma unroll
            for (int i = 0; i < 8; ++i) rsq[i] = *(const float2*)(rsum + (size_t)(row0 + (tid >> 4) + 32 * i) * 2);
#pragma unroll
            for (int i = 0; i < 8; ++i) { const int row = (tid >> 4) + 32 * i; EP8(row, c8, a0, a1);
                const int t = row0 + row;
                const float mean = rsq[i].x * (1.f / D_); float var = rsq[i].y * (1.f / D_) - mean * mean; var = var > 0.f ? var : 0.f;
                const float rstd = __builtin_amdgcn_rsqf(var + LN_EPS), mr = mean * rstd;
                const f32x4 b0 = (a0 * rstd - u0 * mr + c0) * sc, b1 = (a1 * rstd - u1 * mr + c1) * sc; PK8(o, b0, b1);
                *(u32x4*)(Qx + (size_t)t * 2048 + n) = o; }
        } break;
        case J_WO: {
            const int c4 = tid & 31, n = col0 + c4 * 4;
            const f32x4 g = *(const f32x4*)(p.in[17] + n), bb = *(const f32x4*)(p.in[18] + n);
#pragma unroll
            for (int hlf = 0; hlf < 2; ++hlf) {
                float2 sm[8];
#pragma unroll
                for (int i = 0; i < 8; ++i) { const int row = (tid >> 5) + 16 * (hlf * 8 + i), t = row0 + row;
                    const float2 rsq = *(const float2*)((const float*)(ws + WS_RSUM1) + (size_t)t * 2);
                    const float mean = rsq.x * (1.f / D_); float var = rsq.y * (1.f / D_) - mean * mean; var = var > 0.f ? var : 0.f;
                    sm[i] = make_float2(mean, 1.f / sqrtf(var + LN_EPS)); }
#pragma unroll
                for (int i = 0; i < 8; ++i) { const int row = (tid >> 5) + 16 * (hlf * 8 + i), t = row0 + row;
                    const f32x4 v = *(const f32x4*)(ep + row * 132 + c4 * 4);
                    const u32x2 pb = preb[hlf * 8 + i];
                    f32x4 rv; rv.x = bf2f(pb.x & 0xffffu); rv.y = bf2f(pb.x >> 16); rv.z = bf2f(pb.y & 0xffffu); rv.w = bf2f(pb.y >> 16);
                    *(f32x4*)(p.out + (size_t)t * D_ + n) = ((rv - sm[i].x) * sm[i].y * g + bb) * ALPHA + v; }
            }
        } break;
        case J_ROUTER: {
            if (tid < 256) {
                const int row = tid, t = row0 + row;
                const float* er = ep + row * 132;
                unsigned* cnt = (unsigned*)(ws + WS_CTL) + CW_CNT;
                int* list = (int*)(ws + WS_LIST);
                float* wt = (float*)(ws + WS_WTOK);
                float lg[4];
#pragma unroll
                for (int i = 0; i < 4; ++i) lg[i] = er[i] + er[64 + i] + p.in[27][i];
                int grp = 0; float best = lg[0];
#pragma unroll
                for (int i = 1; i < 4; ++i) if (lg[i] > best) { best = lg[i]; grp = i; }
                float se = 0.f;
#pragma unroll
                for (int i = 0; i < 4; ++i) se += expf(lg[i] - best);
                const float wgrp = 1.f / se;
                float le[8];
#pragma unroll
                for (int i = 0; i < 8; ++i) le[i] = er[4 + grp * 8 + i] + er[68 + grp * 8 + i] + p.in[29][grp * 8 + i];
                int i0 = 0; float v0 = le[0];
#pragma unroll
                for (int i = 1; i < 8; ++i) if (le[i] > v0) { v0 = le[i]; i0 = i; }
                int i1 = -1; float v1 = -INFINITY;
#pragma unroll
                for (int i = 0; i < 8; ++i) if (i != i0 && le[i] > v1) { v1 = le[i]; i1 = i; }
                const float ex = expf(v1 - v0);
                const float w0 = wgrp / (1.f + ex), w1 = wgrp * ex / (1.f + ex);
                const int ea = grp * 8 + i0, eb = grp * 8 + i1;
                const unsigned pa = atomicAdd(cnt + ea, 1u); list[(size_t)ea * T_ + pa] = t * 2;
                const unsigned pb = atomicAdd(cnt + eb, 1u); list[(size_t)eb * T_ + pb] = t * 2 + 1;
                wt[t * 2] = w0; wt[t * 2 + 1] = w1;
            }
        } break;
        case J_MOE1: {
            bf16_t* H = (bf16_t*)(ws + WS_BUFB);
#pragma unroll
            for (int i = 0; i < 4; ++i) { const int c = tid + 512 * i, row = c >> 3, c8 = c & 7, hh = c8 >> 2, cc = (c8 & 3) * 8;
                const f32x4 g0 = *(const f32x4*)(ep + row * 132 + hh * 64 + cc), g1 = *(const f32x4*)(ep + row * 132 + hh * 64 + cc + 4);
                const f32x4 u0 = *(const f32x4*)(ep + row * 132 + hh * 64 + 32 + cc), u1 = *(const f32x4*)(ep + row * 132 + hh * 64 + 32 + cc + 4);
                u32x4 o; o.x = cvt_pk_bf16(g0.x * sigmoidf_(g0.x) * u0.x, g0.y * sigmoidf_(g0.y) * u0.y); o.y = cvt_pk_bf16(g0.z * sigmoidf_(g0.z) * u0.z, g0.w * sigmoidf_(g0.w) * u0.w);
                o.z = cvt_pk_bf16(g1.x * sigmoidf_(g1.x) * u1.x, g1.y * sigmoidf_(g1.y) * u1.y); o.w = cvt_pk_bf16(g1.z * sigmoidf_(g1.z) * u1.z, g1.w * sigmoidf_(g1.w) * u1.w);
                *(u32x4*)(H + ((size_t)(etp + rt) * 256 + row) * 512 + (nt * 2 + hh) * 32 + cc) = o; }
        } break;
        default: {
            bf16_t* Y = (bf16_t*)(ws + WS_BUFC);
            const float* wt = (const float*)(ws + WS_WTOK);
            const int c8 = tid & 15;
            int aid[8]; float wv[8];
#pragma unroll
            for (int i = 0; i < 8; ++i) { const int pos = rt * 256 + (tid >> 4) + 32 * i; aid[i] = (pos < ecnt) ? ((const int*)(ws + WS_LIST))[(size_t)e * T_ + pos] : -1; }
#pragma unroll
            for (int i = 0; i < 8; ++i) wv[i] = (aid[i] >= 0) ? wt[aid[i]] : 0.f;
#pragma unroll
            for (int i = 0; i < 8; ++i) { const int row = (tid >> 4) + 32 * i;
                if (aid[i] >= 0) { EP8(row, c8, a0, a1); const f32x4 b0 = a0 * wv[i], b1 = a1 * wv[i]; PK8(o, b0, b1);
                    *(u32x4*)(Y + (size_t)aid[i] * 2048 + col0 + c8 * 8) = o; } }
        } break;
        }
#undef EP8
#undef PK8
        asm volatile("s_waitcnt lgkmcnt(0)" ::: "memory"); __builtin_amdgcn_s_barrier(); asm volatile("" ::: "memory");
    }
}

template <int job>
DEVI void gemm_direct(const Params& p, char* smem) {
    unsigned char* ws = p.ws;
    int tid = threadIdx.x; asm volatile("" : "+v"(tid));
    const int lane = tid & 63, w = tid >> 6, wr = w >> 1, wc = w & 1, fr = lane & 15, fq = lane >> 4;
    const int srow = tid >> 3, schunk = (tid & 7) ^ ((tid >> 4) & 7);
    constexpr int NTILES = 2048;
    const bf16_t* Abase = (const bf16_t*)(ws + (job == J_OUT ? WS_BUFE : job == J_WQ ? WS_BUFB : WS_BUFA)) + (size_t)srow * 2048 + schunk * 8;
    const bf16_t* Bbase = (const bf16_t*)(ws + (job == J_OUT ? WS_WOUT : job == J_WQ ? WS_WQ : WS_WO)) + (size_t)srow * 2048 + schunk * 8;
    const bf16_t* Rsrc = (const bf16_t*)(ws + (job == J_OUT ? WS_BUFA : WS_BUFB));
    int ti = blockIdx.x;
    if (ti >= NTILES) return;
#define GD_MAP(ti_, mt_, nt_) do { const int _x = (ti_) & 7, _jj = (ti_) >> 3, _srl = _jj >> 7, _idx = _jj & 127; mt_ = (_srl * 8 + _x) * 8 + (_idx & 7); nt_ = _idx >> 3; } while (0)
#define GD_PTRS(mt_, nt_, ap_, bp_) do { _Pragma("unroll") for (int r = 0; r < 4; ++r) ap_[r] = Abase + (size_t)((mt_) * 256 + r * 64) * 2048; \
        _Pragma("unroll") for (int r = 0; r < 2; ++r) bp_[r] = Bbase + (size_t)((nt_) * 128 + r * 64) * 2048; } while (0)
#define GD_STAGE(ap_, bp_, kt_, slot_) do { char* _A = smem + (slot_) * GEMM_STAGE_BYTES; char* _B = _A + 32768; const int _k0 = (kt_) << 6; \
        _Pragma("unroll") for (int r = 0; r < 4; ++r) glds16(ap_[r] + _k0, _A + (r * 512 + tid) * 16); \
        _Pragma("unroll") for (int r = 0; r < 2; ++r) glds16(bp_[r] + _k0, _B + (r * 512 + tid) * 16); } while (0)
    int mt, nt; GD_MAP(ti, mt, nt);
    const bf16_t* ap[4]; const bf16_t* bp[2]; GD_PTRS(mt, nt, ap, bp);
    GD_STAGE(ap, bp, 0, 0);
    GD_STAGE(ap, bp, 1, 1);
    int cur = 0;
    bool landed = false;
    constexpr int NPRE = (job == J_OUT) ? 16 : (job == J_WQ) ? 12 : 28;
    for (;;) {
        const int tn = ti + gridDim.x; const bool has_next = tn < NTILES;
        int mtn = 0, ntn = 0; if (has_next) GD_MAP(tn, mtn, ntn);
        const bf16_t* nap[4]; const bf16_t* nbp[2]; GD_PTRS(mtn, ntn, nap, nbp);
        const int row0 = mt * 256 + wr * 64 + fr, col0 = nt * 128 + wc * 64 + fq * 4;
        u32x2 preb[16]; f32x4 va[4], vb[4]; f32x4 rsq01, rsq23;
        if (job != J_WQ) {
#pragma unroll
            for (int i = 0; i < 4; ++i)
#pragma unroll
                for (int j = 0; j < 4; ++j) preb[i * 4 + j] = gload8_asm(Rsrc + (size_t)(row0 + i * 16) * D_ + col0 + j * 16);
        }
        if (job != J_OUT) {
            const float* Va = (job == J_WQ) ? (const float*)(ws + WS_CTL + CTL_U1) : p.in[17];
            const float* Vb = (job == J_WQ) ? (const float*)(ws + WS_CTL + CTL_C1) : p.in[18];
#pragma unroll
            for (int j = 0; j < 4; ++j) { va[j] = gload16_asm(Va + col0 + j * 16); vb[j] = gload16_asm(Vb + col0 + j * 16); }
            const float* rsum = (const float*)(ws + WS_RSUM1);
            u32x2 r0 = gload8_asm(rsum + (size_t)(row0) * 2), r1 = gload8_asm(rsum + (size_t)(row0 + 16) * 2), r2 = gload8_asm(rsum + (size_t)(row0 + 32) * 2), r3 = gload8_asm(rsum + (size_t)(row0 + 48) * 2);
            rsq01.x = __uint_as_float(r0.x); rsq01.y = __uint_as_float(r0.y); rsq01.z = __uint_as_float(r1.x); rsq01.w = __uint_as_float(r1.y);
            rsq23.x = __uint_as_float(r2.x); rsq23.y = __uint_as_float(r2.y); rsq23.z = __uint_as_float(r3.x); rsq23.w = __uint_as_float(r3.y);
        }
        f32x4 acc[4][4];
#pragma unroll
        for (int i = 0; i < 4; ++i)
#pragma unroll
            for (int j = 0; j < 4; ++j) acc[i][j] = (f32x4){0.f, 0.f, 0.f, 0.f};
        for (int kt = 0; kt < 32; ++kt) {
            if (kt == 0 && landed) { }
            else if (kt < 2) asm volatile("s_waitcnt vmcnt(%0)" :: "n"(6 + NPRE) : "memory");
            else if (kt == 31 && !has_next) asm volatile("s_waitcnt vmcnt(0)" ::: "memory");
            else asm volatile("s_waitcnt vmcnt(6)" ::: "memory");
            __builtin_amdgcn_s_barrier();
            asm volatile("" ::: "memory");
            { const int s2 = cur == 0 ? 2 : cur - 1;
              if (kt < 30) GD_STAGE(ap, bp, kt + 2, s2); else if (has_next) GD_STAGE(nap, nbp, kt - 30, s2); }
            const char* A = smem + cur * GEMM_STAGE_BYTES; const char* B = A + 32768;
#pragma unroll
            for (int ks = 0; ks < 2; ++ks) {
                bf16x8 af[4], bfr[4];
                const int coff = ((4 * ks + fq) ^ (fr >> 1)) * 16;
#pragma unroll
                for (int i = 0; i < 4; ++i) {
                    af[i] = *(const bf16x8*)(A + (wr * 64 + i * 16 + fr) * 128 + coff);
                    bfr[i] = *(const bf16x8*)(B + (wc * 64 + i * 16 + fr) * 128 + coff);
                }
                __builtin_amdgcn_s_setprio(1);
#pragma unroll
                for (int i = 0; i < 4; ++i)
#pragma unroll
                    for (int j = 0; j < 4; ++j) acc[i][j] = mfma16(bfr[j], af[i], acc[i][j]);
                __builtin_amdgcn_s_setprio(0);
            }
            cur = cur == 2 ? 0 : cur + 1;
        }
        if (has_next) asm volatile("s_waitcnt vmcnt(6)" ::: "memory");
        landed = true;
        if (job == J_OUT) {
#pragma unroll
            for (int i = 0; i < 4; ++i) { const int t = row0 + i * 16;
                float rs = 0.f, rq = 0.f;
#pragma unroll
                for (int j = 0; j < 4; ++j) { const u32x2 hb = preb[i * 4 + j]; const f32x4 v = acc[i][j];
                    f32x4 y; y.x = bf2f(hb.x & 0xffffu) * ALPHA + v.x; y.y = bf2f(hb.x >> 16) * ALPHA + v.y; y.z = bf2f(hb.y & 0xffffu) * ALPHA + v.z; y.w = bf2f(hb.y >> 16) * ALPHA + v.w;
                    u32x2 yb; yb.x = cvt_pk_bf16(y.x, y.y); yb.y = cvt_pk_bf16(y.z, y.w);
                    *(u32x2*)((bf16_t*)(ws + WS_BUFB) + (size_t)t * D_ + col0 + j * 16) = yb;
                    rs += (y.x + y.y) + (y.z + y.w); rq += (y.x * y.x + y.y * y.y) + (y.z * y.z + y.w * y.w); }
                rs += __shfl_xor(rs, 16); rq += __shfl_xor(rq, 16); rs += __shfl_xor(rs, 32); rq += __shfl_xor(rq, 32);
                if (fq == 0) { float* rsum = (float*)(ws + WS_RSUM1) + (size_t)t * 2; atomicAdd(rsum, rs); atomicAdd(rsum + 1, rq); } }
        } else if (job == J_WQ) {
            bf16_t* Qx = (bf16_t*)(ws + WS_BUFC);
            const float sc = 0.04419417382415922f * LOG2E;
#pragma unroll
            for (int i = 0; i < 4; ++i) { const int t = row0 + i * 16;
                const float sx = (i == 0) ? rsq01.x : (i == 1) ? rsq01.z : (i == 2) ? rsq23.x : rsq23.z, sy = (i == 0) ? rsq01.y : (i == 1) ? rsq01.w : (i == 2) ? rsq23.y : rsq23.w;
                const float mean = sx * (1.f / D_); float var = sy * (1.f / D_) - mean * mean; var = var > 0.f ? var : 0.f;
                const float rstd = __builtin_amdgcn_rsqf(var + LN_EPS), mr = mean * rstd;
#pragma unroll
                for (int j = 0; j < 4; ++j) { const f32x4 b = (acc[i][j] * rstd - va[j] * mr + vb[j]) * sc;
                    u32x2 o; o.x = cvt_pk_bf16(b.x, b.y); o.y = cvt_pk_bf16(b.z, b.w);
                    *(u32x2*)(Qx + (size_t)t * 2048 + col0 + j * 16) = o; } }
        } else {
#pragma unroll
            for (int i = 0; i < 4; ++i) { const int t = row0 + i * 16;
                const float sx = (i == 0) ? rsq01.x : (i == 1) ? rsq01.z : (i == 2) ? rsq23.x : rsq23.z, sy = (i == 0) ? rsq01.y : (i == 1) ? rsq01.w : (i == 2) ? rsq23.y : rsq23.w;
                const float mean = sx * (1.f / D_); float var = sy * (1.f / D_) - mean * mean; var = var > 0.f ? var : 0.f;
                const float rstd = 1.f / sqrtf(var + LN_EPS);
#pragma unroll
                for (int j = 0; j < 4; ++j) { const u32x2 pb = preb[i * 4 + j];
                    f32x4 rv; rv.x = bf2f(pb.x & 0xffffu); rv.y = bf2f(pb.x >> 16); rv.z = bf2f(pb.y & 0xffffu); rv.w = bf2f(pb.y >> 16);
                    *(f32x4*)(p.out + (size_t)t * D_ + col0 + j * 16) = ((rv - mean) * rstd * va[j] + vb[j]) * ALPHA + acc[i][j]; } }
        }
        asm volatile("" ::: "memory");
        if (!has_next) break;
        ti = tn; mt = mtn; nt = ntn;
#pragma unroll
        for (int r = 0; r < 4; ++r) ap[r] = nap[r];
#pragma unroll
        for (int r = 0; r < 2; ++r) bp[r] = nbp[r];
    }
#undef GD_MAP
#undef GD_PTRS
#undef GD_STAGE
    __syncthreads();
}

DEVI void phase_conv(const Params& p) {
    unsigned char* ws = p.ws;
    int tid = threadIdx.x; asm volatile("" : "+v"(tid));
    const int lane = tid & 63, w = tid >> 6;
    const int c0 = tid * 2;
    const bf16_t* Hg = (const bf16_t*)(ws + WS_BUFB + 64 * MiB);
    float* pre = p.out;
    float* cst = (float*)(ws + WS_LIST);
    float wgt[31][2];
    { const float* wp = p.in[12] + c0;
#pragma unroll
      for (int k = 0; k < 31; ++k) { const float2 v = *(const float2*)wp; wgt[k][0] = v.x; wgt[k][1] = v.y; wp += 1024; asm volatile("" : "+v"(wp)); } }
    const float2 cb = *(const float2*)(p.in[13] + c0);
    for (int it = blockIdx.x; it < T_ / 16; it += gridDim.x) {
        const int t0 = it * 16, s0 = t0 & 8191;
        float acc[16][2];
#pragma unroll
        for (int j = 0; j < 16; ++j) { acc[j][0] = cb.x; acc[j][1] = cb.y; }
        const bf16_t* xp = Hg + ((long)t0 - 30) * 1024 + c0;
#pragma unroll
        for (int i = 0; i < 46; ++i) {
            const int s = s0 - 30 + i;
            float x0 = 0.f, x1 = 0.f;
            if (s >= 0) { const unsigned u = *(const unsigned*)xp; x0 = bf2f(u & 0xffffu); x1 = bf2f(u >> 16); }
            xp += 1024; asm volatile("" : "+v"(xp));
#pragma unroll
            for (int j = 0; j < 16; ++j) { const int k = i - j; if (k >= 0 && k <= 30) { acc[j][0] += wgt[k][0] * x0; acc[j][1] += wgt[k][1] * x1; } }
        }
#pragma unroll
        for (int j = 0; j < 16; ++j) {
            *(float2*)(pre + (size_t)(t0 + j) * 1024 + c0) = make_float2(acc[j][0], acc[j][1]);
            const float sv = wave_sum(acc[j][0] + acc[j][1]);
            const float qv = wave_sum(acc[j][0] * acc[j][0] + acc[j][1] * acc[j][1]);
            if (lane == 0) *(float2*)(cst + ((size_t)(t0 + j) * 8 + w) * 2) = make_float2(sv, qv);
        }
    }
}
DEVI void conv_finish(const Params& p) {
    unsigned char* ws = p.ws;
    int tid = threadIdx.x; asm volatile("" : "+v"(tid));
    const int lane = tid & 63, w = tid >> 6;
    const float* pre = p.out;
    const float* cst = (const float*)(ws + WS_LIST);
    bf16_t* CC = (bf16_t*)(ws + WS_BUFE);
    for (int it = blockIdx.x; it < T_ / 8; it += gridDim.x) {
        const int t = it * 8 + w;
        float sv = 0.f, qv = 0.f;
#pragma unroll
        for (int k = 0; k < 8; ++k) { const float2 a = *(const float2*)(cst + ((size_t)t * 8 + k) * 2); sv += a.x; qv += a.y; }
        const float mean = sv * (1.f / 1024.f);
        float var = qv * (1.f / 1024.f) - mean * mean; var = var > 0.f ? var : 0.f;
        const float rstd = 1.f / sqrtf(var + LN_EPS);
#pragma unroll
        for (int c = 0; c < 4; ++c) {
            const int col = c * 256 + lane * 4;
            const f32x4 x = *(const f32x4*)(pre + (size_t)t * 1024 + col), g = *(const f32x4*)(p.in[14] + col), bb = *(const f32x4*)(p.in[15] + col);
            f32x4 y = (x - mean) * rstd * g + bb;
            y.x *= sigmoidf_(y.x); y.y *= sigmoidf_(y.y); y.z *= sigmoidf_(y.z); y.w *= sigmoidf_(y.w);
            u32x2 o; o.x = cvt_pk_bf16(y.x, y.y); o.y = cvt_pk_bf16(y.z, y.w);
            *(u32x2*)(CC + (size_t)t * 2048 + 1024 + col) = o;
        }
    }
}

enum { M_CMP = 0, M_SEL = 1, M_WIN = 2 };
constexpr int KSTR = 72;
constexpr int NSA_KBUF = 0, NSA_VBUF = 49152;
constexpr int NSA_IMP = 98304;
constexpr int NSA_TBL = 132096;
constexpr int NSA_SEL = NSA_TBL + 4096;
constexpr int NSA_UNIT = NSA_SEL + 1024;

DEVI void attn_issue(char* kdst, char* vdst, const bf16_t* kt, const bf16_t* vt, int vstride, int tid) {
    const int row = tid >> 3, c = (tid & 7) ^ ((row >> 1) & 7);
    glds16(kt + row * 64 + c * 8, kdst + tid * 16);
    glds16(vt + (size_t)row * vstride + c * 8, vdst + tid * 16);
}

constexpr float NSA_THR = 8.f;
template <int MODE, int PASS>
DEVI void nsa_branch(char* smem, const bf16_t* kg, const bf16_t* vg, int vstride, int t_lo, int t_hi, int far_lo, int far_hi, const bf16x8 (&qf)[4], int tq,
                     float c31, const LAS float* tblg, const LAS unsigned* selrow, float& m_ref, bool& mset, float& lsum, float inv_l, f32x16 (&o)[2], LAS float* imp_row) {
    int tid = threadIdx.x; asm volatile("" : "+v"(tid));
    const int lane = tid & 63, l31 = lane & 31, h = lane >> 5, xs = (l31 >> 1) & 7;
    const int n = t_hi - t_lo + 1;
    f32x16 cneg;
    { const float cc = c31 - m_ref;
#pragma unroll
      for (int i = 0; i < 16; ++i) cneg[i] = cc; }
    float imp_carry = 0.f;
    const int nS = (n + 1) >> 1;
#define NSA_ISSUE_PAIR(js_) do { const int _sl = (js_) % 3; \
        _Pragma("unroll") for (int _sb = 0; _sb < 2; ++_sb) { int _t = t_lo + 2 * (js_) + _sb; _t = _t > t_hi ? t_hi : _t; \
            attn_issue(smem + NSA_KBUF + _sl * 16384 + _sb * 8192, smem + NSA_VBUF + _sl * 16384 + _sb * 8192, kg + (size_t)_t * 4096, vg + _t * 64, vstride, tid); } } while (0)
    NSA_ISSUE_PAIR(0);
    if (nS > 1) NSA_ISSUE_PAIR(1);
    for (int it = 0; it < n; ++it) {
        const int ti = t_lo + it, js = it >> 1, buf = (js % 3) * 2 + (it & 1);
        if ((it & 1) == 0) {
            if (js + 1 < nS) asm volatile("s_waitcnt vmcnt(4)" ::: "memory"); else asm volatile("s_waitcnt vmcnt(0)" ::: "memory");
            __builtin_amdgcn_s_barrier();
            asm volatile("" ::: "memory");
            if (js + 2 < nS) NSA_ISSUE_PAIR(js + 2);
        }
        bool selbit = true;
        if (MODE == M_SEL) { selbit = (selrow[ti >> 5] >> (ti & 31)) & 1u; if (!__any(selbit)) continue; }
        const char* Kc = smem + NSA_KBUF + buf * 8192; const char* Vc = smem + NSA_VBUF + buf * 8192;
        f32x16 s[2];
        __builtin_amdgcn_s_setprio(1);
        {
            const int off0 = (h ^ xs) << 4;
            s[0] = mfma32(*(const bf16x8*)(Kc + l31 * 128 + off0), qf[0], cneg);
            s[1] = mfma32(*(const bf16x8*)(Kc + (32 + l31) * 128 + off0), qf[0], cneg);
        }
#pragma unroll
        for (int ks = 1; ks < 4; ++ks) {
            const int off = ((2 * ks + h) ^ xs) << 4;
            s[0] = mfma32(*(const bf16x8*)(Kc + l31 * 128 + off), qf[ks], s[0]);
            s[1] = mfma32(*(const bf16x8*)(Kc + (32 + l31) * 128 + off), qf[ks], s[1]);
        }
        __builtin_amdgcn_s_setprio(0);
        const bool far = (ti >= far_lo) && (ti <= far_hi);
        {
        if (!far) {
            const int dbase = (MODE == M_CMP) ? (tq - 31 - 1024 * ti) : (tq - 64 * ti);
#pragma unroll
            for (int u = 0; u < 2; ++u)
#pragma unroll
                for (int i = 0; i < 16; ++i) {
                    const int kk = 32 * u + (i & 3) + 8 * (i >> 2) + 4 * h;
                    const int dist = dbase - ((MODE == M_CMP) ? 16 * kk : kk);
                    const int idx = (dist < -1 ? -1 : (dist > 191 ? 191 : dist)) + 64;
                    float v = s[u][i] + tblg[idx];
                    if (MODE == M_WIN) v = (dist < 512) ? v : -INFINITY;
                    if (MODE == M_SEL) v = selbit ? v : -INFINITY;
                    s[u][i] = v;
                    if ((i & 3) == 3) asm volatile("" ::: "memory");
                }
        }
        if (PASS != 2) {
            float mxa = max3f(s[0][0], s[0][1], s[0][2]), mxb = max3f(s[1][0], s[1][1], s[1][2]);
#pragma unroll
            for (int i = 3; i < 15; i += 2) { mxa = max3f(mxa, s[0][i], s[0][i + 1]); mxb = max3f(mxb, s[1][i], s[1][i + 1]); }
            float mx = max3f(mxa, mxb, s[0][15]); mx = max3f(mx, s[1][15], s[1][15]);
            if (MODE == M_SEL && !selbit) mx = -INFINITY;
            if (__any(mx > NSA_THR || (!mset && mx > -INFINITY))) {
                const float mc = fmaxf(mx, __shfl_xor(mx, 32));
                const bool mv = (mc > NSA_THR) || (!mset && mc > -INFINITY);
                const float delta = mv ? mc : 0.f;
                const float alpha = mset ? fexp2(-delta) : 1.f;
                mset = mset || mv;
                m_ref += delta;
                const float cc = c31 - m_ref;
#pragma unroll
                for (int i = 0; i < 16; ++i) cneg[i] = cc;
                lsum *= alpha;
#pragma unroll
                for (int u = 0; u < 2; ++u)
#pragma unroll
                    for (int i = 0; i < 16; ++i) s[u][i] -= delta;
                if (PASS == 0) {
#pragma unroll
                    for (int v = 0; v < 2; ++v)
#pragma unroll
                        for (int i = 0; i < 16; ++i) o[v][i] *= alpha;
                }
            }
        }
        float ps0 = 0.f, ps1 = 0.f, ps2 = 0.f, ps3 = 0.f;
#pragma unroll
        for (int u = 0; u < 2; ++u)
#pragma unroll
            for (int i = 0; i < 16; i += 4) {
                s[u][i] = fexp2(s[u][i]); s[u][i + 1] = fexp2(s[u][i + 1]); s[u][i + 2] = fexp2(s[u][i + 2]); s[u][i + 3] = fexp2(s[u][i + 3]);
                ps0 += s[u][i]; ps1 += s[u][i + 1]; ps2 += s[u][i + 2]; ps3 += s[u][i + 3];
            }
        { const float ps = (ps0 + ps1) + (ps2 + ps3); lsum += (MODE == M_SEL && far && !selbit) ? 0.f : ps; }
        if (PASS == 2) {
            float mainv[8], halfv[8];
#pragma unroll
            for (int u = 0; u < 2; ++u)
#pragma unroll
                for (int c4 = 0; c4 < 4; ++c4) {
                    float hv = 0.5f * s[u][4 * c4 + 3] * inv_l;
                    float mv = ((s[u][4 * c4] + s[u][4 * c4 + 1]) + s[u][4 * c4 + 2]) * inv_l + hv;
                    mv += __builtin_bit_cast(float, __builtin_amdgcn_update_dpp(0, __builtin_bit_cast(int, mv), 0xB1, 0xF, 0xF, true));
                    hv += __builtin_bit_cast(float, __builtin_amdgcn_update_dpp(0, __builtin_bit_cast(int, hv), 0xB1, 0xF, 0xF, true));
                    mv += __builtin_bit_cast(float, __builtin_amdgcn_update_dpp(0, __builtin_bit_cast(int, mv), 0x4E, 0xF, 0xF, true));
                    hv += __builtin_bit_cast(float, __builtin_amdgcn_update_dpp(0, __builtin_bit_cast(int, hv), 0x4E, 0xF, 0xF, true));
                    mainv[u * 4 + c4] = mv; halfv[u * 4 + c4] = __shfl_xor(hv, 32);
                }
#pragma unroll
            for (int gi = 0; gi < 8; ++gi) {
                const float cin = h ? halfv[gi] : (gi ? halfv[gi - 1] : imp_carry);
                const unsigned ia = (unsigned)(size_t)(imp_row + 16 * ti + 2 * gi + h);
                const float val = mainv[gi] + cin;
                asm volatile("ds_write_b32 %0, %1" :: "v"(ia), "v"(val) : "memory");
            }
            imp_carry = halfv[7];
        }
        const unsigned pmask = (MODE == M_SEL && far && !selbit) ? 0u : 0xFFFFFFFFu;
#pragma unroll
        for (int u = 0; u < 2; ++u)
#pragma unroll
            for (int sI = 0; sI < 2; ++sI) {
                u32x4 pk;
                pk.x = cvt_pk_bf16(s[u][8 * sI + 0], s[u][8 * sI + 1]); pk.y = cvt_pk_bf16(s[u][8 * sI + 2], s[u][8 * sI + 3]);
                pk.z = cvt_pk_bf16(s[u][8 * sI + 4], s[u][8 * sI + 5]); pk.w = cvt_pk_bf16(s[u][8 * sI + 6], s[u][8 * sI + 7]);
                if (MODE == M_SEL) { pk.x &= pmask; pk.y &= pmask; pk.z &= pmask; pk.w &= pmask; }
                const bf16x8 pf = __builtin_bit_cast(bf16x8, pk);
                if (PASS != 1) {
                    const int voff = ((2 * (2 * u + sI) + h) ^ xs) << 4;
                    o[0] = mfma32(*(const bf16x8*)(Vc + l31 * 128 + voff), pf, o[0]);
                    o[1] = mfma32(*(const bf16x8*)(Vc + (32 + l31) * 128 + voff), pf, o[1]);
                }
            }
        }
    }
    if (PASS == 2) {
        const int c = 16 * (t_hi + 1);
        if (h == 0 && c < 128) { const unsigned ia = (unsigned)(size_t)(imp_row + c); asm volatile("ds_write_b32 %0, %1" :: "v"(ia), "v"(imp_carry) : "memory"); }
        asm volatile("s_waitcnt lgkmcnt(0)" ::: "memory");
    }
#undef NSA_ISSUE_PAIR
    __syncthreads();
}

DEVI void phase_nsa(const Params& p, char* smem, int ctr_idx) {
    unsigned char* ws = p.ws;
    const int tid0 = threadIdx.x;
    float* imp = (float*)(smem + NSA_IMP);
    unsigned* tot = (unsigned*)(smem + NSA_IMP);
    float* tbl = (float*)(smem + NSA_TBL);
    unsigned* selm = (unsigned*)(smem + NSA_SEL);
    int* sunit = (int*)(smem + NSA_UNIT);
    unsigned* ctr = (unsigned*)(ws + WS_CTL) + CW_NSA + 256 * ctr_idx;
    unsigned* trc = (unsigned*)(ws + WS_CTL) + CW_TR;
    const bf16_t* Q = (const bf16_t*)(ws + WS_BUFB);
    const float* G = (const float*)(ws + WS_BUFC + C_GATES);
    bf16_t* CC = ctr_idx ? (bf16_t*)(p.out + 32 * 1024 * 1024) : (bf16_t*)(ws + WS_BUFE);
    for (;;) {
        int tid = tid0; asm volatile("" : "+v"(tid));
        const int lane = tid & 63, w = tid >> 6, l31 = lane & 31, h = lane >> 5;
        const int qi = l31 >> 2, g = l31 & 3, ql = 8 * w + qi;
        __syncthreads();
        if (tid == 0) {
            const unsigned x = xb_xcc_id() & 7u; int u = -1;
            for (unsigned k = 0; k < 8u && u < 0; ++k) { const unsigned xx = (x + k) & 7u; const unsigned i = atomicAdd(ctr + 16 * xx, 1u); if (i < 256u) u = (int)(i * 8u + xx); }
            *sunit = u;
        }
        __syncthreads();
        const int unit = *sunit;
        if (unit < 0) break;
        const int xq = unit & 7, iq = unit >> 3;
        const int qt = 127 - (iq >> 1), bh = 2 * xq + (iq & 1), b = bh >> 2, hkv = bh & 3, q0 = qt * 64, cur = qt;
        for (int i = tid; i < 4 * 256; i += 512) {
            const int gg = i >> 8, d = (i & 255) - 64;
            float val = -INFINITY;
            if (d >= 0) {
                int bucket;
                if (d < 16) bucket = d;
                else if (d >= 128) bucket = 31;
                else { const int lg = 16 + (int)(logf((float)d / 16.f) / 2.0794415416798357f * 16.f); bucket = lg < 31 ? lg : 31; }
                val = (p.in[11][bucket * 16 + hkv * 4 + gg] - p.in[11][31 * 16 + hkv * 4 + gg]) * LOG2E;
            }
            tbl[i] = val;
        }
        if (tid < 256) selm[tid] = 0u;
        const int tq = q0 + ql;
        const size_t trow = (size_t)b * 8192 + tq;
        bf16x8 qf[4];
        { const bf16_t* qrow = Q + trow * 1024 + hkv * 256 + g * 64;
#pragma unroll
          for (int ks = 0; ks < 4; ++ks) qf[ks] = *(const bf16x8*)(qrow + 16 * ks + 8 * h); }
        float c31 = p.in[11][31 * 16 + hkv * 4 + g] * LOG2E;
        asm volatile("" : "+v"(qf[0]), "+v"(qf[1]), "+v"(qf[2]), "+v"(qf[3]), "+v"(c31));
        const LAS float* tblg = (const LAS float*)(smem + NSA_TBL) + g * 256;
        const LAS unsigned* selrow = (const LAS unsigned*)(smem + NSA_SEL) + ql * 4;
        f32x16 o[2];
#pragma unroll
        for (int v = 0; v < 2; ++v)
#pragma unroll
            for (int i = 0; i < 16; ++i) o[v][i] = 0.f;
        __syncthreads();
        const bf16_t* kc = (const bf16_t*)(ws + WS_BUFC + C_KC) + (size_t)bh * 512 * 64;
        const bf16_t* vct = (const bf16_t*)(ws + WS_BUFC + C_VCT) + (size_t)bh * 64 * 512;
        const int ct_hi = (q0 + 32) >> 10, cfar_hi = (q0 >= 1167) ? ((q0 - 1167) >> 10) : -1;
        float m_ref = 0.f; bool mset = false;
        float lsum = 0.f;
        const int rmode = ctr_idx ? NSA_REP_MODE : 0;
        if (rmode != 2) nsa_branch<M_CMP, 1>(smem, kc, vct, 512, 0, ct_hi, 0, cfar_hi, qf, tq, c31, tblg, selrow, m_ref, mset, lsum, 0.f, o, (LAS float*)(smem + NSA_IMP) + ql * 132);
        { const float lt = lsum + __shfl_xor(lsum, 32); const float inv = lt > 0.f ? 1.f / lt : 0.f;
          if (rmode != 2 && rmode != 4) nsa_branch<M_CMP, 2>(smem, kc, vct, 512, 0, ct_hi, 0, cfar_hi, qf, tq, c31, tblg, selrow, m_ref, mset, lsum, inv, o, (LAS float*)(smem + NSA_IMP) + ql * 132);
#pragma unroll
          for (int v = 0; v < 2; ++v)
#pragma unroll
            for (int i = 0; i < 16; ++i) o[v][i] *= inv; }
        asm volatile("s_waitcnt lgkmcnt(0)" ::: "memory"); __syncthreads();
        if (rmode < 2) {
            const int q = tid >> 3, sub = tid & 7, t = q0 + q;
            unsigned key[16];
#pragma unroll
            for (int i = 0; i < 16; ++i) {
                const int j = sub * 16 + i;
                const bool forced = (j == 0) || (j == cur) || (j == cur - 1);
                const bool valid = (j * 64 <= t);
                const float v = imp[q * 132 + j];
                key[i] = forced ? 0xFFFFFFFFu : (valid ? (__float_as_uint(v) + 1u) : 0u);
            }
            unsigned tau = 0u;
            for (int bit = 31; bit >= 0; --bit) {
                const unsigned cand = tau | (1u << bit);
                int c = 0;
#pragma unroll
                for (int i = 0; i < 16; ++i) c += (key[i] >= cand) ? 1 : 0;
                c += __builtin_amdgcn_update_dpp(0, c, 0xB1, 0xF, 0xF, true); c += __builtin_amdgcn_update_dpp(0, c, 0x4E, 0xF, 0xF, true); c += __builtin_amdgcn_update_dpp(0, c, 0x141, 0xF, 0xF, true);
                if (c >= 16) tau = cand;
            }
            int gt = 0, eq = 0;
#pragma unroll
            for (int i = 0; i < 16; ++i) { gt += (key[i] > tau) ? 1 : 0; eq += (key[i] == tau) ? 1 : 0; }
            int gtt = gt; gtt += __builtin_amdgcn_update_dpp(0, gtt, 0xB1, 0xF, 0xF, true); gtt += __builtin_amdgcn_update_dpp(0, gtt, 0x4E, 0xF, 0xF, true); gtt += __builtin_amdgcn_update_dpp(0, gtt, 0x141, 0xF, 0xF, true);
            int pre = 0;
#pragma unroll
            for (int sI = 0; sI < 7; ++sI) { const int v = __shfl(eq, (lane & ~7) + sI); if (sI < sub) pre += v; }
            const int need = 16 - gtt;
            unsigned bits = 0u; int run = pre;
#pragma unroll
            for (int i = 0; i < 16; ++i) {
                bool sel = key[i] > tau;
                if (tau > 0u && key[i] == tau) { sel = run < need; ++run; }
                bits |= sel ? (1u << i) : 0u;
            }
            atomicOr(&selm[q * 4 + (sub >> 1)], bits << ((sub & 1) * 16));
        }
        __syncthreads();
        const float gc = G[((size_t)b * 8192 + tq) * 48 + hkv * 12 + g * 3 + 0];
#pragma unroll
        for (int v = 0; v < 2; ++v)
#pragma unroll
            for (int i = 0; i < 16; i += 2) { const float gcc = (PROBE == 1 ? 0.f : gc); tot[(v * 8 + (i >> 1)) * 512 + tid] = cvt_pk_bf16(gcc * o[v][i], gcc * o[v][i + 1]); o[v][i] = 0.f; o[v][i + 1] = 0.f; }
        {
            const bf16_t* ks = (const bf16_t*)(ws + WS_BUFC + C_KS) + (size_t)bh * 8192 * 64;
            const bf16_t* vst = (const bf16_t*)(ws + WS_BUFC + C_VST) + (size_t)bh * 64 * 8192;
            m_ref = 0.f; mset = false;
            lsum = 0.f;
            if (rmode == 0) nsa_branch<M_SEL, 0>(smem, ks, vst, 8192, 0, cur, 0, cur - 3, qf, tq, c31, tblg, selrow, m_ref, mset, lsum, 0.f, o, (LAS float*)nullptr);
            const float gs = G[((size_t)b * 8192 + tq) * 48 + hkv * 12 + g * 3 + 1];
            const float sc = (PROBE == 2 ? 0.f : gs) / (lsum + __shfl_xor(lsum, 32));
#pragma unroll
            for (int v = 0; v < 2; ++v)
#pragma unroll
                for (int i = 0; i < 16; i += 2) { const unsigned tv = tot[(v * 8 + (i >> 1)) * 512 + tid];
                    tot[(v * 8 + (i >> 1)) * 512 + tid] = cvt_pk_bf16(bf2f(tv & 0xffffu) + sc * o[v][i], bf2f(tv >> 16) + sc * o[v][i + 1]); o[v][i] = 0.f; o[v][i + 1] = 0.f; }
        }
        {
            const bf16_t* kw = (const bf16_t*)(ws + WS_BUFC + C_KW) + (size_t)bh * 8192 * 64;
            const bf16_t* vwt = (const bf16_t*)(ws + WS_BUFC + C_VWT) + (size_t)bh * 64 * 8192;
            m_ref = 0.f; mset = false;
            lsum = 0.f;
            const int w_lo = cur >= 8 ? cur - 8 : 0;
            if (rmode == 0 || rmode == 2) nsa_branch<M_WIN, 0>(smem, kw, vwt, 8192, w_lo, cur, cur - 7, cur - 3, qf, tq, c31, tblg, selrow, m_ref, mset, lsum, 0.f, o, (LAS float*)nullptr);
            const float gw = G[((size_t)b * 8192 + tq) * 48 + hkv * 12 + g * 3 + 2];
            const float sc = (PROBE == 3 ? 0.f : gw) / (lsum + __shfl_xor(lsum, 32));
            bf16_t* orow = CC + trow * 2048 + hkv * 256 + g * 64;
#pragma unroll
            for (int v = 0; v < 2; ++v)
#pragma unroll
                for (int c4 = 0; c4 < 4; ++c4) {
                    const unsigned ta = tot[(v * 8 + 2 * c4) * 512 + tid], tb = tot[(v * 8 + 2 * c4 + 1) * 512 + tid];
                    const float r0 = bf2f(ta & 0xffffu) + sc * o[v][4 * c4 + 0], r1 = bf2f(ta >> 16) + sc * o[v][4 * c4 + 1];
                    const float r2 = bf2f(tb & 0xffffu) + sc * o[v][4 * c4 + 2], r3 = bf2f(tb >> 16) + sc * o[v][4 * c4 + 3];
                    u32x2 ov; ov.x = cvt_pk_bf16(r0, r1); ov.y = cvt_pk_bf16(r2, r3);
                    *(u32x2*)(orow + 32 * v + 8 * c4 + 4 * h) = ov;
                }
        }
        if (ctr_idx == 0) {
            __syncthreads();
            for (int k = 0; k < 3; ++k) {
                int item = 0;
                if (lane == 0) item = (int)atomicAdd(trc, 1u);
                item = __builtin_amdgcn_readfirstlane(item);
                if (item >= MOE_W_ITEMS) break;
                moe_weight_item(p, smem, item);
            }
        }
    }
    if (ctr_idx == 0) {
        __syncthreads();
        for (;;) {
            int item = 0;
            if ((threadIdx.x & 63) == 0) item = (int)atomicAdd(trc, 1u);
            item = __builtin_amdgcn_readfirstlane(item);
            if (item >= MOE_W_ITEMS) break;
            moe_weight_item(p, smem, item);
        }
    }
}

template <int which>
DEVI void phase_ln(const Params& p) {
    unsigned char* ws = p.ws;
    int tid = threadIdx.x; asm volatile("" : "+v"(tid));
    const int lane = tid & 63, w = tid >> 6;
    for (int it = blockIdx.x; it < T_ / 8; it += gridDim.x) {
        const int t = it * 8 + w;
        float* row = p.out + (size_t)t * D_;
        f32x4 v[8]; row_load(row, lane, v);
        float mean, rstd; row_stats(v, mean, rstd);
        if (which == 0) {
            if (lane == 0) { float* st = (float*)(ws + WS_STATS); st[t * 2] = mean; st[t * 2 + 1] = rstd; }
            bf16_t* hi = (bf16_t*)(ws + WS_BUFB) + (size_t)t * D_;
#pragma unroll
            for (int c = 0; c < 8; ++c) {
                const int col = c * 256 + lane * 4;
                const f32x4 g = *(const f32x4*)(p.in[17] + col), b = *(const f32x4*)(p.in[18] + col);
                const f32x4 y = (v[c] - mean) * rstd * g + b;
                u32x2 o; o.x = cvt_pk_bf16(y.x, y.y); o.y = cvt_pk_bf16(y.z, y.w);
                *(u32x2*)(hi + col) = o;
            }
        } else if (which == 1) {
            bf16_t* hi = (bf16_t*)(ws + WS_BUFA) + (size_t)t * D_;
            bf16_t* lo = (bf16_t*)(ws + WS_BUFB) + (size_t)t * D_;
#pragma unroll
            for (int c = 0; c < 8; ++c) {
                const int col = c * 256 + lane * 4;
                const f32x4 g = *(const f32x4*)(p.in[24] + col), b = *(const f32x4*)(p.in[25] + col);
                const f32x4 y = (v[c] - mean) * rstd * g + b;
                u32x2 o; o.x = cvt_pk_bf16(y.x, y.y); o.y = cvt_pk_bf16(y.z, y.w);
                *(u32x2*)(hi + col) = o;
                u32x2 ol;
                ol.x = cvt_pk_bf16(y.x - bf2f(o.x & 0xffffu), y.y - bf2f(o.x >> 16));
                ol.y = cvt_pk_bf16(y.z - bf2f(o.y & 0xffffu), y.w - bf2f(o.y >> 16));
                *(u32x2*)(lo + col) = ol;
            }
        } else {
            const bf16_t* y0 = (const bf16_t*)(ws + WS_BUFC) + (size_t)t * 2 * D_;
#pragma unroll
            for (int c = 0; c < 8; ++c) {
                const int col = c * 256 + lane * 4;
                const f32x4 g = *(const f32x4*)(p.in[24] + col), b = *(const f32x4*)(p.in[25] + col);
                const f32x4 x2 = (v[c] - mean) * rstd * g + b;
                const u32x2 a = *(const u32x2*)(y0 + col), bq = *(const u32x2*)(y0 + D_ + col);
                v[c].x = x2.x * ALPHA + (bf2f(a.x & 0xffffu) + bf2f(bq.x & 0xffffu));
                v[c].y = x2.y * ALPHA + (bf2f(a.x >> 16) + bf2f(bq.x >> 16));
                v[c].z = x2.z * ALPHA + (bf2f(a.y & 0xffffu) + bf2f(bq.y & 0xffffu));
                v[c].w = x2.w * ALPHA + (bf2f(a.y >> 16) + bf2f(bq.y >> 16));
            }
            row_stats(v, mean, rstd);
#pragma unroll
            for (int c = 0; c < 8; ++c) {
                const int col = c * 256 + lane * 4;
                const f32x4 g = *(const f32x4*)(p.in[33] + col), b = *(const f32x4*)(p.in[34] + col);
                *(f32x4*)(row + col) = (v[c] - mean) * rstd * g + b;
            }
        }
    }
}

DEVI void phase_xattn(const Params& p, char* smem) {
    unsigned char* ws = p.ws;
    int tid = threadIdx.x; asm volatile("" : "+v"(tid));
    const int lane = tid & 63, w = tid >> 6, l31 = lane & 31, h = lane >> 5;
    const bf16_t* Qx = (const bf16_t*)(ws + WS_BUFC);
    const bf16_t* Kx = (const bf16_t*)(ws + WS_BUFD + 4 * MiB);
    const bf16_t* Vt = (const bf16_t*)(ws + WS_BUFD + 8 * MiB);
    bf16_t* Ox = (bf16_t*)(ws + WS_BUFA);
    bf16_t* Qs = (bf16_t*)smem;
    bf16_t* Ks = Qs + 256 * KSTR;
    bf16_t* Vs = (bf16_t*)smem;
    for (int unit = blockIdx.x; unit < 512; unit += gridDim.x) {
        const int qt = unit & 31, head = (unit >> 5) & 3, b = unit >> 7;
        const size_t t0 = (size_t)b * 8192 + qt * 256;
        const bf16_t* kbase = Kx + (size_t)(b * 4 + head) * 256 * 512;
        const bf16_t* vbase = Vt + (size_t)(b * 4 + head) * 512 * 256;
        f32x16 s[8];
#pragma unroll
        for (int u = 0; u < 8; ++u)
#pragma unroll
            for (int i = 0; i < 16; ++i) s[u][i] = 0.f;
        u32x4 pq[4], pk4[4];
#pragma unroll
        for (int i = 0; i < 4; ++i) { const int c = tid + 512 * i, row = c >> 3, ch = c & 7;
            pq[i] = *(const u32x4*)(Qx + (t0 + row) * 2048 + head * 512 + ch * 8); pk4[i] = *(const u32x4*)(kbase + (size_t)row * 512 + ch * 8); }
        for (int dc = 0; dc < 8; ++dc) {
            __syncthreads();
#pragma unroll
            for (int i = 0; i < 4; ++i) { const int c = tid + 512 * i, row = c >> 3, ch = c & 7;
                *(u32x4*)(Qs + row * KSTR + ch * 8) = pq[i]; *(u32x4*)(Ks + row * KSTR + ch * 8) = pk4[i]; }
            __syncthreads();
            if (dc + 1 < 8) {
#pragma unroll
                for (int i = 0; i < 4; ++i) { const int c = tid + 512 * i, row = c >> 3, ch = c & 7;
                    pq[i] = *(const u32x4*)(Qx + (t0 + row) * 2048 + head * 512 + (dc + 1) * 64 + ch * 8); pk4[i] = *(const u32x4*)(kbase + (size_t)row * 512 + (dc + 1) * 64 + ch * 8); }
            }
#pragma unroll
            for (int ks = 0; ks < 4; ++ks) {
                const bf16x8 qb = *(const bf16x8*)(Qs + (32 * w + l31) * KSTR + 16 * ks + 8 * h);
#pragma unroll
                for (int u = 0; u < 8; ++u) { const bf16x8 ka = *(const bf16x8*)(Ks + (32 * u + l31) * KSTR + 16 * ks + 8 * h); s[u] = mfma32(ka, qb, s[u]); }
            }
        }
        u32x4 pv[4];
#pragma unroll
        for (int i = 0; i < 4; ++i) { const int c = tid + 512 * i, row = c >> 5, ch = c & 31; pv[i] = *(const u32x4*)(vbase + (size_t)row * 256 + ch * 8); }
        float mx = -INFINITY;
#pragma unroll
        for (int u = 0; u < 8; ++u)
#pragma unroll
            for (int i = 0; i < 16; i += 2) mx = max3f(mx, s[u][i], s[u][i + 1]);
        mx = fmaxf(mx, __shfl_xor(mx, 32));
        float ls = 0.f;
        bf16x8 pf[8][2];
#pragma unroll
        for (int u = 0; u < 8; ++u) {
#pragma unroll
            for (int i = 0; i < 16; ++i) { s[u][i] = fexp2(s[u][i] - mx); ls += s[u][i]; }
#pragma unroll
            for (int sI = 0; sI < 2; ++sI) { u32x4 pk;
                pk.x = cvt_pk_bf16(s[u][8 * sI + 0], s[u][8 * sI + 1]); pk.y = cvt_pk_bf16(s[u][8 * sI + 2], s[u][8 * sI + 3]);
                pk.z = cvt_pk_bf16(s[u][8 * sI + 4], s[u][8 * sI + 5]); pk.w = cvt_pk_bf16(s[u][8 * sI + 6], s[u][8 * sI + 7]);
                pf[u][sI] = __builtin_bit_cast(bf16x8, pk); }
        }
        ls += __shfl_xor(ls, 32);
        const float inv = (PROBE == 4 ? 0.f : 1.f) / ls;
        bf16_t* orow = Ox + (t0 + 32 * w + l31) * 2048 + head * 512;
        for (int dc = 0; dc < 8; ++dc) {
            __syncthreads();
#pragma unroll
            for (int i = 0; i < 4; ++i) { const int c = tid + 512 * i, row = c >> 5, ch = c & 31; *(u32x4*)(Vs + row * 264 + ch * 8) = pv[i]; }
            __syncthreads();
            if (dc + 1 < 8) {
#pragma unroll
                for (int i = 0; i < 4; ++i) { const int c = tid + 512 * i, row = c >> 5, ch = c & 31; pv[i] = *(const u32x4*)(vbase + (size_t)((dc + 1) * 64 + row) * 256 + ch * 8); }
            }
            f32x16 o[2];
#pragma unroll
            for (int v = 0; v < 2; ++v)
#pragma unroll
                for (int i = 0; i < 16; ++i) o[v][i] = 0.f;
#pragma unroll
            for (int s4 = 0; s4 < 16; ++s4)
#pragma unroll
                for (int v = 0; v < 2; ++v) {
                    const bf16_t* vr = Vs + (32 * v + l31) * 264 + 16 * s4 + 4 * h;
                    const u32x2 a = *(const u32x2*)vr, bq = *(const u32x2*)(vr + 8);
                    u32x4 vv; vv.x = a.x; vv.y = a.y; vv.z = bq.x; vv.w = bq.y;
                    o[v] = mfma32(__builtin_bit_cast(bf16x8, vv), pf[s4 >> 1][s4 & 1], o[v]);
                }
#pragma unroll
            for (int v = 0; v < 2; ++v)
#pragma unroll
                for (int c4 = 0; c4 < 4; ++c4) {
                    u32x2 ov; ov.x = cvt_pk_bf16(o[v][4 * c4] * inv, o[v][4 * c4 + 1] * inv); ov.y = cvt_pk_bf16(o[v][4 * c4 + 2] * inv, o[v][4 * c4 + 3] * inv);
                    *(u32x2*)(orow + dc * 64 + 32 * v + 8 * c4 + 4 * h) = ov;
                }
        }
        __syncthreads();
    }
}

DEVI void phase_route(const Params& p) {
    unsigned char* ws = p.ws;
    const float* L = (const float*)(ws + WS_LOGITS);
    unsigned* cnt = (unsigned*)(ws + WS_CTL) + CW_CNT;
    int* list = (int*)(ws + WS_LIST);
    float* wt = (float*)(ws + WS_WTOK);
    int tid = threadIdx.x; asm volatile("" : "+v"(tid));
    for (int t = blockIdx.x * NTHREADS + tid; t < T_; t += gridDim.x * NTHREADS) {
        const f32x4 lgv = *(const f32x4*)(L + (size_t)t * 40);
        float lg[4] = {lgv.x + p.in[27][0], lgv.y + p.in[27][1], lgv.z + p.in[27][2], lgv.w + p.in[27][3]};
        int grp = 0; float best = lg[0];
#pragma unroll
        for (int i = 1; i < 4; ++i) if (lg[i] > best) { best = lg[i]; grp = i; }
        float se = 0.f;
#pragma unroll
        for (int i = 0; i < 4; ++i) se += expf(lg[i] - best);
        const float wgrp = 1.f / se;
        const f32x4 e0 = *(const f32x4*)(L + (size_t)t * 40 + 4 + grp * 8), e1 = *(const f32x4*)(L + (size_t)t * 40 + 8 + grp * 8);
        const f32x4 b0 = *(const f32x4*)(p.in[29] + grp * 8), b1 = *(const f32x4*)(p.in[29] + grp * 8 + 4);
        float le[8] = {e0.x + b0.x, e0.y + b0.y, e0.z + b0.z, e0.w + b0.w, e1.x + b1.x, e1.y + b1.y, e1.z + b1.z, e1.w + b1.w};
        int i0 = 0; float v0 = le[0];
#pragma unroll
        for (int i = 1; i < 8; ++i) if (le[i] > v0) { v0 = le[i]; i0 = i; }
        int i1 = -1; float v1 = -INFINITY;
#pragma unroll
        for (int i = 0; i < 8; ++i) if (i != i0 && le[i] > v1) { v1 = le[i]; i1 = i; }
        const float ex = expf(v1 - v0);
        const float w0 = wgrp / (1.f + ex), w1 = wgrp * ex / (1.f + ex);
        const int ea = grp * 8 + i0, eb = grp * 8 + i1;
        const unsigned pa = atomicAdd(cnt + ea, 1u); list[(size_t)ea * T_ + pa] = t * 2;
        const unsigned pb = atomicAdd(cnt + eb, 1u); list[(size_t)eb * T_ + pb] = t * 2 + 1;
        wt[t * 2] = w0; wt[t * 2 + 1] = w1;
    }
}

enum { PH_PREP = 0, PH_PROJ, PH_CMP1, PH_CMP2, PH_NSA, PH_OUT, PH_LN1, PH_WQ, PH_XATTN, PH_WO, PH_LN2, PH_ROUTER, PH_ROUTE, PH_MOE1, PH_MOE2, PH_LN3, PH_COUNT };

__global__ void __launch_bounds__(NTHREADS, 2) fwd_megakernel(Params p) {
    extern __shared__ __attribute__((aligned(16))) char smem[];
    cg::grid_group grid = cg::this_grid();
    volatile LAS unsigned* bar_st = (volatile LAS unsigned*)(smem + LDS_BYTES - 16);
    if (threadIdx.x < 2) bar_st[threadIdx.x] = 0u;
    __syncthreads();
    xcd_barrier_post((unsigned*)(p.ws + WS_CTL) + CW_BAR);
    const int lo = p.ph_lo, hi = p.ph_hi;
    unsigned long long ts0 = 0, ts1 = 0;
    if (TSTAMP_PHASE >= 0) ts0 = __builtin_amdgcn_s_memrealtime();
#ifndef PHMASK
#define PHMASK 0xFFFFFFFFu
#endif
#define IN(k) (lo <= (k) && (k) < hi && ((PHMASK >> (k)) & 1u))
#define SEAM(k) do { if (IN(k) && IN((k) + 1)) { if ((k) == 0) grid.sync(); else xcd_barrier((unsigned*)(p.ws + WS_CTL) + CW_BAR, (volatile LAS unsigned*)(smem + LDS_BYTES - 16)); } if ((k) == TSTAMP_PHASE) ts1 = __builtin_amdgcn_s_memrealtime(); } while (0)
    if (IN(PH_PREP)) for (int r = 0; r < REP_PREP; ++r) phase_prep(p, smem);
    SEAM(PH_PREP);
    if (IN(PH_PROJ)) { for (int r = 0; r < REP_PROJ; ++r) gemm_job<J_PROJ>(p, smem); for (int r = 0; r < REP_SMALL; ++r) gemm_job<J_MEMKV>(p, smem); }
    SEAM(PH_PROJ);
    if (IN(PH_CMP1)) { for (int r = 0; r < REP_SMALL; ++r) gemm_job<J_CMP1>(p, smem); for (int r = 0; r < REP_CONV; ++r) phase_conv(p); }
    SEAM(PH_CMP1);
    if (IN(PH_CMP2)) for (int r = 0; r < REP_SMALL; ++r) gemm_job<J_CMP2>(p, smem);
    SEAM(PH_CMP2);
    if (IN(PH_NSA)) { conv_finish(p); for (int r = 0; r < REP_NSA; ++r) phase_nsa(p, smem, r); }
    SEAM(PH_NSA);
    if (IN(PH_OUT)) for (int r = 0; r < REP_OUT; ++r) gemm_direct<J_OUT>(p, smem);
    SEAM(PH_OUT);
    if (IN(PH_WQ)) { gemm_direct<J_WQ>(p, smem); for (int r = 1; r < REP_WQ; ++r) gemm_job<J_WQ, WQ_VAR>(p, smem); }
    SEAM(PH_WQ);
    if (IN(PH_XATTN)) for (int r = 0; r < REP_XATTN; ++r) phase_xattn(p, smem);
    SEAM(PH_XATTN);
    if (IN(PH_WO)) gemm_direct<J_WO>(p, smem);
    SEAM(PH_WO);
    if (IN(PH_LN2)) phase_ln<1>(p);
    SEAM(PH_LN2);
    if (IN(PH_ROUTER)) for (int r = 0; r < REP_SMALL; ++r) gemm_job<J_ROUTER>(p, smem);
    SEAM(PH_ROUTER);
    if (IN(PH_MOE1)) for (int r = 0; r < REP_MOE; ++r) gemm_job<J_MOE1>(p, smem);
    SEAM(PH_MOE1);
    if (IN(PH_MOE2)) for (int r = 0; r < REP_MOE; ++r) gemm_job<J_MOE2>(p, smem);
    SEAM(PH_MOE2);
    if (IN(PH_LN3)) phase_ln<2>(p);
    if (TSTAMP_PHASE >= 0 && blockIdx.x == 0 && threadIdx.x == 0) { const unsigned long long t2 = __builtin_amdgcn_s_memrealtime(); const unsigned long long wait = 4ull * (ts1 - ts0); while (__builtin_amdgcn_s_memrealtime() - t2 < wait) __builtin_amdgcn_s_sleep(32); }
#undef IN
#undef SEAM
}

#ifndef N_SPLIT
#define N_SPLIT 1
#endif

extern "C" void kernel_launch(void* const* d_in, const int* in_sizes, int n_in, void* d_out, int out_size, void* d_ws, size_t ws_size, hipStream_t stream) {
    static int grid_blocks = 0;
    if (grid_blocks == 0) {
        if (n_in != 35 || ws_size < WS_END || out_size != T_ * D_) { fprintf(stderr, "kernel_launch: unexpected sizes n_in %d ws %zu out %d\n", n_in, ws_size, out_size); grid_blocks = -1; return; }
        int dev = 0, cus = 0, per_cu = 0;
        hipGetDevice(&dev);
        hipDeviceGetAttribute(&cus, hipDeviceAttributeMultiprocessorCount, dev);
        hipFuncSetAttribute((const void*)fwd_megakernel, hipFuncAttributeMaxDynamicSharedMemorySize, LDS_BYTES);
        hipOccupancyMaxActiveBlocksPerMultiprocessor(&per_cu, (const void*)fwd_megakernel, NTHREADS, LDS_BYTES);
        if (per_cu < 1) { fprintf(stderr, "kernel_launch: occupancy query says %d blocks per CU\n", per_cu); grid_blocks = -1; return; }
        if (per_cu > 2) per_cu = 2;
        grid_blocks = cus * per_cu;
        fprintf(stderr, "kernel_launch: %d CUs x %d blocks\n", cus, per_cu);
    }
    if (grid_blocks < 0) return;
    hipMemsetAsync((char*)d_ws + WS_CTL, 0, 1 * MiB, stream);
    hipMemsetAsync((char*)d_ws + WS_RSUM1, 0, 1 * MiB, stream);
    Params p{};
    for (int i = 0; i < 35; ++i) p.in[i] = (const float*)d_in[i];
    p.out = (float*)d_out; p.ws = (unsigned char*)d_ws;
    if (N_SPLIT == 1) {
        p.ph_lo = 0; p.ph_hi = PH_COUNT;
        void* args[] = {&p};
        hipError_t e = hipLaunchCooperativeKernel((const void*)fwd_megakernel, dim3(grid_blocks), dim3(NTHREADS), args, LDS_BYTES, stream);
        if (e != hipSuccess) fprintf(stderr, "cooperative launch failed: %s (grid %d)\n", hipGetErrorString(e), grid_blocks);
    } else {
        for (int ph = 0; ph < PH_COUNT; ++ph) {
            p.ph_lo = ph; p.ph_hi = ph + 1;
            void* args[] = {&p};
            hipError_t e = hipLaunchCooperativeKernel((const void*)fwd_megakernel, dim3(grid_blocks), dim3(NTHREADS), args, LDS_BYTES, stream);
            if (e != hipSuccess) fprintf(stderr, "launch %d failed: %s\n", ph, hipGetErrorString(e));
        }
    }
}
```

```cpp
#include <hip/hip_runtime.h>
#include <hip/hip_cooperative_groups.h>
#include <cstdio>
#include <cstdint>
namespace cg = cooperative_groups;

#define DEVI __device__ __forceinline__
#ifndef REP_PREP
#define REP_PREP 1
#define REP_PROJ 1
#define REP_NSA 1
#define REP_WQ 1
#define WQ_VAR 3
#define REP_XATTN 1
#define REP_MOE 1
#define REP_LN3 1
#define REP_CONV 1
#define REP_OUT 1
#define REP_SMALL 1
#endif
#ifndef NSA_REP_MODE
#define NSA_REP_MODE 0
#endif
#ifndef TSTAMP_PHASE
#define TSTAMP_PHASE -1
#endif
#ifndef PROBE
#define PROBE 0
#endif
typedef unsigned short bf16_t;
typedef __attribute__((ext_vector_type(8))) short bf16x8;
typedef __attribute__((ext_vector_type(4))) float f32x4;
typedef __attribute__((ext_vector_type(16))) float f32x16;
typedef __attribute__((ext_vector_type(4))) unsigned u32x4;
typedef __attribute__((ext_vector_type(2))) unsigned u32x2;

constexpr int T_ = 32768, D_ = 2048, S_ = 8192, NB_ = 4;
constexpr int NPROJ = 4736;
constexpr int IN_COLS = 4656;
constexpr float ALPHA = 1.189207115002721f;
constexpr float LOG2E = 1.4426950408889634f;
constexpr float LN_EPS = 1e-5f;
constexpr int NTHREADS = 512;
constexpr int LDS_BYTES = 147968;

constexpr size_t MiB = 1ull << 20;
constexpr size_t WS_CTL = 0;
constexpr size_t WS_STATS = 1 * MiB;
constexpr size_t WS_C1BIAS = WS_STATS + 256 * 1024;
constexpr size_t WS_WTOK = WS_STATS + 512 * 1024;
constexpr size_t WS_LOGITS = 2 * MiB;
constexpr size_t WS_LIST = 7 * MiB;
constexpr size_t WS_WC1 = 11 * MiB;
constexpr size_t WS_WC2 = 13 * MiB;
constexpr size_t WS_WR = 14 * MiB;
constexpr size_t WS_WIN = 15 * MiB;
constexpr size_t WS_WOUT = 34 * MiB;
constexpr size_t WS_WQ = 42 * MiB;
constexpr size_t WS_WKV = 50 * MiB;
constexpr size_t WS_WO = 66 * MiB;
constexpr size_t WS_WGU = 74 * MiB;
constexpr size_t WS_WD = 202 * MiB;
constexpr size_t WS_BUFA = 266 * MiB;
constexpr size_t WS_BUFB = 394 * MiB;
constexpr size_t WS_BUFC = 522 * MiB;
constexpr size_t WS_BUFD = 650 * MiB;
constexpr size_t WS_BUFE = 778 * MiB;
constexpr size_t WS_END = 906 * MiB;
constexpr size_t C_KCMP = 0, C_VCMP = 16 * MiB, C_KS = 32 * MiB, C_VST = 48 * MiB, C_KW = 64 * MiB, C_VWT = 80 * MiB,
                 C_GATES = 96 * MiB, C_HID = 102 * MiB, C_KC = 110 * MiB, C_VCT = 111 * MiB;
constexpr int CW_CNT = 64;
constexpr int CW_NSA = 1024;
constexpr int CW_TR = 2048;
constexpr int CW_BAR = 4096;
constexpr size_t CTL_U1 = 65536, CTL_C1 = 73728;
constexpr size_t CTL_U2 = 81920, CTL_C2 = 82944;
constexpr size_t CTL_UE = 131072, CTL_CE = 262144;
constexpr size_t WS_RSUM2 = WS_LOGITS + 256 * 1024;
constexpr size_t WS_RSUM1 = WS_LOGITS;

struct Params {
    const float* in[35];
    float* out;
    unsigned char* ws;
    int ph_lo, ph_hi;
};

DEVI unsigned cvt_pk_bf16(float lo, float hi) { unsigned r; asm("v_cvt_pk_bf16_f32 %0, %1, %2" : "=v"(r) : "v"(lo), "v"(hi)); return r; }
DEVI bf16_t f2bf(float x) { return (bf16_t)(cvt_pk_bf16(x, 0.f) & 0xffffu); }
DEVI float bf2f(unsigned b) { return __uint_as_float(b << 16); }
DEVI void glds16(const void* g, void* l) {
    __builtin_amdgcn_global_load_lds((const __attribute__((address_space(1))) void*)g, (__attribute__((address_space(3))) void*)l, 16, 0, 0);
}
DEVI f32x16 mfma32(bf16x8 a, bf16x8 b, f32x16 c) { return __builtin_amdgcn_mfma_f32_32x32x16_bf16(a, b, c, 0, 0, 0); }
DEVI u32x2 gload8_asm(const void* g) { u32x2 r; asm volatile("global_load_dwordx2 %0, %1, off" : "=v"(r) : "v"(g) : "memory"); return r; }
DEVI f32x4 gload16_asm(const void* g) { f32x4 r; asm volatile("global_load_dwordx4 %0, %1, off" : "=v"(r) : "v"(g) : "memory"); return r; }
DEVI f32x4 mfma16(bf16x8 a, bf16x8 b, f32x4 c) { return __builtin_amdgcn_mfma_f32_16x16x32_bf16(a, b, c, 0, 0, 0); }
DEVI float fexp2(float x) { return __builtin_amdgcn_exp2f(x); }
DEVI float max3f(float a, float b, float c) { float r; asm("v_max3_f32 %0, %1, %2, %3" : "=v"(r) : "v"(a), "v"(b), "v"(c)); return r; }
DEVI float wave_sum(float v) {
#pragma unroll
    for (int o = 1; o < 64; o <<= 1) v += __shfl_xor(v, o);
    return v;
}
DEVI float sigmoidf_(float x) { return 1.f / (1.f + __expf(-x)); }
DEVI float gelu_tanh(float x) {
    const float u = 0.7978845608028654f * (x + 0.044715f * x * x * x);
    const float e = __expf(2.f * u);
    const float th = 1.f - 2.f / (e + 1.f);
    return 0.5f * x * (1.f + th);
}

#define LAS __attribute__((address_space(3)))
#define XB_TMO      128
#define XB_XCNT(j)  (256  + 64 * (j))
#define XB_XSUB(j)  (1280 + 64 * (j))
#define XB_XGEN(j)  (2304 + 64 * (j))
#define XB_TOP      3328
#define XB_TOPGEN   3392
#define XB_SPIN_CAP (1u << 22)
DEVI unsigned xb_ld(unsigned* p) { return __hip_atomic_load(p, __ATOMIC_RELAXED, __HIP_MEMORY_SCOPE_AGENT); }
DEVI unsigned xb_add(unsigned* p, unsigned v) { return __hip_atomic_fetch_add(p, v, __ATOMIC_RELAXED, __HIP_MEMORY_SCOPE_AGENT); }
DEVI unsigned xb_xcc_id() { return (unsigned)__builtin_amdgcn_s_getreg((3 << 11) | 20) & 0xFu; }
#define XB_SPIN(cond, bar) do { unsigned _sp = 0; while (cond) { __builtin_amdgcn_s_sleep(1); \
    if ((++_sp & 255u) == 0u) { if (xb_ld(&(bar)[XB_TMO])) break; if (_sp > XB_SPIN_CAP) { atomicAdd(&(bar)[XB_TMO], 1u); break; } } } } while (0)
DEVI void xcd_barrier_post(unsigned* bar) {
    if (threadIdx.x == 0) (void)xb_add(&bar[XB_XCNT(xb_xcc_id())], 1u);
}
DEVI void xcd_barrier_complete(unsigned* bar, unsigned x, unsigned& nloc, unsigned& nx) {
    const unsigned G = gridDim.x * gridDim.y * gridDim.z;
    unsigned sum, cnt, mine, sp = 0u;
    for (;;) {
        sum = 0u; cnt = 0u; mine = 0u;
#pragma unroll
        for (unsigned j = 0; j < 16; ++j) { const unsigned c = xb_ld(&bar[XB_XCNT(j)]); sum += c; cnt += (c > 0u) ? 1u : 0u; mine = (j == x) ? c : mine; }
        if (sum == G) break;
        __builtin_amdgcn_s_sleep(1);
        if ((++sp & 255u) == 0u) { if (xb_ld(&bar[XB_TMO])) break; if (sp > XB_SPIN_CAP) { atomicAdd(&bar[XB_TMO], 1u); break; } }
    }
    nloc = mine > 0u ? mine : 1u; nx = cnt > 0u ? cnt : 1u;
}
DEVI void xcd_barrier(unsigned* bar, volatile LAS unsigned* st) {
    asm volatile("s_waitcnt vmcnt(0)" ::: "memory");
    __syncthreads();
    if (threadIdx.x == 0) {
        const unsigned x = xb_xcc_id();
        __builtin_amdgcn_s_waitcnt(0);
        unsigned nloc = st[0], nx = st[1];
        if (nloc == 0u) { xcd_barrier_complete(bar, x, nloc, nx); st[0] = nloc; st[1] = nx; }
        const unsigned old = xb_add(&bar[XB_XSUB(x)], 1u);
        const unsigned gen = old / nloc;
        if (old + 1u == (gen + 1u) * nloc) {
            __builtin_amdgcn_fence(__ATOMIC_RELEASE, "agent");
            asm volatile("s_waitcnt vmcnt(0)" ::: "memory");
            const unsigned og = xb_add(&bar[XB_TOP], 1u);
            const unsigned tg = og / nx;
            if (og + 1u == (tg + 1u) * nx) xb_add(&bar[XB_TOPGEN], 1u);
            else XB_SPIN(xb_ld(&bar[XB_TOPGEN]) == tg, bar);
            __builtin_amdgcn_fence(__ATOMIC_ACQUIRE, "agent");
            xb_add(&bar[XB_XGEN(x)], 1u);
            asm volatile("s_waitcnt vmcnt(0)" ::: "memory");
        } else {
            XB_SPIN(xb_ld(&bar[XB_XGEN(x)]) == gen, bar);
            __builtin_amdgcn_fence(__ATOMIC_ACQUIRE, "agent");
            asm volatile("s_waitcnt vmcnt(0)" ::: "memory");
        }
    }
    __syncthreads();
}

DEVI void row_load(const float* row, int lane, f32x4 (&v)[8]) {
#pragma unroll
    for (int c = 0; c < 8; ++c) v[c] = *(const f32x4*)(row + c * 256 + lane * 4);
}
DEVI void row_stats(const f32x4 (&v)[8], float& mean, float& rstd) {
    float s = 0.f;
#pragma unroll
    for (int c = 0; c < 8; ++c) s += (v[c].x + v[c].y) + (v[c].z + v[c].w);
    mean = wave_sum(s) * (1.f / D_);
    float q = 0.f;
#pragma unroll
    for (int c = 0; c < 8; ++c) { const f32x4 d = v[c] - mean; q += (d.x * d.x + d.y * d.y) + (d.z * d.z + d.w * d.w); }
    rstd = 1.f / sqrtf(wave_sum(q) * (1.f / D_) + LN_EPS);
}

DEVI const float* wsrc_col(const Params& p, int mat, int e, int n, int& ld) {
    switch (mat) {
    case 0: {
        ld = IN_COLS;
        if (n < 2560) return p.in[4] + n;
        if (n < 2688) { const int j = n - 2560; return j < 48 ? p.in[4] + 2560 + j : nullptr; }
        const int r = n - 2688, grp = r >> 6, within = r & 63;
        const int ch = grp * 32 + (within & 31), isg = within >> 5;
        return p.in[4] + 2608 + isg * 1024 + ch;
    }
    case 1: ld = 256; return p.in[6] + n;
    case 2: ld = 256; return p.in[9] + n;
    case 3: ld = 64; return n < 64 ? p.in[7] + n : nullptr;
    case 4: ld = 64; return n < 64 ? p.in[10] + n : nullptr;
    case 5: ld = 2048; return p.in[16] + n;
    case 6: ld = 2048; return p.in[21] + n;
    case 7: ld = 4096; return p.in[22] + n;
    case 8: ld = 2048; return p.in[23] + n;
    case 9: if (n < 4) { ld = 4; return p.in[26] + n; } if (n < 36) { ld = 32; return p.in[28] + (n - 4); } ld = 1; return nullptr;
    case 10: { ld = 512; const int grp = n >> 6, within = n & 63; const int ch = grp * 32 + (within & 31);
               return ((within >> 5) ? p.in[31] : p.in[30]) + (size_t)e * 2048 * 512 + ch; }
    default: ld = 2048; return p.in[32] + (size_t)e * 512 * 2048 + n;
    }
}
DEVI void wave_transpose_item(const Params& p, char* smem, int mat, int e, int ntile, int ktile, bf16_t* dst, bf16_t* dst_lo, int K,
                                const float* gvec = nullptr, const float* bvec = nullptr, float* U = nullptr, float* C = nullptr) {
    int tid = threadIdx.x; asm volatile("" : "+v"(tid));
    const int lane = tid & 63, w = tid >> 6;
    float* tile = (float*)smem + w * (64 * 65 + 32);
    const int k0 = ktile * 64;
    if (mat == 9) {
        int ld; const float* src = wsrc_col(p, mat, e, ntile * 64 + lane, ld);
#pragma unroll 8
        for (int k = 0; k < 64; ++k) tile[k * 65 + lane] = src ? src[(size_t)(k0 + k) * ld] : 0.f;
    } else {
        const int c4 = lane & 15, kr = lane >> 4;
        int ld; const float* src = wsrc_col(p, mat, e, ntile * 64 + c4 * 4, ld);
        f32x4 v[16];
#pragma unroll
        for (int i = 0; i < 16; ++i) v[i] = src ? *(const f32x4*)(src + (size_t)(k0 + kr + 4 * i) * ld) : (f32x4){0.f, 0.f, 0.f, 0.f};
#pragma unroll
        for (int i = 0; i < 16; ++i) { float* q = tile + (kr + 4 * i) * 65 + c4 * 4; q[0] = v[i].x; q[1] = v[i].y; q[2] = v[i].z; q[3] = v[i].w; }
    }
    asm volatile("s_waitcnt lgkmcnt(0)" ::: "memory");
    if (gvec) {
        float us = 0.f, cs = 0.f;
#pragma unroll 8
        for (int k = 0; k < 64; ++k) { const float wkn = tile[k * 65 + lane]; us += gvec[k0 + k] * wkn; cs += bvec[k0 + k] * wkn; }
        atomicAdd(U + ntile * 64 + lane, us); atomicAdd(C + ntile * 64 + lane, cs);
    }
    const int kc = lane & 7, nr = lane >> 3;
#pragma unroll
    for (int c = 0; c < 8; ++c) {
        const int n = nr + 8 * c;
        float wv[8];
#pragma unroll
        for (int j = 0; j < 8; ++j) wv[j] = tile[(kc * 8 + j) * 65 + n];
        if (gvec) {
#pragma unroll
            for (int j = 0; j < 8; ++j) wv[j] *= gvec[k0 + kc * 8 + j]; }
        u32x4 o; o.x = cvt_pk_bf16(wv[0], wv[1]); o.y = cvt_pk_bf16(wv[2], wv[3]); o.z = cvt_pk_bf16(wv[4], wv[5]); o.w = cvt_pk_bf16(wv[6], wv[7]);
        const size_t off = (size_t)(ntile * 64 + n) * K + k0 + kc * 8;
        if (!dst_lo) *(u32x4*)(dst + off) = o;
        else {
            float r[8];
#pragma unroll
            for (int j = 0; j < 8; ++j) r[j] = wv[j] - bf2f((unsigned)f2bf(wv[j]));
            u32x4 l; l.x = cvt_pk_bf16(r[0], r[1]); l.y = cvt_pk_bf16(r[2], r[3]); l.z = cvt_pk_bf16(r[4], r[5]); l.w = cvt_pk_bf16(r[6], r[7]);
            const size_t o0 = (size_t)n * K + k0 + kc * 8, o1 = (size_t)(64 + n) * K + k0 + kc * 8;
            if (ntile == 0) { *(u32x4*)(dst + o0) = o; *(u32x4*)(dst_lo + o0) = o; *(u32x4*)(dst + o1) = l; }
            else *(u32x4*)(dst_lo + o1) = (u32x4){0u, 0u, 0u, 0u};
        }
    }
    asm volatile("s_waitcnt lgkmcnt(0)" ::: "memory");
}

DEVI void phase_prep(const Params& p, char* smem) {
    int tid = threadIdx.x; asm volatile("" : "+v"(tid));
    const int lane = tid & 63, w = tid >> 6;
    unsigned char* ws = p.ws;
    for (int r = blockIdx.x; r < 8; r += gridDim.x) {
        const int type = r >> 2, n = (r & 3) * 64 + lane;
        const float* pe = p.in[type ? 8 : 5]; const float* w1 = p.in[type ? 9 : 6];
        float sacc = 0.f;
        for (int k = w * 256; k < (w + 1) * 256; ++k) sacc += pe[k] * w1[(size_t)k * 256 + n];
        float* red = (float*)smem;
        __syncthreads();
        red[w * 64 + lane] = sacc;
        __syncthreads();
        if (w == 0) ((float*)(ws + WS_C1BIAS))[type * 256 + n] = ((red[lane] + red[64 + lane]) + (red[128 + lane] + red[192 + lane])) + ((red[256 + lane] + red[320 + lane]) + (red[384 + lane] + red[448 + lane]));
        __syncthreads();
    }
    constexpr int I_LN = T_, I_MEM = 1024;
    constexpr int I_M0 = 74 * 32, I_M12 = 4 * 32, I_M34 = 2 * 4, I_SQ = 32 * 32, I_KV = 64 * 32, I_R = 2 * 32;
    constexpr int TOTAL = I_LN + I_MEM + I_M0 + 2 * I_M12 + 2 * I_M34 + 3 * I_SQ + I_KV + I_R;
    const int gw = blockIdx.x * 8 + w, NW = gridDim.x * 8;
    for (int it = gw; it < TOTAL; it += NW) {
        int r = it;
        if (r < I_LN) {
            const int t = r;
            f32x4 v[8]; row_load(p.in[0] + (size_t)t * D_, lane, v);
            float mean, rstd; row_stats(v, mean, rstd);
            bf16_t* hb = (bf16_t*)(ws + WS_BUFA) + (size_t)t * D_;
#pragma unroll
            for (int c = 0; c < 8; ++c) {
                const int col = c * 256 + lane * 4;
                const f32x4 g = *(const f32x4*)(p.in[2] + col), b = *(const f32x4*)(p.in[3] + col);
                const f32x4 y = (v[c] - mean) * rstd * g + b;
                u32x2 o; o.x = cvt_pk_bf16(y.x, y.y); o.y = cvt_pk_bf16(y.z, y.w);
                *(u32x2*)(hb + col) = o;
            }
            if (lane == 0) { float* st = (float*)(ws + WS_STATS); st[t * 2] = mean; st[t * 2 + 1] = rstd; }
            continue;
        }
        r -= I_LN;
        if (r < I_MEM) {
            const int t = r;
            f32x4 v[8]; row_load(p.in[1] + (size_t)t * D_, lane, v);
            float mean, rstd; row_stats(v, mean, rstd);
            bf16_t* hb = (bf16_t*)(ws + WS_BUFD) + (size_t)t * D_;
#pragma unroll
            for (int c = 0; c < 8; ++c) {
                const int col = c * 256 + lane * 4;
                const f32x4 g = *(const f32x4*)(p.in[19] + col), b = *(const f32x4*)(p.in[20] + col);
                const f32x4 y = (v[c] - mean) * rstd * g + b;
                u32x2 o; o.x = cvt_pk_bf16(y.x, y.y); o.y = cvt_pk_bf16(y.z, y.w);
                *(u32x2*)(hb + col) = o;
            }
            continue;
        }
        r -= I_MEM;
        if (r < I_M0) { wave_transpose_item(p, smem, 0, 0, r / 32, r % 32, (bf16_t*)(ws + WS_WIN), nullptr, 2048); continue; } r -= I_M0;
        if (r < I_M12) { wave_transpose_item(p, smem, 1, 0, r / 32, r % 32, (bf16_t*)(ws + WS_WC1), nullptr, 2048); continue; } r -= I_M12;
        if (r < I_M12) { wave_transpose_item(p, smem, 2, 0, r / 32, r % 32, (bf16_t*)(ws + WS_WC1) + 256 * 2048, nullptr, 2048); continue; } r -= I_M12;
        if (r < I_M34) { wave_transpose_item(p, smem, 3, 0, r / 4, r % 4, (bf16_t*)(ws + WS_WC2), nullptr, 256); continue; } r -= I_M34;
        if (r < I_M34) { wave_transpose_item(p, smem, 4, 0, r / 4, r % 4, (bf16_t*)(ws + WS_WC2) + 128 * 256, nullptr, 256); continue; } r -= I_M34;
        if (r < I_SQ) { wave_transpose_item(p, smem, 5, 0, r / 32, r % 32, (bf16_t*)(ws + WS_WOUT), nullptr, 2048); continue; } r -= I_SQ;
        if (r < I_SQ) { wave_transpose_item(p, smem, 6, 0, r / 32, r % 32, (bf16_t*)(ws + WS_WQ), nullptr, 2048, p.in[17], p.in[18], (float*)(ws + WS_CTL + CTL_U1), (float*)(ws + WS_CTL + CTL_C1)); continue; } r -= I_SQ;
        if (r < I_KV) { wave_transpose_item(p, smem, 7, 0, r / 32, r % 32, (bf16_t*)(ws + WS_WKV), nullptr, 2048); continue; } r -= I_KV;
        if (r < I_SQ) { wave_transpose_item(p, smem, 8, 0, r / 32, r % 32, (bf16_t*)(ws + WS_WO), nullptr, 2048); continue; } r -= I_SQ;
        wave_transpose_item(p, smem, 9, 0, r / 32, r % 32, (bf16_t*)(ws + WS_WR), (bf16_t*)(ws + WS_WR) + 128 * 2048, 2048, p.in[24], p.in[25], (float*)(ws + WS_CTL + CTL_U2), (float*)(ws + WS_CTL + CTL_C2));
    }
    __syncthreads();
}

constexpr int MOE_W_ITEMS = 32 * 16 * 32 + 32 * 32 * 8;
DEVI void moe_weight_item(const Params& p, char* smem, int r) {
    unsigned char* ws = p.ws;
    if (r < 32 * 16 * 32) { const int e = r / 512, q = r % 512; wave_transpose_item(p, smem, 10, e, q / 32, q % 32, (bf16_t*)(ws + WS_WGU) + (size_t)e * 1024 * 2048, nullptr, 2048, p.in[24], p.in[25], (float*)(ws + WS_CTL + CTL_UE) + e * 1024, (float*)(ws + WS_CTL + CTL_CE) + e * 1024); }
    else { r -= 32 * 16 * 32; const int e = r / 256, q = r % 256; wave_transpose_item(p, smem, 11, e, q / 8, q % 8, (bf16_t*)(ws + WS_WD) + (size_t)e * 2048 * 512, nullptr, 512); }
}

enum { J_PROJ = 0, J_MEMKV, J_CMP1, J_CMP2, J_OUT, J_WQ, J_WO, J_ROUTER, J_MOE1, J_MOE2 };
constexpr int GEMM_STAGE_BYTES = 49152;
constexpr int GEMM_TP = 3 * GEMM_STAGE_BYTES;

template <int job, int VAR = 0>
DEVI void gemm_job(const Params& p, char* smem) {
    unsigned char* ws = p.ws;
    int tid = threadIdx.x; asm volatile("" : "+v"(tid));
    const int lane = tid & 63, w = tid >> 6, wr = w >> 1, wc = w & 1, fr = lane & 15, fq = lane >> 4;
    const int srow = tid >> 3, schunk = (tid & 7) ^ ((tid >> 4) & 7);
    int* tp = (int*)(smem + GEMM_TP);
    int MT = 0, NT = 0, K = 2048, nseg = 1, ntiles = 0, RT = 0;
    switch (job) {
    case J_PROJ: MT = 128; NT = 37; break;
    case J_MEMKV: MT = 4; NT = 32; break;
    case J_CMP1: MT = 64; NT = 2; break;
    case J_CMP2: MT = 64; NT = 1; K = 256; break;
    case J_OUT: case J_WQ: case J_WO: MT = 128; NT = 16; break;
    case J_ROUTER: MT = 128; NT = 1; nseg = 2; break;
    default: break;
    }
    const unsigned* cntw = (const unsigned*)(ws + WS_CTL) + CW_CNT;
    if (job == J_MOE1 || job == J_MOE2) {
        __syncthreads();
        if (tid == 0) { int acc = 0; for (int e = 0; e < 32; ++e) { tp[e] = acc; const int c = (int)__hip_atomic_load(cntw + e, __ATOMIC_RELAXED, __HIP_MEMORY_SCOPE_AGENT); tp[33 + e] = c; acc += (c + 255) >> 8; } tp[32] = acc; }
        __syncthreads();
        RT = tp[32];
        NT = (job == J_MOE1) ? 8 : 16; K = (job == J_MOE1) ? 2048 : 512;
        { int mx = 0;
#pragma unroll
          for (int x = 0; x < 8; ++x) { int t = 0;
#pragma unroll
              for (int k = 0; k < 4; ++k) t += (tp[33 + x + 8 * k] + 255) >> 8;
              mx = t > mx ? t : mx; }
          ntiles = mx * NT * 8; }
    } else {
        const int nsr = (MT + 7) >> 3;
        ntiles = (MT < 64) ? MT * NT : ((nsr + 7) >> 3) * 8 * NT * 8;
    }
    int my_tp = 0, my_cnt = 0;
    if (job == J_MOE1 || job == J_MOE2) { my_tp = tp[lane & 31]; my_cnt = tp[33 + (lane & 31)]; }
    const int nk = K >> 6, ntot = nseg * nk;

    for (int ti = blockIdx.x; ti < ntiles; ti += gridDim.x) {
        int mt, nt, e = 0, rt = 0, ecnt = 0, etp = 0;
        if (job == J_MOE1 || job == J_MOE2) {
            const int x = ti & 7; int jj = ti >> 3; bool found = false; mt = 0; nt = 0;
#pragma unroll
            for (int k = 0; k < 4; ++k) {
                const int ee = x + 8 * k;
                const int c = __shfl(my_cnt, ee), rtc = (c + 255) >> 8, tot = rtc * NT;
                if (!found) { if (jj < tot) { found = true; e = ee; ecnt = c; etp = __shfl(my_tp, ee); const int per = 4 * rtc, ng = jj / per, r2 = jj - ng * per; nt = ng * 4 + r2 / rtc; rt = r2 - (r2 / rtc) * rtc; } else jj -= tot; }
            }
            if (!found) continue;
        } else {
            if (MT < 64) { nt = ti / MT; mt = ti - nt * MT; }
            else {
                const int x = ti & 7, jj = ti >> 3, per = 8 * NT, srl = jj / per, idx = jj - srl * per;
                mt = (srl * 8 + x) * 8 + (idx & 7); nt = idx >> 3;
                if (mt >= MT) continue;
            }
        }
        const bf16_t* ap[4]; const bf16_t* bp[2];
#pragma unroll
        for (int r = 0; r < 4; ++r) {
            const int row = r * 64 + srow;
            const bf16_t* a;
            switch (job) {
            case J_PROJ: a = (const bf16_t*)(ws + WS_BUFA) + (size_t)(mt * 256 + row) * 2048; break;
            case J_MEMKV: a = (const bf16_t*)(ws + WS_BUFD) + (size_t)(mt * 256 + row) * 2048; break;
            case J_CMP1: { const int gi = mt >> 1, i = (mt & 1) * 256 + row, ic = i < 510 ? i : 510; const int type = gi >> 4, bh = gi & 15;
                a = (const bf16_t*)(ws + WS_BUFC + (type ? C_VCMP : C_KCMP)) + ((size_t)bh * 8192 + 16 * ic) * 64; break; }
            case J_CMP2: a = (const bf16_t*)(ws + WS_BUFC + C_HID) + (size_t)(mt * 256 + row) * 256; break;
            case J_OUT: a = (const bf16_t*)(ws + WS_BUFE) + (size_t)(mt * 256 + row) * 2048; break;
            case J_WQ: a = (const bf16_t*)(ws + WS_BUFB) + (size_t)(mt * 256 + row) * 2048; break;
            case J_WO: a = (const bf16_t*)(ws + WS_BUFA) + (size_t)(mt * 256 + row) * 2048; break;
            case J_ROUTER: a = (const bf16_t*)(ws + WS_BUFE) + (size_t)(mt * 256 + row) * 2048; break;
            case J_MOE1: { int pos = rt * 256 + row; if (pos >= ecnt) pos = 0; const int aid = ((const int*)(ws + WS_LIST))[(size_t)e * T_ + pos];
                a = (const bf16_t*)(ws + WS_BUFE) + (size_t)(aid >> 1) * 2048; break; }
            default: a = (const bf16_t*)(ws + WS_BUFB) + (size_t)((etp + rt) * 256 + row) * 512; break;
            }
            ap[r] = a + schunk * 8;
        }
#pragma unroll
        for (int r = 0; r < 2; ++r) {
            const int row = r * 64 + srow;
            const bf16_t* b;
            switch (job) {
            case J_PROJ: b = (const bf16_t*)(ws + WS_WIN) + (size_t)(nt * 128 + row) * 2048; break;
            case J_MEMKV: b = (const bf16_t*)(ws + WS_WKV) + (size_t)(nt * 128 + row) * 2048; break;
            case J_CMP1: b = (const bf16_t*)(ws + WS_WC1) + (size_t)(mt >> 5) * 256 * 2048 + (size_t)(nt * 128 + row) * 2048; break;
            case J_CMP2: b = (const bf16_t*)(ws + WS_WC2) + (size_t)(mt >> 5) * 128 * 256 + (size_t)row * 256; break;
            case J_OUT: b = (const bf16_t*)(ws + WS_WOUT) + (size_t)(nt * 128 + row) * 2048; break;
            case J_WQ: b = (const bf16_t*)(ws + WS_WQ) + (size_t)(nt * 128 + row) * 2048; break;
            case J_WO: b = (const bf16_t*)(ws + WS_WO) + (size_t)(nt * 128 + row) * 2048; break;
            case J_ROUTER: b = (const bf16_t*)(ws + WS_WR) + (size_t)row * 2048; break;
            case J_MOE1: b = (const bf16_t*)(ws + WS_WGU) + (size_t)e * 1024 * 2048 + (size_t)(nt * 128 + row) * 2048; break;
            default: b = (const bf16_t*)(ws + WS_WD) + (size_t)e * 2048 * 512 + (size_t)(nt * 128 + row) * 512; break;
            }
            bp[r] = b + schunk * 8;
        }
        const long a_seg1 = ((long)WS_BUFC - (long)WS_BUFE) / 2;
        const long b_seg2 = 128 * 2048;

        f32x4 acc[4][4];
#pragma unroll
        for (int i = 0; i < 4; ++i)
#pragma unroll
            for (int j = 0; j < 4; ++j) acc[i][j] = (f32x4){0.f, 0.f, 0.f, 0.f};

#define GEMM_STAGE(kt_) do { const int _kt = (kt_); int _seg = 0, _k0 = _kt << 6; if (nseg > 1) { _seg = _kt / nk; _k0 = (_kt - _seg * nk) << 6; } \
            const long _ao = (_seg == 1) ? a_seg1 : 0, _bo = (_seg == 1) ? b_seg2 : 0; \
            char* _A = smem + (_kt % 3) * GEMM_STAGE_BYTES; char* _B = _A + 32768; \
            _Pragma("unroll") for (int r = 0; r < 4; ++r) glds16(ap[r] + _ao + _k0, _A + (r * 512 + tid) * 16); \
            _Pragma("unroll") for (int r = 0; r < 2; ++r) glds16(bp[r] + _bo + _k0, _B + (r * 512 + tid) * 16); } while (0)

        u32x2 preb[16];
        if (job == J_OUT || job == J_WO) {
            const bf16_t* src = (const bf16_t*)(ws + (job == J_OUT ? WS_BUFA : WS_BUFB));
#pragma unroll
            for (int i = 0; i < 16; ++i) preb[i] = *(const u32x2*)(src + (size_t)(mt * 256 + (tid >> 5) + 16 * i) * D_ + nt * 128 + (tid & 31) * 4);
        }
        GEMM_STAGE(0);
        if (ntot > 1) GEMM_STAGE(1);
        for (int kt = 0; kt < ntot; ++kt) {
            if (kt + 1 < ntot) asm volatile("s_waitcnt vmcnt(6)" ::: "memory"); else asm volatile("s_waitcnt vmcnt(0)" ::: "memory");
            __builtin_amdgcn_s_barrier();
            asm volatile("" ::: "memory");
            if (kt + 2 < ntot && VAR != 1) GEMM_STAGE(kt + 2);
            if (VAR == 2) continue;
            const char* A = smem + (kt % 3) * GEMM_STAGE_BYTES; const char* B = A + 32768;
#pragma unroll
            for (int ks = 0; ks < 2; ++ks) {
                bf16x8 af[4], bfr[4];
                const int coff = ((4 * ks + fq) ^ (fr >> 1)) * 16;
#pragma unroll
                for (int i = 0; i < 4; ++i) {
                    af[i] = *(const bf16x8*)(A + (wr * 64 + i * 16 + fr) * 128 + coff);
                    bfr[i] = *(const bf16x8*)(B + (wc * 64 + i * 16 + fr) * 128 + coff);
                }
                __builtin_amdgcn_s_setprio(1);
#pragma unroll
                for (int i = 0; i < 4; ++i)
#pragma unroll
                    for (int j = 0; j < 4; ++j) acc[i][j] = mfma16(bfr[j], af[i], acc[i][j]);
                __builtin_amdgcn_s_setprio(0);
            }
        }
#undef GEMM_STAGE
        if (VAR != 0 && VAR != 4) { if (acc[0][0].x == 123.456f) p.out[0] = acc[1][1].y + acc[2][2].z + acc[3][3].w; __syncthreads(); continue; }
        asm volatile("s_waitcnt lgkmcnt(0)" ::: "memory"); __builtin_amdgcn_s_barrier(); asm volatile("" ::: "memory");
        float* ep = (float*)smem;
#pragma unroll
        for (int mi = 0; mi < 4; ++mi)
#pragma unroll
            for (int ni = 0; ni < 4; ++ni) *(f32x4*)(ep + (wr * 64 + mi * 16 + fr) * 132 + wc * 64 + ni * 16 + fq * 4) = acc[mi][ni];
        asm volatile("s_waitcnt lgkmcnt(0)" ::: "memory"); __builtin_amdgcn_s_barrier(); asm volatile("" ::: "memory");
        const int row0 = mt * 256, col0 = nt * 128;
#define EP8(row_, c8_, v0_, v1_) const f32x4 v0_ = *(const f32x4*)(ep + (row_) * 132 + (c8_) * 8), v1_ = *(const f32x4*)(ep + (row_) * 132 + (c8_) * 8 + 4)
#define PK8(o_, v0_, v1_) u32x4 o_; o_.x = cvt_pk_bf16(v0_.x, v0_.y); o_.y = cvt_pk_bf16(v0_.z, v0_.w); o_.z = cvt_pk_bf16(v1_.x, v1_.y); o_.w = cvt_pk_bf16(v1_.z, v1_.w)
        switch (job) {
        case J_PROJ: {
            if (nt < 8) {
                bf16_t* Q = (bf16_t*)(ws + WS_BUFB);
#pragma unroll
                for (int i = 0; i < 8; ++i) { const int c = tid + 512 * i, row = c >> 4, c8 = c & 15; EP8(row, c8, a0, a1);
                    const f32x4 b0 = a0 * (0.125f * LOG2E), b1 = a1 * (0.125f * LOG2E); PK8(o, b0, b1);
                    *(u32x4*)(Q + (size_t)(row0 + row) * 1024 + col0 + c8 * 8) = o; }
            } else if (nt < 20) {
                const int reg = (nt - 8) >> 1;
                bf16_t* dst = (bf16_t*)(ws + WS_BUFC + (reg == 0 ? C_KCMP : reg == 1 ? C_VCMP : reg == 2 ? C_KS : reg == 3 ? C_VST : reg == 4 ? C_KW : C_VWT));
                const int b = row0 >> 13, s0 = row0 & 8191;
                if (reg != 3 && reg != 5) {
#pragma unroll
                    for (int i = 0; i < 8; ++i) { const int c = tid + 512 * i, row = c >> 4, c8 = c & 15; EP8(row, c8, a0, a1); PK8(o, a0, a1);
                        const int bh = b * 4 + ((nt - 8) & 1) * 2 + (c8 >> 3);
                        *(u32x4*)(dst + ((size_t)bh * 8192 + s0 + row) * 64 + (c8 & 7) * 8) = o; }
                } else {
#pragma unroll
                    for (int i = 0; i < 8; ++i) { const int c = tid + 512 * i, tg = c & 31, dcol = c >> 5;
                        const int rb = (tg >> 1) * 16 + (tg & 1) * 4;
                        float v[8];
#pragma unroll
                        for (int j = 0; j < 8; ++j) v[j] = ep[(rb + (j & 3) + (j >> 2) * 8) * 132 + dcol];
                        u32x4 o; o.x = cvt_pk_bf16(v[0], v[1]); o.y = cvt_pk_bf16(v[2], v[3]); o.z = cvt_pk_bf16(v[4], v[5]); o.w = cvt_pk_bf16(v[6], v[7]);
                        const int bh = b * 4 + ((nt - 8) & 1) * 2 + (dcol >> 6);
                        *(u32x4*)(dst + ((size_t)bh * 64 + (dcol & 63)) * 8192 + s0 + tg * 8) = o; }
                }
            } else if (nt == 20) {
                float* G = (float*)(ws + WS_BUFC + C_GATES);
#pragma unroll
                for (int i = 0; i < 6; ++i) { const int c = tid + 512 * i, row = c / 12, c4 = c - row * 12;
                    const f32x4 v = *(const f32x4*)(ep + row * 132 + c4 * 4); f32x4 o; o.x = sigmoidf_(v.x); o.y = sigmoidf_(v.y); o.z = sigmoidf_(v.z); o.w = sigmoidf_(v.w);
                    *(f32x4*)(G + (size_t)(row0 + row) * 48 + c4 * 4) = o; }
            } else {
                bf16_t* Hg = (bf16_t*)(ws + WS_BUFB + 64 * MiB);
#pragma unroll
                for (int i = 0; i < 4; ++i) { const int c = tid + 512 * i, row = c >> 3, c8 = c & 7, hh = c8 >> 2, cc = (c8 & 3) * 8;
                    const f32x4 a0 = *(const f32x4*)(ep + row * 132 + hh * 64 + cc), a1 = *(const f32x4*)(ep + row * 132 + hh * 64 + cc + 4);
                    const f32x4 g0 = *(const f32x4*)(ep + row * 132 + hh * 64 + 32 + cc), g1 = *(const f32x4*)(ep + row * 132 + hh * 64 + 32 + cc + 4);
                    u32x4 o; o.x = cvt_pk_bf16(a0.x * sigmoidf_(g0.x), a0.y * sigmoidf_(g0.y)); o.y = cvt_pk_bf16(a0.z * sigmoidf_(g0.z), a0.w * sigmoidf_(g0.w));
                    o.z = cvt_pk_bf16(a1.x * sigmoidf_(g1.x), a1.y * sigmoidf_(g1.y)); o.w = cvt_pk_bf16(a1.z * sigmoidf_(g1.z), a1.w * sigmoidf_(g1.w));
                    *(u32x4*)(Hg + (size_t)(row0 + row) * 1024 + ((nt - 21) * 2 + hh) * 32 + cc) = o; }
            }
        } break;
        case J_MEMKV: {
            const int b = mt;
            if (nt < 16) {
                bf16_t* Kx = (bf16_t*)(ws + WS_BUFD + 4 * MiB);
                const int head = col0 >> 9, d0 = col0 & 511;
#pragma unroll
                for (int i = 0; i < 8; ++i) { const int c = tid + 512 * i, row = c >> 4, c8 = c & 15; EP8(row, c8, a0, a1); PK8(o, a0, a1);
                    *(u32x4*)(Kx + ((size_t)(b * 4 + head) * 256 + row) * 512 + d0 + c8 * 8) = o; }
            } else {
                bf16_t* Vt = (bf16_t*)(ws + WS_BUFD + 8 * MiB);
                const int n2 = col0 - 2048, head = n2 >> 9, d0 = n2 & 511;
#pragma unroll
                for (int i = 0; i < 8; ++i) { const int c = tid + 512 * i, tg = c & 31, dcol = c >> 5;
                    float v[8];
#pragma unroll
                    for (int j = 0; j < 8; ++j) v[j] = ep[(tg * 8 + j) * 132 + dcol];
                    u32x4 o; o.x = cvt_pk_bf16(v[0], v[1]); o.y = cvt_pk_bf16(v[2], v[3]); o.z = cvt_pk_bf16(v[4], v[5]); o.w = cvt_pk_bf16(v[6], v[7]);
                    *(u32x4*)(Vt + ((size_t)(b * 4 + head) * 512 + d0 + dcol) * 256 + tg * 8) = o; }
            }
        } break;
        case J_CMP1: {
            const int type = mt >> 5;
            const float* bias = (const float*)(ws + WS_C1BIAS) + type * 256;
            bf16_t* Hd = (bf16_t*)(ws + WS_BUFC + C_HID);
            const f32x4 b0 = *(const f32x4*)(bias + col0 + (tid & 15) * 8), b1 = *(const f32x4*)(bias + col0 + (tid & 15) * 8 + 4);
#pragma unroll
            for (int i = 0; i < 8; ++i) { const int c = tid + 512 * i, row = c >> 4, c8 = c & 15; EP8(row, c8, a0, a1);
                u32x4 o; o.x = cvt_pk_bf16(gelu_tanh(a0.x + b0.x), gelu_tanh(a0.y + b0.y)); o.y = cvt_pk_bf16(gelu_tanh(a0.z + b0.z), gelu_tanh(a0.w + b0.w));
                o.z = cvt_pk_bf16(gelu_tanh(a1.x + b1.x), gelu_tanh(a1.y + b1.y)); o.w = cvt_pk_bf16(gelu_tanh(a1.z + b1.z), gelu_tanh(a1.w + b1.w));
                *(u32x4*)(Hd + (size_t)(row0 + row) * 256 + col0 + c8 * 8) = o; }
        } break;
        case J_CMP2: {
            const int gi = mt >> 1, type = gi >> 4, bh = gi & 15, i0 = (mt & 1) * 256;
            if (type == 0) {
                bf16_t* Kc = (bf16_t*)(ws + WS_BUFC + C_KC);
#pragma unroll
                for (int i = 0; i < 4; ++i) { const int c = tid + 512 * i, row = c >> 3, c8 = c & 7; EP8(row, c8, a0, a1); PK8(o, a0, a1);
                    if (i0 + row >= 511) o = (u32x4){0u, 0u, 0u, 0u};
                    *(u32x4*)(Kc + ((size_t)bh * 512 + i0 + row) * 64 + c8 * 8) = o; }
            } else {
                bf16_t* Vc = (bf16_t*)(ws + WS_BUFC + C_VCT);
#pragma unroll
                for (int i = 0; i < 4; ++i) { const int c = tid + 512 * i, tg = c & 31, d = c >> 5;
                    const int rb = (tg >> 1) * 16 + (tg & 1) * 4;
                    float v[8];
#pragma unroll
                    for (int j = 0; j < 8; ++j) { const int r = rb + (j & 3) + (j >> 2) * 8; v[j] = (i0 + r >= 511) ? 0.f : ep[r * 132 + d]; }
                    u32x4 o; o.x = cvt_pk_bf16(v[0], v[1]); o.y = cvt_pk_bf16(v[2], v[3]); o.z = cvt_pk_bf16(v[4], v[5]); o.w = cvt_pk_bf16(v[6], v[7]);
                    *(u32x4*)(Vc + ((size_t)bh * 64 + d) * 512 + i0 + tg * 8) = o; }
            }
        } break;
        case J_OUT: {
            const int c4 = tid & 31, n = col0 + c4 * 4;
#pragma unroll
            for (int i = 0; i < 16; ++i) { const int row = (tid >> 5) + 16 * i, t = row0 + row;
                const f32x4 v = *(const f32x4*)(ep + row * 132 + c4 * 4);
                f32x4 y; y.x = bf2f(preb[i].x & 0xffffu) * ALPHA + v.x; y.y = bf2f(preb[i].x >> 16) * ALPHA + v.y;
                y.z = bf2f(preb[i].y & 0xffffu) * ALPHA + v.z; y.w = bf2f(preb[i].y >> 16) * ALPHA + v.w;
                u32x2 yb; yb.x = cvt_pk_bf16(y.x, y.y); yb.y = cvt_pk_bf16(y.z, y.w);
                *(u32x2*)((bf16_t*)(ws + WS_BUFB) + (size_t)t * D_ + n) = yb;
                float rs = (y.x + y.y) + (y.z + y.w), rq = (y.x * y.x + y.y * y.y) + (y.z * y.z + y.w * y.w);
#pragma unroll
                for (int o = 1; o < 32; o <<= 1) { rs += __shfl_xor(rs, o); rq += __shfl_xor(rq, o); }
                if ((tid & 31) == 0) { float* rsum = (float*)(ws + WS_RSUM1) + (size_t)t * 2; atomicAdd(rsum, rs); atomicAdd(rsum + 1, rq); } }
        } break;
        case J_WQ: {
            bf16_t* Qx = (bf16_t*)(ws + WS_BUFC);
            const float sc = 0.04419417382415922f * LOG2E;
            const float* U = (const float*)(ws + WS_CTL + CTL_U1); const float* Cv = (const float*)(ws + WS_CTL + CTL_C1);
            const float* rsum = (const float*)(ws + WS_RSUM1);
            const int c8 = tid & 15, n = col0 + c8 * 8;
            const f32x4 u0 = *(const f32x4*)(U + n), u1 = *(const f32x4*)(U + n + 4), c0 = *(const f32x4*)(Cv + n), c1 = *(const f32x4*)(Cv + n + 4);
            float2 rsq[8];
#pragma unroll
            for (int i = 0; i < 8; ++i) rsq[i] = *(const float2*)(rsum + (size_t)(row0 + (tid >> 4) + 32 * i) * 2);
#pragma unroll
            for (int i = 0; i < 8; ++i) { const int row = (tid >> 4) + 32 * i; EP8(row, c8, a0, a1);
                const int t = row0 + row;
                const float mean = rsq[i].x * (1.f / D_); float var = rsq[i].y * (1.f / D_) - mean * mean; var = var > 0.f ? var : 0.f;
                const float rstd = __builtin_amdgcn_rsqf(var + LN_EPS), mr = mean * rstd;
                const f32x4 b0 = (a0 * rstd - u0 * mr + c0) * sc, b1 = (a1 * rstd - u1 * mr + c1) * sc; PK8(o, b0, b1);
                *(u32x4*)(Qx + (size_t)t * 2048 + n) = o; }
        } break;
        case J_WO: {
            const int c4 = tid & 31, n = col0 + c4 * 4;
            const f32x4 g = *(const f32x4*)(p.in[17] + n), bb = *(const f32x4*)(p.in[18] + n);
#pragma unroll
            for (int hlf = 0; hlf < 2; ++hlf) {
                float2 sm[8];
#pragma unroll
                for (int i = 0; i < 8; ++i) { const int row = (tid >> 5) + 16 * (hlf * 8 + i), t = row0 + row;
                    const float2 rsq = *(const float2*)((const float*)(ws + WS_RSUM1) + (size_t)t * 2);
                    const float mean = rsq.x * (1.f / D_); float var = rsq.y * (1.f / D_) - mean * mean; var = var > 0.f ? var : 0.f;
                    sm[i] = make_float2(mean, 1.f / sqrtf(var + LN_EPS)); }
#pragma unroll
                for (int i = 0; i < 8; ++i) { const int row = (tid >> 5) + 16 * (hlf * 8 + i), t = row0 + row;
                    const f32x4 v = *(const f32x4*)(ep + row * 132 + c4 * 4);
                    const u32x2 pb = preb[hlf * 8 + i];
                    f32x4 rv; rv.x = bf2f(pb.x & 0xffffu); rv.y = bf2f(pb.x >> 16); rv.z = bf2f(pb.y & 0xffffu); rv.w = bf2f(pb.y >> 16);
                    *(f32x4*)(p.out + (size_t)t * D_ + n) = ((rv - sm[i].x) * sm[i].y * g + bb) * ALPHA + v; }
            }
        } break;
        case J_ROUTER: {
            if (tid < 256) {
                const int row = tid, t = row0 + row;
                const float* er = ep + row * 132;
                unsigned* cnt = (unsigned*)(ws + WS_CTL) + CW_CNT;
                int* list = (int*)(ws + WS_LIST);
                float* wt = (float*)(ws + WS_WTOK);
                const float* U2 = (const float*)(ws + WS_CTL + CTL_U2); const float* C2 = (const float*)(ws + WS_CTL + CTL_C2);
                const float2 rsq = *(const float2*)((const float*)(ws + WS_RSUM2) + (size_t)t * 2);
                const float mean = rsq.x * (1.f / D_); float var = rsq.y * (1.f / D_) - mean * mean; var = var > 0.f ? var : 0.f;
                const float rstd = 1.f / sqrtf(var + LN_EPS), mr = mean * rstd;
                float lg[4];
#pragma unroll
                for (int i = 0; i < 4; ++i) lg[i] = (er[i] + er[64 + i]) * rstd - mr * U2[i] + C2[i] + p.in[27][i];
                int grp = 0; float best = lg[0];
#pragma unroll
                for (int i = 1; i < 4; ++i) if (lg[i] > best) { best = lg[i]; grp = i; }
                float se = 0.f;
#pragma unroll
                for (int i = 0; i < 4; ++i) se += expf(lg[i] - best);
                const float wgrp = 1.f / se;
                float le[8];
#pragma unroll
                for (int i = 0; i < 8; ++i) le[i] = (er[4 + grp * 8 + i] + er[68 + grp * 8 + i]) * rstd - mr * U2[4 + grp * 8 + i] + C2[4 + grp * 8 + i] + p.in[29][grp * 8 + i];
                int i0 = 0; float v0 = le[0];
#pragma unroll
                for (int i = 1; i < 8; ++i) if (le[i] > v0) { v0 = le[i]; i0 = i; }
                int i1 = -1; float v1 = -INFINITY;
#pragma unroll
                for (int i = 0; i < 8; ++i) if (i != i0 && le[i] > v1) { v1 = le[i]; i1 = i; }
                const float ex = expf(v1 - v0);
                const float w0 = wgrp / (1.f + ex), w1 = wgrp * ex / (1.f + ex);
                const int ea = grp * 8 + i0, eb = grp * 8 + i1;
                const unsigned pa = atomicAdd(cnt + ea, 1u); list[(size_t)ea * T_ + pa] = t * 2;
                const unsigned pb = atomicAdd(cnt + eb, 1u); list[(size_t)eb * T_ + pb] = t * 2 + 1;
                wt[t * 2] = w0; wt[t * 2 + 1] = w1;
            }
        } break;
        case J_MOE1: {
            bf16_t* H = (bf16_t*)(ws + WS_BUFB);
            const float* UE = (const float*)(ws + WS_CTL + CTL_UE) + e * 1024 + nt * 128; const float* CE = (const float*)(ws + WS_CTL + CTL_CE) + e * 1024 + nt * 128;
            const int hh = (tid & 7) >> 2, cc = (tid & 3) * 8;
            const f32x4 ug0 = *(const f32x4*)(UE + hh * 64 + cc), ug1 = *(const f32x4*)(UE + hh * 64 + cc + 4), uu0 = *(const f32x4*)(UE + hh * 64 + 32 + cc), uu1 = *(const f32x4*)(UE + hh * 64 + 32 + cc + 4);
            const f32x4 cg0 = *(const f32x4*)(CE + hh * 64 + cc), cg1 = *(const f32x4*)(CE + hh * 64 + cc + 4), cu0 = *(const f32x4*)(CE + hh * 64 + 32 + cc), cu1 = *(const f32x4*)(CE + hh * 64 + 32 + cc + 4);
            float2 rsq[4];
#pragma unroll
            for (int i = 0; i < 4; ++i) { int pos = rt * 256 + ((tid + 512 * i) >> 3); if (pos >= ecnt) pos = 0; const int aid = ((const int*)(ws + WS_LIST))[(size_t)e * T_ + pos];
                rsq[i] = *(const float2*)((const float*)(ws + WS_RSUM2) + (size_t)(aid >> 1) * 2); }
#pragma unroll
            for (int i = 0; i < 4; ++i) { const int c = tid + 512 * i, row = c >> 3;
                const float mean = rsq[i].x * (1.f / D_); float var = rsq[i].y * (1.f / D_) - mean * mean; var = var > 0.f ? var : 0.f;
                const float rstd = 1.f / sqrtf(var + LN_EPS), mr = mean * rstd;
                const f32x4 g0 = *(const f32x4*)(ep + row * 132 + hh * 64 + cc) * rstd - ug0 * mr + cg0, g1 = *(const f32x4*)(ep + row * 132 + hh * 64 + cc + 4) * rstd - ug1 * mr + cg1;
                const f32x4 u0 = *(const f32x4*)(ep + row * 132 + hh * 64 + 32 + cc) * rstd - uu0 * mr + cu0, u1 = *(const f32x4*)(ep + row * 132 + hh * 64 + 32 + cc + 4) * rstd - uu1 * mr + cu1;
                u32x4 o; o.x = cvt_pk_bf16(g0.x * sigmoidf_(g0.x) * u0.x, g0.y * sigmoidf_(g0.y) * u0.y); o.y = cvt_pk_bf16(g0.z * sigmoidf_(g0.z) * u0.z, g0.w * sigmoidf_(g0.w) * u0.w);
                o.z = cvt_pk_bf16(g1.x * sigmoidf_(g1.x) * u1.x, g1.y * sigmoidf_(g1.y) * u1.y); o.w = cvt_pk_bf16(g1.z * sigmoidf_(g1.z) * u1.z, g1.w * sigmoidf_(g1.w) * u1.w);
                *(u32x4*)(H + ((size_t)(etp + rt) * 256 + row) * 512 + (nt * 2 + hh) * 32 + cc) = o; }
        } break;
        default: {
            bf16_t* Y = (bf16_t*)(ws + WS_BUFC);
            const float* wt = (const float*)(ws + WS_WTOK);
            const int c8 = tid & 15;
            int aid[8]; float wv[8];
#pragma unroll
            for (int i = 0; i < 8; ++i) { const int pos = rt * 256 + (tid >> 4) + 32 * i; aid[i] = (pos < ecnt) ? ((const int*)(ws + WS_LIST))[(size_t)e * T_ + pos] : -1; }
#pragma unroll
            for (int i = 0; i < 8; ++i) wv[i] = (aid[i] >= 0) ? wt[aid[i]] : 0.f;
#pragma unroll
            for (int i = 0; i < 8; ++i) { const int row = (tid >> 4) + 32 * i;
                if (aid[i] >= 0) { EP8(row, c8, a0, a1); const f32x4 b0 = a0 * wv[i], b1 = a1 * wv[i]; PK8(o, b0, b1);
                    *(u32x4*)(Y + (size_t)aid[i] * 2048 + col0 + c8 * 8) = o; } }
        } break;
        }
#undef EP8
#undef PK8
        asm volatile("s_waitcnt lgkmcnt(0)" ::: "memory"); __builtin_amdgcn_s_barrier(); asm volatile("" ::: "memory");
    }
}

template <int job>
DEVI void gemm_direct(const Params& p, char* smem) {
    unsigned char* ws = p.ws;
    int tid = threadIdx.x; asm volatile("" : "+v"(tid));
    const int lane = tid & 63, w = tid >> 6, wr = w >> 1, wc = w & 1, fr = lane & 15, fq = lane >> 4;
    const int srow = tid >> 3, schunk = (tid & 7) ^ ((tid >> 4) & 7);
    constexpr int NTILES = 2048;
    const bf16_t* Abase = (const bf16_t*)(ws + (job == J_OUT ? WS_BUFE : job == J_WQ ? WS_BUFB : WS_BUFA)) + (size_t)srow * 2048 + schunk * 8;
    const bf16_t* Bbase = (const bf16_t*)(ws + (job == J_OUT ? WS_WOUT : job == J_WQ ? WS_WQ : WS_WO)) + (size_t)srow * 2048 + schunk * 8;
    const bf16_t* Rsrc = (const bf16_t*)(ws + (job == J_OUT ? WS_BUFA : WS_BUFB));
    int ti = blockIdx.x;
    if (ti >= NTILES) return;
#define GD_MAP(ti_, mt_, nt_) do { const int _x = (ti_) & 7, _jj = (ti_) >> 3, _srl = _jj >> 7, _idx = _jj & 127; mt_ = (_srl * 8 + _x) * 8 + (_idx & 7); nt_ = _idx >> 3; } while (0)
#define GD_PTRS(mt_, nt_, ap_, bp_) do { _Pragma("unroll") for (int r = 0; r < 4; ++r) ap_[r] = Abase + (size_t)((mt_) * 256 + r * 64) * 2048; \
        _Pragma("unroll") for (int r = 0; r < 2; ++r) bp_[r] = Bbase + (size_t)((nt_) * 128 + r * 64) * 2048; } while (0)
#define GD_STAGE(ap_, bp_, kt_, slot_) do { char* _A = smem + (slot_) * GEMM_STAGE_BYTES; char* _B = _A + 32768; const int _k0 = (kt_) << 6; \
        _Pragma("unroll") for (int r = 0; r < 4; ++r) glds16(ap_[r] + _k0, _A + (r * 512 + tid) * 16); \
        _Pragma("unroll") for (int r = 0; r < 2; ++r) glds16(bp_[r] + _k0, _B + (r * 512 + tid) * 16); } while (0)
    int mt, nt; GD_MAP(ti, mt, nt);
    const bf16_t* ap[4]; const bf16_t* bp[2]; GD_PTRS(mt, nt, ap, bp);
    GD_STAGE(ap, bp, 0, 0);
    GD_STAGE(ap, bp, 1, 1);
    int cur = 0;
    bool landed = false;
    constexpr int NPRE = (job == J_OUT) ? 16 : (job == J_WQ) ? 12 : 28;
    for (;;) {
        const int tn = ti + gridDim.x; const bool has_next = tn < NTILES;
        int mtn = 0, ntn = 0; if (has_next) GD_MAP(tn, mtn, ntn);
        const bf16_t* nap[4]; const bf16_t* nbp[2]; GD_PTRS(mtn, ntn, nap, nbp);
        const int row0 = mt * 256 + wr * 64 + fr, col0 = nt * 128 + wc * 64 + fq * 4;
        u32x2 preb[16]; f32x4 va[4], vb[4]; f32x4 rsq01, rsq23;
        if (job != J_WQ) {
#pragma unroll
            for (int i = 0; i < 4; ++i)
#pragma unroll
                for (int j = 0; j < 4; ++j) preb[i * 4 + j] = gload8_asm(Rsrc + (size_t)(row0 + i * 16) * D_ + col0 + j * 16);
        }
        if (job != J_OUT) {
            const float* Va = (job == J_WQ) ? (const float*)(ws + WS_CTL + CTL_U1) : p.in[17];
            const float* Vb = (job == J_WQ) ? (const float*)(ws + WS_CTL + CTL_C1) : p.in[18];
#pragma unroll
            for (int j = 0; j < 4; ++j) { va[j] = gload16_asm(Va + col0 + j * 16); vb[j] = gload16_asm(Vb + col0 + j * 16); }
            const float* rsum = (const float*)(ws + WS_RSUM1);
            u32x2 r0 = gload8_asm(rsum + (size_t)(row0) * 2), r1 = gload8_asm(rsum + (size_t)(row0 + 16) * 2), r2 = gload8_asm(rsum + (size_t)(row0 + 32) * 2), r3 = gload8_asm(rsum + (size_t)(row0 + 48) * 2);
            rsq01.x = __uint_as_float(r0.x); rsq01.y = __uint_as_float(r0.y); rsq01.z = __uint_as_float(r1.x); rsq01.w = __uint_as_float(r1.y);
            rsq23.x = __uint_as_float(r2.x); rsq23.y = __uint_as_float(r2.y); rsq23.z = __uint_as_float(r3.x); rsq23.w = __uint_as_float(r3.y);
        }
        f32x4 acc[4][4];
#pragma unroll
        for (int i = 0; i < 4; ++i)
#pragma unroll
            for (int j = 0; j < 4; ++j) acc[i][j] = (f32x4){0.f, 0.f, 0.f, 0.f};
        for (int kt = 0; kt < 32; ++kt) {
            if (kt == 0 && landed) { }
            else if (kt < 2) asm volatile("s_waitcnt vmcnt(%0)" :: "n"(6 + NPRE) : "memory");
            else if (kt == 31 && !has_next) asm volatile("s_waitcnt vmcnt(0)" ::: "memory");
            else asm volatile("s_waitcnt vmcnt(6)" ::: "memory");
            __builtin_amdgcn_s_barrier();
            asm volatile("" ::: "memory");
            { const int s2 = cur == 0 ? 2 : cur - 1;
              if (kt < 30) GD_STAGE(ap, bp, kt + 2, s2); else if (has_next) GD_STAGE(nap, nbp, kt - 30, s2); }
            const char* A = smem + cur * GEMM_STAGE_BYTES; const char* B = A + 32768;
#pragma unroll
            for (int ks = 0; ks < 2; ++ks) {
                bf16x8 af[4], bfr[4];
                const int coff = ((4 * ks + fq) ^ (fr >> 1)) * 16;
#pragma unroll
                for (int i = 0; i < 4; ++i) {
                    af[i] = *(const bf16x8*)(A + (wr * 64 + i * 16 + fr) * 128 + coff);
                    bfr[i] = *(const bf16x8*)(B + (wc * 64 + i * 16 + fr) * 128 + coff);
                }
                __builtin_amdgcn_s_setprio(1);
#pragma unroll
                for (int i = 0; i < 4; ++i)
#pragma unroll
                    for (int j = 0; j < 4; ++j) acc[i][j] = mfma16(bfr[j], af[i], acc[i][j]);
                __builtin_amdgcn_s_setprio(0);
            }
            cur = cur == 2 ? 0 : cur + 1;
        }
        if (has_next) asm volatile("s_waitcnt vmcnt(6)" ::: "memory");
        landed = true;
        if (job == J_OUT) {
#pragma unroll
            for (int i = 0; i < 4; ++i) { const int t = row0 + i * 16;
                float rs = 0.f, rq = 0.f;
#pragma unroll
                for (int j = 0; j < 4; ++j) { const u32x2 hb = preb[i * 4 + j]; const f32x4 v = acc[i][j];
                    f32x4 y; y.x = bf2f(hb.x & 0xffffu) * ALPHA + v.x; y.y = bf2f(hb.x >> 16) * ALPHA + v.y; y.z = bf2f(hb.y & 0xffffu) * ALPHA + v.z; y.w = bf2f(hb.y >> 16) * ALPHA + v.w;
                    u32x2 yb; yb.x = cvt_pk_bf16(y.x, y.y); yb.y = cvt_pk_bf16(y.z, y.w);
                    *(u32x2*)((bf16_t*)(ws + WS_BUFB) + (size_t)t * D_ + col0 + j * 16) = yb;
                    rs += (y.x + y.y) + (y.z + y.w); rq += (y.x * y.x + y.y * y.y) + (y.z * y.z + y.w * y.w); }
                rs += __shfl_xor(rs, 16); rq += __shfl_xor(rq, 16); rs += __shfl_xor(rs, 32); rq += __shfl_xor(rq, 32);
                if (fq == 0) { float* rsum = (float*)(ws + WS_RSUM1) + (size_t)t * 2; atomicAdd(rsum, rs); atomicAdd(rsum + 1, rq); } }
        } else if (job == J_WQ) {
            bf16_t* Qx = (bf16_t*)(ws + WS_BUFC);
            const float sc = 0.04419417382415922f * LOG2E;
#pragma unroll
            for (int i = 0; i < 4; ++i) { const int t = row0 + i * 16;
                const float sx = (i == 0) ? rsq01.x : (i == 1) ? rsq01.z : (i == 2) ? rsq23.x : rsq23.z, sy = (i == 0) ? rsq01.y : (i == 1) ? rsq01.w : (i == 2) ? rsq23.y : rsq23.w;
                const float mean = sx * (1.f / D_); float var = sy * (1.f / D_) - mean * mean; var = var > 0.f ? var : 0.f;
                const float rstd = __builtin_amdgcn_rsqf(var + LN_EPS), mr = mean * rstd;
#pragma unroll
                for (int j = 0; j < 4; ++j) { const f32x4 b = (acc[i][j] * rstd - va[j] * mr + vb[j]) * sc;
                    u32x2 o; o.x = cvt_pk_bf16(b.x, b.y); o.y = cvt_pk_bf16(b.z, b.w);
                    *(u32x2*)(Qx + (size_t)t * 2048 + col0 + j * 16) = o; } }
        } else {
#pragma unroll
            for (int i = 0; i < 4; ++i) { const int t = row0 + i * 16;
                const float sx = (i == 0) ? rsq01.x : (i == 1) ? rsq01.z : (i == 2) ? rsq23.x : rsq23.z, sy = (i == 0) ? rsq01.y : (i == 1) ? rsq01.w : (i == 2) ? rsq23.y : rsq23.w;
                const float mean = sx * (1.f / D_); float var = sy * (1.f / D_) - mean * mean; var = var > 0.f ? var : 0.f;
                const float rstd = 1.f / sqrtf(var + LN_EPS);
                float rs2 = 0.f, rq2 = 0.f;
#pragma unroll
                for (int j = 0; j < 4; ++j) { const u32x2 pb = preb[i * 4 + j];
                    f32x4 rv; rv.x = bf2f(pb.x & 0xffffu); rv.y = bf2f(pb.x >> 16); rv.z = bf2f(pb.y & 0xffffu); rv.w = bf2f(pb.y >> 16);
                    const f32x4 y = ((rv - mean) * rstd * va[j] + vb[j]) * ALPHA + acc[i][j];
                    u32x2 yh; yh.x = cvt_pk_bf16(y.x, y.y); yh.y = cvt_pk_bf16(y.z, y.w);
                    u32x2 yl; yl.x = cvt_pk_bf16(y.x - bf2f(yh.x & 0xffffu), y.y - bf2f(yh.x >> 16)); yl.y = cvt_pk_bf16(y.z - bf2f(yh.y & 0xffffu), y.w - bf2f(yh.y >> 16));
                    *(u32x2*)((bf16_t*)(ws + WS_BUFE) + (size_t)t * D_ + col0 + j * 16) = yh;
                    *(u32x2*)((bf16_t*)(ws + WS_BUFC) + (size_t)t * D_ + col0 + j * 16) = yl;
                    rs2 += (y.x + y.y) + (y.z + y.w); rq2 += (y.x * y.x + y.y * y.y) + (y.z * y.z + y.w * y.w); }
                rs2 += __shfl_xor(rs2, 16); rq2 += __shfl_xor(rq2, 16); rs2 += __shfl_xor(rs2, 32); rq2 += __shfl_xor(rq2, 32);
                if (fq == 0) { float* rsum2 = (float*)(ws + WS_RSUM2) + (size_t)t * 2; atomicAdd(rsum2, rs2); atomicAdd(rsum2 + 1, rq2); } }
        }
        asm volatile("" ::: "memory");
        if (!has_next) break;
        ti = tn; mt = mtn; nt = ntn;
#pragma unroll
        for (int r = 0; r < 4; ++r) ap[r] = nap[r];
#pragma unroll
        for (int r = 0; r < 2; ++r) bp[r] = nbp[r];
    }
#undef GD_MAP
#undef GD_PTRS
#undef GD_STAGE
    __syncthreads();
}

DEVI void phase_conv(const Params& p) {
    unsigned char* ws = p.ws;
    int tid = threadIdx.x; asm volatile("" : "+v"(tid));
    const int lane = tid & 63, w = tid >> 6;
    const int c0 = tid * 2;
    const bf16_t* Hg = (const bf16_t*)(ws + WS_BUFB + 64 * MiB);
    float* pre = p.out;
    float* cst = (float*)(ws + WS_LIST);
    float wgt[31][2];
    { const float* wp = p.in[12] + c0;
#pragma unroll
      for (int k = 0; k < 31; ++k) { const float2 v = *(const float2*)wp; wgt[k][0] = v.x; wgt[k][1] = v.y; wp += 1024; asm volatile("" : "+v"(wp)); } }
    const float2 cb = *(const float2*)(p.in[13] + c0);
    for (int it = blockIdx.x; it < T_ / 16; it += gridDim.x) {
        const int t0 = it * 16, s0 = t0 & 8191;
        float acc[16][2];
#pragma unroll
        for (int j = 0; j < 16; ++j) { acc[j][0] = cb.x; acc[j][1] = cb.y; }
        const bf16_t* xp = Hg + ((long)t0 - 30) * 1024 + c0;
#pragma unroll
        for (int i = 0; i < 46; ++i) {
            const int s = s0 - 30 + i;
            float x0 = 0.f, x1 = 0.f;
            if (s >= 0) { const unsigned u = *(const unsigned*)xp; x0 = bf2f(u & 0xffffu); x1 = bf2f(u >> 16); }
            xp += 1024; asm volatile("" : "+v"(xp));
#pragma unroll
            for (int j = 0; j < 16; ++j) { const int k = i - j; if (k >= 0 && k <= 30) { acc[j][0] += wgt[k][0] * x0; acc[j][1] += wgt[k][1] * x1; } }
        }
#pragma unroll
        for (int j = 0; j < 16; ++j) {
            *(float2*)(pre + (size_t)(t0 + j) * 1024 + c0) = make_float2(acc[j][0], acc[j][1]);
            const float sv = wave_sum(acc[j][0] + acc[j][1]);
            const float qv = wave_sum(acc[j][0] * acc[j][0] + acc[j][1] * acc[j][1]);
            if (lane == 0) *(float2*)(cst + ((size_t)(t0 + j) * 8 + w) * 2) = make_float2(sv, qv);
        }
    }
}
DEVI void conv_finish(const Params& p) {
    unsigned char* ws = p.ws;
    int tid = threadIdx.x; asm volatile("" : "+v"(tid));
    const int lane = tid & 63, w = tid >> 6;
    const float* pre = p.out;
    const float* cst = (const float*)(ws + WS_LIST);
    bf16_t* CC = (bf16_t*)(ws + WS_BUFE);
    for (int it = blockIdx.x; it < T_ / 8; it += gridDim.x) {
        const int t = it * 8 + w;
        float sv = 0.f, qv = 0.f;
#pragma unroll
        for (int k = 0; k < 8; ++k) { const float2 a = *(const float2*)(cst + ((size_t)t * 8 + k) * 2); sv += a.x; qv += a.y; }
        const float mean = sv * (1.f / 1024.f);
        float var = qv * (1.f / 1024.f) - mean * mean; var = var > 0.f ? var : 0.f;
        const float rstd = 1.f / sqrtf(var + LN_EPS);
#pragma unroll
        for (int c = 0; c < 4; ++c) {
            const int col = c * 256 + lane * 4;
            const f32x4 x = *(const f32x4*)(pre + (size_t)t * 1024 + col), g = *(const f32x4*)(p.in[14] + col), bb = *(const f32x4*)(p.in[15] + col);
            f32x4 y = (x - mean) * rstd * g + bb;
            y.x *= sigmoidf_(y.x); y.y *= sigmoidf_(y.y); y.z *= sigmoidf_(y.z); y.w *= sigmoidf_(y.w);
            u32x2 o; o.x = cvt_pk_bf16(y.x, y.y); o.y = cvt_pk_bf16(y.z, y.w);
            *(u32x2*)(CC + (size_t)t * 2048 + 1024 + col) = o;
        }
    }
}

enum { M_CMP = 0, M_SEL = 1, M_WIN = 2 };
constexpr int KSTR = 72;
constexpr int NSA_KBUF = 0, NSA_VBUF = 49152;
constexpr int NSA_IMP = 98304;
constexpr int NSA_TBL = 132096;
constexpr int NSA_SEL = NSA_TBL + 4096;
constexpr int NSA_UNIT = NSA_SEL + 1024;

DEVI void attn_issue(char* kdst, char* vdst, const bf16_t* kt, const bf16_t* vt, int vstride, int tid) {
    const int row = tid >> 3, c = (tid & 7) ^ ((row >> 1) & 7);
    glds16(kt + row * 64 + c * 8, kdst + tid * 16);
    glds16(vt + (size_t)row * vstride + c * 8, vdst + tid * 16);
}

constexpr float NSA_THR = 8.f;
template <int MODE, int PASS>
DEVI void nsa_branch(char* smem, const bf16_t* kg, const bf16_t* vg, int vstride, int t_lo, int t_hi, int far_lo, int far_hi, const bf16x8 (&qf)[4], int tq,
                     float c31, const LAS float* tblg, const LAS unsigned* selrow, float& m_ref, bool& mset, float& lsum, float inv_l, f32x16 (&o)[2], LAS float* imp_row) {
    int tid = threadIdx.x; asm volatile("" : "+v"(tid));
    const int lane = tid & 63, l31 = lane & 31, h = lane >> 5, xs = (l31 >> 1) & 7;
    const int n = t_hi - t_lo + 1;
    f32x16 cneg;
    { const float cc = c31 - m_ref;
#pragma unroll
      for (int i = 0; i < 16; ++i) cneg[i] = cc; }
    float imp_carry = 0.f;
    const int nS = (n + 1) >> 1;
#define NSA_ISSUE_PAIR(js_) do { const int _sl = (js_) % 3; \
        _Pragma("unroll") for (int _sb = 0; _sb < 2; ++_sb) { int _t = t_lo + 2 * (js_) + _sb; _t = _t > t_hi ? t_hi : _t; \
            attn_issue(smem + NSA_KBUF + _sl * 16384 + _sb * 8192, smem + NSA_VBUF + _sl * 16384 + _sb * 8192, kg + (size_t)_t * 4096, vg + _t * 64, vstride, tid); } } while (0)
    NSA_ISSUE_PAIR(0);
    if (nS > 1) NSA_ISSUE_PAIR(1);
    for (int it = 0; it < n; ++it) {
        const int ti = t_lo + it, js = it >> 1, buf = (js % 3) * 2 + (it & 1);
        if ((it & 1) == 0) {
            if (js + 1 < nS) asm volatile("s_waitcnt vmcnt(4)" ::: "memory"); else asm volatile("s_waitcnt vmcnt(0)" ::: "memory");
            __builtin_amdgcn_s_barrier();
            asm volatile("" ::: "memory");
            if (js + 2 < nS) NSA_ISSUE_PAIR(js + 2);
        }
        bool selbit = true;
        if (MODE == M_SEL) { selbit = (selrow[ti >> 5] >> (ti & 31)) & 1u; if (!__any(selbit)) continue; }
        const char* Kc = smem + NSA_KBUF + buf * 8192; const char* Vc = smem + NSA_VBUF + buf * 8192;
        f32x16 s[2];
        __builtin_amdgcn_s_setprio(1);
        {
            const int off0 = (h ^ xs) << 4;
            s[0] = mfma32(*(const bf16x8*)(Kc + l31 * 128 + off0), qf[0], cneg);
            s[1] = mfma32(*(const bf16x8*)(Kc + (32 + l31) * 128 + off0), qf[0], cneg);
        }
#pragma unroll
        for (int ks = 1; ks < 4; ++ks) {
            const int off = ((2 * ks + h) ^ xs) << 4;
            s[0] = mfma32(*(const bf16x8*)(Kc + l31 * 128 + off), qf[ks], s[0]);
            s[1] = mfma32(*(const bf16x8*)(Kc + (32 + l31) * 128 + off), qf[ks], s[1]);
        }
        __builtin_amdgcn_s_setprio(0);
        const bool far = (ti >= far_lo) && (ti <= far_hi);
        {
        if (!far) {
            const int dbase = (MODE == M_CMP) ? (tq - 31 - 1024 * ti) : (tq - 64 * ti);
#pragma unroll
            for (int u = 0; u < 2; ++u)
#pragma unroll
                for (int i = 0; i < 16; ++i) {
                    const int kk = 32 * u + (i & 3) + 8 * (i >> 2) + 4 * h;
                    const int dist = dbase - ((MODE == M_CMP) ? 16 * kk : kk);
                    const int idx = (dist < -1 ? -1 : (dist > 191 ? 191 : dist)) + 64;
                    float v = s[u][i] + tblg[idx];
                    if (MODE == M_WIN) v = (dist < 512) ? v : -INFINITY;
                    if (MODE == M_SEL) v = selbit ? v : -INFINITY;
                    s[u][i] = v;
                    if ((i & 3) == 3) asm volatile("" ::: "memory");
                }
        }
        if (PASS != 2) {
            float mxa = max3f(s[0][0], s[0][1], s[0][2]), mxb = max3f(s[1][0], s[1][1], s[1][2]);
#pragma unroll
            for (int i = 3; i < 15; i += 2) { mxa = max3f(mxa, s[0][i], s[0][i + 1]); mxb = max3f(mxb, s[1][i], s[1][i + 1]); }
            float mx = max3f(mxa, mxb, s[0][15]); mx = max3f(mx, s[1][15], s[1][15]);
            if (MODE == M_SEL && !selbit) mx = -INFINITY;
            if (__any(mx > NSA_THR || (!mset && mx > -INFINITY))) {
                const float mc = fmaxf(mx, __shfl_xor(mx, 32));
                const bool mv = (mc > NSA_THR) || (!mset && mc > -INFINITY);
                const float delta = mv ? mc : 0.f;
                const float alpha = mset ? fexp2(-delta) : 1.f;
                mset = mset || mv;
                m_ref += delta;
                const float cc = c31 - m_ref;
#pragma unroll
                for (int i = 0; i < 16; ++i) cneg[i] = cc;
                lsum *= alpha;
#pragma unroll
                for (int u = 0; u < 2; ++u)
#pragma unroll
                    for (int i = 0; i < 16; ++i) s[u][i] -= delta;
                if (PASS == 0) {
#pragma unroll
                    for (int v = 0; v < 2; ++v)
#pragma unroll
                        for (int i = 0; i < 16; ++i) o[v][i] *= alpha;
                }
            }
        }
        float ps0 = 0.f, ps1 = 0.f, ps2 = 0.f, ps3 = 0.f;
#pragma unroll
        for (int u = 0; u < 2; ++u)
#pragma unroll
            for (int i = 0; i < 16; i += 4) {
                s[u][i] = fexp2(s[u][i]); s[u][i + 1] = fexp2(s[u][i + 1]); s[u][i + 2] = fexp2(s[u][i + 2]); s[u][i + 3] = fexp2(s[u][i + 3]);
                ps0 += s[u][i]; ps1 += s[u][i + 1]; ps2 += s[u][i + 2]; ps3 += s[u][i + 3];
            }
        { const float ps = (ps0 + ps1) + (ps2 + ps3); lsum += (MODE == M_SEL && far && !selbit) ? 0.f : ps; }
        if (PASS == 2) {
            float mainv[8], halfv[8];
#pragma unroll
            for (int u = 0; u < 2; ++u)
#pragma unroll
                for (int c4 = 0; c4 < 4; ++c4) {
                    float hv = 0.5f * s[u][4 * c4 + 3] * inv_l;
                    float mv = ((s[u][4 * c4] + s[u][4 * c4 + 1]) + s[u][4 * c4 + 2]) * inv_l + hv;
                    mv += __builtin_bit_cast(float, __builtin_amdgcn_update_dpp(0, __builtin_bit_cast(int, mv), 0xB1, 0xF, 0xF, true));
                    hv += __builtin_bit_cast(float, __builtin_amdgcn_update_dpp(0, __builtin_bit_cast(int, hv), 0xB1, 0xF, 0xF, true));
                    mv += __builtin_bit_cast(float, __builtin_amdgcn_update_dpp(0, __builtin_bit_cast(int, mv), 0x4E, 0xF, 0xF, true));
                    hv += __builtin_bit_cast(float, __builtin_amdgcn_update_dpp(0, __builtin_bit_cast(int, hv), 0x4E, 0xF, 0xF, true));
                    mainv[u * 4 + c4] = mv; halfv[u * 4 + c4] = __shfl_xor(hv, 32);
                }
#pragma unroll
            for (int gi = 0; gi < 8; ++gi) {
                const float cin = h ? halfv[gi] : (gi ? halfv[gi - 1] : imp_carry);
                const unsigned ia = (unsigned)(size_t)(imp_row + 16 * ti + 2 * gi + h);
                const float val = mainv[gi] + cin;
                asm volatile("ds_write_b32 %0, %1" :: "v"(ia), "v"(val) : "memory");
            }
            imp_carry = halfv[7];
        }
        const unsigned pmask = (MODE == M_SEL && far && !selbit) ? 0u : 0xFFFFFFFFu;
#pragma unroll
        for (int u = 0; u < 2; ++u)
#pragma unroll
            for (int sI = 0; sI < 2; ++sI) {
                u32x4 pk;
                pk.x = cvt_pk_bf16(s[u][8 * sI + 0], s[u][8 * sI + 1]); pk.y = cvt_pk_bf16(s[u][8 * sI + 2], s[u][8 * sI + 3]);
                pk.z = cvt_pk_bf16(s[u][8 * sI + 4], s[u][8 * sI + 5]); pk.w = cvt_pk_bf16(s[u][8 * sI + 6], s[u][8 * sI + 7]);
                if (MODE == M_SEL) { pk.x &= pmask; pk.y &= pmask; pk.z &= pmask; pk.w &= pmask; }
                const bf16x8 pf = __builtin_bit_cast(bf16x8, pk);
                if (PASS != 1) {
                    const int voff = ((2 * (2 * u + sI) + h) ^ xs) << 4;
                    o[0] = mfma32(*(const bf16x8*)(Vc + l31 * 128 + voff), pf, o[0]);
                    o[1] = mfma32(*(const bf16x8*)(Vc + (32 + l31) * 128 + voff), pf, o[1]);
                }
            }
        }
    }
    if (PASS == 2) {
        const int c = 16 * (t_hi + 1);
        if (h == 0 && c < 128) { const unsigned ia = (unsigned)(size_t)(imp_row + c); asm volatile("ds_write_b32 %0, %1" :: "v"(ia), "v"(imp_carry) : "memory"); }
        asm volatile("s_waitcnt lgkmcnt(0)" ::: "memory");
    }
#undef NSA_ISSUE_PAIR
    __syncthreads();
}

DEVI void phase_nsa(const Params& p, char* smem, int ctr_idx) {
    unsigned char* ws = p.ws;
    const int tid0 = threadIdx.x;
    float* imp = (float*)(smem + NSA_IMP);
    unsigned* tot = (unsigned*)(smem + NSA_IMP);
    float* tbl = (float*)(smem + NSA_TBL);
    unsigned* selm = (unsigned*)(smem + NSA_SEL);
    int* sunit = (int*)(smem + NSA_UNIT);
    unsigned* ctr = (unsigned*)(ws + WS_CTL) + CW_NSA + 256 * ctr_idx;
    unsigned* trc = (unsigned*)(ws + WS_CTL) + CW_TR;
    const bf16_t* Q = (const bf16_t*)(ws + WS_BUFB);
    const float* G = (const float*)(ws + WS_BUFC + C_GATES);
    bf16_t* CC = ctr_idx ? (bf16_t*)(p.out + 32 * 1024 * 1024) : (bf16_t*)(ws + WS_BUFE);
    for (;;) {
        int tid = tid0; asm volatile("" : "+v"(tid));
        const int lane = tid & 63, w = tid >> 6, l31 = lane & 31, h = lane >> 5;
        const int qi = l31 >> 2, g = l31 & 3, ql = 8 * w + qi;
        __syncthreads();
        if (tid == 0) {
            const unsigned x = xb_xcc_id() & 7u; int u = -1;
            for (unsigned k = 0; k < 8u && u < 0; ++k) { const unsigned xx = (x + k) & 7u; const unsigned i = atomicAdd(ctr + 16 * xx, 1u); if (i < 256u) u = (int)(i * 8u + xx); }
            *sunit = u;
        }
        __syncthreads();
        const int unit = *sunit;
        if (unit < 0) break;
        const int xq = unit & 7, iq = unit >> 3;
        const int qt = 127 - (iq >> 1), bh = 2 * xq + (iq & 1), b = bh >> 2, hkv = bh & 3, q0 = qt * 64, cur = qt;
        for (int i = tid; i < 4 * 256; i += 512) {
            const int gg = i >> 8, d = (i & 255) - 64;
            float val = -INFINITY;
            if (d >= 0) {
                int bucket;
                if (d < 16) bucket = d;
                else if (d >= 128) bucket = 31;
                else { const int lg = 16 + (int)(logf((float)d / 16.f) / 2.0794415416798357f * 16.f); bucket = lg < 31 ? lg : 31; }
                val = (p.in[11][bucket * 16 + hkv * 4 + gg] - p.in[11][31 * 16 + hkv * 4 + gg]) * LOG2E;
            }
            tbl[i] = val;
        }
        if (tid < 256) selm[tid] = 0u;
        const int tq = q0 + ql;
        const size_t trow = (size_t)b * 8192 + tq;
        bf16x8 qf[4];
        { const bf16_t* qrow = Q + trow * 1024 + hkv * 256 + g * 64;
#pragma unroll
          for (int ks = 0; ks < 4; ++ks) qf[ks] = *(const bf16x8*)(qrow + 16 * ks + 8 * h); }
        float c31 = p.in[11][31 * 16 + hkv * 4 + g] * LOG2E;
        asm volatile("" : "+v"(qf[0]), "+v"(qf[1]), "+v"(qf[2]), "+v"(qf[3]), "+v"(c31));
        const LAS float* tblg = (const LAS float*)(smem + NSA_TBL) + g * 256;
        const LAS unsigned* selrow = (const LAS unsigned*)(smem + NSA_SEL) + ql * 4;
        f32x16 o[2];
#pragma unroll
        for (int v = 0; v < 2; ++v)
#pragma unroll
            for (int i = 0; i < 16; ++i) o[v][i] = 0.f;
        __syncthreads();
        const bf16_t* kc = (const bf16_t*)(ws + WS_BUFC + C_KC) + (size_t)bh * 512 * 64;
        const bf16_t* vct = (const bf16_t*)(ws + WS_BUFC + C_VCT) + (size_t)bh * 64 * 512;
        const int ct_hi = (q0 + 32) >> 10, cfar_hi = (q0 >= 1167) ? ((q0 - 1167) >> 10) : -1;
        float m_ref = 0.f; bool mset = false;
        float lsum = 0.f;
        const int rmode = ctr_idx ? NSA_REP_MODE : 0;
        if (rmode != 2) nsa_branch<M_CMP, 1>(smem, kc, vct, 512, 0, ct_hi, 0, cfar_hi, qf, tq, c31, tblg, selrow, m_ref, mset, lsum, 0.f, o, (LAS float*)(smem + NSA_IMP) + ql * 132);
        { const float lt = lsum + __shfl_xor(lsum, 32); const float inv = lt > 0.f ? 1.f / lt : 0.f;
          if (rmode != 2 && rmode != 4) nsa_branch<M_CMP, 2>(smem, kc, vct, 512, 0, ct_hi, 0, cfar_hi, qf, tq, c31, tblg, selrow, m_ref, mset, lsum, inv, o, (LAS float*)(smem + NSA_IMP) + ql * 132);
#pragma unroll
          for (int v = 0; v < 2; ++v)
#pragma unroll
            for (int i = 0; i < 16; ++i) o[v][i] *= inv; }
        asm volatile("s_waitcnt lgkmcnt(0)" ::: "memory"); __syncthreads();
        if (rmode < 2) {
            const int q = tid >> 3, sub = tid & 7, t = q0 + q;
            unsigned key[16];
#pragma unroll
            for (int i = 0; i < 16; ++i) {
                const int j = sub * 16 + i;
                const bool forced = (j == 0) || (j == cur) || (j == cur - 1);
                const bool valid = (j * 64 <= t);
                const float v = imp[q * 132 + j];
                key[i] = forced ? 0xFFFFFFFFu : (valid ? (__float_as_uint(v) + 1u) : 0u);
            }
            unsigned tau = 0u;
            for (int bit = 31; bit >= 0; --bit) {
                const unsigned cand = tau | (1u << bit);
                int c = 0;
#pragma unroll
                for (int i = 0; i < 16; ++i) c += (key[i] >= cand) ? 1 : 0;
                c += __builtin_amdgcn_update_dpp(0, c, 0xB1, 0xF, 0xF, true); c += __builtin_amdgcn_update_dpp(0, c, 0x4E, 0xF, 0xF, true); c += __builtin_amdgcn_update_dpp(0, c, 0x141, 0xF, 0xF, true);
                if (c >= 16) tau = cand;
            }
            int gt = 0, eq = 0;
#pragma unroll
            for (int i = 0; i < 16; ++i) { gt += (key[i] > tau) ? 1 : 0; eq += (key[i] == tau) ? 1 : 0; }
            int gtt = gt; gtt += __builtin_amdgcn_update_dpp(0, gtt, 0xB1, 0xF, 0xF, true); gtt += __builtin_amdgcn_update_dpp(0, gtt, 0x4E, 0xF, 0xF, true); gtt += __builtin_amdgcn_update_dpp(0, gtt, 0x141, 0xF, 0xF, true);
            int pre = 0;
#pragma unroll
            for (int sI = 0; sI < 7; ++sI) { const int v = __shfl(eq, (lane & ~7) + sI); if (sI < sub) pre += v; }
            const int need = 16 - gtt;
            unsigned bits = 0u; int run = pre;
#pragma unroll
            for (int i = 0; i < 16; ++i) {
                bool sel = key[i] > tau;
                if (tau > 0u && key[i] == tau) { sel = run < need; ++run; }
                bits |= sel ? (1u << i) : 0u;
            }
            atomicOr(&selm[q * 4 + (sub >> 1)], bits << ((sub & 1) * 16));
        }
        __syncthreads();
        const float gc = G[((size_t)b * 8192 + tq) * 48 + hkv * 12 + g * 3 + 0];
#pragma unroll
        for (int v = 0; v < 2; ++v)
#pragma unroll
            for (int i = 0; i < 16; i += 2) { const float gcc = (PROBE == 1 ? 0.f : gc); tot[(v * 8 + (i >> 1)) * 512 + tid] = cvt_pk_bf16(gcc * o[v][i], gcc * o[v][i + 1]); o[v][i] = 0.f; o[v][i + 1] = 0.f; }
        {
            const bf16_t* ks = (const bf16_t*)(ws + WS_BUFC + C_KS) + (size_t)bh * 8192 * 64;
            const bf16_t* vst = (const bf16_t*)(ws + WS_BUFC + C_VST) + (size_t)bh * 64 * 8192;
            m_ref = 0.f; mset = false;
            lsum = 0.f;
            if (rmode == 0) nsa_branch<M_SEL, 0>(smem, ks, vst, 8192, 0, cur, 0, cur - 3, qf, tq, c31, tblg, selrow, m_ref, mset, lsum, 0.f, o, (LAS float*)nullptr);
            const float gs = G[((size_t)b * 8192 + tq) * 48 + hkv * 12 + g * 3 + 1];
            const float sc = (PROBE == 2 ? 0.f : gs) / (lsum + __shfl_xor(lsum, 32));
#pragma unroll
            for (int v = 0; v < 2; ++v)
#pragma unroll
                for (int i = 0; i < 16; i += 2) { const unsigned tv = tot[(v * 8 + (i >> 1)) * 512 + tid];
                    tot[(v * 8 + (i >> 1)) * 512 + tid] = cvt_pk_bf16(bf2f(tv & 0xffffu) + sc * o[v][i], bf2f(tv >> 16) + sc * o[v][i + 1]); o[v][i] = 0.f; o[v][i + 1] = 0.f; }
        }
        {
            const bf16_t* kw = (const bf16_t*)(ws + WS_BUFC + C_KW) + (size_t)bh * 8192 * 64;
            const bf16_t* vwt = (const bf16_t*)(ws + WS_BUFC + C_VWT) + (size_t)bh * 64 * 8192;
            m_ref = 0.f; mset = false;
            lsum = 0.f;
            const int w_lo = cur >= 8 ? cur - 8 : 0;
            if (rmode == 0 || rmode == 2) nsa_branch<M_WIN, 0>(smem, kw, vwt, 8192, w_lo, cur, cur - 7, cur - 3, qf, tq, c31, tblg, selrow, m_ref, mset, lsum, 0.f, o, (LAS float*)nullptr);
            const float gw = G[((size_t)b * 8192 + tq) * 48 + hkv * 12 + g * 3 + 2];
            const float sc = (PROBE == 3 ? 0.f : gw) / (lsum + __shfl_xor(lsum, 32));
            bf16_t* orow = CC + trow * 2048 + hkv * 256 + g * 64;
#pragma unroll
            for (int v = 0; v < 2; ++v)
#pragma unroll
                for (int c4 = 0; c4 < 4; ++c4) {
                    const unsigned ta = tot[(v * 8 + 2 * c4) * 512 + tid], tb = tot[(v * 8 + 2 * c4 + 1) * 512 + tid];
                    const float r0 = bf2f(ta & 0xffffu) + sc * o[v][4 * c4 + 0], r1 = bf2f(ta >> 16) + sc * o[v][4 * c4 + 1];
                    const float r2 = bf2f(tb & 0xffffu) + sc * o[v][4 * c4 + 2], r3 = bf2f(tb >> 16) + sc * o[v][4 * c4 + 3];
                    u32x2 ov; ov.x = cvt_pk_bf16(r0, r1); ov.y = cvt_pk_bf16(r2, r3);
                    *(u32x2*)(orow + 32 * v + 8 * c4 + 4 * h) = ov;
                }
        }
        if (ctr_idx == 0) {
            __syncthreads();
            for (int k = 0; k < 3; ++k) {
                int item = 0;
                if (lane == 0) item = (int)atomicAdd(trc, 1u);
                item = __builtin_amdgcn_readfirstlane(item);
                if (item >= MOE_W_ITEMS) break;
                moe_weight_item(p, smem, item);
            }
        }
    }
    if (ctr_idx == 0) {
        __syncthreads();
        for (;;) {
            int item = 0;
            if ((threadIdx.x & 63) == 0) item = (int)atomicAdd(trc, 1u);
            item = __builtin_amdgcn_readfirstlane(item);
            if (item >= MOE_W_ITEMS) break;
            moe_weight_item(p, smem, item);
        }
    }
}

template <int which>
DEVI void phase_ln(const Params& p) {
    unsigned char* ws = p.ws;
    int tid = threadIdx.x; asm volatile("" : "+v"(tid));
    const int lane = tid & 63, w = tid >> 6;
    for (int it = blockIdx.x; it < T_ / 8; it += gridDim.x) {
        const int t = it * 8 + w;
        float* row = p.out + (size_t)t * D_;
        f32x4 v[8];
        if (which == 2) {
            const bf16_t* yh = (const bf16_t*)(ws + WS_BUFE) + (size_t)t * D_;
#pragma unroll
            for (int c = 0; c < 8; ++c) { const u32x2 a = *(const u32x2*)(yh + c * 256 + lane * 4);
                v[c].x = bf2f(a.x & 0xffffu); v[c].y = bf2f(a.x >> 16); v[c].z = bf2f(a.y & 0xffffu); v[c].w = bf2f(a.y >> 16); }
        } else row_load(row, lane, v);
        float mean, rstd; row_stats(v, mean, rstd);
        if (which == 0) {
            if (lane == 0) { float* st = (float*)(ws + WS_STATS); st[t * 2] = mean; st[t * 2 + 1] = rstd; }
            bf16_t* hi = (bf16_t*)(ws + WS_BUFB) + (size_t)t * D_;
#pragma unroll
            for (int c = 0; c < 8; ++c) {
                const int col = c * 256 + lane * 4;
                const f32x4 g = *(const f32x4*)(p.in[17] + col), b = *(const f32x4*)(p.in[18] + col);
                const f32x4 y = (v[c] - mean) * rstd * g + b;
                u32x2 o; o.x = cvt_pk_bf16(y.x, y.y); o.y = cvt_pk_bf16(y.z, y.w);
                *(u32x2*)(hi + col) = o;
            }
        } else if (which == 1) {
            bf16_t* hi = (bf16_t*)(ws + WS_BUFA) + (size_t)t * D_;
            bf16_t* lo = (bf16_t*)(ws + WS_BUFB) + (size_t)t * D_;
#pragma unroll
            for (int c = 0; c < 8; ++c) {
                const int col = c * 256 + lane * 4;
                const f32x4 g = *(const f32x4*)(p.in[24] + col), b = *(const f32x4*)(p.in[25] + col);
                const f32x4 y = (v[c] - mean) * rstd * g + b;
                u32x2 o; o.x = cvt_pk_bf16(y.x, y.y); o.y = cvt_pk_bf16(y.z, y.w);
                *(u32x2*)(hi + col) = o;
                u32x2 ol;
                ol.x = cvt_pk_bf16(y.x - bf2f(o.x & 0xffffu), y.y - bf2f(o.x >> 16));
                ol.y = cvt_pk_bf16(y.z - bf2f(o.y & 0xffffu), y.w - bf2f(o.y >> 16));
                *(u32x2*)(lo + col) = ol;
            }
        } else {
            const bf16_t* y0 = (const bf16_t*)(ws + WS_BUFC) + (size_t)t * 2 * D_;
#pragma unroll
            for (int c = 0; c < 8; ++c) {
                const int col = c * 256 + lane * 4;
                const f32x4 g = *(const f32x4*)(p.in[24] + col), b = *(const f32x4*)(p.in[25] + col);
                const f32x4 x2 = (v[c] - mean) * rstd * g + b;
                const u32x2 a = *(const u32x2*)(y0 + col), bq = *(const u32x2*)(y0 + D_ + col);
                v[c].x = x2.x * ALPHA + (bf2f(a.x & 0xffffu) + bf2f(bq.x & 0xffffu));
                v[c].y = x2.y * ALPHA + (bf2f(a.x >> 16) + bf2f(bq.x >> 16));
                v[c].z = x2.z * ALPHA + (bf2f(a.y & 0xffffu) + bf2f(bq.y & 0xffffu));
                v[c].w = x2.w * ALPHA + (bf2f(a.y >> 16) + bf2f(bq.y >> 16));
            }
            row_stats(v, mean, rstd);
#pragma unroll
            for (int c = 0; c < 8; ++c) {
                const int col = c * 256 + lane * 4;
                const f32x4 g = *(const f32x4*)(p.in[33] + col), b = *(const f32x4*)(p.in[34] + col);
                *(f32x4*)(row + col) = (v[c] - mean) * rstd * g + b;
            }
        }
    }
}

DEVI void phase_xattn(const Params& p, char* smem) {
    unsigned char* ws = p.ws;
    int tid = threadIdx.x; asm volatile("" : "+v"(tid));
    const int lane = tid & 63, w = tid >> 6, l31 = lane & 31, h = lane >> 5;
    const bf16_t* Qx = (const bf16_t*)(ws + WS_BUFC);
    const bf16_t* Kx = (const bf16_t*)(ws + WS_BUFD + 4 * MiB);
    const bf16_t* Vt = (const bf16_t*)(ws + WS_BUFD + 8 * MiB);
    bf16_t* Ox = (bf16_t*)(ws + WS_BUFA);
    bf16_t* Qs = (bf16_t*)smem;
    bf16_t* Ks = Qs + 256 * KSTR;
    bf16_t* Vs = (bf16_t*)smem;
    for (int unit = blockIdx.x; unit < 512; unit += gridDim.x) {
        const int qt = unit & 31, head = (unit >> 5) & 3, b = unit >> 7;
        const size_t t0 = (size_t)b * 8192 + qt * 256;
        const bf16_t* kbase = Kx + (size_t)(b * 4 + head) * 256 * 512;
        const bf16_t* vbase = Vt + (size_t)(b * 4 + head) * 512 * 256;
        f32x16 s[8];
#pragma unroll
        for (int u = 0; u < 8; ++u)
#pragma unroll
            for (int i = 0; i < 16; ++i) s[u][i] = 0.f;
        u32x4 pq[4], pk4[4];
#pragma unroll
        for (int i = 0; i < 4; ++i) { const int c = tid + 512 * i, row = c >> 3, ch = c & 7;
            pq[i] = *(const u32x4*)(Qx + (t0 + row) * 2048 + head * 512 + ch * 8); pk4[i] = *(const u32x4*)(kbase + (size_t)row * 512 + ch * 8); }
        for (int dc = 0; dc < 8; ++dc) {
            __syncthreads();
#pragma unroll
            for (int i = 0; i < 4; ++i) { const int c = tid + 512 * i, row = c >> 3, ch = c & 7;
                *(u32x4*)(Qs + row * KSTR + ch * 8) = pq[i]; *(u32x4*)(Ks + row * KSTR + ch * 8) = pk4[i]; }
            __syncthreads();
            if (dc + 1 < 8) {
#pragma unroll
                for (int i = 0; i < 4; ++i) { const int c = tid + 512 * i, row = c >> 3, ch = c & 7;
                    pq[i] = *(const u32x4*)(Qx + (t0 + row) * 2048 + head * 512 + (dc + 1) * 64 + ch * 8); pk4[i] = *(const u32x4*)(kbase + (size_t)row * 512 + (dc + 1) * 64 + ch * 8); }
            }
#pragma unroll
            for (int ks = 0; ks < 4; ++ks) {
                const bf16x8 qb = *(const bf16x8*)(Qs + (32 * w + l31) * KSTR + 16 * ks + 8 * h);
#pragma unroll
                for (int u = 0; u < 8; ++u) { const bf16x8 ka = *(const bf16x8*)(Ks + (32 * u + l31) * KSTR + 16 * ks + 8 * h); s[u] = mfma32(ka, qb, s[u]); }
            }
        }
        u32x4 pv[4];
#pragma unroll
        for (int i = 0; i < 4; ++i) { const int c = tid + 512 * i, row = c >> 5, ch = c & 31; pv[i] = *(const u32x4*)(vbase + (size_t)row * 256 + ch * 8); }
        float mx = -INFINITY;
#pragma unroll
        for (int u = 0; u < 8; ++u)
#pragma unroll
            for (int i = 0; i < 16; i += 2) mx = max3f(mx, s[u][i], s[u][i + 1]);
        mx = fmaxf(mx, __shfl_xor(mx, 32));
        float ls = 0.f;
        bf16x8 pf[8][2];
#pragma unroll
        for (int u = 0; u < 8; ++u) {
#pragma unroll
            for (int i = 0; i < 16; ++i) { s[u][i] = fexp2(s[u][i] - mx); ls += s[u][i]; }
#pragma unroll
            for (int sI = 0; sI < 2; ++sI) { u32x4 pk;
                pk.x = cvt_pk_bf16(s[u][8 * sI + 0], s[u][8 * sI + 1]); pk.y = cvt_pk_bf16(s[u][8 * sI + 2], s[u][8 * sI + 3]);
                pk.z = cvt_pk_bf16(s[u][8 * sI + 4], s[u][8 * sI + 5]); pk.w = cvt_pk_bf16(s[u][8 * sI + 6], s[u][8 * sI + 7]);
                pf[u][sI] = __builtin_bit_cast(bf16x8, pk); }
        }
        ls += __shfl_xor(ls, 32);
        const float inv = (PROBE == 4 ? 0.f : 1.f) / ls;
        bf16_t* orow = Ox + (t0 + 32 * w + l31) * 2048 + head * 512;
        for (int dc = 0; dc < 8; ++dc) {
            __syncthreads();
#pragma unroll
            for (int i = 0; i < 4; ++i) { const int c = tid + 512 * i, row = c >> 5, ch = c & 31; *(u32x4*)(Vs + row * 264 + ch * 8) = pv[i]; }
            __syncthreads();
            if (dc + 1 < 8) {
#pragma unroll
                for (int i = 0; i < 4; ++i) { const int c = tid + 512 * i, row = c >> 5, ch = c & 31; pv[i] = *(const u32x4*)(vbase + (size_t)((dc + 1) * 64 + row) * 256 + ch * 8); }
            }
            f32x16 o[2];
#pragma unroll
            for (int v = 0; v < 2; ++v)
#pragma unroll
                for (int i = 0; i < 16; ++i) o[v][i] = 0.f;
#pragma unroll
            for (int s4 = 0; s4 < 16; ++s4)
#pragma unroll
                for (int v = 0; v < 2; ++v) {
                    const bf16_t* vr = Vs + (32 * v + l31) * 264 + 16 * s4 + 4 * h;
                    const u32x2 a = *(const u32x2*)vr, bq = *(const u32x2*)(vr + 8);
                    u32x4 vv; vv.x = a.x; vv.y = a.y; vv.z = bq.x; vv.w = bq.y;
                    o[v] = mfma32(__builtin_bit_cast(bf16x8, vv), pf[s4 >> 1][s4 & 1], o[v]);
                }
#pragma unroll
            for (int v = 0; v < 2; ++v)
#pragma unroll
                for (int c4 = 0; c4 < 4; ++c4) {
                    u32x2 ov; ov.x = cvt_pk_bf16(o[v][4 * c4] * inv, o[v][4 * c4 + 1] * inv); ov.y = cvt_pk_bf16(o[v][4 * c4 + 2] * inv, o[v][4 * c4 + 3] * inv);
                    *(u32x2*)(orow + dc * 64 + 32 * v + 8 * c4 + 4 * h) = ov;
                }
        }
        __syncthreads();
    }
}

DEVI void phase_route(const Params& p) {
    unsigned char* ws = p.ws;
    const float* L = (const float*)(ws + WS_LOGITS);
    unsigned* cnt = (unsigned*)(ws + WS_CTL) + CW_CNT;
    int* list = (int*)(ws + WS_LIST);
    float* wt = (float*)(ws + WS_WTOK);
    int tid = threadIdx.x; asm volatile("" : "+v"(tid));
    for (int t = blockIdx.x * NTHREADS + tid; t < T_; t += gridDim.x * NTHREADS) {
        const f32x4 lgv = *(const f32x4*)(L + (size_t)t * 40);
        float lg[4] = {lgv.x + p.in[27][0], lgv.y + p.in[27][1], lgv.z + p.in[27][2], lgv.w + p.in[27][3]};
        int grp = 0; float best = lg[0];
#pragma unroll
        for (int i = 1; i < 4; ++i) if (lg[i] > best) { best = lg[i]; grp = i; }
        float se = 0.f;
#pragma unroll
        for (int i = 0; i < 4; ++i) se += expf(lg[i] - best);
        const float wgrp = 1.f / se;
        const f32x4 e0 = *(const f32x4*)(L + (size_t)t * 40 + 4 + grp * 8), e1 = *(const f32x4*)(L + (size_t)t * 40 + 8 + grp * 8);
        const f32x4 b0 = *(const f32x4*)(p.in[29] + grp * 8), b1 = *(const f32x4*)(p.in[29] + grp * 8 + 4);
        float le[8] = {e0.x + b0.x, e0.y + b0.y, e0.z + b0.z, e0.w + b0.w, e1.x + b1.x, e1.y + b1.y, e1.z + b1.z, e1.w + b1.w};
        int i0 = 0; float v0 = le[0];
#pragma unroll
        for (int i = 1; i < 8; ++i) if (le[i] > v0) { v0 = le[i]; i0 = i; }
        int i1 = -1; float v1 = -INFINITY;
#pragma unroll
        for (int i = 0; i < 8; ++i) if (i != i0 && le[i] > v1) { v1 = le[i]; i1 = i; }
        const float ex = expf(v1 - v0);
        const float w0 = wgrp / (1.f + ex), w1 = wgrp * ex / (1.f + ex);
        const int ea = grp * 8 + i0, eb = grp * 8 + i1;
        const unsigned pa = atomicAdd(cnt + ea, 1u); list[(size_t)ea * T_ + pa] = t * 2;
        const unsigned pb = atomicAdd(cnt + eb, 1u); list[(size_t)eb * T_ + pb] = t * 2 + 1;
        wt[t * 2] = w0; wt[t * 2 + 1] = w1;
    }
}

enum { PH_PREP = 0, PH_PROJ, PH_CMP1, PH_CMP2, PH_NSA, PH_OUT, PH_LN1, PH_WQ, PH_XATTN, PH_WO, PH_LN2, PH_ROUTER, PH_ROUTE, PH_MOE1, PH_MOE2, PH_LN3, PH_COUNT };

__global__ void __launch_bounds__(NTHREADS, 2) fwd_megakernel(Params p) {
    extern __shared__ __attribute__((aligned(16))) char smem[];
    cg::grid_group grid = cg::this_grid();
    volatile LAS unsigned* bar_st = (volatile LAS unsigned*)(smem + LDS_BYTES - 16);
    if (threadIdx.x < 2) bar_st[threadIdx.x] = 0u;
    __syncthreads();
    xcd_barrier_post((unsigned*)(p.ws + WS_CTL) + CW_BAR);
    const int lo = p.ph_lo, hi = p.ph_hi;
    unsigned long long ts0 = 0, ts1 = 0;
    if (TSTAMP_PHASE >= 0) ts0 = __builtin_amdgcn_s_memrealtime();
#ifndef PHMASK
#define PHMASK 0xFFFFFFFFu
#endif
#define IN(k) (lo <= (k) && (k) < hi && ((PHMASK >> (k)) & 1u))
#define SEAM(k) do { if (IN(k) && IN((k) + 1)) { if ((k) == 0) grid.sync(); else xcd_barrier((unsigned*)(p.ws + WS_CTL) + CW_BAR, (volatile LAS unsigned*)(smem + LDS_BYTES - 16)); } if ((k) == TSTAMP_PHASE) ts1 = __builtin_amdgcn_s_memrealtime(); } while (0)
    if (IN(PH_PREP)) for (int r = 0; r < REP_PREP; ++r) phase_prep(p, smem);
    SEAM(PH_PREP);
    if (IN(PH_PROJ)) { for (int r = 0; r < REP_PROJ; ++r) gemm_job<J_PROJ>(p, smem); for (int r = 0; r < REP_SMALL; ++r) gemm_job<J_MEMKV>(p, smem); }
    SEAM(PH_PROJ);
    if (IN(PH_CMP1)) { for (int r = 0; r < REP_SMALL; ++r) gemm_job<J_CMP1>(p, smem); for (int r = 0; r < REP_CONV; ++r) phase_conv(p); }
    SEAM(PH_CMP1);
    if (IN(PH_CMP2)) for (int r = 0; r < REP_SMALL; ++r) gemm_job<J_CMP2>(p, smem);
    SEAM(PH_CMP2);
    if (IN(PH_NSA)) { conv_finish(p); for (int r = 0; r < REP_NSA; ++r) phase_nsa(p, smem, r); }
    SEAM(PH_NSA);
    if (IN(PH_OUT)) for (int r = 0; r < REP_OUT; ++r) gemm_direct<J_OUT>(p, smem);
    SEAM(PH_OUT);
    if (IN(PH_WQ)) { gemm_direct<J_WQ>(p, smem); for (int r = 1; r < REP_WQ; ++r) gemm_job<J_WQ, WQ_VAR>(p, smem); }
    SEAM(PH_WQ);
    if (IN(PH_XATTN)) for (int r = 0; r < REP_XATTN; ++r) phase_xattn(p, smem);
    SEAM(PH_XATTN);
    if (IN(PH_WO)) gemm_direct<J_WO>(p, smem);
    SEAM(PH_WO);
    if (IN(PH_ROUTER)) for (int r = 0; r < REP_SMALL; ++r) gemm_job<J_ROUTER>(p, smem);
    SEAM(PH_ROUTER);
    if (IN(PH_MOE1)) for (int r = 0; r < REP_MOE; ++r) gemm_job<J_MOE1>(p, smem);
    SEAM(PH_MOE1);
    if (IN(PH_MOE2)) for (int r = 0; r < REP_MOE; ++r) gemm_job<J_MOE2>(p, smem);
    SEAM(PH_MOE2);
    if (IN(PH_LN3)) phase_ln<2>(p);
    if (TSTAMP_PHASE >= 0 && blockIdx.x == 0 && threadIdx.x == 0) { const unsigned long long t2 = __builtin_amdgcn_s_memrealtime(); const unsigned long long wait = 4ull * (ts1 - ts0); while (__builtin_amdgcn_s_memrealtime() - t2 < wait) __builtin_amdgcn_s_sleep(32); }
#undef IN
#undef SEAM
}

#ifndef N_SPLIT
#define N_SPLIT 1
#endif

extern "C" void kernel_launch(void* const* d_in, const int* in_sizes, int n_in, void* d_out, int out_size, void* d_ws, size_t ws_size, hipStream_t stream) {
    static int grid_blocks = 0;
    if (grid_blocks == 0) {
        if (n_in != 35 || ws_size < WS_END || out_size != T_ * D_) { fprintf(stderr, "kernel_launch: unexpected sizes n_in %d ws %zu out %d\n", n_in, ws_size, out_size); grid_blocks = -1; return; }
        int dev = 0, cus = 0, per_cu = 0;
        hipGetDevice(&dev);
        hipDeviceGetAttribute(&cus, hipDeviceAttributeMultiprocessorCount, dev);
        hipFuncSetAttribute((const void*)fwd_megakernel, hipFuncAttributeMaxDynamicSharedMemorySize, LDS_BYTES);
        hipOccupancyMaxActiveBlocksPerMultiprocessor(&per_cu, (const void*)fwd_megakernel, NTHREADS, LDS_BYTES);
        if (per_cu < 1) { fprintf(stderr, "kernel_launch: occupancy query says %d blocks per CU\n", per_cu); grid_blocks = -1; return; }
        if (per_cu > 2) per_cu = 2;
        grid_blocks = cus * per_cu;
        fprintf(stderr, "kernel_launch: %d CUs x %d blocks\n", cus, per_cu);
    }
    if (grid_blocks < 0) return;
    hipMemsetAsync((char*)d_ws + WS_CTL, 0, 1 * MiB, stream);
    hipMemsetAsync((char*)d_ws + WS_RSUM1, 0, 1 * MiB, stream);
    Params p{};
    for (int i = 0; i < 35; ++i) p.in[i] = (const float*)d_in[i];
    p.out = (float*)d_out; p.ws = (unsigned char*)d_ws;
    if (N_SPLIT == 1) {
        p.ph_lo = 0; p.ph_hi = PH_COUNT;
        void* args[] = {&p};
        hipError_t e = hipLaunchCooperativeKernel((const void*)fwd_megakernel, dim3(grid_blocks), dim3(NTHREADS), args, LDS_BYTES, stream);
        if (e != hipSuccess) fprintf(stderr, "cooperative launch failed: %s (grid %d)\n", hipGetErrorString(e), grid_blocks);
    } else {
        for (int ph = 0; ph < PH_COUNT; ++ph) {
            p.ph_lo = ph; p.ph_hi = ph + 1;
            void* args[] = {&p};
            hipError_t e = hipLaunchCooperativeKernel((const void*)fwd_megakernel, dim3(grid_blocks), dim3(NTHREADS), args, LDS_BYTES, stream);
            if (e != hipSuccess) fprintf(stderr, "launch %d failed: %s\n", ph, hipGetErrorString(e));
        }
    }
}
```

```cpp
#include <hip/hip_runtime.h>
#include <hip/hip_cooperative_groups.h>
#include <cstdio>
#include <cstdint>
namespace cg = cooperative_groups;

#define DEVI __device__ __forceinline__
#ifndef REP_PREP
#define REP_PREP 1
#define REP_PROJ 1
#define REP_NSA 1
#define REP_WQ 1
#define WQ_VAR 3
#define REP_XATTN 1
#define REP_MOE 1
#define REP_LN3 1
#define REP_CONV 1
#define REP_OUT 1
#define REP_SMALL 1
#endif
#ifndef NSA_REP_MODE
#define NSA_REP_MODE 0
#endif
#ifndef TSTAMP_PHASE
#define TSTAMP_PHASE -1
#endif
#ifndef PROBE
#define PROBE 0
#endif
typedef unsigned short bf16_t;
typedef __attribute__((ext_vector_type(8))) short bf16x8;
typedef __attribute__((ext_vector_type(4))) float f32x4;
typedef __attribute__((ext_vector_type(16))) float f32x16;
typedef __attribute__((ext_vector_type(4))) unsigned u32x4;
typedef __attribute__((ext_vector_type(2))) unsigned u32x2;

constexpr int T_ = 32768, D_ = 2048, S_ = 8192, NB_ = 4;
constexpr int NPROJ = 4736;
constexpr int IN_COLS = 4656;
constexpr float ALPHA = 1.189207115002721f;
constexpr float LOG2E = 1.4426950408889634f;
constexpr float LN_EPS = 1e-5f;
constexpr int NTHREADS = 512;
constexpr int LDS_BYTES = 147968;

constexpr size_t MiB = 1ull << 20;
constexpr size_t WS_CTL = 0;
constexpr size_t WS_STATS = 1 * MiB;
constexpr size_t WS_C1BIAS = WS_STATS + 256 * 1024;
constexpr size_t WS_UPART2 = WS_C1BIAS + 16 * 1024, WS_CPART2 = WS_UPART2 + 16 * 1024;
constexpr size_t WS_WTOK = WS_STATS + 512 * 1024;
constexpr size_t WS_LOGITS = 2 * MiB;
constexpr size_t WS_WLIST = 3 * MiB;
constexpr size_t WS_LIST = 7 * MiB;
constexpr size_t WS_WC1 = 11 * MiB;
constexpr size_t WS_WC2 = 13 * MiB;
constexpr size_t WS_WR = 14 * MiB;
constexpr size_t WS_WIN = 15 * MiB;
constexpr size_t WS_WOUT = 34 * MiB;
constexpr size_t WS_WQ = 42 * MiB;
constexpr size_t WS_WKV = 50 * MiB;
constexpr size_t WS_WO = 66 * MiB;
constexpr size_t WS_WGU = 74 * MiB;
constexpr size_t WS_WD = 202 * MiB;
constexpr size_t WS_BUFA = 266 * MiB;
constexpr size_t WS_BUFB = 394 * MiB;
constexpr size_t WS_BUFC = 522 * MiB;
constexpr size_t WS_BUFD = 650 * MiB;
constexpr size_t WS_BUFE = 778 * MiB;
constexpr size_t WS_SLIST = 906 * MiB;
constexpr size_t WS_RP2 = 914 * MiB;
constexpr size_t WS_END = 922 * MiB;
constexpr size_t C_KCMP = 0, C_VCMP = 16 * MiB, C_KS = 32 * MiB, C_VST = 48 * MiB, C_KW = 64 * MiB, C_VWT = 80 * MiB,
                 C_GATES = 96 * MiB, C_HID = 102 * MiB, C_KC = 110 * MiB, C_VCT = 111 * MiB;
constexpr int CW_CNT = 64;
constexpr int CW_NSA = 1024;
constexpr int CW_CONV = 3072;
constexpr int CW_TR = 2048;
constexpr int CW_BAR = 4096;
constexpr size_t CTL_U1 = 65536, CTL_C1 = 73728;
constexpr size_t CTL_C1BIAS = 83968;
constexpr size_t CTL_U2 = 81920, CTL_C2 = 82944;
constexpr size_t CTL_UE = 131072, CTL_CE = 262144;
constexpr size_t WS_RSUM2 = WS_LOGITS + 256 * 1024;
constexpr size_t WS_RSUM1 = WS_LOGITS;

struct Params {
    const float* in[35];
    float* out;
    unsigned char* ws;
    int ph_lo, ph_hi;
};

DEVI unsigned cvt_pk_bf16(float lo, float hi) { unsigned r; asm("v_cvt_pk_bf16_f32 %0, %1, %2" : "=v"(r) : "v"(lo), "v"(hi)); return r; }
DEVI bf16_t f2bf(float x) { return (bf16_t)(cvt_pk_bf16(x, 0.f) & 0xffffu); }
DEVI float bf2f(unsigned b) { return __uint_as_float(b << 16); }
DEVI void glds16(const void* g, void* l) {
    __builtin_amdgcn_global_load_lds((const __attribute__((address_space(1))) void*)g, (__attribute__((address_space(3))) void*)l, 16, 0, 0);
}
DEVI f32x16 mfma32(bf16x8 a, bf16x8 b, f32x16 c) { return __builtin_amdgcn_mfma_f32_32x32x16_bf16(a, b, c, 0, 0, 0); }
DEVI u32x2 gload8_asm(const void* g) { u32x2 r; asm volatile("global_load_dwordx2 %0, %1, off" : "=v"(r) : "v"(g) : "memory"); return r; }
DEVI unsigned gload4_asm(const void* g) { unsigned r; asm volatile("global_load_dword %0, %1, off" : "=v"(r) : "v"(g) : "memory"); return r; }
DEVI f32x4 gload16_asm(const void* g) { f32x4 r; asm volatile("global_load_dwordx4 %0, %1, off" : "=v"(r) : "v"(g) : "memory"); return r; }
DEVI f32x4 mfma16(bf16x8 a, bf16x8 b, f32x4 c) { return __builtin_amdgcn_mfma_f32_16x16x32_bf16(a, b, c, 0, 0, 0); }
DEVI float fexp2(float x) { return __builtin_amdgcn_exp2f(x); }
DEVI float max3f(float a, float b, float c) { float r; asm("v_max3_f32 %0, %1, %2, %3" : "=v"(r) : "v"(a), "v"(b), "v"(c)); return r; }
DEVI float wave_sum(float v) {
#pragma unroll
    for (int o = 1; o < 64; o <<= 1) v += __shfl_xor(v, o);
    return v;
}
DEVI float sigmoidf_(float x) { return 1.f / (1.f + __expf(-x)); }
DEVI float gelu_tanh(float x) {
    const float u = 0.7978845608028654f * (x + 0.044715f * x * x * x);
    const float e = __expf(2.f * u);
    const float th = 1.f - 2.f / (e + 1.f);
    return 0.5f * x * (1.f + th);
}

#define LAS __attribute__((address_space(3)))
#define XB_TMO      128
#define XB_XCNT(j)  (256  + 64 * (j))
#define XB_XSUB(j)  (1280 + 64 * (j))
#define XB_XGEN(j)  (2304 + 64 * (j))
#define XB_TOP      3328
#define XB_TOPGEN   3392
#define XB_SPIN_CAP (1u << 22)
DEVI unsigned xb_ld(unsigned* p) { return __hip_atomic_load(p, __ATOMIC_RELAXED, __HIP_MEMORY_SCOPE_AGENT); }
DEVI unsigned xb_add(unsigned* p, unsigned v) { return __hip_atomic_fetch_add(p, v, __ATOMIC_RELAXED, __HIP_MEMORY_SCOPE_AGENT); }
DEVI unsigned xb_xcc_id() { return (unsigned)__builtin_amdgcn_s_getreg((3 << 11) | 20) & 0xFu; }
#define XB_SPIN(cond, bar) do { unsigned _sp = 0; while (cond) { __builtin_amdgcn_s_sleep(1); \
    if ((++_sp & 255u) == 0u) { if (xb_ld(&(bar)[XB_TMO])) break; if (_sp > XB_SPIN_CAP) { atomicAdd(&(bar)[XB_TMO], 1u); break; } } } } while (0)
DEVI void xcd_barrier_post(unsigned* bar) {
    if (threadIdx.x == 0) (void)xb_add(&bar[XB_XCNT(xb_xcc_id())], 1u);
}
DEVI void xcd_barrier_complete(unsigned* bar, unsigned x, unsigned& nloc, unsigned& nx) {
    const unsigned G = gridDim.x * gridDim.y * gridDim.z;
    unsigned sum, cnt, mine, sp = 0u;
    for (;;) {
        sum = 0u; cnt = 0u; mine = 0u;
#pragma unroll
        for (unsigned j = 0; j < 16; ++j) { const unsigned c = xb_ld(&bar[XB_XCNT(j)]); sum += c; cnt += (c > 0u) ? 1u : 0u; mine = (j == x) ? c : mine; }
        if (sum == G) break;
        __builtin_amdgcn_s_sleep(1);
        if ((++sp & 255u) == 0u) { if (xb_ld(&bar[XB_TMO])) break; if (sp > XB_SPIN_CAP) { atomicAdd(&bar[XB_TMO], 1u); break; } }
    }
    nloc = mine > 0u ? mine : 1u; nx = cnt > 0u ? cnt : 1u;
}
DEVI void xcd_barrier(unsigned* bar, volatile LAS unsigned* st) {
    asm volatile("s_waitcnt vmcnt(0)" ::: "memory");
    __syncthreads();
    if (threadIdx.x == 0) {
        const unsigned x = xb_xcc_id();
        __builtin_amdgcn_s_waitcnt(0);
        unsigned nloc = st[0], nx = st[1];
        if (nloc == 0u) { xcd_barrier_complete(bar, x, nloc, nx); st[0] = nloc; st[1] = nx; }
        const unsigned old = xb_add(&bar[XB_XSUB(x)], 1u);
        const unsigned gen = old / nloc;
        if (old + 1u == (gen + 1u) * nloc) {
            __builtin_amdgcn_fence(__ATOMIC_RELEASE, "agent");
            asm volatile("s_waitcnt vmcnt(0)" ::: "memory");
            const unsigned og = xb_add(&bar[XB_TOP], 1u);
            const unsigned tg = og / nx;
            if (og + 1u == (tg + 1u) * nx) xb_add(&bar[XB_TOPGEN], 1u);
            else XB_SPIN(xb_ld(&bar[XB_TOPGEN]) == tg, bar);
            __builtin_amdgcn_fence(__ATOMIC_ACQUIRE, "agent");
            xb_add(&bar[XB_XGEN(x)], 1u);
            asm volatile("s_waitcnt vmcnt(0)" ::: "memory");
        } else {
            XB_SPIN(xb_ld(&bar[XB_XGEN(x)]) == gen, bar);
            __builtin_amdgcn_fence(__ATOMIC_ACQUIRE, "agent");
            asm volatile("s_waitcnt vmcnt(0)" ::: "memory");
        }
    }
    __syncthreads();
}

DEVI void row_load(const float* row, int lane, f32x4 (&v)[8]) {
#pragma unroll
    for (int c = 0; c < 8; ++c) v[c] = *(const f32x4*)(row + c * 256 + lane * 4);
}
DEVI void row_stats(const f32x4 (&v)[8], float& mean, float& rstd) {
    float s = 0.f;
#pragma unroll
    for (int c = 0; c < 8; ++c) s += (v[c].x + v[c].y) + (v[c].z + v[c].w);
    mean = wave_sum(s) * (1.f / D_);
    float q = 0.f;
#pragma unroll
    for (int c = 0; c < 8; ++c) { const f32x4 d = v[c] - mean; q += (d.x * d.x + d.y * d.y) + (d.z * d.z + d.w * d.w); }
    rstd = 1.f / sqrtf(wave_sum(q) * (1.f / D_) + LN_EPS);
}

DEVI const float* wsrc_col(const Params& p, int mat, int e, int n, int& ld) {
    switch (mat) {
    case 0: {
        ld = IN_COLS;
        if (n < 2560) return p.in[4] + n;
        if (n < 2688) { const int j = n - 2560; return j < 48 ? p.in[4] + 2560 + j : nullptr; }
        const int r = n - 2688, grp = r >> 6, within = r & 63;
        const int ch = grp * 32 + (within & 31), isg = within >> 5;
        return p.in[4] + 2608 + isg * 1024 + ch;
    }
    case 1: ld = 256; return p.in[6] + n;
    case 2: ld = 256; return p.in[9] + n;
    case 3: ld = 64; return n < 64 ? p.in[7] + n : nullptr;
    case 4: ld = 64; return n < 64 ? p.in[10] + n : nullptr;
    case 5: ld = 2048; return p.in[16] + n;
    case 6: ld = 2048; return p.in[21] + n;
    case 7: ld = 4096; return p.in[22] + n;
    case 8: ld = 2048; return p.in[23] + n;
    case 9: if (n < 4) { ld = 4; return p.in[26] + n; } if (n < 36) { ld = 32; return p.in[28] + (n - 4); } ld = 1; return nullptr;
    case 10: { ld = 512; const int grp = n >> 6, within = n & 63; const int ch = grp * 32 + (within & 31);
               return ((within >> 5) ? p.in[31] : p.in[30]) + (size_t)e * 2048 * 512 + ch; }
    default: ld = 2048; return p.in[32] + (size_t)e * 512 * 2048 + n;
    }
}
DEVI void wt_load(const Params& p, int mat, int e, int ntile, int ktile, f32x4 (&v)[16]) {
    int tid = threadIdx.x; asm volatile("" : "+v"(tid));
    const int lane = tid & 63, c4 = lane & 15, kr = lane >> 4, k0 = ktile * 64;
    int ld; const float* src = wsrc_col(p, mat, e, ntile * 64 + c4 * 4, ld);
#pragma unroll
    for (int i = 0; i < 16; ++i) v[i] = src ? *(const f32x4*)(src + (size_t)(k0 + kr + 4 * i) * ld) : (f32x4){0.f, 0.f, 0.f, 0.f};
}
DEVI void wave_transpose_body(const Params& p, char* smem, int mat, int e, int ntile, int ktile, bf16_t* dst, bf16_t* dst_lo, int K, const f32x4 (&v)[16],
                                const float* gvec = nullptr, const float* bvec = nullptr, float* U = nullptr, float* C = nullptr) {
    int tid = threadIdx.x; asm volatile("" : "+v"(tid));
    const int lane = tid & 63, w = tid >> 6;
    float* tile = (float*)smem + w * (64 * 65 + 32);
    const int k0 = ktile * 64;
    if (mat == 9) {
        int ld; const float* src = wsrc_col(p, mat, e, ntile * 64 + lane, ld);
        const float* sp = src ? src : p.in[26]; const int ldd = src ? ld : 0; const float msk = src ? 1.f : 0.f;
#pragma unroll
        for (int kb = 0; kb < 64; kb += 16) { float v[16];
#pragma unroll
            for (int j = 0; j < 16; ++j) v[j] = sp[(size_t)(k0 + kb + j) * ldd];
#pragma unroll
            for (int j = 0; j < 16; ++j) tile[(kb + j) * 65 + lane] = v[j] * msk; }
    } else {
        const int c4 = lane & 15, kr = lane >> 4;
#pragma unroll
        for (int i = 0; i < 16; ++i) { float* q = tile + (kr + 4 * i) * 65 + c4 * 4; q[0] = v[i].x; q[1] = v[i].y; q[2] = v[i].z; q[3] = v[i].w; }
    }
    asm volatile("s_waitcnt lgkmcnt(0)" ::: "memory");
    if (gvec) {
        float us = 0.f, cs = 0.f;
#pragma unroll 8
        for (int k = 0; k < 64; ++k) { const float wkn = tile[k * 65 + lane]; us += gvec[k0 + k] * wkn; cs += bvec[k0 + k] * wkn; }
        if (mat == 9) { U[ktile * 128 + ntile * 64 + lane] = us; C[ktile * 128 + ntile * 64 + lane] = cs; }
        else { atomicAdd(U + ntile * 64 + lane, us); atomicAdd(C + ntile * 64 + lane, cs); }
    }
    const int kc = lane & 7, nr = lane >> 3;
    float gsc[8];
#pragma unroll
    for (int j = 0; j < 8; ++j) gsc[j] = 1.f;
    if (gvec) { const f32x4 g0 = *(const f32x4*)(gvec + k0 + kc * 8), g1 = *(const f32x4*)(gvec + k0 + kc * 8 + 4);
        gsc[0] = g0.x; gsc[1] = g0.y; gsc[2] = g0.z; gsc[3] = g0.w; gsc[4] = g1.x; gsc[5] = g1.y; gsc[6] = g1.z; gsc[7] = g1.w; }
#pragma unroll
    for (int c = 0; c < 8; ++c) {
        const int n = nr + 8 * c;
        float wv[8];
#pragma unroll
        for (int j = 0; j < 8; ++j) wv[j] = tile[(kc * 8 + j) * 65 + n];
        if (gvec) {
#pragma unroll
            for (int j = 0; j < 8; ++j) wv[j] *= gsc[j]; }
        u32x4 o; o.x = cvt_pk_bf16(wv[0], wv[1]); o.y = cvt_pk_bf16(wv[2], wv[3]); o.z = cvt_pk_bf16(wv[4], wv[5]); o.w = cvt_pk_bf16(wv[6], wv[7]);
        const size_t off = (size_t)(ntile * 64 + n) * K + k0 + kc * 8;
        if (!dst_lo) *(u32x4*)(dst + off) = o;
        else {
            float r[8];
#pragma unroll
            for (int j = 0; j < 8; ++j) r[j] = wv[j] - bf2f((unsigned)f2bf(wv[j]));
            u32x4 l; l.x = cvt_pk_bf16(r[0], r[1]); l.y = cvt_pk_bf16(r[2], r[3]); l.z = cvt_pk_bf16(r[4], r[5]); l.w = cvt_pk_bf16(r[6], r[7]);
            const size_t o0 = (size_t)n * K + k0 + kc * 8, o1 = (size_t)(64 + n) * K + k0 + kc * 8;
            if (ntile == 0) { *(u32x4*)(dst + o0) = o; *(u32x4*)(dst_lo + o0) = o; *(u32x4*)(dst + o1) = l; }
            else *(u32x4*)(dst_lo + o1) = (u32x4){0u, 0u, 0u, 0u};
        }
    }
    asm volatile("s_waitcnt lgkmcnt(0)" ::: "memory");
}

DEVI void wave_transpose_item(const Params& p, char* smem, int mat, int e, int ntile, int ktile, bf16_t* dst, bf16_t* dst_lo, int K,
                                const float* gvec = nullptr, const float* bvec = nullptr, float* U = nullptr, float* C = nullptr) {
    f32x4 v[16];
    if (mat != 9) wt_load(p, mat, e, ntile, ktile, v);
    else {
#pragma unroll
        for (int i = 0; i < 16; ++i) v[i] = (f32x4){0.f, 0.f, 0.f, 0.f}; }
    wave_transpose_body(p, smem, mat, e, ntile, ktile, dst, dst_lo, K, v, gvec, bvec, U, C);
}

DEVI void phase_prep(const Params& p, char* smem) {
    int tid = threadIdx.x; asm volatile("" : "+v"(tid));
    const int lane = tid & 63, w = tid >> 6;
    unsigned char* ws = p.ws;
    constexpr int I_LN = T_, I_MEM = 1024;
    constexpr int I_M0 = 74 * 32, I_M12 = 4 * 32, I_M34 = 2 * 4, I_SQ = 32 * 32, I_KV = 64 * 32, I_R = 2 * 32;
    constexpr int I_CB = 2 * 4 * 8;
    constexpr int TOTAL = I_LN + I_MEM + I_M0 + 2 * I_M12 + 2 * I_M34 + 3 * I_SQ + I_KV + I_R + I_CB;
    const int gw = blockIdx.x * 8 + w, NW = gridDim.x * 8;
    {
        f32x4 Gi[8], Bi[8];
#pragma unroll
        for (int c = 0; c < 8; ++c) { Gi[c] = *(const f32x4*)(p.in[2] + c * 256 + lane * 4); Bi[c] = *(const f32x4*)(p.in[3] + c * 256 + lane * 4); }
        for (int t = gw; t < I_LN; t += NW) {
            f32x4 v[8]; row_load(p.in[0] + (size_t)t * D_, lane, v);
            float mean, rstd; row_stats(v, mean, rstd);
            bf16_t* hb = (bf16_t*)(ws + WS_BUFA) + (size_t)t * D_;
#pragma unroll
            for (int c = 0; c < 8; ++c) {
                const int col = c * 256 + lane * 4;
                const f32x4 y = (v[c] - mean) * rstd * Gi[c] + Bi[c];
                u32x2 o; o.x = cvt_pk_bf16(y.x, y.y); o.y = cvt_pk_bf16(y.z, y.w);
                *(u32x2*)(hb + col) = o;
            }
            if (lane == 0) { float* st = (float*)(ws + WS_STATS); st[t * 2] = mean; st[t * 2 + 1] = rstd; }
        }
    }
    for (int it = I_LN + ((gw + NW - (I_LN % NW)) % NW); it < TOTAL; it += NW) {
        int r = it;
        r -= I_LN;
        if (r < I_MEM) {
            const int t = r;
            f32x4 v[8]; row_load(p.in[1] + (size_t)t * D_, lane, v);
            float mean, rstd; row_stats(v, mean, rstd);
            bf16_t* hb = (bf16_t*)(ws + WS_BUFD) + (size_t)t * D_;
#pragma unroll
            for (int c = 0; c < 8; ++c) {
                const int col = c * 256 + lane * 4;
                const f32x4 g = *(const f32x4*)(p.in[19] + col), b = *(const f32x4*)(p.in[20] + col);
                const f32x4 y = (v[c] - mean) * rstd * g + b;
                u32x2 o; o.x = cvt_pk_bf16(y.x, y.y); o.y = cvt_pk_bf16(y.z, y.w);
                *(u32x2*)(hb + col) = o;
            }
            continue;
        }
        r -= I_MEM;
        if (r < I_M0) { wave_transpose_item(p, smem, 0, 0, r / 32, r % 32, (bf16_t*)(ws + WS_WIN), nullptr, 2048); continue; } r -= I_M0;
        if (r < I_M12) { wave_transpose_item(p, smem, 1, 0, r / 32, r % 32, (bf16_t*)(ws + WS_WC1), nullptr, 2048); continue; } r -= I_M12;
        if (r < I_M12) { wave_transpose_item(p, smem, 2, 0, r / 32, r % 32, (bf16_t*)(ws + WS_WC1) + 256 * 2048, nullptr, 2048); continue; } r -= I_M12;
        if (r < I_M34) { wave_transpose_item(p, smem, 3, 0, r / 4, r % 4, (bf16_t*)(ws + WS_WC2), nullptr, 256); continue; } r -= I_M34;
        if (r < I_M34) { wave_transpose_item(p, smem, 4, 0, r / 4, r % 4, (bf16_t*)(ws + WS_WC2) + 128 * 256, nullptr, 256); continue; } r -= I_M34;
        if (r < I_SQ) { wave_transpose_item(p, smem, 5, 0, r / 32, r % 32, (bf16_t*)(ws + WS_WOUT), nullptr, 2048); continue; } r -= I_SQ;
        if (r < I_SQ) { wave_transpose_item(p, smem, 6, 0, r / 32, r % 32, (bf16_t*)(ws + WS_WQ), nullptr, 2048, p.in[17], p.in[18], (float*)(ws + WS_CTL + CTL_U1), (float*)(ws + WS_CTL + CTL_C1)); continue; } r -= I_SQ;
        if (r < I_KV) { wave_transpose_item(p, smem, 7, 0, r / 32, r % 32, (bf16_t*)(ws + WS_WKV), nullptr, 2048); continue; } r -= I_KV;
        if (r < I_SQ) { wave_transpose_item(p, smem, 8, 0, r / 32, r % 32, (bf16_t*)(ws + WS_WO), nullptr, 2048); continue; } r -= I_SQ;
        if (r < I_R) { wave_transpose_item(p, smem, 9, 0, r / 32, r % 32, (bf16_t*)(ws + WS_WR), (bf16_t*)(ws + WS_WR) + 128 * 2048, 2048, p.in[24], p.in[25], (float*)(ws + WS_UPART2), (float*)(ws + WS_CPART2)); continue; } r -= I_R;
        { const int type = r >> 5, ng = (r >> 3) & 3, kc = r & 7, n = ng * 64 + lane;
          const float* pe = p.in[type ? 8 : 5] + kc * 256; const float* w1 = p.in[type ? 9 : 6] + (size_t)kc * 256 * 256 + n;
          float sacc = 0.f;
          for (int kb = 0; kb < 256; kb += 32) {
#pragma unroll
              for (int k = 0; k < 32; ++k) sacc += pe[kb + k] * w1[(size_t)(kb + k) * 256]; }
          ((float*)(ws + WS_C1BIAS))[(type * 8 + kc) * 256 + n] = sacc; }
    }
    __syncthreads();
}

constexpr int MOE_W_ITEMS = 32 * 16 * 32 + 32 * 32 * 8;
static_assert((32 * 16 * 32 + 32 * 32 * 8) % 3 == 0, "triples");
DEVI void moe_item_load(const Params& p, int r, f32x4 (&v)[16]) {
    if (r < 32 * 16 * 32) { const int e = r / 512, q = r % 512; wt_load(p, 10, e, q / 32, q % 32, v); }
    else { r -= 32 * 16 * 32; const int e = r / 256, q = r % 256; wt_load(p, 11, e, q / 8, q % 8, v); }
}
DEVI void moe_item_process(const Params& p, char* smem, int r, const f32x4 (&v)[16]) {
    unsigned char* ws = p.ws;
    if (r < 32 * 16 * 32) { const int e = r / 512, q = r % 512; wave_transpose_body(p, smem, 10, e, q / 32, q % 32, (bf16_t*)(ws + WS_WGU) + (size_t)e * 1024 * 2048, nullptr, 2048, v, p.in[24], p.in[25], (float*)(ws + WS_CTL + CTL_UE) + e * 1024, (float*)(ws + WS_CTL + CTL_CE) + e * 1024); }
    else { r -= 32 * 16 * 32; const int e = r / 256, q = r % 256; wave_transpose_body(p, smem, 11, e, q / 8, q % 8, (bf16_t*)(ws + WS_WD) + (size_t)e * 2048 * 512, nullptr, 512, v); }
}
DEVI void moe_weight_triple(const Params& p, char* smem, int base) {
    f32x4 va[16], vb[16];
    moe_item_load(p, base, va);
    moe_item_load(p, base + 1, vb);
    moe_item_process(p, smem, base, va);
    moe_item_load(p, base + 2, va);
    moe_item_process(p, smem, base + 1, vb);
    moe_item_process(p, smem, base + 2, va);
}
DEVI void moe_weight_item(const Params& p, char* smem, int r) {
    unsigned char* ws = p.ws;
    if (r < 32 * 16 * 32) { const int e = r / 512, q = r % 512; wave_transpose_item(p, smem, 10, e, q / 32, q % 32, (bf16_t*)(ws + WS_WGU) + (size_t)e * 1024 * 2048, nullptr, 2048, p.in[24], p.in[25], (float*)(ws + WS_CTL + CTL_UE) + e * 1024, (float*)(ws + WS_CTL + CTL_CE) + e * 1024); }
    else { r -= 32 * 16 * 32; const int e = r / 256, q = r % 256; wave_transpose_item(p, smem, 11, e, q / 8, q % 8, (bf16_t*)(ws + WS_WD) + (size_t)e * 2048 * 512, nullptr, 512); }
}

enum { J_PROJ = 0, J_MEMKV, J_CMP1, J_CMP2, J_OUT, J_WQ, J_WO, J_ROUTER, J_MOE1, J_MOE2 };
constexpr int GEMM_STAGE_BYTES = 49152;
constexpr int GEMM_TP = 3 * GEMM_STAGE_BYTES;

template <int job, int VAR = 0>
DEVI void gemm_job(const Params& p, char* smem) {
    unsigned char* ws = p.ws;
    int tid = threadIdx.x; asm volatile("" : "+v"(tid));
    const int lane = tid & 63, w = tid >> 6, wr = w >> 1, wc = w & 1, fr = lane & 15, fq = lane >> 4;
    const int srow = tid >> 3, schunk = (tid & 7) ^ ((tid >> 4) & 7);
    int* tp = (int*)(smem + GEMM_TP);
    int MT = 0, NT = 0, K = 2048, nseg = 1, ntiles = 0, RT = 0;
    switch (job) {
    case J_PROJ: MT = 128; NT = 37; break;
    case J_MEMKV: MT = 4; NT = 32; break;
    case J_CMP1: MT = 64; NT = 2; break;
    case J_CMP2: MT = 64; NT = 1; K = 256; break;
    case J_OUT: case J_WQ: case J_WO: MT = 128; NT = 16; break;
    case J_ROUTER: MT = 256; NT = 1; nseg = 2; break;
    default: break;
    }
    const unsigned* cntw = (const unsigned*)(ws + WS_CTL) + CW_CNT;
    if (job == J_MOE1 || job == J_MOE2) {
        __syncthreads();
        if (tid == 0) { int acc = 0; for (int e = 0; e < 32; ++e) { tp[e] = acc; const int c = (int)__hip_atomic_load(cntw + e, __ATOMIC_RELAXED, __HIP_MEMORY_SCOPE_AGENT); tp[33 + e] = c; acc += (c + 255) >> 8; } tp[32] = acc; }
        __syncthreads();
        RT = tp[32];
        NT = (job == J_MOE1) ? 8 : 16; K = (job == J_MOE1) ? 2048 : 512;
        { int mx = 0;
#pragma unroll
          for (int x = 0; x < 8; ++x) { int t = 0;
#pragma unroll
              for (int k = 0; k < 4; ++k) t += (tp[33 + x + 8 * k] + 255) >> 8;
              mx = t > mx ? t : mx; }
          ntiles = mx * NT * 8; }
    } else {
        const int nsr = (MT + 7) >> 3;
        ntiles = (MT < 64) ? MT * NT : ((nsr + 7) >> 3) * 8 * NT * 8;
    }
    int my_tp = 0, my_cnt = 0;
    if (job == J_MOE1 || job == J_MOE2) { my_tp = tp[lane & 31]; my_cnt = tp[33 + (lane & 31)]; }
    const int nk = K >> 6, ntot = nseg * nk;

    for (int ti = blockIdx.x; ti < ntiles; ti += gridDim.x) {
        int mt, nt, e = 0, rt = 0, ecnt = 0, etp = 0;
        if (job == J_MOE1 || job == J_MOE2) {
            const int x = ti & 7; int jj = ti >> 3; bool found = false; mt = 0; nt = 0;
#pragma unroll
            for (int k = 0; k < 4; ++k) {
                const int ee = x + 8 * k;
                const int c = __shfl(my_cnt, ee), rtc = (c + 255) >> 8, tot = rtc * NT;
                if (!found) { if (jj < tot) { found = true; e = ee; ecnt = c; etp = __shfl(my_tp, ee); const int per = 4 * rtc, ng = jj / per, r2 = jj - ng * per; nt = ng * 4 + r2 / rtc; rt = r2 - (r2 / rtc) * rtc; } else jj -= tot; }
            }
            if (!found) continue;
        } else {
            if (MT < 64) { nt = ti / MT; mt = ti - nt * MT; }
            else {
                const int x = ti & 7, jj = ti >> 3, per = 8 * NT, srl = jj / per, idx = jj - srl * per;
                mt = (srl * 8 + x) * 8 + (idx & 7); nt = idx >> 3;
                if (mt >= MT) continue;
            }
        }
        const bf16_t* ap[4]; const bf16_t* bp[2];
#pragma unroll
        for (int r = 0; r < 4; ++r) {
            const int row = r * 64 + srow;
            const bf16_t* a;
            switch (job) {
            case J_PROJ: a = (const bf16_t*)(ws + WS_BUFA) + (size_t)(mt * 256 + row) * 2048; break;
            case J_MEMKV: a = (const bf16_t*)(ws + WS_BUFD) + (size_t)(mt * 256 + row) * 2048; break;
            case J_CMP1: { const int gi = mt >> 1, i = (mt & 1) * 256 + row, ic = i < 510 ? i : 510; const int type = gi >> 4, bh = gi & 15;
                a = (const bf16_t*)(ws + WS_BUFC + (type ? C_VCMP : C_KCMP)) + ((size_t)bh * 8192 + 16 * ic) * 64; break; }
            case J_CMP2: a = (const bf16_t*)(ws + WS_BUFC + C_HID) + (size_t)(mt * 256 + row) * 256; break;
            case J_OUT: a = (const bf16_t*)(ws + WS_BUFE) + (size_t)(mt * 256 + row) * 2048; break;
            case J_WQ: a = (const bf16_t*)(ws + WS_BUFB) + (size_t)(mt * 256 + row) * 2048; break;
            case J_WO: a = (const bf16_t*)(ws + WS_BUFA) + (size_t)(mt * 256 + row) * 2048; break;
            case J_ROUTER: a = (const bf16_t*)(ws + WS_BUFE) + (size_t)(mt * 128 + (row & 127)) * 2048; break;
            case J_MOE1: { int pos = rt * 256 + row; if (pos >= ecnt) pos = 0; const int aid = ((const int*)(ws + WS_LIST))[(size_t)e * T_ + pos];
                a = (const bf16_t*)(ws + WS_BUFE) + (size_t)(aid >> 1) * 2048; break; }
            default: a = (const bf16_t*)(ws + WS_BUFB) + (size_t)((etp + rt) * 256 + row) * 512; break;
            }
            ap[r] = a + schunk * 8;
        }
#pragma unroll
        for (int r = 0; r < 2; ++r) {
            const int row = r * 64 + srow;
            const bf16_t* b;
            switch (job) {
            case J_PROJ: b = (const bf16_t*)(ws + WS_WIN) + (size_t)(nt * 128 + row) * 2048; break;
            case J_MEMKV: b = (const bf16_t*)(ws + WS_WKV) + (size_t)(nt * 128 + row) * 2048; break;
            case J_CMP1: b = (const bf16_t*)(ws + WS_WC1) + (size_t)(mt >> 5) * 256 * 2048 + (size_t)(nt * 128 + row) * 2048; break;
            case J_CMP2: b = (const bf16_t*)(ws + WS_WC2) + (size_t)(mt >> 5) * 128 * 256 + (size_t)row * 256; break;
            case J_OUT: b = (const bf16_t*)(ws + WS_WOUT) + (size_t)(nt * 128 + row) * 2048; break;
            case J_WQ: b = (const bf16_t*)(ws + WS_WQ) + (size_t)(nt * 128 + row) * 2048; break;
            case J_WO: b = (const bf16_t*)(ws + WS_WO) + (size_t)(nt * 128 + row) * 2048; break;
            case J_ROUTER: b = (const bf16_t*)(ws + WS_WR) + (size_t)row * 2048; break;
            case J_MOE1: b = (const bf16_t*)(ws + WS_WGU) + (size_t)e * 1024 * 2048 + (size_t)(nt * 128 + row) * 2048; break;
            default: b = (const bf16_t*)(ws + WS_WD) + (size_t)e * 2048 * 512 + (size_t)(nt * 128 + row) * 512; break;
            }
            bp[r] = b + schunk * 8;
        }
        const long a_seg1 = ((long)WS_BUFC - (long)WS_BUFE) / 2;
        const long b_seg2 = 128 * 2048;

        f32x4 acc[4][4];
#pragma unroll
        for (int i = 0; i < 4; ++i)
#pragma unroll
            for (int j = 0; j < 4; ++j) acc[i][j] = (f32x4){0.f, 0.f, 0.f, 0.f};

#define GEMM_STAGE(kt_) do { const int _kt = (kt_); int _seg = 0, _k0 = _kt << 6; if (nseg > 1) { _seg = _kt / nk; _k0 = (_kt - _seg * nk) << 6; } \
            const long _ao = (_seg == 1) ? a_seg1 : 0, _bo = (_seg == 1) ? b_seg2 : 0; \
            char* _A = smem + (_kt % 3) * GEMM_STAGE_BYTES; char* _B = _A + 32768; \
            _Pragma("unroll") for (int r = 0; r < 4; ++r) glds16(ap[r] + _ao + _k0, _A + (r * 512 + tid) * 16); \
            _Pragma("unroll") for (int r = 0; r < 2; ++r) glds16(bp[r] + _bo + _k0, _B + (r * 512 + tid) * 16); } while (0)

        u32x2 preb[16];
        if (job == J_OUT || job == J_WO) {
            const bf16_t* src = (const bf16_t*)(ws + (job == J_OUT ? WS_BUFA : WS_BUFB));
#pragma unroll
            for (int i = 0; i < 16; ++i) preb[i] = *(const u32x2*)(src + (size_t)(mt * 256 + (tid >> 5) + 16 * i) * D_ + nt * 128 + (tid & 31) * 4);
        }
        GEMM_STAGE(0);
        if (ntot > 1) GEMM_STAGE(1);
        for (int kt = 0; kt < ntot; ++kt) {
            if (kt + 1 < ntot) asm volatile("s_waitcnt vmcnt(6)" ::: "memory"); else asm volatile("s_waitcnt vmcnt(0)" ::: "memory");
            __builtin_amdgcn_s_barrier();
            asm volatile("" ::: "memory");
            if (kt + 2 < ntot && VAR != 1) GEMM_STAGE(kt + 2);
            if (VAR == 2 || (job == J_ROUTER && wr >= 2)) continue;
            const char* A = smem + (kt % 3) * GEMM_STAGE_BYTES; const char* B = A + 32768;
#pragma unroll
            for (int ks = 0; ks < 2; ++ks) {
                bf16x8 af[4], bfr[4];
                const int coff = ((4 * ks + fq) ^ (fr >> 1)) * 16;
#pragma unroll
                for (int i = 0; i < 4; ++i) {
                    af[i] = *(const bf16x8*)(A + (wr * 64 + i * 16 + fr) * 128 + coff);
                    bfr[i] = *(const bf16x8*)(B + (wc * 64 + i * 16 + fr) * 128 + coff);
                }
                __builtin_amdgcn_s_setprio(1);
#pragma unroll
                for (int i = 0; i < 4; ++i)
#pragma unroll
                    for (int j = 0; j < 4; ++j) acc[i][j] = mfma16(bfr[j], af[i], acc[i][j]);
                __builtin_amdgcn_s_setprio(0);
            }
        }
#undef GEMM_STAGE
        if (VAR != 0 && VAR != 4) { if (acc[0][0].x == 123.456f) p.out[0] = acc[1][1].y + acc[2][2].z + acc[3][3].w; __syncthreads(); continue; }
        asm volatile("s_waitcnt lgkmcnt(0)" ::: "memory"); __builtin_amdgcn_s_barrier(); asm volatile("" ::: "memory");
        float* ep = (float*)smem;
#pragma unroll
        for (int mi = 0; mi < 4; ++mi)
#pragma unroll
            for (int ni = 0; ni < 4; ++ni) *(f32x4*)(ep + (wr * 64 + mi * 16 + fr) * 132 + wc * 64 + ni * 16 + fq * 4) = acc[mi][ni];
        asm volatile("s_waitcnt lgkmcnt(0)" ::: "memory"); __builtin_amdgcn_s_barrier(); asm volatile("" ::: "memory");
        const int row0 = mt * 256, col0 = nt * 128;
#define EP8(row_, c8_, v0_, v1_) const f32x4 v0_ = *(const f32x4*)(ep + (row_) * 132 + (c8_) * 8), v1_ = *(const f32x4*)(ep + (row_) * 132 + (c8_) * 8 + 4)
#define PK8(o_, v0_, v1_) u32x4 o_; o_.x = cvt_pk_bf16(v0_.x, v0_.y); o_.y = cvt_pk_bf16(v0_.z, v0_.w); o_.z = cvt_pk_bf16(v1_.x, v1_.y); o_.w = cvt_pk_bf16(v1_.z, v1_.w)
        switch (job) {
        case J_PROJ: {
            if (nt < 8) {
                bf16_t* Q = (bf16_t*)(ws + WS_BUFB);
#pragma unroll
                for (int i = 0; i < 8; ++i) { const int c = tid + 512 * i, row = c >> 4, c8 = c & 15; EP8(row, c8, a0, a1);
                    const f32x4 b0 = a0 * (0.125f * LOG2E), b1 = a1 * (0.125f * LOG2E); PK8(o, b0, b1);
                    *(u32x4*)(Q + (size_t)(row0 + row) * 1024 + col0 + c8 * 8) = o; }
            } else if (nt < 20) {
                const int reg = (nt - 8) >> 1;
                bf16_t* dst = (bf16_t*)(ws + WS_BUFC + (reg == 0 ? C_KCMP : reg == 1 ? C_VCMP : reg == 2 ? C_KS : reg == 3 ? C_VST : reg == 4 ? C_KW : C_VWT));
                const int b = row0 >> 13, s0 = row0 & 8191;
                if (reg != 3 && reg != 5) {
#pragma unroll
                    for (int i = 0; i < 8; ++i) { const int c = tid + 512 * i, row = c >> 4, c8 = c & 15; EP8(row, c8, a0, a1); PK8(o, a0, a1);
                        const int bh = b * 4 + ((nt - 8) & 1) * 2 + (c8 >> 3);
                        *(u32x4*)(dst + ((size_t)bh * 8192 + s0 + row) * 64 + (c8 & 7) * 8) = o; }
                } else {
#pragma unroll
                    for (int i = 0; i < 8; ++i) { const int c = tid + 512 * i, tg = c & 31, dcol = c >> 5;
                        const int rb = (tg >> 1) * 16 + (tg & 1) * 4;
                        float v[8];
#pragma unroll
                        for (int j = 0; j < 8; ++j) v[j] = ep[(rb + (j & 3) + (j >> 2) * 8) * 132 + dcol];
                        u32x4 o; o.x = cvt_pk_bf16(v[0], v[1]); o.y = cvt_pk_bf16(v[2], v[3]); o.z = cvt_pk_bf16(v[4], v[5]); o.w = cvt_pk_bf16(v[6], v[7]);
                        const int bh = b * 4 + ((nt - 8) & 1) * 2 + (dcol >> 6);
                        *(u32x4*)(dst + ((size_t)bh * 64 + (dcol & 63)) * 8192 + s0 + tg * 8) = o; }
                }
            } else if (nt == 20) {
                float* G = (float*)(ws + WS_BUFC + C_GATES);
#pragma unroll
                for (int i = 0; i < 6; ++i) { const int c = tid + 512 * i, row = c / 12, c4 = c - row * 12;
                    const f32x4 v = *(const f32x4*)(ep + row * 132 + c4 * 4); f32x4 o; o.x = sigmoidf_(v.x); o.y = sigmoidf_(v.y); o.z = sigmoidf_(v.z); o.w = sigmoidf_(v.w);
                    *(f32x4*)(G + (size_t)(row0 + row) * 48 + c4 * 4) = o; }
            } else {
                bf16_t* Hg = (bf16_t*)(ws + WS_BUFB + 64 * MiB);
#pragma unroll
                for (int i = 0; i < 4; ++i) { const int c = tid + 512 * i, row = c >> 3, c8 = c & 7, hh = c8 >> 2, cc = (c8 & 3) * 8;
                    const f32x4 a0 = *(const f32x4*)(ep + row * 132 + hh * 64 + cc), a1 = *(const f32x4*)(ep + row * 132 + hh * 64 + cc + 4);
                    const f32x4 g0 = *(const f32x4*)(ep + row * 132 + hh * 64 + 32 + cc), g1 = *(const f32x4*)(ep + row * 132 + hh * 64 + 32 + cc + 4);
                    u32x4 o; o.x = cvt_pk_bf16(a0.x * sigmoidf_(g0.x), a0.y * sigmoidf_(g0.y)); o.y = cvt_pk_bf16(a0.z * sigmoidf_(g0.z), a0.w * sigmoidf_(g0.w));
                    o.z = cvt_pk_bf16(a1.x * sigmoidf_(g1.x), a1.y * sigmoidf_(g1.y)); o.w = cvt_pk_bf16(a1.z * sigmoidf_(g1.z), a1.w * sigmoidf_(g1.w));
                    *(u32x4*)(Hg + (size_t)(row0 + row) * 1024 + ((nt - 21) * 2 + hh) * 32 + cc) = o; }
            }
        } break;
        case J_MEMKV: {
            const int b = mt;
            if (nt < 16) {
                bf16_t* Kx = (bf16_t*)(ws + WS_BUFD + 4 * MiB);
                const int head = col0 >> 9, d0 = col0 & 511;
#pragma unroll
                for (int i = 0; i < 8; ++i) { const int c = tid + 512 * i, row = c >> 4, c8 = c & 15; EP8(row, c8, a0, a1); PK8(o, a0, a1);
                    *(u32x4*)(Kx + ((size_t)(b * 4 + head) * 256 + row) * 512 + d0 + c8 * 8) = o; }
            } else {
                bf16_t* Vt = (bf16_t*)(ws + WS_BUFD + 8 * MiB);
                const int n2 = col0 - 2048, head = n2 >> 9, d0 = n2 & 511;
#pragma unroll
                for (int i = 0; i < 8; ++i) { const int c = tid + 512 * i, tg = c & 31, dcol = c >> 5;
                    float v[8];
#pragma unroll
                    for (int j = 0; j < 8; ++j) v[j] = ep[(tg * 8 + j) * 132 + dcol];
                    u32x4 o; o.x = cvt_pk_bf16(v[0], v[1]); o.y = cvt_pk_bf16(v[2], v[3]); o.z = cvt_pk_bf16(v[4], v[5]); o.w = cvt_pk_bf16(v[6], v[7]);
                    *(u32x4*)(Vt + ((size_t)(b * 4 + head) * 512 + d0 + dcol) * 256 + tg * 8) = o; }
            }
        } break;
        case J_CMP1: {
            const int type = mt >> 5;
            const float* bias = (const float*)(ws + WS_C1BIAS) + type * 8 * 256;
            bf16_t* Hd = (bf16_t*)(ws + WS_BUFC + C_HID);
            f32x4 b0 = (f32x4){0.f, 0.f, 0.f, 0.f}, b1 = (f32x4){0.f, 0.f, 0.f, 0.f};
#pragma unroll
            for (int kc = 0; kc < 8; ++kc) { b0 += *(const f32x4*)(bias + kc * 256 + col0 + (tid & 15) * 8); b1 += *(const f32x4*)(bias + kc * 256 + col0 + (tid & 15) * 8 + 4); }
#pragma unroll
            for (int i = 0; i < 8; ++i) { const int c = tid + 512 * i, row = c >> 4, c8 = c & 15; EP8(row, c8, a0, a1);
                u32x4 o; o.x = cvt_pk_bf16(gelu_tanh(a0.x + b0.x), gelu_tanh(a0.y + b0.y)); o.y = cvt_pk_bf16(gelu_tanh(a0.z + b0.z), gelu_tanh(a0.w + b0.w));
                o.z = cvt_pk_bf16(gelu_tanh(a1.x + b1.x), gelu_tanh(a1.y + b1.y)); o.w = cvt_pk_bf16(gelu_tanh(a1.z + b1.z), gelu_tanh(a1.w + b1.w));
                *(u32x4*)(Hd + (size_t)(row0 + row) * 256 + col0 + c8 * 8) = o; }
        } break;
        case J_CMP2: {
            const int gi = mt >> 1, type = gi >> 4, bh = gi & 15, i0 = (mt & 1) * 256;
            if (type == 0) {
                bf16_t* Kc = (bf16_t*)(ws + WS_BUFC + C_KC);
#pragma unroll
                for (int i = 0; i < 4; ++i) { const int c = tid + 512 * i, row = c >> 3, c8 = c & 7; EP8(row, c8, a0, a1); PK8(o, a0, a1);
                    if (i0 + row >= 511) o = (u32x4){0u, 0u, 0u, 0u};
                    *(u32x4*)(Kc + ((size_t)bh * 512 + i0 + row) * 64 + c8 * 8) = o; }
            } else {
                bf16_t* Vc = (bf16_t*)(ws + WS_BUFC + C_VCT);
#pragma unroll
                for (int i = 0; i < 4; ++i) { const int c = tid + 512 * i, tg = c & 31, d = c >> 5;
                    const int rb = (tg >> 1) * 16 + (tg & 1) * 4;
                    float v[8];
#pragma unroll
                    for (int j = 0; j < 8; ++j) { const int r = rb + (j & 3) + (j >> 2) * 8; v[j] = (i0 + r >= 511) ? 0.f : ep[r * 132 + d]; }
                    u32x4 o; o.x = cvt_pk_bf16(v[0], v[1]); o.y = cvt_pk_bf16(v[2], v[3]); o.z = cvt_pk_bf16(v[4], v[5]); o.w = cvt_pk_bf16(v[6], v[7]);
                    *(u32x4*)(Vc + ((size_t)bh * 64 + d) * 512 + i0 + tg * 8) = o; }
            }
        } break;
        case J_OUT: {
            const int c4 = tid & 31, n = col0 + c4 * 4;
#pragma unroll
            for (int i = 0; i < 16; ++i) { const int row = (tid >> 5) + 16 * i, t = row0 + row;
                const f32x4 v = *(const f32x4*)(ep + row * 132 + c4 * 4);
                f32x4 y; y.x = bf2f(preb[i].x & 0xffffu) * ALPHA + v.x; y.y = bf2f(preb[i].x >> 16) * ALPHA + v.y;
                y.z = bf2f(preb[i].y & 0xffffu) * ALPHA + v.z; y.w = bf2f(preb[i].y >> 16) * ALPHA + v.w;
                u32x2 yb; yb.x = cvt_pk_bf16(y.x, y.y); yb.y = cvt_pk_bf16(y.z, y.w);
                *(u32x2*)((bf16_t*)(ws + WS_BUFB) + (size_t)t * D_ + n) = yb;
                float rs = (y.x + y.y) + (y.z + y.w), rq = (y.x * y.x + y.y * y.y) + (y.z * y.z + y.w * y.w);
#pragma unroll
                for (int o = 1; o < 32; o <<= 1) { rs += __shfl_xor(rs, o); rq += __shfl_xor(rq, o); }
                if ((tid & 31) == 0) { float* rsum = (float*)(ws + WS_RSUM1) + (size_t)t * 2; atomicAdd(rsum, rs); atomicAdd(rsum + 1, rq); } }
        } break;
        case J_WQ: {
            bf16_t* Qx = (bf16_t*)(ws + WS_BUFC);
            const float sc = 0.04419417382415922f * LOG2E;
            const float* U = (const float*)(ws + WS_CTL + CTL_U1); const float* Cv = (const float*)(ws + WS_CTL + CTL_C1);
            const float* rsum = (const float*)(ws + WS_RSUM1);
            const int c8 = tid & 15, n = col0 + c8 * 8;
            const f32x4 u0 = *(const f32x4*)(U + n), u1 = *(const f32x4*)(U + n + 4), c0 = *(const f32x4*)(Cv + n), c1 = *(const f32x4*)(Cv + n + 4);
            float2 rsq[8];
#pragma unroll
            for (int i = 0; i < 8; ++i) rsq[i] = *(const float2*)(rsum + (size_t)(row0 + (tid >> 4) + 32 * i) * 2);
#pragma unroll
            for (int i = 0; i < 8; ++i) { const int row = (tid >> 4) + 32 * i; EP8(row, c8, a0, a1);
                const int t = row0 + row;
                const float mean = rsq[i].x * (1.f / D_); float var = rsq[i].y * (1.f / D_) - mean * mean; var = var > 0.f ? var : 0.f;
                const float rstd = __builtin_amdgcn_rsqf(var + LN_EPS), mr = mean * rstd;
                const f32x4 b0 = (a0 * rstd - u0 * mr + c0) * sc, b1 = (a1 * rstd - u1 * mr + c1) * sc; PK8(o, b0, b1);
                *(u32x4*)(Qx + (size_t)t * 2048 + n) = o; }
        } break;
        case J_WO: {
            const int c4 = tid & 31, n = col0 + c4 * 4;
            const f32x4 g = *(const f32x4*)(p.in[17] + n), bb = *(const f32x4*)(p.in[18] + n);
#pragma unroll
            for (int hlf = 0; hlf < 2; ++hlf) {
                float2 sm[8];
#pragma unroll
                for (int i = 0; i < 8; ++i) { const int row = (tid >> 5) + 16 * (hlf * 8 + i), t = row0 + row;
                    const float2 rsq = *(const float2*)((const float*)(ws + WS_RSUM1) + (size_t)t * 2);
                    const float mean = rsq.x * (1.f / D_); float var = rsq.y * (1.f / D_) - mean * mean; var = var > 0.f ? var : 0.f;
                    sm[i] = make_float2(mean, 1.f / sqrtf(var + LN_EPS)); }
#pragma unroll
                for (int i = 0; i < 8; ++i) { const int row = (tid >> 5) + 16 * (hlf * 8 + i), t = row0 + row;
                    const f32x4 v = *(const f32x4*)(ep + row * 132 + c4 * 4);
                    const u32x2 pb = preb[hlf * 8 + i];
                    f32x4 rv; rv.x = bf2f(pb.x & 0xffffu); rv.y = bf2f(pb.x >> 16); rv.z = bf2f(pb.y & 0xffffu); rv.w = bf2f(pb.y >> 16);
                    *(f32x4*)(p.out + (size_t)t * D_ + n) = ((rv - sm[i].x) * sm[i].y * g + bb) * ALPHA + v; }
            }
        } break;
        case J_ROUTER: {
            unsigned* hist = (unsigned*)(smem + 256 * 132 * 4);
            if (tid < 32) hist[tid] = 0u;
            float* lu = (float*)(hist + 64); float* lc = lu + 128;
            if (tid < 128) { float u = 0.f, c = 0.f;
#pragma unroll 8
                for (int kt = 0; kt < 32; ++kt) { u += ((const float*)(ws + WS_UPART2))[kt * 128 + tid]; c += ((const float*)(ws + WS_CPART2))[kt * 128 + tid]; }
                lu[tid] = u; lc[tid] = c; }
            __syncthreads();
            int ea = 0, eb = 0, t = 0; unsigned ra = 0, rb = 0; float w0s = 0.f, w1s = 0.f, mrs = 0.f, rstds = 0.f;
            unsigned* cnt = (unsigned*)(ws + WS_CTL) + CW_CNT;
            if (tid < 128) {
                const int row = tid; t = mt * 128 + row;
                const float* er = ep + row * 132;
                float* wt = (float*)(ws + WS_WTOK);
                const float* U2 = lu; const float* C2 = lc;
                float sx = 0.f, sy = 0.f;
                { const f32x4* rp = (const f32x4*)((const float2*)(ws + WS_RP2) + (size_t)t * 32);
#pragma unroll
                  for (int i = 0; i < 16; ++i) { const f32x4 v = rp[i]; sx += v.x; sy += v.y; sx += v.z; sy += v.w; } }
                const float mean = sx * (1.f / D_); float var = sy * (1.f / D_) - mean * mean; var = var > 0.f ? var : 0.f;
                const float rstd = 1.f / sqrtf(var + LN_EPS), mr = mean * rstd;
                float lg[4];
#pragma unroll
                for (int i = 0; i < 4; ++i) lg[i] = (er[i] + er[64 + i]) * rstd - mr * U2[i] + C2[i] + p.in[27][i];
                int grp = 0; float best = lg[0];
#pragma unroll
                for (int i = 1; i < 4; ++i) if (lg[i] > best) { best = lg[i]; grp = i; }
                float se = 0.f;
#pragma unroll
                for (int i = 0; i < 4; ++i) se += expf(lg[i] - best);
                const float wgrp = 1.f / se;
                float le[8];
#pragma unroll
                for (int i = 0; i < 8; ++i) le[i] = (er[4 + grp * 8 + i] + er[68 + grp * 8 + i]) * rstd - mr * U2[4 + grp * 8 + i] + C2[4 + grp * 8 + i] + p.in[29][grp * 8 + i];
                int i0 = 0; float v0 = le[0];
#pragma unroll
                for (int i = 1; i < 8; ++i) if (le[i] > v0) { v0 = le[i]; i0 = i; }
                int i1 = -1; float v1 = -INFINITY;
#pragma unroll
                for (int i = 0; i < 8; ++i) if (i != i0 && le[i] > v1) { v1 = le[i]; i1 = i; }
                const float ex = expf(v1 - v0);
                const float w0 = wgrp / (1.f + ex), w1 = wgrp * ex / (1.f + ex);
                ea = grp * 8 + i0; eb = grp * 8 + i1;
                ra = atomicAdd(hist + ea, 1u); rb = atomicAdd(hist + eb, 1u);
                wt[t * 2] = w0; wt[t * 2 + 1] = w1; w0s = w0; w1s = w1; mrs = mr; rstds = rstd;
            }
            __syncthreads();
            if (tid < 32) { const unsigned c = hist[tid]; hist[32 + tid] = c ? atomicAdd(cnt + tid, c) : 0u; }
            __syncthreads();
            if (tid < 128) { int* list = (int*)(ws + WS_LIST); float* wl = (float*)(ws + WS_WLIST); float2* sl = (float2*)(ws + WS_SLIST);
                const size_t sa = (size_t)ea * T_ + hist[32 + ea] + ra, sb = (size_t)eb * T_ + hist[32 + eb] + rb;
                list[sa] = t * 2; list[sb] = t * 2 + 1; wl[sa] = w0s; wl[sb] = w1s; sl[sa] = make_float2(mrs, rstds); sl[sb] = make_float2(mrs, rstds); }
        } break;
        case J_MOE1: {
            bf16_t* H = (bf16_t*)(ws + WS_BUFB);
            const float* UE = (const float*)(ws + WS_CTL + CTL_UE) + e * 1024 + nt * 128; const float* CE = (const float*)(ws + WS_CTL + CTL_CE) + e * 1024 + nt * 128;
            const int hh = (tid & 7) >> 2, cc = (tid & 3) * 8;
            const f32x4 ug0 = *(const f32x4*)(UE + hh * 64 + cc), ug1 = *(const f32x4*)(UE + hh * 64 + cc + 4), uu0 = *(const f32x4*)(UE + hh * 64 + 32 + cc), uu1 = *(const f32x4*)(UE + hh * 64 + 32 + cc + 4);
            const f32x4 cg0 = *(const f32x4*)(CE + hh * 64 + cc), cg1 = *(const f32x4*)(CE + hh * 64 + cc + 4), cu0 = *(const f32x4*)(CE + hh * 64 + 32 + cc), cu1 = *(const f32x4*)(CE + hh * 64 + 32 + cc + 4);
            float2 rsq[4];
#pragma unroll
            for (int i = 0; i < 4; ++i) { int pos = rt * 256 + ((tid + 512 * i) >> 3); if (pos >= ecnt) pos = 0; const int aid = ((const int*)(ws + WS_LIST))[(size_t)e * T_ + pos];
                rsq[i] = *(const float2*)((const float*)(ws + WS_RSUM2) + (size_t)(aid >> 1) * 2); }
#pragma unroll
            for (int i = 0; i < 4; ++i) { const int c = tid + 512 * i, row = c >> 3;
                const float mean = rsq[i].x * (1.f / D_); float var = rsq[i].y * (1.f / D_) - mean * mean; var = var > 0.f ? var : 0.f;
                const float rstd = 1.f / sqrtf(var + LN_EPS), mr = mean * rstd;
                const f32x4 g0 = *(const f32x4*)(ep + row * 132 + hh * 64 + cc) * rstd - ug0 * mr + cg0, g1 = *(const f32x4*)(ep + row * 132 + hh * 64 + cc + 4) * rstd - ug1 * mr + cg1;
                const f32x4 u0 = *(const f32x4*)(ep + row * 132 + hh * 64 + 32 + cc) * rstd - uu0 * mr + cu0, u1 = *(const f32x4*)(ep + row * 132 + hh * 64 + 32 + cc + 4) * rstd - uu1 * mr + cu1;
                u32x4 o; o.x = cvt_pk_bf16(g0.x * sigmoidf_(g0.x) * u0.x, g0.y * sigmoidf_(g0.y) * u0.y); o.y = cvt_pk_bf16(g0.z * sigmoidf_(g0.z) * u0.z, g0.w * sigmoidf_(g0.w) * u0.w);
                o.z = cvt_pk_bf16(g1.x * sigmoidf_(g1.x) * u1.x, g1.y * sigmoidf_(g1.y) * u1.y); o.w = cvt_pk_bf16(g1.z * sigmoidf_(g1.z) * u1.z, g1.w * sigmoidf_(g1.w) * u1.w);
                *(u32x4*)(H + ((size_t)(etp + rt) * 256 + row) * 512 + (nt * 2 + hh) * 32 + cc) = o; }
        } break;
        default: {
            bf16_t* Y = (bf16_t*)(ws + WS_BUFC);
            const float* wt = (const float*)(ws + WS_WTOK);
            const int c8 = tid & 15;
            int aid[8]; float wv[8];
#pragma unroll
            for (int i = 0; i < 8; ++i) { const int pos = rt * 256 + (tid >> 4) + 32 * i; aid[i] = (pos < ecnt) ? ((const int*)(ws + WS_LIST))[(size_t)e * T_ + pos] : -1; }
#pragma unroll
            for (int i = 0; i < 8; ++i) wv[i] = (aid[i] >= 0) ? wt[aid[i]] : 0.f;
#pragma unroll
            for (int i = 0; i < 8; ++i) { const int row = (tid >> 4) + 32 * i;
                if (aid[i] >= 0) { EP8(row, c8, a0, a1); const f32x4 b0 = a0 * wv[i], b1 = a1 * wv[i]; PK8(o, b0, b1);
                    *(u32x4*)(Y + (size_t)aid[i] * 2048 + col0 + c8 * 8) = o; } }
        } break;
        }
#undef EP8
#undef PK8
        asm volatile("s_waitcnt lgkmcnt(0)" ::: "memory"); __builtin_amdgcn_s_barrier(); asm volatile("" ::: "memory");
    }
}

template <int job>
DEVI void gemm_direct(const Params& p, char* smem) {
    unsigned char* ws = p.ws;
    int tid = threadIdx.x; asm volatile("" : "+v"(tid));
    const int lane = tid & 63, w = tid >> 6, wr = w >> 1, wc = w & 1, fr = lane & 15, fq = lane >> 4;
    const int srow = tid >> 3, schunk = (tid & 7) ^ ((tid >> 4) & 7);
    constexpr int NTILES = 2048;
    const bf16_t* Abase = (const bf16_t*)(ws + (job == J_OUT ? WS_BUFE : job == J_WQ ? WS_BUFB : WS_BUFA)) + (size_t)srow * 2048 + schunk * 8;
    const bf16_t* Bbase = (const bf16_t*)(ws + (job == J_OUT ? WS_WOUT : job == J_WQ ? WS_WQ : WS_WO)) + (size_t)srow * 2048 + schunk * 8;
    const bf16_t* Rsrc = (const bf16_t*)(ws + (job == J_OUT ? WS_BUFA : WS_BUFB));
    int ti = blockIdx.x;
    if (ti >= NTILES) return;
#define GD_MAP(ti_, mt_, nt_) do { const int _x = (ti_) & 7, _jj = (ti_) >> 3, _srl = _jj >> 7, _idx = _jj & 127; mt_ = (_srl * 8 + _x) * 8 + (_idx & 7); nt_ = _idx >> 3; } while (0)
#define GD_PTRS(mt_, nt_, ap_, bp_) do { _Pragma("unroll") for (int r = 0; r < 4; ++r) ap_[r] = Abase + (size_t)((mt_) * 256 + r * 64) * 2048; \
        _Pragma("unroll") for (int r = 0; r < 2; ++r) bp_[r] = Bbase + (size_t)((nt_) * 128 + r * 64) * 2048; } while (0)
#define GD_STAGE(ap_, bp_, kt_, slot_) do { char* _A = smem + (slot_) * GEMM_STAGE_BYTES; char* _B = _A + 32768; const int _k0 = (kt_) << 6; \
        _Pragma("unroll") for (int r = 0; r < 4; ++r) glds16(ap_[r] + _k0, _A + (r * 512 + tid) * 16); \
        _Pragma("unroll") for (int r = 0; r < 2; ++r) glds16(bp_[r] + _k0, _B + (r * 512 + tid) * 16); } while (0)
    int mt, nt; GD_MAP(ti, mt, nt);
    const bf16_t* ap[4]; const bf16_t* bp[2]; GD_PTRS(mt, nt, ap, bp);
    GD_STAGE(ap, bp, 0, 0);
    GD_STAGE(ap, bp, 1, 1);
    int cur = 0;
    bool landed = false;
    constexpr int NPRE = (job == J_OUT) ? 16 : (job == J_WQ) ? 12 : 28;
    for (;;) {
        const int tn = ti + gridDim.x; const bool has_next = tn < NTILES;
        int mtn = 0, ntn = 0; if (has_next) GD_MAP(tn, mtn, ntn);
        const bf16_t* nap[4]; const bf16_t* nbp[2]; GD_PTRS(mtn, ntn, nap, nbp);
        const int row0 = mt * 256 + wr * 64 + fr, col0 = nt * 128 + wc * 64 + fq * 4;
        u32x2 preb[16]; f32x4 va[4], vb[4]; f32x4 rsq01, rsq23;
        if (job != J_WQ) {
#pragma unroll
            for (int i = 0; i < 4; ++i)
#pragma unroll
                for (int j = 0; j < 4; ++j) preb[i * 4 + j] = gload8_asm(Rsrc + (size_t)(row0 + i * 16) * D_ + col0 + j * 16);
        }
        if (job != J_OUT) {
            const float* Va = (job == J_WQ) ? (const float*)(ws + WS_CTL + CTL_U1) : p.in[17];
            const float* Vb = (job == J_WQ) ? (const float*)(ws + WS_CTL + CTL_C1) : p.in[18];
#pragma unroll
            for (int j = 0; j < 4; ++j) { va[j] = gload16_asm(Va + col0 + j * 16); vb[j] = gload16_asm(Vb + col0 + j * 16); }
            const float* rsum = (const float*)(ws + WS_RSUM1);
            u32x2 r0 = gload8_asm(rsum + (size_t)(row0) * 2), r1 = gload8_asm(rsum + (size_t)(row0 + 16) * 2), r2 = gload8_asm(rsum + (size_t)(row0 + 32) * 2), r3 = gload8_asm(rsum + (size_t)(row0 + 48) * 2);
            rsq01.x = __uint_as_float(r0.x); rsq01.y = __uint_as_float(r0.y); rsq01.z = __uint_as_float(r1.x); rsq01.w = __uint_as_float(r1.y);
            rsq23.x = __uint_as_float(r2.x); rsq23.y = __uint_as_float(r2.y); rsq23.z = __uint_as_float(r3.x); rsq23.w = __uint_as_float(r3.y);
        }
        f32x4 acc[4][4];
#pragma unroll
        for (int i = 0; i < 4; ++i)
#pragma unroll
            for (int j = 0; j < 4; ++j) acc[i][j] = (f32x4){0.f, 0.f, 0.f, 0.f};
        for (int kt = 0; kt < 32; ++kt) {
            if (kt == 0 && landed) { }
            else if (kt < 2) asm volatile("s_waitcnt vmcnt(%0)" :: "n"(6 + NPRE) : "memory");
            else if (kt == 31 && !has_next) asm volatile("s_waitcnt vmcnt(0)" ::: "memory");
            else asm volatile("s_waitcnt vmcnt(6)" ::: "memory");
            __builtin_amdgcn_s_barrier();
            asm volatile("" ::: "memory");
            { const int s2 = cur == 0 ? 2 : cur - 1;
              if (kt < 30) GD_STAGE(ap, bp, kt + 2, s2); else if (has_next) GD_STAGE(nap, nbp, kt - 30, s2); }
            const char* A = smem + cur * GEMM_STAGE_BYTES; const char* B = A + 32768;
#pragma unroll
            for (int ks = 0; ks < 2; ++ks) {
                bf16x8 af[4], bfr[4];
                const int coff = ((4 * ks + fq) ^ (fr >> 1)) * 16;
#pragma unroll
                for (int i = 0; i < 4; ++i) {
                    af[i] = *(const bf16x8*)(A + (wr * 64 + i * 16 + fr) * 128 + coff);
                    bfr[i] = *(const bf16x8*)(B + (wc * 64 + i * 16 + fr) * 128 + coff);
                }
                __builtin_amdgcn_s_setprio(1);
#pragma unroll
                for (int i = 0; i < 4; ++i)
#pragma unroll
                    for (int j = 0; j < 4; ++j) acc[i][j] = mfma16(bfr[j], af[i], acc[i][j]);
                __builtin_amdgcn_s_setprio(0);
            }
            cur = cur == 2 ? 0 : cur + 1;
        }
        if (has_next) asm volatile("s_waitcnt vmcnt(6)" ::: "memory");
        landed = true;
        if (job == J_OUT) {
#pragma unroll
            for (int i = 0; i < 4; ++i) { const int t = row0 + i * 16;
                float rs = 0.f, rq = 0.f;
#pragma unroll
                for (int j = 0; j < 4; ++j) { const u32x2 hb = preb[i * 4 + j]; const f32x4 v = acc[i][j];
                    f32x4 y; y.x = bf2f(hb.x & 0xffffu) * ALPHA + v.x; y.y = bf2f(hb.x >> 16) * ALPHA + v.y; y.z = bf2f(hb.y & 0xffffu) * ALPHA + v.z; y.w = bf2f(hb.y >> 16) * ALPHA + v.w;
                    u32x2 yb; yb.x = cvt_pk_bf16(y.x, y.y); yb.y = cvt_pk_bf16(y.z, y.w);
                    *(u32x2*)((bf16_t*)(ws + WS_BUFB) + (size_t)t * D_ + col0 + j * 16) = yb;
                    rs += (y.x + y.y) + (y.z + y.w); rq += (y.x * y.x + y.y * y.y) + (y.z * y.z + y.w * y.w); }
                rs += __shfl_xor(rs, 16); rq += __shfl_xor(rq, 16); rs += __shfl_xor(rs, 32); rq += __shfl_xor(rq, 32);
                if (fq == 0) { float* rsum = (float*)(ws + WS_RSUM1) + (size_t)t * 2; atomicAdd(rsum, rs); atomicAdd(rsum + 1, rq); } }
        } else if (job == J_WQ) {
            bf16_t* Qx = (bf16_t*)(ws + WS_BUFC);
            const float sc = 0.04419417382415922f * LOG2E;
#pragma unroll
            for (int i = 0; i < 4; ++i) { const int t = row0 + i * 16;
                const float sx = (i == 0) ? rsq01.x : (i == 1) ? rsq01.z : (i == 2) ? rsq23.x : rsq23.z, sy = (i == 0) ? rsq01.y : (i == 1) ? rsq01.w : (i == 2) ? rsq23.y : rsq23.w;
                const float mean = sx * (1.f / D_); float var = sy * (1.f / D_) - mean * mean; var = var > 0.f ? var : 0.f;
                const float rstd = __builtin_amdgcn_rsqf(var + LN_EPS), mr = mean * rstd;
#pragma unroll
                for (int j = 0; j < 4; ++j) { const f32x4 b = (acc[i][j] * rstd - va[j] * mr + vb[j]) * sc;
                    u32x2 o; o.x = cvt_pk_bf16(b.x, b.y); o.y = cvt_pk_bf16(b.z, b.w);
                    *(u32x2*)(Qx + (size_t)t * 2048 + col0 + j * 16) = o; } }
        } else {
#pragma unroll
            for (int i = 0; i < 4; ++i) { const int t = row0 + i * 16;
                const float sx = (i == 0) ? rsq01.x : (i == 1) ? rsq01.z : (i == 2) ? rsq23.x : rsq23.z, sy = (i == 0) ? rsq01.y : (i == 1) ? rsq01.w : (i == 2) ? rsq23.y : rsq23.w;
                const float mean = sx * (1.f / D_); float var = sy * (1.f / D_) - mean * mean; var = var > 0.f ? var : 0.f;
                const float rstd = 1.f / sqrtf(var + LN_EPS);
                float rs2 = 0.f, rq2 = 0.f;
#pragma unroll
                for (int j = 0; j < 4; ++j) { const u32x2 pb = preb[i * 4 + j];
                    f32x4 rv; rv.x = bf2f(pb.x & 0xffffu); rv.y = bf2f(pb.x >> 16); rv.z = bf2f(pb.y & 0xffffu); rv.w = bf2f(pb.y >> 16);
                    const f32x4 y = ((rv - mean) * rstd * va[j] + vb[j]) * ALPHA + acc[i][j];
                    u32x2 yh; yh.x = cvt_pk_bf16(y.x, y.y); yh.y = cvt_pk_bf16(y.z, y.w);
                    u32x2 yl; yl.x = cvt_pk_bf16(y.x - bf2f(yh.x & 0xffffu), y.y - bf2f(yh.x >> 16)); yl.y = cvt_pk_bf16(y.z - bf2f(yh.y & 0xffffu), y.w - bf2f(yh.y >> 16));
                    *(u32x2*)((bf16_t*)(ws + WS_BUFE) + (size_t)t * D_ + col0 + j * 16) = yh;
                    *(u32x2*)((bf16_t*)(ws + WS_BUFC) + (size_t)t * D_ + col0 + j * 16) = yl;
                    rs2 += (y.x + y.y) + (y.z + y.w); rq2 += (y.x * y.x + y.y * y.y) + (y.z * y.z + y.w * y.w); }
                rs2 += __shfl_xor(rs2, 16); rq2 += __shfl_xor(rq2, 16); rs2 += __shfl_xor(rs2, 32); rq2 += __shfl_xor(rq2, 32);
                if (fq == 0) ((float2*)(ws + WS_RP2))[(size_t)t * 32 + nt * 2 + wc] = make_float2(rs2, rq2); }
        }
        asm volatile("" ::: "memory");
        if (!has_next) break;
        ti = tn; mt = mtn; nt = ntn;
#pragma unroll
        for (int r = 0; r < 4; ++r) ap[r] = nap[r];
#pragma unroll
        for (int r = 0; r < 2; ++r) bp[r] = nbp[r];
    }
#undef GD_MAP
#undef GD_PTRS
#undef GD_STAGE
    __syncthreads();
}

template <int job>
DEVI void gemm_lc(const Params& p, char* smem) {
    unsigned char* ws = p.ws;
    int tid = threadIdx.x; asm volatile("" : "+v"(tid));
    const int lane = tid & 63, w = tid >> 6, fr = lane & 15, fq = lane >> 4;
    constexpr int NTILES = 2048;
    if (blockIdx.x >= NTILES) return;
#define LC_MAP(ti_, mt_, nt_) do { const int _x = (ti_) & 7, _jj = (ti_) >> 3, _srl = _jj >> 7, _idx = _jj & 127; mt_ = (_srl * 8 + _x) * 8 + (_idx & 7); nt_ = _idx >> 3; } while (0)
    if (w >= 4) {
        const int lt = tid - 256, srow = lt >> 3, schunk = (lt & 7) ^ ((lt >> 4) & 7);
        const bf16_t* Abase = (const bf16_t*)(ws + (job == J_OUT ? WS_BUFE : job == J_WQ ? WS_BUFB : WS_BUFA)) + (size_t)srow * 2048 + schunk * 8;
        const bf16_t* Bbase = (const bf16_t*)(ws + (job == J_OUT ? WS_WOUT : job == J_WQ ? WS_WQ : WS_WO)) + (size_t)srow * 2048 + schunk * 8;
#define LC_STAGE(ap_, bp_, kt_, slot_) do { char* _A = smem + (slot_) * GEMM_STAGE_BYTES; char* _B = _A + 32768; const int _k0 = (kt_) << 6; \
            _Pragma("unroll") for (int r = 0; r < 4; ++r) { glds16(ap_[r] + _k0, _A + (r * 512 + lt) * 16); glds16(ap_[r] + 32 * 2048 + _k0, _A + (r * 512 + lt + 256) * 16); } \
            _Pragma("unroll") for (int r = 0; r < 2; ++r) { glds16(bp_[r] + _k0, _B + (r * 512 + lt) * 16); glds16(bp_[r] + 32 * 2048 + _k0, _B + (r * 512 + lt + 256) * 16); } } while (0)
#define LC_PTRS(mt_, nt_, ap_, bp_) do { _Pragma("unroll") for (int r = 0; r < 4; ++r) ap_[r] = Abase + (size_t)((mt_) * 256 + r * 64) * 2048; \
            _Pragma("unroll") for (int r = 0; r < 2; ++r) bp_[r] = Bbase + (size_t)((nt_) * 128 + r * 64) * 2048; } while (0)
        int ti = blockIdx.x, mt, nt; LC_MAP(ti, mt, nt);
        const bf16_t* ap[4]; const bf16_t* bp[2]; LC_PTRS(mt, nt, ap, bp);
        LC_STAGE(ap, bp, 0, 0); LC_STAGE(ap, bp, 1, 1);
        int cur = 0;
        for (;;) {
            const int tn = ti + gridDim.x; const bool has_next = tn < NTILES;
            int mtn = 0, ntn = 0; if (has_next) LC_MAP(tn, mtn, ntn);
            const bf16_t* nap[4]; const bf16_t* nbp[2]; LC_PTRS(mtn, ntn, nap, nbp);
            for (int kt = 0; kt < 32; ++kt) {
                if (kt == 31 && !has_next) asm volatile("s_waitcnt vmcnt(0)" ::: "memory"); else asm volatile("s_waitcnt vmcnt(12)" ::: "memory");
                __builtin_amdgcn_s_barrier();
                asm volatile("" ::: "memory");
                const int s2 = cur == 0 ? 2 : cur - 1;
                if (kt < 30) LC_STAGE(ap, bp, kt + 2, s2); else if (has_next) LC_STAGE(nap, nbp, kt - 30, s2);
                cur = cur == 2 ? 0 : cur + 1;
            }
            if (!has_next) break;
            ti = tn;
#pragma unroll
            for (int r = 0; r < 4; ++r) ap[r] = nap[r];
#pragma unroll
            for (int r = 0; r < 2; ++r) bp[r] = nbp[r];
        }
#undef LC_STAGE
#undef LC_PTRS
    } else {
        const int wr2 = w >> 1, wc = w & 1;
        int ti = blockIdx.x, cur = 0;
        for (;;) {
            int mt, nt; LC_MAP(ti, mt, nt);
            f32x4 acc[8][4];
#pragma unroll
            for (int i = 0; i < 8; ++i)
#pragma unroll
                for (int j = 0; j < 4; ++j) acc[i][j] = (f32x4){0.f, 0.f, 0.f, 0.f};
            u32x2 rpre[4][4];
            for (int kt = 0; kt < 32; ++kt) {
                __builtin_amdgcn_s_barrier();
                asm volatile("" ::: "memory");
                if (job != J_WQ && kt == 0) {
                    const bf16_t* Rs = (const bf16_t*)(ws + (job == J_OUT ? WS_BUFA : WS_BUFB)) + (size_t)(mt * 256 + wr2 * 128 + fr) * D_ + nt * 128 + wc * 64 + fq * 4;
#pragma unroll
                    for (int i = 0; i < 4; ++i)
#pragma unroll
                        for (int j = 0; j < 4; ++j) rpre[i][j] = *(const u32x2*)(Rs + (size_t)(i * 16) * D_ + j * 16);
                }
                const char* A = smem + cur * GEMM_STAGE_BYTES; const char* B = A + 32768;
#pragma unroll
                for (int ks = 0; ks < 2; ++ks) {
                    bf16x8 af[8], bfr[4];
                    const int coff = ((4 * ks + fq) ^ (fr >> 1)) * 16;
#pragma unroll
                    for (int i = 0; i < 8; ++i) af[i] = *(const bf16x8*)(A + (wr2 * 128 + i * 16 + fr) * 128 + coff);
#pragma unroll
                    for (int j = 0; j < 4; ++j) bfr[j] = *(const bf16x8*)(B + (wc * 64 + j * 16 + fr) * 128 + coff);
#pragma unroll
                    for (int i = 0; i < 8; ++i)
#pragma unroll
                        for (int j = 0; j < 4; ++j) acc[i][j] = mfma16(bfr[j], af[i], acc[i][j]);
                }
                cur = cur == 2 ? 0 : cur + 1;
            }
            if (job == J_OUT) {
                const bf16_t* Hsrc = (const bf16_t*)(ws + WS_BUFA); bf16_t* Y1 = (bf16_t*)(ws + WS_BUFB);
                const int row0 = mt * 256 + wr2 * 128 + fr, col0 = nt * 128 + wc * 64 + fq * 4;
                u32x2 hb[8][4];
#pragma unroll
                for (int i = 0; i < 8; ++i)
#pragma unroll
                    for (int j = 0; j < 4; ++j) { if (i < 4) hb[i][j] = rpre[i][j]; else hb[i][j] = *(const u32x2*)(Hsrc + (size_t)(row0 + i * 16) * D_ + col0 + j * 16); }
#pragma unroll
                for (int i = 0; i < 8; ++i) { const int t = row0 + i * 16;
                    float rs = 0.f, rq = 0.f;
#pragma unroll
                    for (int j = 0; j < 4; ++j) { const f32x4 v = acc[i][j];
                        f32x4 y; y.x = bf2f(hb[i][j].x & 0xffffu) * ALPHA + v.x; y.y = bf2f(hb[i][j].x >> 16) * ALPHA + v.y; y.z = bf2f(hb[i][j].y & 0xffffu) * ALPHA + v.z; y.w = bf2f(hb[i][j].y >> 16) * ALPHA + v.w;
                        u32x2 yb; yb.x = cvt_pk_bf16(y.x, y.y); yb.y = cvt_pk_bf16(y.z, y.w);
                        *(u32x2*)(Y1 + (size_t)t * D_ + col0 + j * 16) = yb;
                        rs += (y.x + y.y) + (y.z + y.w); rq += (y.x * y.x + y.y * y.y) + (y.z * y.z + y.w * y.w); }
                    rs += __shfl_xor(rs, 16); rq += __shfl_xor(rq, 16); rs += __shfl_xor(rs, 32); rq += __shfl_xor(rq, 32);
                    if (fq == 0) { float* rsum = (float*)(ws + WS_RSUM1) + (size_t)t * 2; atomicAdd(rsum, rs); atomicAdd(rsum + 1, rq); } }
            } else if (job == J_WO) {
                const bf16_t* Y1 = (const bf16_t*)(ws + WS_BUFB);
                const float* rsum = (const float*)(ws + WS_RSUM1);
                const int row0 = mt * 256 + wr2 * 128 + fr, col0 = nt * 128 + wc * 64 + fq * 4;
                f32x4 gg[4], bb[4];
#pragma unroll
                for (int j = 0; j < 4; ++j) { gg[j] = *(const f32x4*)(p.in[17] + col0 + j * 16); bb[j] = *(const f32x4*)(p.in[18] + col0 + j * 16); }
#pragma unroll
                for (int i = 0; i < 8; ++i) { const int t = row0 + i * 16;
                    u32x2 pb[4];
#pragma unroll
                    for (int j = 0; j < 4; ++j) { if (i < 4) pb[j] = rpre[i][j]; else pb[j] = *(const u32x2*)(Y1 + (size_t)t * D_ + col0 + j * 16); }
                    const float2 rsq = *(const float2*)(rsum + (size_t)t * 2);
                    const float mean = rsq.x * (1.f / D_); float var = rsq.y * (1.f / D_) - mean * mean; var = var > 0.f ? var : 0.f;
                    const float rstd = 1.f / sqrtf(var + LN_EPS);
                    float rs2 = 0.f, rq2 = 0.f;
#pragma unroll
                    for (int j = 0; j < 4; ++j) {
                        f32x4 rv; rv.x = bf2f(pb[j].x & 0xffffu); rv.y = bf2f(pb[j].x >> 16); rv.z = bf2f(pb[j].y & 0xffffu); rv.w = bf2f(pb[j].y >> 16);
                        const f32x4 y = ((rv - mean) * rstd * gg[j] + bb[j]) * ALPHA + acc[i][j];
                        u32x2 yh; yh.x = cvt_pk_bf16(y.x, y.y); yh.y = cvt_pk_bf16(y.z, y.w);
                        u32x2 yl; yl.x = cvt_pk_bf16(y.x - bf2f(yh.x & 0xffffu), y.y - bf2f(yh.x >> 16)); yl.y = cvt_pk_bf16(y.z - bf2f(yh.y & 0xffffu), y.w - bf2f(yh.y >> 16));
                        *(u32x2*)((bf16_t*)(ws + WS_BUFE) + (size_t)t * D_ + col0 + j * 16) = yh;
                        *(u32x2*)((bf16_t*)(ws + WS_BUFC) + (size_t)t * D_ + col0 + j * 16) = yl;
                        rs2 += (y.x + y.y) + (y.z + y.w); rq2 += (y.x * y.x + y.y * y.y) + (y.z * y.z + y.w * y.w); }
                    rs2 += __shfl_xor(rs2, 16); rq2 += __shfl_xor(rq2, 16); rs2 += __shfl_xor(rs2, 32); rq2 += __shfl_xor(rq2, 32);
                    if (fq == 0) ((float2*)(ws + WS_RP2))[(size_t)t * 32 + nt * 2 + wc] = make_float2(rs2, rq2); }
            } else {
                bf16_t* Qx = (bf16_t*)(ws + WS_BUFC);
                const float sc = 0.04419417382415922f * LOG2E;
                const float* U = (const float*)(ws + WS_CTL + CTL_U1); const float* Cv = (const float*)(ws + WS_CTL + CTL_C1);
                const float* rsum = (const float*)(ws + WS_RSUM1);
                const int row0 = mt * 256 + wr2 * 128 + fr, col0 = nt * 128 + wc * 64 + fq * 4;
                f32x4 uu[4], cc[4];
#pragma unroll
                for (int j = 0; j < 4; ++j) { uu[j] = *(const f32x4*)(U + col0 + j * 16); cc[j] = *(const f32x4*)(Cv + col0 + j * 16); }
#pragma unroll
                for (int i = 0; i < 8; ++i) { const int t = row0 + i * 16;
                    const float2 rsq = *(const float2*)(rsum + (size_t)t * 2);
                    const float mean = rsq.x * (1.f / D_); float var = rsq.y * (1.f / D_) - mean * mean; var = var > 0.f ? var : 0.f;
                    const float rstd = __builtin_amdgcn_rsqf(var + LN_EPS), mr = mean * rstd;
#pragma unroll
                    for (int j = 0; j < 4; ++j) { const f32x4 b = (acc[i][j] * rstd - uu[j] * mr + cc[j]) * sc;
                        u32x2 o; o.x = cvt_pk_bf16(b.x, b.y); o.y = cvt_pk_bf16(b.z, b.w);
                        *(u32x2*)(Qx + (size_t)t * 2048 + col0 + j * 16) = o; } }
            }
            asm volatile("" ::: "memory");
            ti += gridDim.x;
            if (ti >= NTILES) break;
        }
    }
#undef LC_MAP
    __syncthreads();
}

template <int job>
DEVI void gemm_direct_moe(const Params& p, char* smem) {
    unsigned char* ws = p.ws;
    int tid = threadIdx.x; asm volatile("" : "+v"(tid));
    const int lane = tid & 63, w = tid >> 6, wr = w >> 1, wc = w & 1, fr = lane & 15, fq = lane >> 4;
    const int srow = tid >> 3, schunk = (tid & 7) ^ ((tid >> 4) & 7);
    constexpr int NT = (job == J_MOE1) ? 8 : 16, K = (job == J_MOE1) ? 2048 : 512, NK = K >> 6;
    int* tp = (int*)(smem + GEMM_TP);
    const unsigned* cntw = (const unsigned*)(ws + WS_CTL) + CW_CNT;
    __syncthreads();
    if (tid < 64) {
        const int c = (lane < 32) ? (int)__hip_atomic_load(cntw + lane, __ATOMIC_RELAXED, __HIP_MEMORY_SCOPE_AGENT) : 0;
        const int rtc = (c + 255) >> 8; int incl = rtc;
#pragma unroll
        for (int o = 1; o < 32; o <<= 1) { const int v = __shfl_up(incl, o); if (lane >= o) incl += v; }
        if (lane < 32) { tp[lane] = incl - rtc; tp[33 + lane] = c; }
        if (lane == 31) tp[32] = incl;
    }
    __syncthreads();
    int ntiles;
    { int mx = 0;
#pragma unroll
      for (int x = 0; x < 8; ++x) { int t = 0;
#pragma unroll
          for (int k = 0; k < 4; ++k) t += (tp[33 + x + 8 * k] + 255) >> 8;
          mx = t > mx ? t : mx; }
      ntiles = mx * NT * 8; }
    const int my_tp = tp[lane & 31], my_cnt = tp[33 + (lane & 31)];
    const int* list = (const int*)(ws + WS_LIST);
#define GM_MAP(ti_, ok_, e_, nt_, rt_, ecnt_, etp_) do { const int _x = (ti_) & 7; int _jj = (ti_) >> 3; ok_ = false; e_ = 0; nt_ = 0; rt_ = 0; ecnt_ = 0; etp_ = 0; \
        _Pragma("unroll") for (int _k = 0; _k < 4; ++_k) { const int _ee = _x + 8 * _k; const int _c = __shfl(my_cnt, _ee), _rtc = (_c + 255) >> 8, _tot = _rtc * NT; \
            if (!ok_) { if (_jj < _tot) { ok_ = true; e_ = _ee; ecnt_ = _c; etp_ = __shfl(my_tp, _ee); const int _per = 4 * _rtc, _ng = _jj / _per, _r2 = _jj - _ng * _per; nt_ = _ng * 4 + _r2 / _rtc; rt_ = _r2 - (_r2 / _rtc) * _rtc; } else _jj -= _tot; } } } while (0)
#define GM_BPTRS(e_, nt_, bp_) do { _Pragma("unroll") for (int r = 0; r < 2; ++r) bp_[r] = (job == J_MOE1 ? (const bf16_t*)(ws + WS_WGU) + (size_t)(e_) * 1024 * 2048 : (const bf16_t*)(ws + WS_WD) + (size_t)(e_) * 2048 * 512) \
        + (size_t)((nt_) * 128 + r * 64 + srow) * K + schunk * 8; } while (0)
#define GM_STAGE(ap_, bp_, kt_, slot_) do { char* _A = smem + (slot_) * GEMM_STAGE_BYTES; char* _B = _A + 32768; const int _k0 = (kt_) << 6; \
        _Pragma("unroll") for (int r = 0; r < 4; ++r) glds16(ap_[r] + _k0, _A + (r * 512 + tid) * 16); \
        _Pragma("unroll") for (int r = 0; r < 2; ++r) glds16(bp_[r] + _k0, _B + (r * 512 + tid) * 16); } while (0)
    int ti = blockIdx.x; bool ok = false; int e = 0, nt = 0, rt = 0, ecnt = 0, etp = 0;
    for (; ti < ntiles; ti += gridDim.x) { GM_MAP(ti, ok, e, nt, rt, ecnt, etp); if (ok) break; }
    if (ok) {
    const bf16_t* ap[4]; const bf16_t* bp[2];
#pragma unroll
    for (int r = 0; r < 4; ++r) {
        if (job == J_MOE1) { int pos = rt * 256 + r * 64 + srow; if (pos >= ecnt) pos = 0; const int aid = list[(size_t)e * T_ + pos]; ap[r] = (const bf16_t*)(ws + WS_BUFE) + (size_t)(aid >> 1) * 2048 + schunk * 8; }
        else ap[r] = (const bf16_t*)(ws + WS_BUFB) + (size_t)((etp + rt) * 256 + r * 64 + srow) * 512 + schunk * 8;
    }
    GM_BPTRS(e, nt, bp);
    GM_STAGE(ap, bp, 0, 0);
    GM_STAGE(ap, bp, 1, 1);
    int cur = 0; bool landed = false;
    constexpr int NPRE = (job == J_MOE1) ? 16 : 8;
    for (;;) {
        int tn = ti + gridDim.x; bool okn = false; int en = 0, ntn = 0, rtn = 0, ecntn = 0, etpn = 0;
        for (; tn < ntiles; tn += gridDim.x) { GM_MAP(tn, okn, en, ntn, rtn, ecntn, etpn); if (okn) break; }
        const bool has_next = okn;
        const bf16_t* nap[4]; const bf16_t* nbp[2]; GM_BPTRS(en, ntn, nbp);
        unsigned nlist[4]; u32x2 sl[4]; f32x4 ue[4], ce[4]; unsigned aidv[4], wv[4];
        if (job == J_MOE1) {
#pragma unroll
            for (int r = 0; r < 4; ++r) { int pos = rtn * 256 + r * 64 + srow; if (pos >= ecntn) pos = 0; nlist[r] = gload4_asm(list + (size_t)en * T_ + pos); }
#pragma unroll
            for (int i = 0; i < 4; ++i) { int pos = rt * 256 + wr * 64 + i * 16 + fr; if (pos >= ecnt) pos = 0; sl[i] = gload8_asm((const float2*)(ws + WS_SLIST) + (size_t)e * T_ + pos); }
            const float* UE = (const float*)(ws + WS_CTL + CTL_UE) + e * 1024 + nt * 128 + wc * 64 + fq * 4; const float* CE = (const float*)(ws + WS_CTL + CTL_CE) + e * 1024 + nt * 128 + wc * 64 + fq * 4;
#pragma unroll
            for (int j = 0; j < 4; ++j) { ue[j] = gload16_asm(UE + j * 16); ce[j] = gload16_asm(CE + j * 16); }
        } else {
#pragma unroll
            for (int i = 0; i < 4; ++i) { int pos = rt * 256 + wr * 64 + i * 16 + fr; if (pos >= ecnt) pos = 0; aidv[i] = gload4_asm(list + (size_t)e * T_ + pos); wv[i] = gload4_asm((const float*)(ws + WS_WLIST) + (size_t)e * T_ + pos); }
#pragma unroll
            for (int r = 0; r < 4; ++r) nap[r] = (const bf16_t*)(ws + WS_BUFB) + (size_t)((etpn + rtn) * 256 + r * 64 + srow) * 512 + schunk * 8;
        }
        f32x4 acc[4][4];
#pragma unroll
        for (int i = 0; i < 4; ++i)
#pragma unroll
            for (int j = 0; j < 4; ++j) acc[i][j] = (f32x4){0.f, 0.f, 0.f, 0.f};
        for (int kt = 0; kt < NK; ++kt) {
            if (kt == 0 && landed) { }
            else if (kt < 2) asm volatile("s_waitcnt vmcnt(%0)" :: "n"(6 + NPRE) : "memory");
            else if (kt == NK - 1 && !has_next) asm volatile("s_waitcnt vmcnt(0)" ::: "memory");
            else asm volatile("s_waitcnt vmcnt(6)" ::: "memory");
            __builtin_amdgcn_s_barrier();
            asm volatile("" ::: "memory");
            if (job == J_MOE1 && kt == 2) {
#pragma unroll
                for (int r = 0; r < 4; ++r) nap[r] = (const bf16_t*)(ws + WS_BUFE) + (size_t)(nlist[r] >> 1) * 2048 + schunk * 8;
            }
            { const int s2 = cur == 0 ? 2 : cur - 1;
              if (kt < NK - 2) GM_STAGE(ap, bp, kt + 2, s2); else if (has_next) GM_STAGE(nap, nbp, kt - (NK - 2), s2); }
            const char* A = smem + cur * GEMM_STAGE_BYTES; const char* B = A + 32768;
#pragma unroll
            for (int ks = 0; ks < 2; ++ks) {
                bf16x8 af[4], bfr[4];
                const int coff = ((4 * ks + fq) ^ (fr >> 1)) * 16;
#pragma unroll
                for (int i = 0; i < 4; ++i) {
                    af[i] = *(const bf16x8*)(A + (wr * 64 + i * 16 + fr) * 128 + coff);
                    bfr[i] = *(const bf16x8*)(B + (wc * 64 + i * 16 + fr) * 128 + coff);
                }
                __builtin_amdgcn_s_setprio(1);
#pragma unroll
                for (int i = 0; i < 4; ++i)
#pragma unroll
                    for (int j = 0; j < 4; ++j) acc[i][j] = mfma16(bfr[j], af[i], acc[i][j]);
                __builtin_amdgcn_s_setprio(0);
            }
            cur = cur == 2 ? 0 : cur + 1;
        }
        if (has_next) asm volatile("s_waitcnt vmcnt(6)" ::: "memory");
        landed = true;
        if (job == J_MOE1) {
            bf16_t* H = (bf16_t*)(ws + WS_BUFB);
#pragma unroll
            for (int i = 0; i < 4; ++i) {
                const float mr = __uint_as_float(sl[i].x), rstd = __uint_as_float(sl[i].y);
                const size_t hrow = (size_t)((etp + rt) * 256 + wr * 64 + i * 16 + fr) * 512 + (nt * 2 + wc) * 32 + fq * 4;
#pragma unroll
                for (int j = 0; j < 2; ++j) { const f32x4 g = acc[i][j] * rstd - ue[j] * mr + ce[j], u = acc[i][j + 2] * rstd - ue[j + 2] * mr + ce[j + 2];
                    u32x2 o; o.x = cvt_pk_bf16(g.x * sigmoidf_(g.x) * u.x, g.y * sigmoidf_(g.y) * u.y); o.y = cvt_pk_bf16(g.z * sigmoidf_(g.z) * u.z, g.w * sigmoidf_(g.w) * u.w);
                    *(u32x2*)(H + hrow + j * 16) = o; } }
        } else {
            bf16_t* Y = (bf16_t*)(ws + WS_BUFC);
#pragma unroll
            for (int i = 0; i < 4; ++i) { const int pos = rt * 256 + wr * 64 + i * 16 + fr;
                if (pos < ecnt) { const float wt = __uint_as_float(wv[i]); bf16_t* yrow = Y + (size_t)aidv[i] * 2048 + nt * 128 + wc * 64 + fq * 4;
#pragma unroll
                    for (int j = 0; j < 4; ++j) { const f32x4 b = acc[i][j] * wt; u32x2 o; o.x = cvt_pk_bf16(b.x, b.y); o.y = cvt_pk_bf16(b.z, b.w); *(u32x2*)(yrow + j * 16) = o; } } }
        }
        asm volatile("" ::: "memory");
        if (!has_next) break;
        ti = tn; e = en; nt = ntn; rt = rtn; ecnt = ecntn; etp = etpn;
#pragma unroll
        for (int r = 0; r < 4; ++r) ap[r] = nap[r];
#pragma unroll
        for (int r = 0; r < 2; ++r) bp[r] = nbp[r];
    }
    }
#undef GM_MAP
#undef GM_BPTRS
#undef GM_STAGE
    __syncthreads();
}

template <int job>
DEVI void gemm_lc_moe(const Params& p, char* smem) {
    unsigned char* ws = p.ws;
    int tid = threadIdx.x; asm volatile("" : "+v"(tid));
    const int lane = tid & 63, w = tid >> 6, fr = lane & 15, fq = lane >> 4;
    constexpr int NT = (job == J_MOE1) ? 8 : 16, K = (job == J_MOE1) ? 2048 : 512, NK = K >> 6;
    int* tp = (int*)(smem + GEMM_TP);
    const unsigned* cntw = (const unsigned*)(ws + WS_CTL) + CW_CNT;
    __syncthreads();
    if (tid < 64) {
        const int c = (lane < 32) ? (int)__hip_atomic_load(cntw + lane, __ATOMIC_RELAXED, __HIP_MEMORY_SCOPE_AGENT) : 0;
        const int rtc = (c + 255) >> 8; int incl = rtc;
#pragma unroll
        for (int o = 1; o < 32; o <<= 1) { const int v = __shfl_up(incl, o); if (lane >= o) incl += v; }
        if (lane < 32) { tp[lane] = incl - rtc; tp[33 + lane] = c; }
        if (lane == 31) tp[32] = incl;
    }
    __syncthreads();
    int ntiles;
    { int mx = 0;
#pragma unroll
      for (int x = 0; x < 8; ++x) { int t = 0;
#pragma unroll
          for (int k = 0; k < 4; ++k) t += (tp[33 + x + 8 * k] + 255) >> 8;
          mx = t > mx ? t : mx; }
      ntiles = mx * NT * 8; }
    const int my_tp = tp[lane & 31], my_cnt = tp[33 + (lane & 31)];
    const int* list = (const int*)(ws + WS_LIST);
#define LM_MAP(ti_, ok_, e_, nt_, rt_, ecnt_, etp_) do { const int _x = (ti_) & 7; int _jj = (ti_) >> 3; ok_ = false; e_ = 0; nt_ = 0; rt_ = 0; ecnt_ = 0; etp_ = 0; \
        _Pragma("unroll") for (int _k = 0; _k < 4; ++_k) { const int _ee = _x + 8 * _k; const int _c = __shfl(my_cnt, _ee), _rtc = (_c + 255) >> 8, _tot = _rtc * NT; \
            if (!ok_) { if (_jj < _tot) { ok_ = true; e_ = _ee; ecnt_ = _c; etp_ = __shfl(my_tp, _ee); const int _per = 4 * _rtc, _ng = _jj / _per, _r2 = _jj - _ng * _per; nt_ = _ng * 4 + _r2 / _rtc; rt_ = _r2 - (_r2 / _rtc) * _rtc; } else _jj -= _tot; } } } while (0)
    int ti = blockIdx.x; bool ok = false; int e = 0, nt = 0, rt = 0, ecnt = 0, etp = 0;
    for (; ti < ntiles; ti += gridDim.x) { LM_MAP(ti, ok, e, nt, rt, ecnt, etp); if (ok) break; }
    if (ok) {
    if (w >= 4) {
        const int lt = tid - 256, srow = lt >> 3, schunk = (lt & 7) ^ ((lt >> 4) & 7);
        constexpr int NPL = (job == J_MOE1) ? 8 : 0;
#define LM_APTR(e_, rt_, ecnt_, etp_, r_, hh_, lv_) ((job == J_MOE1) ? (const bf16_t*)(ws + WS_BUFE) + (size_t)((lv_) >> 1) * 2048 + schunk * 8 \
            : (const bf16_t*)(ws + WS_BUFB) + (size_t)(((etp_) + (rt_)) * 256 + (r_) * 64 + srow + 32 * (hh_)) * 512 + schunk * 8)
#define LM_BPTRS(e_, nt_, bp_) do { _Pragma("unroll") for (int r = 0; r < 2; ++r) bp_[r] = (job == J_MOE1 ? (const bf16_t*)(ws + WS_WGU) + (size_t)(e_) * 1024 * 2048 : (const bf16_t*)(ws + WS_WD) + (size_t)(e_) * 2048 * 512) \
            + (size_t)((nt_) * 128 + r * 64 + srow) * K + schunk * 8; } while (0)
#define LM_STAGE(ap_, bp_, kt_, slot_) do { char* _A = smem + (slot_) * GEMM_STAGE_BYTES; char* _B = _A + 32768; const int _k0 = (kt_) << 6; \
            _Pragma("unroll") for (int r = 0; r < 4; ++r) { glds16(ap_[2 * r] + _k0, _A + (r * 512 + lt) * 16); glds16(ap_[2 * r + 1] + _k0, _A + (r * 512 + lt + 256) * 16); } \
            _Pragma("unroll") for (int r = 0; r < 2; ++r) { glds16(bp_[r] + _k0, _B + (r * 512 + lt) * 16); glds16(bp_[r] + 32 * K + _k0, _B + (r * 512 + lt + 256) * 16); } } while (0)
        const bf16_t* ap[8]; const bf16_t* bp[2];
#pragma unroll
        for (int r = 0; r < 4; ++r)
#pragma unroll
            for (int hh = 0; hh < 2; ++hh) { unsigned lv = 0u;
                if (job == J_MOE1) { int pos = rt * 256 + r * 64 + srow + 32 * hh; if (pos >= ecnt) pos = 0; lv = (unsigned)list[(size_t)e * T_ + pos]; }
                ap[2 * r + hh] = LM_APTR(e, rt, ecnt, etp, r, hh, lv); }
        LM_BPTRS(e, nt, bp);
        LM_STAGE(ap, bp, 0, 0); LM_STAGE(ap, bp, 1, 1);
        int cur = 0;
        for (;;) {
            int tn = ti + gridDim.x; bool okn = false; int en = 0, ntn = 0, rtn = 0, ecntn = 0, etpn = 0;
            for (; tn < ntiles; tn += gridDim.x) { LM_MAP(tn, okn, en, ntn, rtn, ecntn, etpn); if (okn) break; }
            const bool has_next = okn;
            const bf16_t* nap[8]; const bf16_t* nbp[2]; LM_BPTRS(en, ntn, nbp);
            unsigned nlist[8];
            if (job == J_MOE1) {
#pragma unroll
                for (int r = 0; r < 4; ++r)
#pragma unroll
                    for (int hh = 0; hh < 2; ++hh) { int pos = rtn * 256 + r * 64 + srow + 32 * hh; if (pos >= ecntn) pos = 0; nlist[2 * r + hh] = gload4_asm(list + (size_t)en * T_ + pos); }
            } else {
#pragma unroll
                for (int r = 0; r < 4; ++r)
#pragma unroll
                    for (int hh = 0; hh < 2; ++hh) nap[2 * r + hh] = LM_APTR(en, rtn, ecntn, etpn, r, hh, 0u);
            }
            for (int kt = 0; kt < NK; ++kt) {
                if (kt == NK - 1 && !has_next) asm volatile("s_waitcnt vmcnt(0)" ::: "memory");
                else if (kt < 2) asm volatile("s_waitcnt vmcnt(%0)" :: "n"(12 + NPL) : "memory");
                else asm volatile("s_waitcnt vmcnt(12)" ::: "memory");
                __builtin_amdgcn_s_barrier();
                asm volatile("" ::: "memory");
                if (job == J_MOE1 && kt == 2) {
#pragma unroll
                    for (int q = 0; q < 8; ++q) nap[q] = (const bf16_t*)(ws + WS_BUFE) + (size_t)(nlist[q] >> 1) * 2048 + schunk * 8;
                }
                const int s2 = cur == 0 ? 2 : cur - 1;
                if (kt < NK - 2) LM_STAGE(ap, bp, kt + 2, s2); else if (has_next) LM_STAGE(nap, nbp, kt - (NK - 2), s2);
                cur = cur == 2 ? 0 : cur + 1;
            }
            if (!has_next) break;
            ti = tn;
#pragma unroll
            for (int q = 0; q < 8; ++q) ap[q] = nap[q];
#pragma unroll
            for (int r = 0; r < 2; ++r) bp[r] = nbp[r];
        }
#undef LM_APTR
#undef LM_BPTRS
#undef LM_STAGE
    } else {
        const int wr2 = w >> 1, wc = w & 1;
        int cur = 0;
        for (;;) {
            f32x4 acc[8][4];
#pragma unroll
            for (int i = 0; i < 8; ++i)
#pragma unroll
                for (int j = 0; j < 4; ++j) acc[i][j] = (f32x4){0.f, 0.f, 0.f, 0.f};
            const bool active = rt * 256 + wr2 * 128 < ecnt;
            for (int kt = 0; kt < NK; ++kt) {
                __builtin_amdgcn_s_barrier();
                asm volatile("" ::: "memory");
                const char* A = smem + cur * GEMM_STAGE_BYTES; const char* B = A + 32768;
                if (active)
#pragma unroll
                for (int ks = 0; ks < 2; ++ks) {
                    bf16x8 af[8], bfr[4];
                    const int coff = ((4 * ks + fq) ^ (fr >> 1)) * 16;
#pragma unroll
                    for (int i = 0; i < 8; ++i) af[i] = *(const bf16x8*)(A + (wr2 * 128 + i * 16 + fr) * 128 + coff);
#pragma unroll
                    for (int j = 0; j < 4; ++j) bfr[j] = *(const bf16x8*)(B + (wc * 64 + j * 16 + fr) * 128 + coff);
#pragma unroll
                    for (int i = 0; i < 8; ++i)
#pragma unroll
                        for (int j = 0; j < 4; ++j) acc[i][j] = mfma16(bfr[j], af[i], acc[i][j]);
                }
                cur = cur == 2 ? 0 : cur + 1;
            }
            if (job == J_MOE1) {
                bf16_t* H = (bf16_t*)(ws + WS_BUFB);
                const float* UE = (const float*)(ws + WS_CTL + CTL_UE) + e * 1024 + nt * 128 + wc * 64 + fq * 4; const float* CE = (const float*)(ws + WS_CTL + CTL_CE) + e * 1024 + nt * 128 + wc * 64 + fq * 4;
                f32x4 ue[4], ce[4]; float2 sl[8];
#pragma unroll
                for (int j = 0; j < 4; ++j) { ue[j] = *(const f32x4*)(UE + j * 16); ce[j] = *(const f32x4*)(CE + j * 16); }
#pragma unroll
                for (int i = 0; i < 8; ++i) { int pos = rt * 256 + wr2 * 128 + i * 16 + fr; if (pos >= ecnt) pos = 0; sl[i] = ((const float2*)(ws + WS_SLIST))[(size_t)e * T_ + pos]; }
#pragma unroll
                for (int i = 0; i < 8; ++i) { const float mr = sl[i].x, rstd = sl[i].y;
                    const size_t hrow = (size_t)((etp + rt) * 256 + wr2 * 128 + i * 16 + fr) * 512 + (nt * 2 + wc) * 32 + fq * 4;
#pragma unroll
                    for (int j = 0; j < 2; ++j) { const f32x4 g = acc[i][j] * rstd - ue[j] * mr + ce[j], u = acc[i][j + 2] * rstd - ue[j + 2] * mr + ce[j + 2];
                        u32x2 o; o.x = cvt_pk_bf16(g.x * sigmoidf_(g.x) * u.x, g.y * sigmoidf_(g.y) * u.y); o.y = cvt_pk_bf16(g.z * sigmoidf_(g.z) * u.z, g.w * sigmoidf_(g.w) * u.w);
                        *(u32x2*)(H + hrow + j * 16) = o; } }
            } else {
                bf16_t* Y = (bf16_t*)(ws + WS_BUFC);
                int aidv[8]; float wtv[8];
#pragma unroll
                for (int i = 0; i < 8; ++i) { int pos = rt * 256 + wr2 * 128 + i * 16 + fr; if (pos >= ecnt) pos = 0; aidv[i] = list[(size_t)e * T_ + pos]; wtv[i] = ((const float*)(ws + WS_WLIST))[(size_t)e * T_ + pos]; }
#pragma unroll
                for (int i = 0; i < 8; ++i) { const int pos = rt * 256 + wr2 * 128 + i * 16 + fr;
                    if (pos < ecnt) { bf16_t* yrow = Y + (size_t)aidv[i] * 2048 + nt * 128 + wc * 64 + fq * 4;
#pragma unroll
                        for (int j = 0; j < 4; ++j) { const f32x4 b = acc[i][j] * wtv[i]; u32x2 o; o.x = cvt_pk_bf16(b.x, b.y); o.y = cvt_pk_bf16(b.z, b.w); *(u32x2*)(yrow + j * 16) = o; } } }
            }
            asm volatile("" ::: "memory");
            int tn = ti + gridDim.x; bool okn = false; int en = 0, ntn = 0, rtn = 0, ecntn = 0, etpn = 0;
            for (; tn < ntiles; tn += gridDim.x) { LM_MAP(tn, okn, en, ntn, rtn, ecntn, etpn); if (okn) break; }
            if (!okn) break;
            ti = tn; e = en; nt = ntn; rt = rtn; ecnt = ecntn; etp = etpn;
        }
    }
    }
#undef LM_MAP
    __syncthreads();
}

DEVI void phase_conv(const Params& p, char* smem) {
    unsigned char* ws = p.ws;
    int tid = threadIdx.x; asm volatile("" : "+v"(tid));
    const int lane = tid & 63, w = tid >> 6;
    const int c0 = tid * 2;
    const bf16_t* Hg = (const bf16_t*)(ws + WS_BUFB + 64 * MiB);
    float* pre = p.out;
    float* cst = (float*)(ws + WS_LIST);
    float wgt[31][2];
    { const float* wp = p.in[12] + c0;
#pragma unroll
      for (int k = 0; k < 31; ++k) { const float2 v = *(const float2*)wp; wgt[k][0] = v.x; wgt[k][1] = v.y; wp += 1024; asm volatile("" : "+v"(wp)); } }
    const float2 cb = *(const float2*)(p.in[13] + c0);
    unsigned* cvc = (unsigned*)(ws + WS_CTL) + CW_CONV;
    LAS unsigned* itb = (LAS unsigned*)(smem + 64);
    for (;;) {
        __syncthreads();
        if (tid == 0) *itb = atomicAdd(cvc, 1u);
        __syncthreads();
        const int it = (int)*itb;
        if (it >= T_ / 16) break;
        const int t0 = it * 16, s0 = t0 & 8191;
        float acc[16][2];
#pragma unroll
        for (int j = 0; j < 16; ++j) { acc[j][0] = cb.x; acc[j][1] = cb.y; }
        const bf16_t* xp = Hg + ((long)t0 - 30) * 1024 + c0;
#pragma unroll
        for (int i = 0; i < 46; ++i) {
            const int s = s0 - 30 + i;
            const unsigned u = *(const unsigned*)xp;
            float x0 = bf2f(u & 0xffffu), x1 = bf2f(u >> 16);
            if (s < 0) { x0 = 0.f; x1 = 0.f; }
            xp += 1024; asm volatile("" : "+v"(xp));
#pragma unroll
            for (int j = 0; j < 16; ++j) { const int k = i - j; if (k >= 0 && k <= 30) { acc[j][0] += wgt[k][0] * x0; acc[j][1] += wgt[k][1] * x1; } }
        }
        float red[32];
#pragma unroll
        for (int j = 0; j < 16; ++j) {
            *(float2*)(pre + (size_t)(t0 + j) * 1024 + c0) = make_float2(acc[j][0], acc[j][1]);
            red[j] = acc[j][0] + acc[j][1]; red[16 + j] = acc[j][0] * acc[j][0] + acc[j][1] * acc[j][1];
        }
#pragma unroll
        for (int st = 0; st < 5; ++st) {
            const int half = 16 >> st, bit = 32 >> st;
            const bool upper = (lane & bit) != 0;
#pragma unroll
            for (int k = 0; k < half; ++k) {
                const float a = red[k], b = red[half + k];
                const float keep = upper ? b : a, send = upper ? a : b;
                red[k] = keep + __shfl_xor(send, bit);
            }
        }
        { const float v = red[0] + __shfl_xor(red[0], 1);
          const int k = lane >> 1;
          if ((lane & 1) == 0) cst[((size_t)(t0 + (k & 15)) * 8 + w) * 2 + (k >> 4)] = v; }
    }
}
DEVI void conv_finish(const Params& p) {
    unsigned char* ws = p.ws;
    int tid = threadIdx.x; asm volatile("" : "+v"(tid));
    const int lane = tid & 63, w = tid >> 6;
    const float* pre = p.out;
    const float* cst = (const float*)(ws + WS_LIST);
    bf16_t* CC = (bf16_t*)(ws + WS_BUFE);
    for (int it = blockIdx.x; it < T_ / 8; it += gridDim.x) {
        const int t = it * 8 + w;
        float sv = 0.f, qv = 0.f;
#pragma unroll
        for (int k = 0; k < 8; ++k) { const float2 a = *(const float2*)(cst + ((size_t)t * 8 + k) * 2); sv += a.x; qv += a.y; }
        const float mean = sv * (1.f / 1024.f);
        float var = qv * (1.f / 1024.f) - mean * mean; var = var > 0.f ? var : 0.f;
        const float rstd = 1.f / sqrtf(var + LN_EPS);
#pragma unroll
        for (int c = 0; c < 4; ++c) {
            const int col = c * 256 + lane * 4;
            const f32x4 x = *(const f32x4*)(pre + (size_t)t * 1024 + col), g = *(const f32x4*)(p.in[14] + col), bb = *(const f32x4*)(p.in[15] + col);
            f32x4 y = (x - mean) * rstd * g + bb;
            y.x *= sigmoidf_(y.x); y.y *= sigmoidf_(y.y); y.z *= sigmoidf_(y.z); y.w *= sigmoidf_(y.w);
            u32x2 o; o.x = cvt_pk_bf16(y.x, y.y); o.y = cvt_pk_bf16(y.z, y.w);
            *(u32x2*)(CC + (size_t)t * 2048 + 1024 + col) = o;
        }
    }
}

enum { M_CMP = 0, M_SEL = 1, M_WIN = 2 };
constexpr int KSTR = 72;
constexpr int NSA_KBUF = 0, NSA_VBUF = 49152;
constexpr int NSA_IMP = 98304;
constexpr int NSA_TBL = 132096;
constexpr int NSA_SEL = NSA_TBL + 4096;
constexpr int NSA_UNIT = NSA_SEL + 1024;

DEVI void attn_issue(char* kdst, char* vdst, const bf16_t* kt, const bf16_t* vt, int vstride, int tid) {
    const int row = tid >> 3, c = (tid & 7) ^ ((row >> 1) & 7);
    glds16(kt + row * 64 + c * 8, kdst + tid * 16);
    glds16(vt + (size_t)row * vstride + c * 8, vdst + tid * 16);
}

constexpr float NSA_THR = 8.f;
template <int MODE, int PASS>
DEVI void nsa_branch(char* smem, const bf16_t* kg, const bf16_t* vg, int vstride, int t_lo, int t_hi, int far_lo, int far_hi, const bf16x8 (&qf)[4], int tq,
                     float c31, const LAS float* tblg, const LAS unsigned* selrow, float& m_ref, bool& mset, float& lsum, float inv_l, f32x16 (&o)[2], LAS float* imp_row) {
    int tid = threadIdx.x; asm volatile("" : "+v"(tid));
    const int lane = tid & 63, l31 = lane & 31, h = lane >> 5, xs = (l31 >> 1) & 7;
    const int n = t_hi - t_lo + 1;
    f32x16 cneg;
    { const float cc = c31 - m_ref;
#pragma unroll
      for (int i = 0; i < 16; ++i) cneg[i] = cc; }
    float imp_carry = 0.f;
    const int nS = (n + 1) >> 1;
#define NSA_ISSUE_PAIR(js_) do { const int _sl = (js_) % 3; \
        _Pragma("unroll") for (int _sb = 0; _sb < 2; ++_sb) { int _t = t_lo + 2 * (js_) + _sb; _t = _t > t_hi ? t_hi : _t; \
            attn_issue(smem + NSA_KBUF + _sl * 16384 + _sb * 8192, smem + NSA_VBUF + _sl * 16384 + _sb * 8192, kg + (size_t)_t * 4096, vg + _t * 64, vstride, tid); } } while (0)
    NSA_ISSUE_PAIR(0);
    if (nS > 1) NSA_ISSUE_PAIR(1);
    for (int it = 0; it < n; ++it) {
        const int ti = t_lo + it, js = it >> 1, buf = (js % 3) * 2 + (it & 1);
        if ((it & 1) == 0) {
            if (js + 1 < nS) asm volatile("s_waitcnt vmcnt(4)" ::: "memory"); else asm volatile("s_waitcnt vmcnt(0)" ::: "memory");
            __builtin_amdgcn_s_barrier();
            asm volatile("" ::: "memory");
            if (js + 2 < nS) NSA_ISSUE_PAIR(js + 2);
        }
        bool selbit = true;
        if (MODE == M_SEL) { selbit = (selrow[ti >> 5] >> (ti & 31)) & 1u; if (!__any(selbit)) continue; }
        const char* Kc = smem + NSA_KBUF + buf * 8192; const char* Vc = smem + NSA_VBUF + buf * 8192;
        f32x16 s[2];
        __builtin_amdgcn_s_setprio(1);
        {
            const int off0 = (h ^ xs) << 4;
            s[0] = mfma32(*(const bf16x8*)(Kc + l31 * 128 + off0), qf[0], cneg);
            s[1] = mfma32(*(const bf16x8*)(Kc + (32 + l31) * 128 + off0), qf[0], cneg);
        }
#pragma unroll
        for (int ks = 1; ks < 4; ++ks) {
            const int off = ((2 * ks + h) ^ xs) << 4;
            s[0] = mfma32(*(const bf16x8*)(Kc + l31 * 128 + off), qf[ks], s[0]);
            s[1] = mfma32(*(const bf16x8*)(Kc + (32 + l31) * 128 + off), qf[ks], s[1]);
        }
        __builtin_amdgcn_s_setprio(0);
        const bool far = (ti >= far_lo) && (ti <= far_hi);
        {
        if (!far) {
            const int dbase = (MODE == M_CMP) ? (tq - 31 - 1024 * ti) : (tq - 64 * ti);
#pragma unroll
            for (int u = 0; u < 2; ++u)
#pragma unroll
                for (int i = 0; i < 16; ++i) {
                    const int kk = 32 * u + (i & 3) + 8 * (i >> 2) + 4 * h;
                    const int dist = dbase - ((MODE == M_CMP) ? 16 * kk : kk);
                    const int idx = (dist < -1 ? -1 : (dist > 191 ? 191 : dist)) + 64;
                    float v = s[u][i] + tblg[idx];
                    if (MODE == M_WIN) v = (dist < 512) ? v : -INFINITY;
                    if (MODE == M_SEL) v = selbit ? v : -INFINITY;
                    s[u][i] = v;
                    if ((i & 3) == 3) asm volatile("" ::: "memory");
                }
        }
        if (PASS != 2) {
            float mxa = max3f(s[0][0], s[0][1], s[0][2]), mxb = max3f(s[1][0], s[1][1], s[1][2]);
#pragma unroll
            for (int i = 3; i < 15; i += 2) { mxa = max3f(mxa, s[0][i], s[0][i + 1]); mxb = max3f(mxb, s[1][i], s[1][i + 1]); }
            float mx = max3f(mxa, mxb, s[0][15]); mx = max3f(mx, s[1][15], s[1][15]);
            if (MODE == M_SEL && !selbit) mx = -INFINITY;
            if (__any(mx > NSA_THR || (!mset && mx > -INFINITY))) {
                const float mc = fmaxf(mx, __shfl_xor(mx, 32));
                const bool mv = (mc > NSA_THR) || (!mset && mc > -INFINITY);
                const float delta = mv ? mc : 0.f;
                const float alpha = mset ? fexp2(-delta) : 1.f;
                mset = mset || mv;
                m_ref += delta;
                const float cc = c31 - m_ref;
#pragma unroll
                for (int i = 0; i < 16; ++i) cneg[i] = cc;
                lsum *= alpha;
#pragma unroll
                for (int u = 0; u < 2; ++u)
#pragma unroll
                    for (int i = 0; i < 16; ++i) s[u][i] -= delta;
                if (PASS == 0) {
#pragma unroll
                    for (int v = 0; v < 2; ++v)
#pragma unroll
                        for (int i = 0; i < 16; ++i) o[v][i] *= alpha;
                }
            }
        }
        float ps0 = 0.f, ps1 = 0.f, ps2 = 0.f, ps3 = 0.f;
#pragma unroll
        for (int u = 0; u < 2; ++u)
#pragma unroll
            for (int i = 0; i < 16; i += 4) {
                s[u][i] = fexp2(s[u][i]); s[u][i + 1] = fexp2(s[u][i + 1]); s[u][i + 2] = fexp2(s[u][i + 2]); s[u][i + 3] = fexp2(s[u][i + 3]);
                ps0 += s[u][i]; ps1 += s[u][i + 1]; ps2 += s[u][i + 2]; ps3 += s[u][i + 3];
            }
        { const float ps = (ps0 + ps1) + (ps2 + ps3); lsum += (MODE == M_SEL && far && !selbit) ? 0.f : ps; }
        if (PASS == 2) {
            float mainv[8], halfv[8];
#pragma unroll
            for (int u = 0; u < 2; ++u)
#pragma unroll
                for (int c4 = 0; c4 < 4; ++c4) {
                    float hv = 0.5f * s[u][4 * c4 + 3] * inv_l;
                    float mv = ((s[u][4 * c4] + s[u][4 * c4 + 1]) + s[u][4 * c4 + 2]) * inv_l + hv;
                    mv += __builtin_bit_cast(float, __builtin_amdgcn_update_dpp(0, __builtin_bit_cast(int, mv), 0xB1, 0xF, 0xF, true));
                    hv += __builtin_bit_cast(float, __builtin_amdgcn_update_dpp(0, __builtin_bit_cast(int, hv), 0xB1, 0xF, 0xF, true));
                    mv += __builtin_bit_cast(float, __builtin_amdgcn_update_dpp(0, __builtin_bit_cast(int, mv), 0x4E, 0xF, 0xF, true));
                    hv += __builtin_bit_cast(float, __builtin_amdgcn_update_dpp(0, __builtin_bit_cast(int, hv), 0x4E, 0xF, 0xF, true));
                    mainv[u * 4 + c4] = mv; halfv[u * 4 + c4] = __shfl_xor(hv, 32);
                }
#pragma unroll
            for (int gi = 0; gi < 8; ++gi) {
                const float cin = h ? halfv[gi] : (gi ? halfv[gi - 1] : imp_carry);
                const unsigned ia = (unsigned)(size_t)(imp_row + 16 * ti + 2 * gi + h);
                const float val = mainv[gi] + cin;
                asm volatile("ds_write_b32 %0, %1" :: "v"(ia), "v"(val) : "memory");
            }
            imp_carry = halfv[7];
        }
        const unsigned pmask = (MODE == M_SEL && far && !selbit) ? 0u : 0xFFFFFFFFu;
#pragma unroll
        for (int u = 0; u < 2; ++u)
#pragma unroll
            for (int sI = 0; sI < 2; ++sI) {
                u32x4 pk;
                pk.x = cvt_pk_bf16(s[u][8 * sI + 0], s[u][8 * sI + 1]); pk.y = cvt_pk_bf16(s[u][8 * sI + 2], s[u][8 * sI + 3]);
                pk.z = cvt_pk_bf16(s[u][8 * sI + 4], s[u][8 * sI + 5]); pk.w = cvt_pk_bf16(s[u][8 * sI + 6], s[u][8 * sI + 7]);
                if (MODE == M_SEL) { pk.x &= pmask; pk.y &= pmask; pk.z &= pmask; pk.w &= pmask; }
                const bf16x8 pf = __builtin_bit_cast(bf16x8, pk);
                if (PASS != 1) {
                    const int voff = ((2 * (2 * u + sI) + h) ^ xs) << 4;
                    o[0] = mfma32(*(const bf16x8*)(Vc + l31 * 128 + voff), pf, o[0]);
                    o[1] = mfma32(*(const bf16x8*)(Vc + (32 + l31) * 128 + voff), pf, o[1]);
                }
            }
        }
    }
    if (PASS == 2) {
        const int c = 16 * (t_hi + 1);
        if (h == 0 && c < 128) { const unsigned ia = (unsigned)(size_t)(imp_row + c); asm volatile("ds_write_b32 %0, %1" :: "v"(ia), "v"(imp_carry) : "memory"); }
        asm volatile("s_waitcnt lgkmcnt(0)" ::: "memory");
    }
#undef NSA_ISSUE_PAIR
    __syncthreads();
}

DEVI void phase_nsa(const Params& p, char* smem, int ctr_idx) {
    unsigned char* ws = p.ws;
    const int tid0 = threadIdx.x;
    float* imp = (float*)(smem + NSA_IMP);
    unsigned* tot = (unsigned*)(smem + NSA_IMP);
    float* tbl = (float*)(smem + NSA_TBL);
    unsigned* selm = (unsigned*)(smem + NSA_SEL);
    int* sunit = (int*)(smem + NSA_UNIT);
    unsigned* ctr = (unsigned*)(ws + WS_CTL) + CW_NSA + 256 * ctr_idx;
    unsigned* trc = (unsigned*)(ws + WS_CTL) + CW_TR;
    const bf16_t* Q = (const bf16_t*)(ws + WS_BUFB);
    const float* G = (const float*)(ws + WS_BUFC + C_GATES);
    bf16_t* CC = ctr_idx ? (bf16_t*)(p.out + 32 * 1024 * 1024) : (bf16_t*)(ws + WS_BUFE);
    for (;;) {
        int tid = tid0; asm volatile("" : "+v"(tid));
        const int lane = tid & 63, w = tid >> 6, l31 = lane & 31, h = lane >> 5;
        const int qi = l31 >> 2, g = l31 & 3, ql = 8 * w + qi;
        __syncthreads();
        if (tid == 0) {
            const unsigned x = xb_xcc_id() & 7u; int u = -1;
            for (unsigned k = 0; k < 8u && u < 0; ++k) { const unsigned xx = (x + k) & 7u; const unsigned i = atomicAdd(ctr + 16 * xx, 1u); if (i < 256u) u = (int)(i * 8u + xx); }
            *sunit = u;
        }
        __syncthreads();
        const int unit = *sunit;
        if (unit < 0) break;
        const int xq = unit & 7, iq = unit >> 3;
        const int qt = 127 - (iq >> 1), bh = 2 * xq + (iq & 1), b = bh >> 2, hkv = bh & 3, q0 = qt * 64, cur = qt;
        for (int i = tid; i < 4 * 256; i += 512) {
            const int gg = i >> 8, d = (i & 255) - 64;
            float val = -INFINITY;
            if (d >= 0) {
                int bucket;
                if (d < 16) bucket = d;
                else if (d >= 128) bucket = 31;
                else { const int lg = 16 + (int)(logf((float)d / 16.f) / 2.0794415416798357f * 16.f); bucket = lg < 31 ? lg : 31; }
                val = (p.in[11][bucket * 16 + hkv * 4 + gg] - p.in[11][31 * 16 + hkv * 4 + gg]) * LOG2E;
            }
            tbl[i] = val;
        }
        if (tid < 256) selm[tid] = 0u;
        const int tq = q0 + ql;
        const size_t trow = (size_t)b * 8192 + tq;
        bf16x8 qf[4];
        { const bf16_t* qrow = Q + trow * 1024 + hkv * 256 + g * 64;
#pragma unroll
          for (int ks = 0; ks < 4; ++ks) qf[ks] = *(const bf16x8*)(qrow + 16 * ks + 8 * h); }
        float c31 = p.in[11][31 * 16 + hkv * 4 + g] * LOG2E;
        asm volatile("" : "+v"(qf[0]), "+v"(qf[1]), "+v"(qf[2]), "+v"(qf[3]), "+v"(c31));
        const LAS float* tblg = (const LAS float*)(smem + NSA_TBL) + g * 256;
        const LAS unsigned* selrow = (const LAS unsigned*)(smem + NSA_SEL) + ql * 4;
        f32x16 o[2];
#pragma unroll
        for (int v = 0; v < 2; ++v)
#pragma unroll
            for (int i = 0; i < 16; ++i) o[v][i] = 0.f;
        __syncthreads();
        const bf16_t* kc = (const bf16_t*)(ws + WS_BUFC + C_KC) + (size_t)bh * 512 * 64;
        const bf16_t* vct = (const bf16_t*)(ws + WS_BUFC + C_VCT) + (size_t)bh * 64 * 512;
        const int ct_hi = (q0 + 32) >> 10, cfar_hi = (q0 >= 1167) ? ((q0 - 1167) >> 10) : -1;
        float m_ref = 0.f; bool mset = false;
        float lsum = 0.f;
        const int rmode = ctr_idx ? NSA_REP_MODE : 0;
        if (rmode != 2) nsa_branch<M_CMP, 1>(smem, kc, vct, 512, 0, ct_hi, 0, cfar_hi, qf, tq, c31, tblg, selrow, m_ref, mset, lsum, 0.f, o, (LAS float*)(smem + NSA_IMP) + ql * 132);
        { const float lt = lsum + __shfl_xor(lsum, 32); const float inv = lt > 0.f ? 1.f / lt : 0.f;
          if (rmode != 2 && rmode != 4) nsa_branch<M_CMP, 2>(smem, kc, vct, 512, 0, ct_hi, 0, cfar_hi, qf, tq, c31, tblg, selrow, m_ref, mset, lsum, inv, o, (LAS float*)(smem + NSA_IMP) + ql * 132);
#pragma unroll
          for (int v = 0; v < 2; ++v)
#pragma unroll
            for (int i = 0; i < 16; ++i) o[v][i] *= inv; }
        asm volatile("s_waitcnt lgkmcnt(0)" ::: "memory"); __syncthreads();
        if (rmode < 2) {
            const int q = tid >> 3, sub = tid & 7, t = q0 + q;
            unsigned key[16];
#pragma unroll
            for (int i = 0; i < 16; ++i) {
                const int j = sub * 16 + i;
                const bool forced = (j == 0) || (j == cur) || (j == cur - 1);
                const bool valid = (j * 64 <= t);
                const float v = imp[q * 132 + j];
                key[i] = forced ? 0xFFFFFFFFu : (valid ? (__float_as_uint(v) + 1u) : 0u);
            }
            unsigned tau = 0u;
            for (int bit = 31; bit >= 0; --bit) {
                const unsigned cand = tau | (1u << bit);
                int c = 0;
#pragma unroll
                for (int i = 0; i < 16; ++i) c += (key[i] >= cand) ? 1 : 0;
                c += __builtin_amdgcn_update_dpp(0, c, 0xB1, 0xF, 0xF, true); c += __builtin_amdgcn_update_dpp(0, c, 0x4E, 0xF, 0xF, true); c += __builtin_amdgcn_update_dpp(0, c, 0x141, 0xF, 0xF, true);
                if (c >= 16) tau = cand;
            }
            int gt = 0, eq = 0;
#pragma unroll
            for (int i = 0; i < 16; ++i) { gt += (key[i] > tau) ? 1 : 0; eq += (key[i] == tau) ? 1 : 0; }
            int gtt = gt; gtt += __builtin_amdgcn_update_dpp(0, gtt, 0xB1, 0xF, 0xF, true); gtt += __builtin_amdgcn_update_dpp(0, gtt, 0x4E, 0xF, 0xF, true); gtt += __builtin_amdgcn_update_dpp(0, gtt, 0x141, 0xF, 0xF, true);
            int pre = 0;
#pragma unroll
            for (int sI = 0; sI < 7; ++sI) { const int v = __shfl(eq, (lane & ~7) + sI); if (sI < sub) pre += v; }
            const int need = 16 - gtt;
            unsigned bits = 0u; int run = pre;
#pragma unroll
            for (int i = 0; i < 16; ++i) {
                bool sel = key[i] > tau;
                if (tau > 0u && key[i] == tau) { sel = run < need; ++run; }
                bits |= sel ? (1u << i) : 0u;
            }
            atomicOr(&selm[q * 4 + (sub >> 1)], bits << ((sub & 1) * 16));
        }
        __syncthreads();
        const float gc = G[((size_t)b * 8192 + tq) * 48 + hkv * 12 + g * 3 + 0];
#pragma unroll
        for (int v = 0; v < 2; ++v)
#pragma unroll
            for (int i = 0; i < 16; i += 2) { const float gcc = (PROBE == 1 ? 0.f : gc); tot[(v * 8 + (i >> 1)) * 512 + tid] = cvt_pk_bf16(gcc * o[v][i], gcc * o[v][i + 1]); o[v][i] = 0.f; o[v][i + 1] = 0.f; }
        {
            const bf16_t* ks = (const bf16_t*)(ws + WS_BUFC + C_KS) + (size_t)bh * 8192 * 64;
            const bf16_t* vst = (const bf16_t*)(ws + WS_BUFC + C_VST) + (size_t)bh * 64 * 8192;
            m_ref = 0.f; mset = false;
            lsum = 0.f;
            if (rmode == 0) nsa_branch<M_SEL, 0>(smem, ks, vst, 8192, 0, cur, 0, cur - 3, qf, tq, c31, tblg, selrow, m_ref, mset, lsum, 0.f, o, (LAS float*)nullptr);
            const float gs = G[((size_t)b * 8192 + tq) * 48 + hkv * 12 + g * 3 + 1];
            const float sc = (PROBE == 2 ? 0.f : gs) / (lsum + __shfl_xor(lsum, 32));
#pragma unroll
            for (int v = 0; v < 2; ++v)
#pragma unroll
                for (int i = 0; i < 16; i += 2) { const unsigned tv = tot[(v * 8 + (i >> 1)) * 512 + tid];
                    tot[(v * 8 + (i >> 1)) * 512 + tid] = cvt_pk_bf16(bf2f(tv & 0xffffu) + sc * o[v][i], bf2f(tv >> 16) + sc * o[v][i + 1]); o[v][i] = 0.f; o[v][i + 1] = 0.f; }
        }
        {
            const bf16_t* kw = (const bf16_t*)(ws + WS_BUFC + C_KW) + (size_t)bh * 8192 * 64;
            const bf16_t* vwt = (const bf16_t*)(ws + WS_BUFC + C_VWT) + (size_t)bh * 64 * 8192;
            m_ref = 0.f; mset = false;
            lsum = 0.f;
            const int w_lo = cur >= 8 ? cur - 8 : 0;
            if (rmode == 0 || rmode == 2) nsa_branch<M_WIN, 0>(smem, kw, vwt, 8192, w_lo, cur, cur - 7, cur - 3, qf, tq, c31, tblg, selrow, m_ref, mset, lsum, 0.f, o, (LAS float*)nullptr);
            const float gw = G[((size_t)b * 8192 + tq) * 48 + hkv * 12 + g * 3 + 2];
            const float sc = (PROBE == 3 ? 0.f : gw) / (lsum + __shfl_xor(lsum, 32));
            bf16_t* orow = CC + trow * 2048 + hkv * 256 + g * 64;
#pragma unroll
            for (int v = 0; v < 2; ++v)
#pragma unroll
                for (int c4 = 0; c4 < 4; ++c4) {
                    const unsigned ta = tot[(v * 8 + 2 * c4) * 512 + tid], tb = tot[(v * 8 + 2 * c4 + 1) * 512 + tid];
                    const float r0 = bf2f(ta & 0xffffu) + sc * o[v][4 * c4 + 0], r1 = bf2f(ta >> 16) + sc * o[v][4 * c4 + 1];
                    const float r2 = bf2f(tb & 0xffffu) + sc * o[v][4 * c4 + 2], r3 = bf2f(tb >> 16) + sc * o[v][4 * c4 + 3];
                    u32x2 ov; ov.x = cvt_pk_bf16(r0, r1); ov.y = cvt_pk_bf16(r2, r3);
                    *(u32x2*)(orow + 32 * v + 8 * c4 + 4 * h) = ov;
                }
        }
        if (ctr_idx == 0) {
            __syncthreads();
            { int item = 0;
              if (lane == 0) item = (int)atomicAdd(trc, 3u);
              item = __builtin_amdgcn_readfirstlane(item);
              if (item < MOE_W_ITEMS) moe_weight_triple(p, smem, item); }
        }
    }
    if (ctr_idx == 0) {
        __syncthreads();
        for (;;) {
            int item = 0;
            if ((threadIdx.x & 63) == 0) item = (int)atomicAdd(trc, 3u);
            item = __builtin_amdgcn_readfirstlane(item);
            if (item >= MOE_W_ITEMS) break;
            moe_weight_triple(p, smem, item);
        }
    }
}

template <int which>
DEVI void phase_ln(const Params& p) {
    unsigned char* ws = p.ws;
    int tid = threadIdx.x; asm volatile("" : "+v"(tid));
    const int lane = tid & 63, w = tid >> 6;
    f32x4 G2[8], B2[8], G3[8], B3[8];
    if (which == 2) {
#pragma unroll
        for (int c = 0; c < 8; ++c) { const int col = c * 256 + lane * 4;
            G2[c] = *(const f32x4*)(p.in[24] + col); B2[c] = *(const f32x4*)(p.in[25] + col); G3[c] = *(const f32x4*)(p.in[33] + col); B3[c] = *(const f32x4*)(p.in[34] + col); }
    }
    for (int it = blockIdx.x; it < T_ / 8; it += gridDim.x) {
        const int t = it * 8 + w;
        float* row = p.out + (size_t)t * D_;
        f32x4 v[8];
        if (which == 2) {
            const bf16_t* yh = (const bf16_t*)(ws + WS_BUFE) + (size_t)t * D_;
#pragma unroll
            for (int c = 0; c < 8; ++c) { const u32x2 a = *(const u32x2*)(yh + c * 256 + lane * 4);
                v[c].x = bf2f(a.x & 0xffffu); v[c].y = bf2f(a.x >> 16); v[c].z = bf2f(a.y & 0xffffu); v[c].w = bf2f(a.y >> 16); }
        } else row_load(row, lane, v);
        float mean, rstd; row_stats(v, mean, rstd);
        if (which == 0) {
            if (lane == 0) { float* st = (float*)(ws + WS_STATS); st[t * 2] = mean; st[t * 2 + 1] = rstd; }
            bf16_t* hi = (bf16_t*)(ws + WS_BUFB) + (size_t)t * D_;
#pragma unroll
            for (int c = 0; c < 8; ++c) {
                const int col = c * 256 + lane * 4;
                const f32x4 g = *(const f32x4*)(p.in[17] + col), b = *(const f32x4*)(p.in[18] + col);
                const f32x4 y = (v[c] - mean) * rstd * g + b;
                u32x2 o; o.x = cvt_pk_bf16(y.x, y.y); o.y = cvt_pk_bf16(y.z, y.w);
                *(u32x2*)(hi + col) = o;
            }
        } else if (which == 1) {
            bf16_t* hi = (bf16_t*)(ws + WS_BUFA) + (size_t)t * D_;
            bf16_t* lo = (bf16_t*)(ws + WS_BUFB) + (size_t)t * D_;
#pragma unroll
            for (int c = 0; c < 8; ++c) {
                const int col = c * 256 + lane * 4;
                const f32x4 g = *(const f32x4*)(p.in[24] + col), b = *(const f32x4*)(p.in[25] + col);
                const f32x4 y = (v[c] - mean) * rstd * g + b;
                u32x2 o; o.x = cvt_pk_bf16(y.x, y.y); o.y = cvt_pk_bf16(y.z, y.w);
                *(u32x2*)(hi + col) = o;
                u32x2 ol;
                ol.x = cvt_pk_bf16(y.x - bf2f(o.x & 0xffffu), y.y - bf2f(o.x >> 16));
                ol.y = cvt_pk_bf16(y.z - bf2f(o.y & 0xffffu), y.w - bf2f(o.y >> 16));
                *(u32x2*)(lo + col) = ol;
            }
        } else {
            const bf16_t* y0 = (const bf16_t*)(ws + WS_BUFC) + (size_t)t * 2 * D_;
#pragma unroll
            for (int c = 0; c < 8; ++c) {
                const int col = c * 256 + lane * 4;
                const f32x4 x2 = (v[c] - mean) * rstd * G2[c] + B2[c];
                const u32x2 a = *(const u32x2*)(y0 + col), bq = *(const u32x2*)(y0 + D_ + col);
                v[c].x = x2.x * ALPHA + (bf2f(a.x & 0xffffu) + bf2f(bq.x & 0xffffu));
                v[c].y = x2.y * ALPHA + (bf2f(a.x >> 16) + bf2f(bq.x >> 16));
                v[c].z = x2.z * ALPHA + (bf2f(a.y & 0xffffu) + bf2f(bq.y & 0xffffu));
                v[c].w = x2.w * ALPHA + (bf2f(a.y >> 16) + bf2f(bq.y >> 16));
            }
            row_stats(v, mean, rstd);
#pragma unroll
            for (int c = 0; c < 8; ++c) {
                const int col = c * 256 + lane * 4;
                *(f32x4*)(row + col) = (v[c] - mean) * rstd * G3[c] + B3[c];
            }
        }
    }
}

DEVI void phase_xattn(const Params& p, char* smem) {
    unsigned char* ws = p.ws;
    int tid = threadIdx.x; asm volatile("" : "+v"(tid));
    const int lane = tid & 63, w = tid >> 6, l31 = lane & 31, h = lane >> 5;
    const bf16_t* Qx = (const bf16_t*)(ws + WS_BUFC);
    const bf16_t* Kx = (const bf16_t*)(ws + WS_BUFD + 4 * MiB);
    const bf16_t* Vt = (const bf16_t*)(ws + WS_BUFD + 8 * MiB);
    bf16_t* Ox = (bf16_t*)(ws + WS_BUFA);
    bf16_t* Qs = (bf16_t*)smem;
    bf16_t* Ks = Qs + 256 * KSTR;
    bf16_t* Vs = (bf16_t*)smem;
    for (int unit = blockIdx.x; unit < 512; unit += gridDim.x) {
        const int qt = unit & 31, head = (unit >> 5) & 3, b = unit >> 7;
        const size_t t0 = (size_t)b * 8192 + qt * 256;
        const bf16_t* kbase = Kx + (size_t)(b * 4 + head) * 256 * 512;
        const bf16_t* vbase = Vt + (size_t)(b * 4 + head) * 512 * 256;
        f32x16 s[8];
#pragma unroll
        for (int u = 0; u < 8; ++u)
#pragma unroll
            for (int i = 0; i < 16; ++i) s[u][i] = 0.f;
        u32x4 pq[4], pk4[4];
#pragma unroll
        for (int i = 0; i < 4; ++i) { const int c = tid + 512 * i, row = c >> 3, ch = c & 7;
            pq[i] = *(const u32x4*)(Qx + (t0 + row) * 2048 + head * 512 + ch * 8); pk4[i] = *(const u32x4*)(kbase + (size_t)row * 512 + ch * 8); }
        for (int dc = 0; dc < 8; ++dc) {
            __syncthreads();
#pragma unroll
            for (int i = 0; i < 4; ++i) { const int c = tid + 512 * i, row = c >> 3, ch = c & 7;
                *(u32x4*)(Qs + row * KSTR + ch * 8) = pq[i]; *(u32x4*)(Ks + row * KSTR + ch * 8) = pk4[i]; }
            __syncthreads();
            if (dc + 1 < 8) {
#pragma unroll
                for (int i = 0; i < 4; ++i) { const int c = tid + 512 * i, row = c >> 3, ch = c & 7;
                    pq[i] = *(const u32x4*)(Qx + (t0 + row) * 2048 + head * 512 + (dc + 1) * 64 + ch * 8); pk4[i] = *(const u32x4*)(kbase + (size_t)row * 512 + (dc + 1) * 64 + ch * 8); }
            }
#pragma unroll
            for (int ks = 0; ks < 4; ++ks) {
                const bf16x8 qb = *(const bf16x8*)(Qs + (32 * w + l31) * KSTR + 16 * ks + 8 * h);
#pragma unroll
                for (int u = 0; u < 8; ++u) { const bf16x8 ka = *(const bf16x8*)(Ks + (32 * u + l31) * KSTR + 16 * ks + 8 * h); s[u] = mfma32(ka, qb, s[u]); }
            }
        }
        u32x4 pv[4];
#pragma unroll
        for (int i = 0; i < 4; ++i) { const int c = tid + 512 * i, row = c >> 5, ch = c & 31; pv[i] = *(const u32x4*)(vbase + (size_t)row * 256 + ch * 8); }
        float mx = -INFINITY;
#pragma unroll
        for (int u = 0; u < 8; ++u)
#pragma unroll
            for (int i = 0; i < 16; i += 2) mx = max3f(mx, s[u][i], s[u][i + 1]);
        mx = fmaxf(mx, __shfl_xor(mx, 32));
        float ls = 0.f;
        bf16x8 pf[8][2];
#pragma unroll
        for (int u = 0; u < 8; ++u) {
#pragma unroll
            for (int i = 0; i < 16; ++i) { s[u][i] = fexp2(s[u][i] - mx); ls += s[u][i]; }
#pragma unroll
            for (int sI = 0; sI < 2; ++sI) { u32x4 pk;
                pk.x = cvt_pk_bf16(s[u][8 * sI + 0], s[u][8 * sI + 1]); pk.y = cvt_pk_bf16(s[u][8 * sI + 2], s[u][8 * sI + 3]);
                pk.z = cvt_pk_bf16(s[u][8 * sI + 4], s[u][8 * sI + 5]); pk.w = cvt_pk_bf16(s[u][8 * sI + 6], s[u][8 * sI + 7]);
                pf[u][sI] = __builtin_bit_cast(bf16x8, pk); }
        }
        ls += __shfl_xor(ls, 32);
        const float inv = (PROBE == 4 ? 0.f : 1.f) / ls;
        bf16_t* orow = Ox + (t0 + 32 * w + l31) * 2048 + head * 512;
        for (int dc = 0; dc < 8; ++dc) {
            __syncthreads();
#pragma unroll
            for (int i = 0; i < 4; ++i) { const int c = tid + 512 * i, row = c >> 5, ch = c & 31; *(u32x4*)(Vs + row * 264 + ch * 8) = pv[i]; }
            __syncthreads();
            if (dc + 1 < 8) {
#pragma unroll
                for (int i = 0; i < 4; ++i) { const int c = tid + 512 * i, row = c >> 5, ch = c & 31; pv[i] = *(const u32x4*)(vbase + (size_t)((dc + 1) * 64 + row) * 256 + ch * 8); }
            }
            f32x16 o[2];
#pragma unroll
            for (int v = 0; v < 2; ++v)
#pragma unroll
                for (int i = 0; i < 16; ++i) o[v][i] = 0.f;
#pragma unroll
            for (int s4 = 0; s4 < 16; ++s4)
#pragma unroll
                for (int v = 0; v < 2; ++v) {
                    const bf16_t* vr = Vs + (32 * v + l31) * 264 + 16 * s4 + 4 * h;
                    const u32x2 a = *(const u32x2*)vr, bq = *(const u32x2*)(vr + 8);
                    u32x4 vv; vv.x = a.x; vv.y = a.y; vv.z = bq.x; vv.w = bq.y;
                    o[v] = mfma32(__builtin_bit_cast(bf16x8, vv), pf[s4 >> 1][s4 & 1], o[v]);
                }
#pragma unroll
            for (int v = 0; v < 2; ++v)
#pragma unroll
                for (int c4 = 0; c4 < 4; ++c4) {
                    u32x2 ov; ov.x = cvt_pk_bf16(o[v][4 * c4] * inv, o[v][4 * c4 + 1] * inv); ov.y = cvt_pk_bf16(o[v][4 * c4 + 2] * inv, o[v][4 * c4 + 3] * inv);
                    *(u32x2*)(orow + dc * 64 + 32 * v + 8 * c4 + 4 * h) = ov;
                }
        }
        __syncthreads();
    }
}

DEVI void phase_route(const Params& p) {
    unsigned char* ws = p.ws;
    const float* L = (const float*)(ws + WS_LOGITS);
    unsigned* cnt = (unsigned*)(ws + WS_CTL) + CW_CNT;
    int* list = (int*)(ws + WS_LIST);
    float* wt = (float*)(ws + WS_WTOK);
    int tid = threadIdx.x; asm volatile("" : "+v"(tid));
    for (int t = blockIdx.x * NTHREADS + tid; t < T_; t += gridDim.x * NTHREADS) {
        const f32x4 lgv = *(const f32x4*)(L + (size_t)t * 40);
        float lg[4] = {lgv.x + p.in[27][0], lgv.y + p.in[27][1], lgv.z + p.in[27][2], lgv.w + p.in[27][3]};
        int grp = 0; float best = lg[0];
#pragma unroll
        for (int i = 1; i < 4; ++i) if (lg[i] > best) { best = lg[i]; grp = i; }
        float se = 0.f;
#pragma unroll
        for (int i = 0; i < 4; ++i) se += expf(lg[i] - best);
        const float wgrp = 1.f / se;
        const f32x4 e0 = *(const f32x4*)(L + (size_t)t * 40 + 4 + grp * 8), e1 = *(const f32x4*)(L + (size_t)t * 40 + 8 + grp * 8);
        const f32x4 b0 = *(const f32x4*)(p.in[29] + grp * 8), b1 = *(const f32x4*)(p.in[29] + grp * 8 + 4);
        float le[8] = {e0.x + b0.x, e0.y + b0.y, e0.z + b0.z, e0.w + b0.w, e1.x + b1.x, e1.y + b1.y, e1.z + b1.z, e1.w + b1.w};
        int i0 = 0; float v0 = le[0];
#pragma unroll
        for (int i = 1; i < 8; ++i) if (le[i] > v0) { v0 = le[i]; i0 = i; }
        int i1 = -1; float v1 = -INFINITY;
#pragma unroll
        for (int i = 0; i < 8; ++i) if (i != i0 && le[i] > v1) { v1 = le[i]; i1 = i; }
        const float ex = expf(v1 - v0);
        const float w0 = wgrp / (1.f + ex), w1 = wgrp * ex / (1.f + ex);
        const int ea = grp * 8 + i0, eb = grp * 8 + i1;
        const unsigned pa = atomicAdd(cnt + ea, 1u); list[(size_t)ea * T_ + pa] = t * 2;
        const unsigned pb = atomicAdd(cnt + eb, 1u); list[(size_t)eb * T_ + pb] = t * 2 + 1;
        wt[t * 2] = w0; wt[t * 2 + 1] = w1;
    }
}

enum { PH_PREP = 0, PH_PROJ, PH_CMP1, PH_CMP2, PH_NSA, PH_OUT, PH_LN1, PH_WQ, PH_XATTN, PH_WO, PH_LN2, PH_ROUTER, PH_ROUTE, PH_MOE1, PH_MOE2, PH_LN3, PH_COUNT };

__global__ void __launch_bounds__(NTHREADS, 2) fwd_megakernel(Params p) {
    extern __shared__ __attribute__((aligned(16))) char smem[];
    cg::grid_group grid = cg::this_grid();
    volatile LAS unsigned* bar_st = (volatile LAS unsigned*)(smem + LDS_BYTES - 16);
    if (threadIdx.x < 2) bar_st[threadIdx.x] = 0u;
    __syncthreads();
    xcd_barrier_post((unsigned*)(p.ws + WS_CTL) + CW_BAR);
    const int lo = p.ph_lo, hi = p.ph_hi;
    unsigned long long ts0 = 0, ts1 = 0;
    if (TSTAMP_PHASE >= 0) ts0 = __builtin_amdgcn_s_memrealtime();
#ifndef PHMASK
#define PHMASK 0xFFFFFFFFu
#endif
#define IN(k) (lo <= (k) && (k) < hi && ((PHMASK >> (k)) & 1u))
#define SEAM(k) do { if (IN(k) && IN((k) + 1)) { if ((k) == 0) grid.sync(); else xcd_barrier((unsigned*)(p.ws + WS_CTL) + CW_BAR, (volatile LAS unsigned*)(smem + LDS_BYTES - 16)); } if ((k) == TSTAMP_PHASE) ts1 = __builtin_amdgcn_s_memrealtime(); } while (0)
    if (IN(PH_PREP)) for (int r = 0; r < REP_PREP; ++r) phase_prep(p, smem);
    SEAM(PH_PREP);
    if (IN(PH_PROJ)) { for (int r = 0; r < REP_PROJ; ++r) gemm_job<J_PROJ>(p, smem); for (int r = 0; r < REP_SMALL; ++r) gemm_job<J_MEMKV>(p, smem); }
    SEAM(PH_PROJ);
    if (IN(PH_CMP1)) { for (int r = 0; r < REP_SMALL; ++r) gemm_job<J_CMP1>(p, smem); for (int r = 0; r < REP_CONV; ++r) phase_conv(p, smem); }
    SEAM(PH_CMP1);
    if (IN(PH_CMP2)) for (int r = 0; r < REP_SMALL; ++r) gemm_job<J_CMP2>(p, smem);
    SEAM(PH_CMP2);
    if (IN(PH_NSA)) { conv_finish(p); for (int r = 0; r < REP_NSA; ++r) phase_nsa(p, smem, r); }
    SEAM(PH_NSA);
    if (IN(PH_OUT)) for (int r = 0; r < REP_OUT; ++r) gemm_lc<J_OUT>(p, smem);
    SEAM(PH_OUT);
    if (IN(PH_WQ)) { gemm_lc<J_WQ>(p, smem); for (int r = 1; r < REP_WQ; ++r) gemm_job<J_WQ, WQ_VAR>(p, smem); }
    SEAM(PH_WQ);
    if (IN(PH_XATTN)) for (int r = 0; r < REP_XATTN; ++r) phase_xattn(p, smem);
    SEAM(PH_XATTN);
    if (IN(PH_WO)) gemm_lc<J_WO>(p, smem);
    SEAM(PH_WO);
    if (IN(PH_ROUTER)) for (int r = 0; r < REP_SMALL; ++r) gemm_job<J_ROUTER>(p, smem);
    SEAM(PH_ROUTER);
    if (IN(PH_MOE1)) for (int r = 0; r < REP_MOE; ++r) gemm_lc_moe<J_MOE1>(p, smem);
    SEAM(PH_MOE1);
    if (IN(PH_MOE2)) for (int r = 0; r < REP_MOE; ++r) gemm_lc_moe<J_MOE2>(p, smem);
    SEAM(PH_MOE2);
    if (IN(PH_LN3)) phase_ln<2>(p);
    if (TSTAMP_PHASE >= 0 && blockIdx.x == 0 && threadIdx.x == 0) { const unsigned long long t2 = __builtin_amdgcn_s_memrealtime(); const unsigned long long wait = 4ull * (ts1 - ts0); while (__builtin_amdgcn_s_memrealtime() - t2 < wait) __builtin_amdgcn_s_sleep(32); }
#undef IN
#undef SEAM
}

#ifndef N_SPLIT
#define N_SPLIT 1
#endif

extern "C" void kernel_launch(void* const* d_in, const int* in_sizes, int n_in, void* d_out, int out_size, void* d_ws, size_t ws_size, hipStream_t stream) {
    static int grid_blocks = 0;
    if (grid_blocks == 0) {
        if (n_in != 35 || ws_size < WS_END || out_size != T_ * D_) { fprintf(stderr, "kernel_launch: unexpected sizes n_in %d ws %zu out %d\n", n_in, ws_size, out_size); grid_blocks = -1; return; }
        int dev = 0, cus = 0, per_cu = 0;
        hipGetDevice(&dev);
        hipDeviceGetAttribute(&cus, hipDeviceAttributeMultiprocessorCount, dev);
        hipFuncSetAttribute((const void*)fwd_megakernel, hipFuncAttributeMaxDynamicSharedMemorySize, LDS_BYTES);
        hipOccupancyMaxActiveBlocksPerMultiprocessor(&per_cu, (const void*)fwd_megakernel, NTHREADS, LDS_BYTES);
        if (per_cu < 1) { fprintf(stderr, "kernel_launch: occupancy query says %d blocks per CU\n", per_cu); grid_blocks = -1; return; }
        if (per_cu > 2) per_cu = 2;
        grid_blocks = cus * per_cu;
        fprintf(stderr, "kernel_launch: %d CUs x %d blocks\n", cus, per_cu);
    }
    if (grid_blocks < 0) return;
    hipMemsetAsync((char*)d_ws + WS_CTL, 0, 1 * MiB, stream);
    hipMemsetAsync((char*)d_ws + WS_RSUM1, 0, 1 * MiB, stream);
    Params p{};
    for (int i = 0; i < 35; ++i) p.in[i] = (const float*)d_in[i];
    p.out = (float*)d_out; p.ws = (unsigned char*)d_ws;
    if (N_SPLIT == 1) {
        p.ph_lo = 0; p.ph_hi = PH_COUNT;
        void* args[] = {&p};
        hipError_t e = hipLaunchCooperativeKernel((const void*)fwd_megakernel, dim3(grid_blocks), dim3(NTHREADS), args, LDS_BYTES, stream);
        if (e != hipSuccess) fprintf(stderr, "cooperative launch failed: %s (grid %d)\n", hipGetErrorString(e), grid_blocks);
    } else {
        for (int ph = 0; ph < PH_COUNT; ++ph) {
            p.ph_lo = ph; p.ph_hi = ph + 1;
            void* args[] = {&p};
            hipError_t e = hipLaunchCooperativeKernel((const void*)fwd_megakernel, dim3(grid_blocks), dim3(NTHREADS), args, LDS_BYTES, stream);
            if (e != hipSuccess) fprintf(stderr, "launch %d failed: %s\n", ph, hipGetErrorString(e));
        }
    }
}
```
